# Optimizing an MI355X kernel written in HIP

```python
import math
import jax, jax.numpy as jnp
from jax import lax
import numpy as np

D_MODEL = 1024
BATCH = 8
SEQ = 2048
DEPTH = 1

CTX_LEN = 256
GRID_W = 64
D_MIX = D_MODEL
S5_WIDTH = D_MIX // 2
S5_GROUP = 16
S5_GROUPS = S5_WIDTH // S5_GROUP
S5_STATE = 64
FOURIER_WIDTH = D_MIX - S5_WIDTH
FOURIER_GROUPS = 4
FOURIER_GROUP = FOURIER_WIDTH // FOURIER_GROUPS
PEER_HEADS = 8
PEER_KEYS = 128
PEER_EXPERTS = PEER_KEYS * PEER_KEYS
PEER_TOPK = 16
PEER_DKEY = 256
PEER_HALF = PEER_DKEY // 2
PEER_CHUNK = 128
N_MOD = 6
RMS_EPS = 1e-6
DT_MIN = 1e-3
DT_MAX = 1e-1
POS_BASE = 10000.0

kernel_name = 'hymba_s5_fnet_peer_dit_layer'


def rmsnorm(x, g):
    xf = x.astype(jnp.float32)
    inv = lax.rsqrt(jnp.mean(xf * xf, axis=-1, keepdims=True) + RMS_EPS)
    return (xf * inv).astype(x.dtype) * g


def modulate(h, shift, scale):
    return h * (1 + scale) + shift


def grid_pos_embed(rows, dim, dtype):
    quarter = dim // 4
    omega = 1.0 / (POS_BASE ** (jnp.arange(quarter, dtype=jnp.float32) / quarter))
    r = jnp.repeat(jnp.arange(rows, dtype=jnp.float32), GRID_W)[:, None] * omega
    col = jnp.tile(jnp.arange(GRID_W, dtype=jnp.float32), rows)[:, None] * omega
    emb = jnp.concatenate([jnp.sin(r), jnp.cos(r), jnp.sin(col), jnp.cos(col)], axis=-1)
    return emb.astype(dtype)


def _ssm_combine(e1, e2):
    a1r, a1i, b1r, b1i = e1
    a2r, a2i, b2r, b2i = e2
    return (a2r * a1r - a2i * a1i,
            a2r * a1i + a2i * a1r,
            a2r * b1r - a2i * b1i + b2r,
            a2r * b1i + a2i * b1r + b2i)


def s5_discretise(lam_re, lam_im, log_dt, b_re, b_im):
    dt = jnp.exp(log_dt.astype(jnp.float32))[:, None]
    lr = lam_re.astype(jnp.float32)
    li = lam_im.astype(jnp.float32)
    mag = jnp.exp(lr * dt)
    ar = mag * jnp.cos(li * dt)
    ai = mag * jnp.sin(li * dt)
    den = lr * lr + li * li
    cr = ((ar - 1.0) * lr + ai * li) / den
    ci = (ai * lr - (ar - 1.0) * li) / den
    bbr = cr[..., None] * b_re - ci[..., None] * b_im
    bbi = cr[..., None] * b_im + ci[..., None] * b_re
    return ar, ai, bbr, bbi


def s5_scan(u_t, disc, h0, reverse):
    ar, ai, bbr, bbi = disc
    bu_re = jnp.einsum('lbgp,gnp->lbgn', u_t, bbr)
    bu_im = jnp.einsum('lbgp,gnp->lbgn', u_t, bbi)
    h0_re, h0_im = h0
    first = u_t.shape[0] - 1 if reverse else 0
    bu_re = bu_re.at[first].add(ar * h0_re - ai * h0_im)
    bu_im = bu_im.at[first].add(ar * h0_im + ai * h0_re)
    a_shape = (u_t.shape[0], 1) + ar.shape
    a_re = jnp.broadcast_to(ar, a_shape)
    a_im = jnp.broadcast_to(ai, a_shape)
    _, _, s_re, s_im = lax.associative_scan(_ssm_combine, (a_re, a_im, bu_re, bu_im),
                                            reverse=reverse, axis=0)
    return s_re, s_im


def s5_states(u, h0s, lam_re, lam_im, log_dt, b_re, b_im):
    bsz, length, _ = u.shape
    u_t = jnp.moveaxis(u.astype(jnp.float32).reshape(bsz, length, S5_GROUPS, S5_GROUP), 1, 0)
    fwd = s5_scan(u_t, s5_discretise(lam_re[0], lam_im[0], log_dt[0], b_re[0], b_im[0]), h0s[0], False)
    bwd = s5_scan(u_t, s5_discretise(lam_re[1], lam_im[1], log_dt[1], b_re[1], b_im[1]), h0s[1], True)
    return fwd, bwd


def s5_final_states(states):
    fwd, bwd = states
    return (fwd[0][-1], fwd[1][-1]), (bwd[0][0], bwd[1][0])


def s5_readout(s_re, s_im, c_re, c_im):
    return jnp.einsum('lbgn,gpn->lbgp', s_re, c_re) - jnp.einsum('lbgn,gpn->lbgp', s_im, c_im)


def s5_output(u, states, c_re, c_im, d_skip, w_glu, b_glu):
    bsz, length, _ = u.shape
    (fr, fi), (br, bi) = states
    y_t = s5_readout(fr, fi, c_re[0], c_im[0]) + s5_readout(br, bi, c_re[1], c_im[1])
    y = jnp.moveaxis(y_t, 0, 1).reshape(bsz, length, S5_WIDTH) + d_skip * u.astype(jnp.float32)
    y = jax.nn.gelu(y)
    y = y * jax.nn.sigmoid(y @ w_glu + b_glu)
    return y.astype(u.dtype)


def fourier_branch(f, w_fourier):
    bsz, length, _ = f.shape
    fg = f.astype(jnp.float32).reshape(bsz, length, FOURIER_GROUPS, FOURIER_GROUP)
    mixed = jnp.fft.fft2(fg, axes=(1, 3), norm='ortho').real
    out = jnp.einsum('blgc,gcd->blgd', mixed, w_fourier)
    return out.reshape(bsz, length, FOURIER_WIDTH).astype(f.dtype)


def peer(h, w_q, sub_keys, u_tab, v_tab):
    bsz, length, dim = h.shape
    blocks = h.reshape(-1, PEER_CHUNK, dim)

    def block_fn(hc):
        q = (hc @ w_q).reshape(PEER_CHUNK, PEER_HEADS, 2, PEER_HALF)
        s = jnp.einsum('chsd,hskd->chsk', q, sub_keys).astype(jnp.float32)
        sv, si = lax.top_k(s, PEER_TOPK)
        cand = sv[:, :, 0, :, None] + sv[:, :, 1, None, :]
        best, flat = lax.top_k(cand.reshape(PEER_CHUNK, PEER_HEADS, PEER_TOPK * PEER_TOPK), PEER_TOPK)
        idx1 = jnp.take_along_axis(si[:, :, 0], flat // PEER_TOPK, axis=-1)
        idx2 = jnp.take_along_axis(si[:, :, 1], flat % PEER_TOPK, axis=-1)
        expert = idx1 * PEER_KEYS + idx2
        g = jax.nn.softmax(best, axis=-1)
        act = jax.nn.gelu(jnp.einsum('cd,chkd->chk', hc, u_tab[expert]))
        return jnp.einsum('chk,chkd->cd', (g * act).astype(hc.dtype), v_tab[expert])

    return lax.map(block_fn, blocks).reshape(bsz, length, dim)


def trunk_layer(x, ctx, c_act, cc_act, w_mod, b_mod, norm1_g, norm2_g, w_in, w_out,
                lam_re, lam_im, log_dt, b_re, b_im, c_re, c_im, d_skip, w_glu, b_glu,
                w_fourier, w_q, sub_keys, u_tab, v_tab, update_ctx):
    sh1, sc1, g1, sh2, sc2, g2 = jnp.split((c_act @ w_mod + b_mod)[:, None, :], N_MOD, axis=-1)
    csh1, csc1, cg1, csh2, csc2, cg2 = jnp.split(cc_act @ w_mod + b_mod, N_MOD, axis=-1)

    h = modulate(rmsnorm(x, norm1_g), sh1, sc1)
    hc = modulate(rmsnorm(ctx, norm1_g), csh1, csc1)
    z = h @ w_in
    u, f = z[..., :S5_WIDTH], z[..., S5_WIDTH:]
    zc = hc @ w_in if update_ctx else hc @ w_in[:, :S5_WIDTH]
    uc = zc[..., :S5_WIDTH]

    zero = jnp.zeros((ctx.shape[0], S5_GROUPS, S5_STATE), jnp.float32)
    ctx_states = s5_states(uc, ((zero, zero), (zero, zero)), lam_re, lam_im, log_dt, b_re, b_im)
    lat_states = s5_states(u, s5_final_states(ctx_states), lam_re, lam_im, log_dt, b_re, b_im)

    mix = jnp.concatenate([s5_output(u, lat_states, c_re, c_im, d_skip, w_glu, b_glu),
                           fourier_branch(f, w_fourier)], axis=-1) @ w_out
    x = x + g1 * mix
    x = x + g2 * peer(modulate(rmsnorm(x, norm2_g), sh2, sc2), w_q, sub_keys, u_tab, v_tab)

    if update_ctx:
        mix_c = jnp.concatenate([s5_output(uc, ctx_states, c_re, c_im, d_skip, w_glu, b_glu),
                                 fourier_branch(zc[..., S5_WIDTH:], w_fourier)], axis=-1) @ w_out
        ctx = ctx + cg1 * mix_c
        ctx = ctx + cg2 * peer(modulate(rmsnorm(ctx, norm2_g), csh2, csc2), w_q, sub_keys, u_tab, v_tab)
    return x, ctx


def setup_inputs(seed: int = 0) -> dict:
    key = jax.random.key(seed)
    ks = jax.random.split(key, 32)
    f32 = jnp.float32
    nrm = lambda k, shape, s: jax.random.normal(k, shape, f32) * s
    L, G, N, P = DEPTH, S5_GROUPS, S5_STATE, S5_GROUP
    lam_re = -0.5 + nrm(ks[16], (L, 2, G, N), 0.01)
    lam_im = math.pi * jnp.arange(N, dtype=f32) + nrm(ks[17], (L, 2, G, N), 0.01)
    log_dt = jax.random.uniform(ks[18], (L, 2, G), f32, math.log(DT_MIN), math.log(DT_MAX))
    return {
        'x': nrm(ks[0], (BATCH, SEQ, D_MODEL), 1.0),
        'c': nrm(ks[1], (BATCH, D_MODEL), 1.0),
        'ctx': nrm(ks[2], (BATCH, CTX_LEN, D_MODEL), 1.0),
        'c_ctx': nrm(ks[3], (D_MODEL,), 1.0),
        'w_mod': nrm(ks[4], (L, D_MODEL, N_MOD * D_MODEL), D_MODEL ** -0.5),
        'b_mod': nrm(ks[5], (L, N_MOD * D_MODEL), 0.01),
        'norm1_g': 1.0 + nrm(ks[6], (L, D_MODEL), 0.05),
        'norm2_g': 1.0 + nrm(ks[7], (L, D_MODEL), 0.05),
        'w_in': nrm(ks[8], (L, D_MODEL, D_MIX), D_MODEL ** -0.5),
        'w_out': nrm(ks[9], (L, D_MIX, D_MODEL), D_MIX ** -0.5),
        's5_lam_re': lam_re,
        's5_lam_im': lam_im,
        's5_log_dt': log_dt,
        's5_b_re': nrm(ks[10], (L, 2, G, N, P), (2 * P) ** -0.5),
        's5_b_im': nrm(ks[11], (L, 2, G, N, P), (2 * P) ** -0.5),
        's5_c_re': nrm(ks[12], (L, 2, G, P, N), N ** -0.5),
        's5_c_im': nrm(ks[13], (L, 2, G, P, N), N ** -0.5),
        's5_d': nrm(ks[14], (L, S5_WIDTH), 1.0),
        'w_glu': nrm(ks[15], (L, S5_WIDTH, S5_WIDTH), S5_WIDTH ** -0.5),
        'b_glu': nrm(ks[19], (L, S5_WIDTH), 0.01),
        'w_fourier': nrm(ks[20], (L, FOURIER_GROUPS, FOURIER_GROUP, FOURIER_GROUP), FOURIER_GROUP ** -0.5),
        'peer_w_q': nrm(ks[21], (L, D_MODEL, PEER_HEADS * PEER_DKEY), D_MODEL ** -0.5),
        'peer_sub_keys': nrm(ks[22], (L, PEER_HEADS, 2, PEER_KEYS, PEER_HALF), PEER_HALF ** -0.5),
        'peer_u': nrm(ks[23], (L, PEER_EXPERTS, D_MODEL), D_MODEL ** -0.5),
        'peer_v': nrm(ks[24], (L, PEER_EXPERTS, D_MODEL), 1.0),
        'final_g': 1.0 + nrm(ks[25], (D_MODEL,), 0.05),
    }


def reference(x, c, ctx, c_ctx, w_mod, b_mod, norm1_g, norm2_g, w_in, w_out,
              s5_lam_re, s5_lam_im, s5_log_dt, s5_b_re, s5_b_im, s5_c_re, s5_c_im, s5_d,
              w_glu, b_glu, w_fourier, peer_w_q, peer_sub_keys, peer_u, peer_v, final_g):
    rows = x.shape[1] // GRID_W
    x = x + grid_pos_embed(rows, D_MODEL, x.dtype)[None]
    c_act = jax.nn.silu(c)
    cc_act = jax.nn.silu(c_ctx)
    for l in range(DEPTH):
        x, ctx = trunk_layer(x, ctx, c_act, cc_act, w_mod[l], b_mod[l], norm1_g[l], norm2_g[l],
                             w_in[l], w_out[l], s5_lam_re[l], s5_lam_im[l], s5_log_dt[l],
                             s5_b_re[l], s5_b_im[l], s5_c_re[l], s5_c_im[l], s5_d[l],
                             w_glu[l], b_glu[l], w_fourier[l], peer_w_q[l], peer_sub_keys[l],
                             peer_u[l], peer_v[l], update_ctx=(l < DEPTH - 1))
    return rmsnorm(x, final_g)
```

```cpp
#define REPMASK 0
#define P0REP 0
#include <hip/hip_runtime.h>
#include <hip/hip_cooperative_groups.h>
#include <stdint.h>
#include <math.h>
namespace cg = cooperative_groups;

#define DM 1024
#define NB 8
#define SEQ 2048
#define CTXL 256
#define NTOK (NB * SEQ)
#define NCTX (NB * CTXL)
#define NMOD 6144
#define MiB (1024ull * 1024ull)
#define LAS __attribute__((address_space(3)))
typedef unsigned short bf16_t;
typedef short bf16x8 __attribute__((ext_vector_type(8)));
typedef float f32x4 __attribute__((ext_vector_type(4)));
typedef float f32x2 __attribute__((ext_vector_type(2)));
typedef unsigned u32x4 __attribute__((ext_vector_type(4)));
typedef unsigned u32x2 __attribute__((ext_vector_type(2)));

__device__ __forceinline__ float gelu_tanh(float x) {
    const float c = 0.7978845608028654f;
    return 0.5f * x * (1.0f + tanhf(c * (x + 0.044715f * x * x * x)));
}
__device__ __forceinline__ float sigmoidf_(float x) { return 1.0f / (1.0f + expf(-x)); }
__device__ __forceinline__ float silu_(float x) { return x * sigmoidf_(x); }
__device__ __forceinline__ float wave_sum(float v) {
#pragma unroll
    for (int o = 32; o > 0; o >>= 1) v += __shfl_xor(v, o);
    return v;
}
__device__ __forceinline__ unsigned cvt_pk_bf16(float lo, float hi) { unsigned r; asm volatile("v_cvt_pk_bf16_f32 %0, %1, %2" : "=v"(r) : "v"(lo), "v"(hi)); return r; }
__device__ __forceinline__ float bf2f(bf16_t v) { return __uint_as_float(((unsigned)v) << 16); }
__device__ __forceinline__ float bflo(unsigned w) { return __uint_as_float(w << 16); }
__device__ __forceinline__ float bfhi(unsigned w) { return __uint_as_float(w & 0xffff0000u); }
#define XB_TMO      128
#define XB_XCNT(j)  (256  + 64 * (j))
#define XB_XSUB(j)  (1280 + 64 * (j))
#define XB_XGEN(j)  (2304 + 64 * (j))
#define XB_TOP      3328
#define XB_TOPGEN   3392
#define XCD_BAR_WORDS 3456
#define XB_SPIN_CAP (1u << 18)
__device__ __forceinline__ unsigned xb_ld(unsigned* p)              { return __hip_atomic_load(p, __ATOMIC_RELAXED, __HIP_MEMORY_SCOPE_AGENT); }
__device__ __forceinline__ unsigned xb_add(unsigned* p, unsigned v) { return __hip_atomic_fetch_add(p, v, __ATOMIC_RELAXED, __HIP_MEMORY_SCOPE_AGENT); }
__device__ __forceinline__ unsigned xb_xcc_id() { return (unsigned)__builtin_amdgcn_s_getreg((3 << 11) | 20) & 0xFu; }
#define XB_SPIN(cond, bar) do { unsigned _sp = 0; while (cond) { __builtin_amdgcn_s_sleep(1); \
    if ((++_sp & 255u) == 0u) { if (xb_ld(&(bar)[XB_TMO])) break; if (_sp > XB_SPIN_CAP) { atomicAdd(&(bar)[XB_TMO], 1u); break; } } } } while (0)
struct XcdBarrier { unsigned* bar; unsigned x; volatile LAS unsigned* st; };
__device__ __forceinline__ XcdBarrier xcd_barrier_post(unsigned* bar, volatile LAS unsigned* st) {
    XcdBarrier b; b.bar = bar; b.x = xb_xcc_id(); b.st = st;
    if (threadIdx.x == 0) (void)xb_add(&bar[XB_XCNT(b.x)], 1u);
    return b;
}
__device__ __forceinline__ void xcd_barrier_complete(unsigned* bar, unsigned x, unsigned& nloc, unsigned& nx) {
    const unsigned G = gridDim.x * gridDim.y * gridDim.z;
    unsigned sum, cnt, mine, sp = 0u;
    for (;;) {
        sum = 0u; cnt = 0u; mine = 0u;
#pragma unroll
        for (unsigned j = 0; j < 16; ++j) { const unsigned c = xb_ld(&bar[XB_XCNT(j)]); sum += c; cnt += (c > 0u) ? 1u : 0u; mine = (j == x) ? c : mine; }
        if (sum == G) break;
        __builtin_amdgcn_s_sleep(1);
        if ((++sp & 255u) == 0u) { if (xb_ld(&bar[XB_TMO])) break; if (sp > XB_SPIN_CAP) { atomicAdd(&bar[XB_TMO], 1u); break; } }
    }
    nloc = mine > 0u ? mine : 1u; nx = cnt > 0u ? cnt : 1u;
}
__device__ __forceinline__ void xcd_barrier(const XcdBarrier& b) {
    asm volatile("s_waitcnt vmcnt(0)" ::: "memory");
    __syncthreads();
    if (threadIdx.x == 0) {
        unsigned* bar = b.bar;
        __builtin_amdgcn_s_waitcnt(0);
        unsigned nloc = b.st[0], nx = b.st[1];
        if (nloc == 0u) { xcd_barrier_complete(bar, b.x, nloc, nx); b.st[0] = nloc; b.st[1] = nx; }
        const unsigned old = xb_add(&bar[XB_XSUB(b.x)], 1u);
        const unsigned gen = old / nloc;
        if (old + 1u == (gen + 1u) * nloc) {
            __builtin_amdgcn_fence(__ATOMIC_RELEASE, "agent");
            asm volatile("s_waitcnt vmcnt(0)" ::: "memory");
            const unsigned og = xb_add(&bar[XB_TOP], 1u);
            const unsigned tg = og / nx;
            if (og + 1u == (tg + 1u) * nx) xb_add(&bar[XB_TOPGEN], 1u);
            else XB_SPIN(xb_ld(&bar[XB_TOPGEN]) == tg, bar);
            __builtin_amdgcn_fence(__ATOMIC_ACQUIRE, "agent");
            xb_add(&bar[XB_XGEN(b.x)], 1u);
            asm volatile("s_waitcnt vmcnt(0)" ::: "memory");
        } else {
            XB_SPIN(xb_ld(&bar[XB_XGEN(b.x)]) == gen, bar);
            __builtin_amdgcn_fence(__ATOMIC_ACQUIRE, "agent");
            asm volatile("s_waitcnt vmcnt(0)" ::: "memory");
        }
    }
    __syncthreads();
}
namespace pg8 {
constexpr int BM = 256, BK = 64, HALF = 128, HTB = HALF * BK * 2, STAGE_BYTES = 8 * HTB;
__device__ __forceinline__ int lds_byte(int r, int c) { const int st = (r >> 4) * 2 + (c >> 5), rr = r & 15, cc = c & 31, ob = rr * 64 + cc * 2; return st * 1024 + (ob ^ (((ob >> 9) & 1) << 5)); }
__device__ __forceinline__ void stage_rc(int b, int& R, int& C) { const int st = b / 1024, sb = b % 1024, swz = sb ^ (((sb >> 9) & 1) << 5); R = (st >> 1) * 16 + swz / 64; C = (st & 1) * 32 + (swz % 64) / 2; }
__device__ __forceinline__ int perm32(int rho) { const int n = rho >> 4, i = rho & 15; return 8 * (i >> 2) + 4 * n + (i & 3); }
struct Unit { const char* a; const char* b; int pm, pn, z; };
struct Gemm { int lda, ldb, K; };
template <class Epi>
__device__ __forceinline__ void gemm_unit(LAS unsigned char* lds, const Gemm g, const Unit cur, const Epi& E) {
    const int tid = threadIdx.x, wid = __builtin_amdgcn_readfirstlane(tid >> 6), lane = tid & 63, wr = wid >> 2, wc = wid & 3, fr = lane & 15, fq = lane >> 4;
    const int K = g.K, nt = K / BK;
    unsigned voffA[2], voffB[2];
#pragma unroll
    for (int i = 0; i < 2; ++i) { int R, C; stage_rc(tid * 16 + i * 8192, R, C); const int Rb = Epi::PERM ? ((R & ~31) + perm32(R & 31)) : R;
        voffA[i] = (unsigned)(R * g.lda + C) * 2u; voffB[i] = (unsigned)(Rb * g.ldb + C) * 2u; }
    const size_t kstep = (size_t)(BK * 2);
    const size_t hstepA = (size_t)HALF * g.lda * 2, hstepB = (size_t)HALF * g.ldb * 2;
    const unsigned ldsw = (unsigned)wid * 1024u;
    const int aoff = lds_byte(wr * 64 + fr, fq * 8), boff = lds_byte(wc * 32 + fr, fq * 8);
#define PG8_SA(b, h) (((b) * 2 + (h)) * HTB)
#define PG8_SB(b, h) ((4 + (b) * 2 + (h)) * HTB)
#define PG8_STAGE(bufoff, gbase, voff) do { _Pragma("unroll") for (int _i = 0; _i < 2; ++_i) \
        __builtin_amdgcn_global_load_lds((const unsigned*)((const char*)(gbase) + (voff)[_i]), (LAS unsigned*)(lds + (bufoff) + ldsw + _i * 8192), 16, 0, 0); } while (0)
#define PG8_LDA(dst, b, h) do { _Pragma("unroll") for (int m = 0; m < 4; ++m) _Pragma("unroll") for (int k = 0; k < 2; ++k) dst[m][k] = *(const LAS bf16x8*)(lds + PG8_SA(b, h) + aoff + m * 2048 + k * 1024); } while (0)
#define PG8_LDB(dst, b, h) do { _Pragma("unroll") for (int n = 0; n < 2; ++n) _Pragma("unroll") for (int k = 0; k < 2; ++k) dst[n][k] = *(const LAS bf16x8*)(lds + PG8_SB(b, h) + boff + n * 2048 + k * 1024); } while (0)
#define PG8_MMA(ai, bj, At, Bt) do { __builtin_amdgcn_s_setprio(1); _Pragma("unroll") for (int m = 0; m < 4; ++m) _Pragma("unroll") for (int n = 0; n < 2; ++n) _Pragma("unroll") for (int k = 0; k < 2; ++k) \
        acc[ai][bj][m][n] = __builtin_amdgcn_mfma_f32_16x16x32_bf16(Bt[n][k], At[m][k], acc[ai][bj][m][n], 0, 0, 0); __builtin_amdgcn_s_setprio(0); } while (0)
#define PG8_WAIT_V(n) asm volatile("s_waitcnt vmcnt(" #n ")" ::: "memory")
#define PG8_WAIT_L(n) asm volatile("s_waitcnt lgkmcnt(" #n ")" ::: "memory")
#define PG8_BAR __builtin_amdgcn_s_barrier()
#define PG8_SCHED __builtin_amdgcn_sched_barrier(0)
    f32x4 acc[2][2][4][2];
#pragma unroll
    for (int a = 0; a < 2; ++a)
#pragma unroll
        for (int b = 0; b < 2; ++b)
#pragma unroll
            for (int m = 0; m < 4; ++m)
#pragma unroll
                for (int n = 0; n < 2; ++n) acc[a][b][m][n] = (f32x4){0.f, 0.f, 0.f, 0.f};
    bf16x8 At[4][2], B0[2][2], B1[2][2];
    const char* cA = cur.a; const char* cB = cur.b;
    PG8_STAGE(PG8_SB(0, 0), cB, voffB); PG8_STAGE(PG8_SA(0, 0), cA, voffA); PG8_STAGE(PG8_SB(0, 1), cB + hstepB, voffB); PG8_STAGE(PG8_SA(0, 1), cA + hstepA, voffA);
    if (wr == 1) PG8_BAR;
    PG8_WAIT_V(4); PG8_BAR;
    PG8_STAGE(PG8_SB(1, 0), cB + kstep, voffB); PG8_STAGE(PG8_SA(1, 0), cA + kstep, voffA); PG8_STAGE(PG8_SB(1, 1), cB + hstepB + kstep, voffB);
    PG8_WAIT_V(6); PG8_BAR;
    for (int t = 0; t < nt; t += 2) {
        const bool last = (t == nt - 2);
        const char* a1 = cA + (size_t)(t + 1) * kstep;
        const char* a2 = last ? cA : cA + (size_t)(t + 2) * kstep; const char* b2 = last ? cB : cB + (size_t)(t + 2) * kstep;
        const char* a3 = a2 + kstep; const char* b3 = b2 + kstep;
        PG8_LDB(B0, 0, 0); PG8_SCHED; PG8_LDA(At, 0, 0); PG8_STAGE(PG8_SA(1, 1), a1 + hstepA, voffA);
        PG8_WAIT_L(8); PG8_BAR; PG8_WAIT_L(0); PG8_MMA(0, 0, At, B0); PG8_BAR; PG8_SCHED;
        PG8_LDB(B1, 0, 1); PG8_STAGE(PG8_SB(0, 0), b2, voffB);
        PG8_BAR; PG8_WAIT_L(0); PG8_MMA(0, 1, At, B1); PG8_BAR;
        PG8_LDA(At, 0, 1); PG8_STAGE(PG8_SA(0, 0), a2, voffA);
        PG8_BAR; PG8_WAIT_L(0); PG8_MMA(1, 0, At, B0); PG8_BAR; PG8_SCHED;
        PG8_STAGE(PG8_SB(0, 1), b2 + hstepB, voffB);
        PG8_WAIT_V(6); PG8_BAR; PG8_MMA(1, 1, At, B1); PG8_BAR;
        PG8_LDB(B0, 1, 0); PG8_SCHED; PG8_LDA(At, 1, 0); PG8_STAGE(PG8_SA(0, 1), a2 + hstepA, voffA);
        PG8_WAIT_L(8); PG8_BAR; PG8_WAIT_L(0); PG8_MMA(0, 0, At, B0); PG8_BAR; PG8_SCHED;
        PG8_LDB(B1, 1, 1); PG8_STAGE(PG8_SB(1, 0), b3, voffB);
        PG8_BAR; PG8_WAIT_L(0); PG8_MMA(0, 1, At, B1); PG8_BAR;
        PG8_LDA(At, 1, 1); PG8_STAGE(PG8_SA(1, 0), a3, voffA);
        PG8_BAR; PG8_WAIT_L(0); PG8_MMA(1, 0, At, B0); PG8_BAR; PG8_SCHED;
        PG8_STAGE(PG8_SB(1, 1), b3 + hstepB, voffB);
        PG8_WAIT_V(6); PG8_BAR; PG8_MMA(1, 1, At, B1); PG8_BAR;
    }
    if constexpr (!Epi::AFTER_DRAIN) { E(acc, cur, wr, wc, fr, fq); }
    PG8_WAIT_V(0);
    if (wr == 0) PG8_BAR;
    PG8_BAR;
    if constexpr (Epi::AFTER_DRAIN) { E.fused(acc, cur, wr, wc, fr, fq, lds, wid, lane); }
#undef PG8_SA
#undef PG8_SB
#undef PG8_STAGE
#undef PG8_LDA
#undef PG8_LDB
#undef PG8_MMA
#undef PG8_WAIT_V
#undef PG8_WAIT_L
#undef PG8_BAR
#undef PG8_SCHED
}
}
constexpr size_t WS_W1T = 0 * MiB;
constexpr size_t WS_WGLUT = 2 * MiB;
constexpr size_t WS_WOUTT = 3 * MiB;
constexpr size_t WS_WST = 5 * MiB;
constexpr size_t WS_WCST = 9 * MiB;
constexpr size_t WS_CS = 10 * MiB;
constexpr size_t WS_WENDT = 26 * MiB;
constexpr size_t WS_MAPT = 34 * MiB;
constexpr size_t WS_KTAB = 59 * MiB;
constexpr size_t WS_XB = 68 * MiB;
constexpr size_t WS_HCB = 100 * MiB;
constexpr size_t WS_AEXT = 108 * MiB;
constexpr size_t WS_FB = 144 * MiB;
constexpr size_t WS_GT = 160 * MiB;
constexpr size_t WS_CSPART = 176 * MiB;
constexpr size_t WS_E = 192 * MiB;
constexpr size_t WS_MISC = 250 * MiB;
constexpr size_t MISC_MOD = 0, MISC_POS = 256 * 1024, MISC_BIAS = 512 * 1024, MISC_BAR = 640 * 1024, MISC_EC = 704 * 1024, MISC_O1024 = 720 * 1024;

struct Params {
    const float *x, *c, *ctx, *c_ctx, *w_mod, *b_mod, *norm1_g, *norm2_g, *w_in, *w_out, *lam_re, *lam_im, *log_dt, *b_re, *b_im, *c_re, *c_im, *s5_d,
        *w_glu, *b_glu, *w_fourier, *w_q, *sub_keys, *u_tab, *v_tab, *final_g;
    float* out; unsigned char* ws; int ph_lo, ph_hi;
};
constexpr int LDS_BYTES = 147456;

__device__ __forceinline__ void p0_mod_item(const Params& P, LAS float* L, int item) {
    const int tid = threadIdx.x, w = tid >> 6, l = tid & 63;
    LAS float* act = L; LAS float* red = L + 9 * 1024;
    for (int idx = tid; idx < 9 * 1024; idx += 512) { int r = idx >> 10, k = idx & 1023; float v = (r < 8) ? P.c[r * 1024 + k] : P.c_ctx[k]; act[idx] = silu_(v); }
    __syncthreads();
    const int j = item * 64 + l;
    float acc[9];
#pragma unroll
    for (int r = 0; r < 9; ++r) acc[r] = 0.f;
    for (int k0 = w * 128; k0 < w * 128 + 128; k0 += 16) {
        float wv[16];
#pragma unroll
        for (int i = 0; i < 16; ++i) wv[i] = P.w_mod[(size_t)(k0 + i) * NMOD + j];
#pragma unroll
        for (int i = 0; i < 16; ++i)
#pragma unroll
            for (int r = 0; r < 9; ++r) acc[r] += act[r * 1024 + k0 + i] * wv[i];
    }
#pragma unroll
    for (int r = 0; r < 9; ++r) red[(w * 9 + r) * 64 + l] = acc[r];
    __syncthreads();
    float* mod = (float*)(P.ws + WS_MISC + MISC_MOD);
    for (int idx = tid; idx < 9 * 64; idx += 512) {
        int r = idx >> 6, l2 = idx & 63; float s = 0.f;
#pragma unroll
        for (int ww = 0; ww < 8; ++ww) s += red[(ww * 9 + r) * 64 + l2];
        mod[r * NMOD + item * 64 + l2] = s + P.b_mod[item * 64 + l2];
    }
}
__device__ __forceinline__ void p0_transpose_item(const float* src, int K, int N, bf16_t* dst, LAS float* L, int item) {
    const int tid = threadIdx.x; const int ntn = N / 64; const int k0 = (item / ntn) * 64, n0 = (item % ntn) * 64;
#pragma unroll
    for (int pass = 0; pass < 2; ++pass) {
        int kk = (tid >> 4) + 32 * pass, c4 = (tid & 15) * 4;
        f32x4 v = *(const f32x4*)(src + (size_t)(k0 + kk) * N + n0 + c4);
        L[kk * 65 + c4 + 0] = v.x; L[kk * 65 + c4 + 1] = v.y; L[kk * 65 + c4 + 2] = v.z; L[kk * 65 + c4 + 3] = v.w;
    }
    __syncthreads();
    const int n = tid >> 3, k8 = (tid & 7) * 8;
    u32x4 o;
    o.x = cvt_pk_bf16(L[(k8 + 0) * 65 + n], L[(k8 + 1) * 65 + n]); o.y = cvt_pk_bf16(L[(k8 + 2) * 65 + n], L[(k8 + 3) * 65 + n]);
    o.z = cvt_pk_bf16(L[(k8 + 4) * 65 + n], L[(k8 + 5) * 65 + n]); o.w = cvt_pk_bf16(L[(k8 + 6) * 65 + n], L[(k8 + 7) * 65 + n]);
    *(u32x4*)(dst + (size_t)(n0 + n) * K + k0 + k8) = o;
}
__device__ __forceinline__ void p0_ws_item(const Params& P, LAS float* L, int item) {
    const int tid = threadIdx.x; const int hs = item >> 4, k0 = (item & 15) * 64;
    LAS float* keysT = L;
    LAS float* wqT = L + 128 * 132;
    {
        f32x4 kv[8];
#pragma unroll
        for (int i = 0; i < 8; ++i) kv[i] = *(const f32x4*)(P.sub_keys + (size_t)hs * 16384 + (tid + 512 * i) * 4);
        f32x4 wv[4];
#pragma unroll
        for (int i = 0; i < 4; ++i) { const int idx = tid + 512 * i; const int kk = idx >> 5, d4 = (idx & 31) * 4; wv[i] = *(const f32x4*)(P.w_q + (size_t)(k0 + kk) * 2048 + hs * 128 + d4); }
#pragma unroll
        for (int i = 0; i < 8; ++i) { const int idx = (tid + 512 * i) * 4; const int key = idx >> 7, d = idx & 127;
            keysT[(d + 0) * 132 + key] = kv[i].x; keysT[(d + 1) * 132 + key] = kv[i].y; keysT[(d + 2) * 132 + key] = kv[i].z; keysT[(d + 3) * 132 + key] = kv[i].w; }
#pragma unroll
        for (int i = 0; i < 4; ++i) { const int idx = tid + 512 * i; const int kk = idx >> 5, d4 = (idx & 31) * 4;
            wqT[(d4 + 0) * 68 + kk] = wv[i].x; wqT[(d4 + 1) * 68 + kk] = wv[i].y; wqT[(d4 + 2) * 68 + kk] = wv[i].z; wqT[(d4 + 3) * 68 + kk] = wv[i].w; }
    }
    __syncthreads();
    const int kq = (tid & 31) * 4, kg = (tid >> 5) * 4;
    f32x4 acc[4];
#pragma unroll
    for (int i = 0; i < 4; ++i) acc[i] = (f32x4){0.f, 0.f, 0.f, 0.f};
#pragma unroll 4
    for (int d = 0; d < 128; ++d) {
        const f32x4 kv = *(const LAS f32x4*)(keysT + d * 132 + kq), wv = *(const LAS f32x4*)(wqT + d * 68 + kg);
        acc[0] = acc[0] + wv * kv.x; acc[1] = acc[1] + wv * kv.y; acc[2] = acc[2] + wv * kv.z; acc[3] = acc[3] + wv * kv.w;
    }
    bf16_t* dst = (bf16_t*)(P.ws + WS_WST) + (size_t)(hs * 128 + kq) * 1024 + k0 + kg;
#pragma unroll
    for (int i = 0; i < 4; ++i) { u32x2 o; o.x = cvt_pk_bf16(acc[i].x, acc[i].y); o.y = cvt_pk_bf16(acc[i].z, acc[i].w); *(u32x2*)(dst + (size_t)i * 1024) = o; }
}
__device__ __forceinline__ void p0_wcs_item(const Params& P, LAS float* L, int item) {
    const int tid = threadIdx.x; const int cs = item >> 2, g = item & 3;
    LAS float* wfL = L; LAS float* tab = L + 16384;
    for (int idx = tid; idx < 16384; idx += 512) wfL[idx] = P.w_fourier[(size_t)g * 16384 + idx];
    if (tid < 128) { float a = (float)tid / 64.0f; tab[tid] = cs ? -sinpif(a) : cospif(a); }
    __syncthreads();
    const int d = tid & 127, cgp = tid >> 7;
    float acc[32];
#pragma unroll
    for (int i = 0; i < 32; ++i) acc[i] = 0.f;
    for (int m = 0; m < 128; ++m) {
        float wv = wfL[m * 128 + d];
#pragma unroll
        for (int i = 0; i < 32; ++i) acc[i] += tab[((cgp * 32 + i) * m) & 127] * wv;
    }
    const float alpha = 1.0f / sqrtf(2048.0f * 128.0f);
    bf16_t* row = (bf16_t*)(P.ws + WS_WCST) + (size_t)(cs * 512 + g * 128 + d) * 512;
#pragma unroll
    for (int g2 = 0; g2 < 4; ++g2)
#pragma unroll
        for (int ch = 0; ch < 4; ++ch) {
            u32x4 o = (u32x4){0u, 0u, 0u, 0u};
            if (g2 == g) {
                o.x = cvt_pk_bf16(acc[ch * 8 + 0] * alpha, acc[ch * 8 + 1] * alpha); o.y = cvt_pk_bf16(acc[ch * 8 + 2] * alpha, acc[ch * 8 + 3] * alpha);
                o.z = cvt_pk_bf16(acc[ch * 8 + 4] * alpha, acc[ch * 8 + 5] * alpha); o.w = cvt_pk_bf16(acc[ch * 8 + 6] * alpha, acc[ch * 8 + 7] * alpha);
            }
            *(u32x4*)(row + g2 * 128 + cgp * 32 + ch * 8) = o;
        }
}
__device__ __forceinline__ void p0_s5_item(const Params& P, LAS float* L, int item) {
    const int tid = threadIdx.x; const int g = item >> 3, dir = (item >> 2) & 1, qd = item & 3;
    LAS float* Pr = L; LAS float* Pi = L + 33 * 64; LAS float* Bbr = L + 2 * 33 * 64; LAS float* Bbi = Bbr + 1024; LAS float* Cr = Bbi + 1024; LAS float* Ci = Cr + 1024;
    const int dg = dir * 32 + g;
    const float dt = expf(P.log_dt[dg]);
    if (tid < 64) {
        const int n = tid; const int i = dg * 64 + n;
        float lr = P.lam_re[i], li = P.lam_im[i];
        float mag = expf(lr * dt); float ar = mag * cosf(li * dt), ai = mag * sinf(li * dt);
        float den = lr * lr + li * li;
        float cr = ((ar - 1.0f) * lr + ai * li) / den, ci = (ai * lr - (ar - 1.0f) * li) / den;
        for (int q = 0; q < 16; ++q) {
            float br = P.b_re[(size_t)i * 16 + q], bi = P.b_im[(size_t)i * 16 + q];
            Bbr[n * 16 + q] = cr * br - ci * bi; Bbi[n * 16 + q] = cr * bi + ci * br;
        }
    }
    for (int idx = tid; idx < 33 * 64; idx += 512) {
        int tau = idx >> 6, n = idx & 63; const int i = dg * 64 + n;
        float lr = P.lam_re[i], li = P.lam_im[i];
        float mag = expf((float)tau * lr * dt), ang = (float)tau * (li * dt);
        Pr[idx] = mag * cosf(ang); Pi[idx] = mag * sinf(ang);
    }
    for (int idx = tid; idx < 1024; idx += 512) { Cr[idx] = P.c_re[(size_t)dg * 1024 + idx]; Ci[idx] = P.c_im[(size_t)dg * 1024 + idx]; }
    __syncthreads();
    {
        const int pq = tid & 255, p = pq >> 4, q = pq & 15, tau0 = qd * 8 + (tid >> 8) * 4;
        float s[4] = {0.f, 0.f, 0.f, 0.f};
#pragma unroll 4
        for (int n = 0; n < 64; ++n) {
            const float cr = Cr[p * 64 + n], ci = Ci[p * 64 + n], br = Bbr[n * 16 + q], bi = Bbi[n * 16 + q];
            const float xr = cr * br - ci * bi, xi = cr * bi + ci * br;
#pragma unroll
            for (int j = 0; j < 4; ++j) s[j] += xr * Pr[(tau0 + j) * 64 + n] - xi * Pi[(tau0 + j) * 64 + n];
        }
        float* Kt = (float*)(P.ws + WS_KTAB) + (size_t)(g * 2 + dir) * 32 * 256;
#pragma unroll
        for (int j = 0; j < 4; ++j) Kt[(tau0 + j) * 256 + pq] = s[j];
    }
    {
        bf16_t* W = (bf16_t*)(P.ws + WS_WENDT) + (size_t)(g * 256 + dir * 128 + qd * 32) * 512;
        for (int idx = tid; idx < 32 * 512 / 2; idx += 512) {
            const int row = idx >> 8, col = (idx & 255) * 2; const int n = qd * 16 + (row >> 1), ri = row & 1, s = col >> 4, q = col & 15;
            const int tau = dir ? s : (31 - s);
            const float pr = Pr[tau * 64 + n], pi = Pi[tau * 64 + n];
            const float br0 = Bbr[n * 16 + q], bi0 = Bbi[n * 16 + q], br1 = Bbr[n * 16 + q + 1], bi1 = Bbi[n * 16 + q + 1];
            const float v0 = ri ? (pr * bi0 + pi * br0) : (pr * br0 - pi * bi0), v1 = ri ? (pr * bi1 + pi * br1) : (pr * br1 - pi * bi1);
            *(unsigned*)(W + (size_t)row * 512 + col) = cvt_pk_bf16(v0, v1);
        }
    }
    {
        bf16_t* Mp = (bf16_t*)(P.ws + WS_MAPT) + ((size_t)g * 512 + qd * 128) * 768 + 512 + dir * 128;
        for (int idx = tid; idx < 128 * 64; idx += 512) {
            const int row = idx >> 6, n = idx & 63; const int t = qd * 8 + (row >> 4), p = row & 15;
            const int tau = dir ? (32 - t) : (t + 1);
            const float cr = Cr[p * 64 + n], ci = Ci[p * 64 + n], pr = Pr[tau * 64 + n], pi = Pi[tau * 64 + n];
            *(unsigned*)(Mp + (size_t)row * 768 + n * 2) = cvt_pk_bf16(cr * pr - ci * pi, -(cr * pi + ci * pr));
        }
    }
}
__device__ __forceinline__ void p0_pos_item(const Params& P) {
    float* postab = (float*)(P.ws + WS_MISC + MISC_POS);
    for (int idx = threadIdx.x; idx < 96 * 512; idx += 512) {
        int row = idx >> 9, j = idx & 511, jj = j & 255;
        float omega = 1.0f / powf(10000.0f, (float)jj / 256.0f);
        float p = (float)(row < 32 ? row : row - 32);
        float a = p * omega;
        postab[idx] = (j < 256) ? sinf(a) : cosf(a);
    }
}
__device__ __forceinline__ void tables_to_fp8(const Params& P, int wgi, int nwg);
constexpr int P0_MOD = 96, P0_TW1 = 256, P0_TGLU = 64, P0_TOUT = 256, P0_WS = 256, P0_WCS = 8, P0_S5 = 256, P0_POS = 1;
constexpr int P0_NITEMS = P0_MOD + P0_TW1 + P0_TGLU + P0_TOUT + P0_WS + P0_WCS + P0_S5 + P0_POS;
__device__ __forceinline__ void phase0(const Params& P, LAS unsigned char* lds) {
    LAS float* L = (LAS float*)lds;
    for (int it = blockIdx.x; it < P0_NITEMS; it += gridDim.x) {
        __syncthreads();
        int r = it;
        if (r < P0_S5) { p0_s5_item(P, L, r); continue; } r -= P0_S5;
        if (r < P0_WS) { p0_ws_item(P, L, r); continue; } r -= P0_WS;
        if (r < P0_MOD) { p0_mod_item(P, L, r); continue; } r -= P0_MOD;
        if (r < P0_TW1) { p0_transpose_item(P.w_in, 1024, 1024, (bf16_t*)(P.ws + WS_W1T), L, r); continue; } r -= P0_TW1;
        if (r < P0_TOUT) { p0_transpose_item(P.w_out, 1024, 1024, (bf16_t*)(P.ws + WS_WOUTT), L, r); continue; } r -= P0_TOUT;
        if (r < P0_TGLU) { p0_transpose_item(P.w_glu, 512, 512, (bf16_t*)(P.ws + WS_WGLUT), L, r); continue; } r -= P0_TGLU;
        if (r < P0_WCS) { p0_wcs_item(P, L, r); continue; } r -= P0_WCS;
        p0_pos_item(P);
    }
    __syncthreads();
    for (int i = threadIdx.x; i < 2048; i += 512) L[i] = cospif((float)i / 1024.0f);
    __syncthreads();
    bf16_t* CS = (bf16_t*)(P.ws + WS_CS);
    for (int i8 = blockIdx.x * 512 + threadIdx.x; i8 < 2 * 1024 * 1024 / 8; i8 += gridDim.x * 512) {
        const int e = i8 * 8, cs = e >> 20, k = (e >> 10) & 1023, l0 = e & 1023, sh = cs ? 512 : 0;
        float v[8];
#pragma unroll
        for (int j = 0; j < 8; ++j) v[j] = L[((k * (l0 + j)) - sh) & 2047];
        u32x4 o; o.x = cvt_pk_bf16(v[0], v[1]); o.y = cvt_pk_bf16(v[2], v[3]); o.z = cvt_pk_bf16(v[4], v[5]); o.w = cvt_pk_bf16(v[6], v[7]);
        *(u32x4*)(CS + (size_t)e) = o;
    }
}

template <bool TOK>
__device__ __forceinline__ void row_norm(int lane, const float* src, const float* posr, const float* posc, const float* gn, const float* sh, const float* sc, float* xpd, bf16_t* dst) {
    f32x4 v[4]; float ss = 0.f;
#pragma unroll
    for (int j = 0; j < 4; ++j) {
        const int col = 4 * lane + 256 * j;
        v[j] = *(const f32x4*)(src + col);
        if (TOK) { f32x4 p = (j < 2) ? *(const f32x4*)(posr + col) : *(const f32x4*)(posc + col - 512); v[j] = v[j] + p; *(f32x4*)(xpd + col) = v[j]; }
        ss += (v[j].x * v[j].x + v[j].y * v[j].y) + (v[j].z * v[j].z + v[j].w * v[j].w);
    }
    ss = wave_sum(ss);
    const float inv = rsqrtf(ss * (1.0f / 1024.0f) + 1e-6f);
#pragma unroll
    for (int j = 0; j < 4; ++j) {
        const int col = 4 * lane + 256 * j;
        f32x4 g = *(const f32x4*)(gn + col), s1 = *(const f32x4*)(sc + col), s0 = *(const f32x4*)(sh + col);
        f32x4 h = v[j] * inv * g * (s1 + 1.0f) + s0;
        u32x2 o; o.x = cvt_pk_bf16(h.x, h.y); o.y = cvt_pk_bf16(h.z, h.w);
        *(u32x2*)(dst + col) = o;
    }
}
struct EpiU {
    static constexpr bool PERM = true, AFTER_DRAIN = false;
    bf16_t* aext; bf16_t* fb; int ctx_b;
    __device__ __forceinline__ void operator()(const f32x4 (&acc)[2][2][4][2], const pg8::Unit& u, int wr, int wc, int fr, int fq) const {
#pragma unroll
        for (int ai = 0; ai < 2; ++ai)
#pragma unroll
            for (int m = 0; m < 4; ++m) {
                const int rt = 128 * ai + 64 * wr + 16 * m + fr;
#pragma unroll
                for (int bj = 0; bj < 2; ++bj) {
                    const int gcol = u.pn * 256 + 128 * bj + 32 * wc + 8 * fq;
                    const f32x4 v0 = acc[ai][bj][m][0], v1 = acc[ai][bj][m][1];
                    u32x4 w; w.x = cvt_pk_bf16(v0.x, v0.y); w.y = cvt_pk_bf16(v0.z, v0.w); w.z = cvt_pk_bf16(v1.x, v1.y); w.w = cvt_pk_bf16(v1.z, v1.w);
                    bf16_t* dst;
                    if (ctx_b >= 0) {
                        const int t = rt, g = gcol >> 4, q0 = gcol & 15, row = 512 + ctx_b * 8 + (t >> 5);
                        dst = aext + ((size_t)(g * 768 + row) * 768 + (t & 31) * 16 + q0);
                    } else {
                        const int r = u.pm * 256 + rt;
                        if (u.pn < 2) { const int b = r >> 11, t = r & 2047, g = gcol >> 4, q0 = gcol & 15, row = b * 64 + (t >> 5);
                            dst = aext + ((size_t)(g * 768 + row) * 768 + (t & 31) * 16 + q0); }
                        else dst = fb + (size_t)r * 512 + (gcol - 512);
                    }
                    *(u32x4*)dst = w;
                }
            }
    }
};
__device__ __forceinline__ void phase1(const Params& P, LAS unsigned char* lds) {
    const int tid = threadIdx.x, lane = tid & 63, wave = tid >> 6, wg = blockIdx.x;
    const float* mod = (const float*)(P.ws + WS_MISC + MISC_MOD);
    const float* postab = (const float*)(P.ws + WS_MISC + MISC_POS);
    if (wg < 16) {
        const int b = wg >> 1, pn = wg & 1;
        bf16_t* hcb = (bf16_t*)(P.ws + WS_HCB) + (size_t)wg * 256 * 1024;
        for (int j = 0; j < 32; ++j) {
            const int rr = wave * 32 + j;
            row_norm<false>(lane, P.ctx + (size_t)(b * 256 + rr) * 1024, nullptr, nullptr, P.norm1_g, mod + 8 * NMOD, mod + 8 * NMOD + 1024, nullptr, hcb + (size_t)rr * 1024);
        }
        asm volatile("s_waitcnt vmcnt(0)" ::: "memory");
        __syncthreads();
        pg8::Gemm g{1024, 1024, 1024};
        pg8::Unit u{(const char*)hcb, (const char*)((const bf16_t*)(P.ws + WS_W1T) + (size_t)pn * 256 * 1024), 0, pn, 0};
        EpiU E{(bf16_t*)(P.ws + WS_AEXT), nullptr, b};
        pg8::gemm_unit<EpiU>(lds, g, u, E);
    } else {
    const int gw = (wg - 16) * 8 + wave, ngw = (gridDim.x - 16) * 8;
    bf16_t* xb = (bf16_t*)(P.ws + WS_XB);
    for (int r = gw; r < NTOK; r += ngw) {
        const int b = r >> 11, t = r & 2047;
        row_norm<true>(lane, P.x + (size_t)r * 1024, postab + (size_t)(t >> 6) * 512, postab + (size_t)(32 + (t & 63)) * 512, P.norm1_g, mod + (size_t)b * NMOD, mod + (size_t)b * NMOD + 1024,
                       P.out + (size_t)r * 1024, xb + (size_t)r * 1024);
    }
    {
        LAS float* sh2 = (LAS float*)lds;
        for (int idx = tid; idx < 8 * 1024; idx += 512) sh2[idx] = mod[(size_t)(idx >> 10) * NMOD + 3 * 1024 + (idx & 1023)];
        __syncthreads();
        const bf16_t* WsT = (const bf16_t*)(P.ws + WS_WST);
        float* bias = (float*)(P.ws + WS_MISC + MISC_BIAS);
        for (int n = gw; n < 2048; n += ngw) {
            float acc[8];
#pragma unroll
            for (int b = 0; b < 8; ++b) acc[b] = 0.f;
#pragma unroll
            for (int j = 0; j < 2; ++j) {
                const int k0 = lane * 8 + 512 * j;
                u32x4 wv = *(const u32x4*)(WsT + (size_t)n * 1024 + k0);
                float wf[8] = {bflo(wv.x), bfhi(wv.x), bflo(wv.y), bfhi(wv.y), bflo(wv.z), bfhi(wv.z), bflo(wv.w), bfhi(wv.w)};
#pragma unroll
                for (int b = 0; b < 8; ++b)
#pragma unroll
                    for (int i = 0; i < 8; ++i) acc[b] += sh2[b * 1024 + k0 + i] * wf[i];
            }
#pragma unroll
            for (int b = 0; b < 8; ++b) { float s = wave_sum(acc[b]); if (lane == 0) bias[b * 2048 + n] = s; }
        }
    }
    {
        const float* Kt = (const float*)(P.ws + WS_KTAB);
        bf16_t* Mp = (bf16_t*)(P.ws + WS_MAPT);
        const int nthr = (gridDim.x - 16) * 512;
        for (int i8 = (wg - 16) * 512 + tid; i8 < 32 * 512 * 64; i8 += nthr) {
            const int g = i8 >> 15, row = (i8 >> 6) & 511, ch = i8 & 63; const int t = row >> 4, p = row & 15, s = ch >> 1, q8 = (ch & 1) * 8;
            f32x4 a0 = (f32x4){0.f, 0.f, 0.f, 0.f}, a1 = a0;
            if (t >= s) { const float* kp = Kt + ((size_t)((g * 2 + 0) * 32 + (t - s)) * 256 + p * 16 + q8); a0 = a0 + *(const f32x4*)kp; a1 = a1 + *(const f32x4*)(kp + 4); }
            if (s >= t) { const float* kp = Kt + ((size_t)((g * 2 + 1) * 32 + (s - t)) * 256 + p * 16 + q8); a0 = a0 + *(const f32x4*)kp; a1 = a1 + *(const f32x4*)(kp + 4); }
            u32x4 o; o.x = cvt_pk_bf16(a0.x, a0.y); o.y = cvt_pk_bf16(a0.z, a0.w); o.z = cvt_pk_bf16(a1.x, a1.y); o.w = cvt_pk_bf16(a1.z, a1.w);
            *(u32x4*)(Mp + ((size_t)(g * 512 + row) * 768 + s * 16 + q8)) = o;
        }
    }
    tables_to_fp8(P, wg - 16, gridDim.x - 16);
    }
}
__device__ __forceinline__ void phase2(const Params& P, LAS unsigned char* lds) {
    const int wg = blockIdx.x;
    const int wgid = (wg & 7) * 32 + (wg >> 3);
    const int pm = (wgid >> 5) * 8 + (wgid & 7), pn = (wgid & 31) >> 3;
    pg8::Gemm g{1024, 1024, 1024};
    pg8::Unit u{(const char*)((const bf16_t*)(P.ws + WS_XB) + (size_t)pm * 256 * 1024), (const char*)((const bf16_t*)(P.ws + WS_W1T) + (size_t)pn * 256 * 1024), pm, pn, 0};
    EpiU E{(bf16_t*)(P.ws + WS_AEXT), (bf16_t*)(P.ws + WS_FB), -1};
    pg8::gemm_unit<EpiU>(lds, g, u, E);
}

constexpr size_t WS_FOLD = WS_XB;
constexpr size_t WS_YGELU = WS_FB;
constexpr size_t WS_MIXIN = WS_XB;
struct EpiGT {
    static constexpr bool PERM = true, AFTER_DRAIN = false;
    bf16_t* gt;
    __device__ __forceinline__ void operator()(const f32x4 (&acc)[2][2][4][2], const pg8::Unit& u, int wr, int wc, int fr, int fq) const {
        const int b = u.pn >> 2;
#pragma unroll
        for (int ai = 0; ai < 2; ++ai)
#pragma unroll
            for (int m = 0; m < 4; ++m) {
                const int chp = u.pm * 256 + 128 * ai + 64 * wr + 16 * m + fr;
#pragma unroll
                for (int bj = 0; bj < 2; ++bj) {
                    const int l = (u.pn & 3) * 256 + 128 * bj + 32 * wc + 8 * fq;
                    const f32x4 v0 = acc[ai][bj][m][0], v1 = acc[ai][bj][m][1];
                    u32x4 w; w.x = cvt_pk_bf16(v0.x, v0.y); w.y = cvt_pk_bf16(v0.z, v0.w); w.z = cvt_pk_bf16(v1.x, v1.y); w.w = cvt_pk_bf16(v1.z, v1.w);
                    *(u32x4*)(gt + ((size_t)((b * 512 + (chp & 511)) * 2 + (chp >> 9)) * 1024 + l)) = w;
                }
            }
    }
};
struct EpiE {
    static constexpr bool PERM = false, AFTER_DRAIN = false;
    float* base;
    __device__ __forceinline__ void operator()(const f32x4 (&acc)[2][2][4][2], const pg8::Unit& u, int wr, int wc, int fr, int fq) const {
#pragma unroll
        for (int ai = 0; ai < 2; ++ai)
#pragma unroll
            for (int m = 0; m < 4; ++m) {
                const int rt = 128 * ai + 64 * wr + 16 * m + fr;
#pragma unroll
                for (int bj = 0; bj < 2; ++bj)
#pragma unroll
                    for (int n = 0; n < 2; ++n) *(f32x4*)(base + (size_t)rt * 256 + 128 * bj + 32 * wc + 16 * n + 4 * fq) = acc[ai][bj][m][n];
            }
    }
};
__device__ __forceinline__ unsigned bf2_add(unsigned a, unsigned b, float sg) { return cvt_pk_bf16(bflo(a) + sg * bflo(b), bfhi(a) + sg * bfhi(b)); }
__device__ __forceinline__ void phase3(const Params& P, LAS unsigned char* lds) {
    const int wg = blockIdx.x;
    if (wg < 128) {
        const int pm = wg & 3, pn = wg >> 2; const int cs = pm >> 1, b = pn >> 2, lbase = (pn & 3) * 256;
        bf16_t* fold = (bf16_t*)(P.ws + WS_FOLD) + (size_t)wg * 256 * 512;
        const bf16_t* fb = (const bf16_t*)(P.ws + WS_FB) + (size_t)b * 2048 * 512;
        const float sg = cs ? -1.0f : 1.0f;
        for (int it = threadIdx.x; it < 256 * 64; it += 512 * 4) {
            u32x4 a[4], m[4];
#pragma unroll
            for (int q = 0; q < 4; ++q) { const int i = it + 512 * q; const int row = i >> 6, ch8 = (i & 63) * 8; const int l = lbase + row;
                a[q] = *(const u32x4*)(fb + (size_t)l * 512 + ch8); m[q] = *(const u32x4*)(fb + (size_t)((2048 - l) & 2047) * 512 + ch8); }
#pragma unroll
            for (int q = 0; q < 4; ++q) { const int i = it + 512 * q; const int row = i >> 6, ch8 = (i & 63) * 8; const int l = lbase + row;
                u32x4 o;
                if (l == 0) { o = cs ? (u32x4){0u, 0u, 0u, 0u} : a[q]; }
                else { o.x = bf2_add(a[q].x, m[q].x, sg); o.y = bf2_add(a[q].y, m[q].y, sg); o.z = bf2_add(a[q].z, m[q].z, sg); o.w = bf2_add(a[q].w, m[q].w, sg); }
                *(u32x4*)(fold + (size_t)row * 512 + ch8) = o; }
        }
        asm volatile("s_waitcnt vmcnt(0)" ::: "memory");
        __syncthreads();
        pg8::Gemm g{512, 512, 512};
        pg8::Unit u{(const char*)((const bf16_t*)(P.ws + WS_WCST) + (size_t)pm * 256 * 512), (const char*)fold, pm, pn, 0};
        EpiGT E{(bf16_t*)(P.ws + WS_GT)};
        pg8::gemm_unit<EpiGT>(lds, g, u, E);
    } else if (wg < 224) {
        const int w2 = wg - 128; const int gg = w2 / 3, mt = w2 % 3;
        pg8::Gemm g{768, 512, 512};
        pg8::Unit u{(const char*)((const bf16_t*)(P.ws + WS_AEXT) + (size_t)(gg * 768 + mt * 256) * 768), (const char*)((const bf16_t*)(P.ws + WS_WENDT) + (size_t)gg * 256 * 512), mt, 0, gg};
        EpiE E{(float*)(P.ws + WS_E) + (size_t)(gg * 768 + mt * 256) * 256};
        pg8::gemm_unit<EpiE>(lds, g, u, E);
    }
    {
        const int lane = threadIdx.x & 63, wave = threadIdx.x >> 6;
        float* ecv = (float*)(P.ws + WS_MISC + MISC_EC);
        const bf16_t* WcsT = (const bf16_t*)(P.ws + WS_WCST); const bf16_t* fb = (const bf16_t*)(P.ws + WS_FB);
#pragma unroll
        for (int q = 0; q < 2; ++q) {
            const int ent = wg * 16 + wave * 2 + q; const int b = ent >> 9, ch = ent & 511, gq = ch >> 7;
            const unsigned fw = *(const unsigned*)(fb + ((size_t)b * 2048 + 1024) * 512 + gq * 128 + 2 * lane);
            const unsigned ww = *(const unsigned*)(WcsT + (size_t)ch * 512 + gq * 128 + 2 * lane);
            float e = bflo(fw) * bflo(ww) + bfhi(fw) * bfhi(ww);
            e = wave_sum(e);
            if (lane == 0) ecv[ent] = e;
        }
    }
}
struct EpiY {
    static constexpr bool PERM = true, AFTER_DRAIN = false;
    const bf16_t* arow; const float* dskip; bf16_t* yg; int g, mt, nt;
    __device__ __forceinline__ void operator()(const f32x4 (&acc)[2][2][4][2], const pg8::Unit& u, int wr, int wc, int fr, int fq) const {
#pragma unroll
        for (int ai = 0; ai < 2; ++ai)
#pragma unroll
            for (int m = 0; m < 4; ++m) {
                const int row = mt * 256 + 128 * ai + 64 * wr + 16 * m + fr; const int b = row >> 6, c = row & 63;
#pragma unroll
                for (int bj = 0; bj < 2; ++bj) {
                    const int col0 = nt * 256 + 128 * bj + 32 * wc + 8 * fq; const int t = col0 >> 4, p0 = col0 & 15;
                    const u32x4 uv = *(const u32x4*)(arow + (size_t)row * 768 + t * 16 + p0);
                    const f32x4 d0 = *(const f32x4*)(dskip + g * 16 + p0), d1 = *(const f32x4*)(dskip + g * 16 + p0 + 4);
                    const f32x4 v0 = acc[ai][bj][m][0], v1 = acc[ai][bj][m][1];
                    float y[8] = {v0.x + d0.x * bflo(uv.x), v0.y + d0.y * bfhi(uv.x), v0.z + d0.z * bflo(uv.y), v0.w + d0.w * bfhi(uv.y),
                                  v1.x + d1.x * bflo(uv.z), v1.y + d1.y * bfhi(uv.z), v1.z + d1.z * bflo(uv.w), v1.w + d1.w * bfhi(uv.w)};
#pragma unroll
                    for (int i = 0; i < 8; ++i) y[i] = gelu_tanh(y[i]);
                    u32x4 w; w.x = cvt_pk_bf16(y[0], y[1]); w.y = cvt_pk_bf16(y[2], y[3]); w.z = cvt_pk_bf16(y[4], y[5]); w.w = cvt_pk_bf16(y[6], y[7]);
                    const size_t tok = (size_t)b * 2048 + c * 32 + t;
                    *(u32x4*)(yg + tok * 512 + g * 16 + p0) = w;
                }
            }
    }
};
struct EpiP {
    static constexpr bool PERM = true, AFTER_DRAIN = false;
    bf16_t* base;
    __device__ __forceinline__ void operator()(const f32x4 (&acc)[2][2][4][2], const pg8::Unit& u, int wr, int wc, int fr, int fq) const {
#pragma unroll
        for (int ai = 0; ai < 2; ++ai)
#pragma unroll
            for (int m = 0; m < 4; ++m) {
                const int rt = 128 * ai + 64 * wr + 16 * m + fr;
#pragma unroll
                for (int bj = 0; bj < 2; ++bj) {
                    const f32x4 v0 = acc[ai][bj][m][0], v1 = acc[ai][bj][m][1];
                    u32x4 w; w.x = cvt_pk_bf16(v0.x, v0.y); w.y = cvt_pk_bf16(v0.z, v0.w); w.z = cvt_pk_bf16(v1.x, v1.y); w.w = cvt_pk_bf16(v1.z, v1.w);
                    *(u32x4*)(base + (size_t)rt * 512 + 128 * bj + 32 * wc + 8 * fq) = w;
                }
            }
    }
};
__device__ __forceinline__ void s5_carry(const Params& P, int g, int mt) {
    const int tid = threadIdx.x; const int bl = tid >> 7, dir = (tid >> 6) & 1, n = tid & 63; const int b = mt * 4 + bl;
    const int dg = dir * 32 + g, i = dg * 64 + n;
    const float dt = expf(P.log_dt[dg]); const float lr = P.lam_re[i], li = P.lam_im[i];
    const float mag = expf(32.0f * lr * dt), ang = 32.0f * (li * dt);
    const float atr = mag * cosf(ang), ati = mag * sinf(ang);
    const float* Eg = (const float*)(P.ws + WS_E) + (size_t)g * 768 * 256 + dir * 128 + n * 2;
    bf16_t* Ag = (bf16_t*)(P.ws + WS_AEXT) + (size_t)g * 768 * 768 + 512 + dir * 128 + n * 2;
    float hr = 0.f, hi = 0.f;
    {
        f32x2 e[8];
#pragma unroll
        for (int k = 0; k < 8; ++k) { const int cp = dir ? 7 - k : k; e[k] = *(const f32x2*)(Eg + (size_t)(512 + b * 8 + cp) * 256); }
#pragma unroll
        for (int k = 0; k < 8; ++k) { const float nr = atr * hr - ati * hi + e[k].x, ni = atr * hi + ati * hr + e[k].y; hr = nr; hi = ni; }
    }
    for (int k0 = 0; k0 < 64; k0 += 8) {
        f32x2 e[8];
#pragma unroll
        for (int k = 0; k < 8; ++k) { const int c = dir ? 63 - (k0 + k) : (k0 + k); e[k] = *(const f32x2*)(Eg + (size_t)(b * 64 + c) * 256); }
#pragma unroll
        for (int k = 0; k < 8; ++k) {
            const int c = dir ? 63 - (k0 + k) : (k0 + k);
            *(unsigned*)(Ag + (size_t)(b * 64 + c) * 768) = cvt_pk_bf16(hr, hi);
            const float nr = atr * hr - ati * hi + e[k].x, ni = atr * hi + ati * hr + e[k].y; hr = nr; hi = ni;
        }
    }
}
__device__ __forceinline__ void phase4(const Params& P, LAS unsigned char* lds) {
    const int wg = blockIdx.x;
    if (wg < 128) {
        const int gg = wg >> 2, mt = (wg >> 1) & 1, nt = wg & 1;
        s5_carry(P, gg, mt);
        asm volatile("s_waitcnt vmcnt(0)" ::: "memory");
        __syncthreads();
        const bf16_t* Ag = (const bf16_t*)(P.ws + WS_AEXT) + (size_t)gg * 768 * 768;
        pg8::Gemm g{768, 768, 768};
        pg8::Unit u{(const char*)(Ag + (size_t)mt * 256 * 768), (const char*)((const bf16_t*)(P.ws + WS_MAPT) + (size_t)(gg * 512 + nt * 256) * 768), mt, nt, gg};
        EpiY E{Ag, P.s5_d, (bf16_t*)(P.ws + WS_YGELU), gg, mt, nt};
        pg8::gemm_unit<EpiY>(lds, g, u, E);
    }
    else {
        const int idx = wg - 128; const int b = idx & 7, j = idx >> 3; const int cs = j >> 3, mt = (j >> 1) & 3, nt = j & 1;
        pg8::Gemm g{1024, 2048, 1024};
        pg8::Unit u{(const char*)((const bf16_t*)(P.ws + WS_CS) + (size_t)(cs * 1024 + mt * 256) * 1024),
                    (const char*)((const bf16_t*)(P.ws + WS_GT) + ((size_t)(b * 512 + nt * 256) * 2 + cs) * 1024), mt, nt, b};
        EpiP E{(bf16_t*)(P.ws + WS_CSPART) + ((size_t)(cs * 8 + b) * 1024 + mt * 256) * 512 + nt * 256};
        pg8::gemm_unit<EpiP>(lds, g, u, E);
    }
    {
        const int lane = threadIdx.x & 63, wave = threadIdx.x >> 6;
        const float* ecv = (const float*)(P.ws + WS_MISC + MISC_EC); float* o1024 = (float*)(P.ws + WS_MISC + MISC_O1024);
        const bf16_t* GT = (const bf16_t*)(P.ws + WS_GT);
#pragma unroll
        for (int q = 0; q < 2; ++q) {
            const int ent = wg * 16 + wave * 2 + q; const int b = ent >> 9, ch = ent & 511;
            const u32x4 g0 = *(const u32x4*)(GT + (size_t)(b * 512 + ch) * 2048 + 16 * lane), g1 = *(const u32x4*)(GT + (size_t)(b * 512 + ch) * 2048 + 16 * lane + 8);
            float s = (bflo(g0.x) - bfhi(g0.x)) + (bflo(g0.y) - bfhi(g0.y)) + (bflo(g0.z) - bfhi(g0.z)) + (bflo(g0.w) - bfhi(g0.w))
                    + (bflo(g1.x) - bfhi(g1.x)) + (bflo(g1.y) - bfhi(g1.y)) + (bflo(g1.z) - bfhi(g1.z)) + (bflo(g1.w) - bfhi(g1.w));
            s = wave_sum(s);
            if (lane == 0) o1024[ent] = s + ecv[ent];
        }
    }
}
struct EpiGlu {
    static constexpr bool PERM = true, AFTER_DRAIN = false;
    const bf16_t* yg; const float* bglu; bf16_t* mixin;
    __device__ __forceinline__ void operator()(const f32x4 (&acc)[2][2][4][2], const pg8::Unit& u, int wr, int wc, int fr, int fq) const {
#pragma unroll
        for (int ai = 0; ai < 2; ++ai)
#pragma unroll
            for (int m = 0; m < 4; ++m) {
                const size_t r = (size_t)u.pm * 256 + 128 * ai + 64 * wr + 16 * m + fr;
#pragma unroll
                for (int bj = 0; bj < 2; ++bj) {
                    const int c0 = u.pn * 256 + 128 * bj + 32 * wc + 8 * fq;
                    const u32x4 yv = *(const u32x4*)(yg + r * 512 + c0);
                    const f32x4 b0 = *(const f32x4*)(bglu + c0), b1 = *(const f32x4*)(bglu + c0 + 4);
                    const f32x4 v0 = acc[ai][bj][m][0] + b0, v1 = acc[ai][bj][m][1] + b1;
                    float s[8] = {bflo(yv.x) * sigmoidf_(v0.x), bfhi(yv.x) * sigmoidf_(v0.y), bflo(yv.y) * sigmoidf_(v0.z), bfhi(yv.y) * sigmoidf_(v0.w),
                                  bflo(yv.z) * sigmoidf_(v1.x), bfhi(yv.z) * sigmoidf_(v1.y), bflo(yv.w) * sigmoidf_(v1.z), bfhi(yv.w) * sigmoidf_(v1.w)};
                    u32x4 w; w.x = cvt_pk_bf16(s[0], s[1]); w.y = cvt_pk_bf16(s[2], s[3]); w.z = cvt_pk_bf16(s[4], s[5]); w.w = cvt_pk_bf16(s[6], s[7]);
                    *(u32x4*)(mixin + r * 1024 + c0) = w;
                }
            }
    }
};
__device__ __forceinline__ void phase5(const Params& P, LAS unsigned char* lds) {
    const int wg = blockIdx.x;
    bf16_t* mixin = (bf16_t*)(P.ws + WS_MIXIN);
    if (wg < 128) {
        const int pm = wg >> 1, pn = wg & 1;
        const bf16_t* yg = (const bf16_t*)(P.ws + WS_YGELU);
        pg8::Gemm g{512, 512, 512};
        pg8::Unit u{(const char*)(yg + (size_t)pm * 256 * 512), (const char*)((const bf16_t*)(P.ws + WS_WGLUT) + (size_t)pn * 256 * 512), pm, pn, 0};
        EpiGlu E{yg, P.b_glu, mixin};
        pg8::gemm_unit<EpiGlu>(lds, g, u, E);
    } else {
        const bf16_t* Cp = (const bf16_t*)(P.ws + WS_CSPART); const bf16_t* Sp = Cp + (size_t)8 * 1024 * 512;
        const float* ecv = (const float*)(P.ws + WS_MISC + MISC_EC); const float* o1024 = (const float*)(P.ws + WS_MISC + MISC_O1024);
        for (int i8 = (wg - 128) * 512 + threadIdx.x; i8 < NTOK * 64; i8 += 128 * 512) {
            const int tok = i8 >> 6, ch = (i8 & 63) * 8; const int b = tok >> 11, k = tok & 2047;
            const f32x4 e0 = *(const f32x4*)(ecv + b * 512 + ch), e1 = *(const f32x4*)(ecv + b * 512 + ch + 4);
            float v[8];
            if (k == 1024) {
                const f32x4 o0 = *(const f32x4*)(o1024 + b * 512 + ch), o1 = *(const f32x4*)(o1024 + b * 512 + ch + 4);
                v[0] = o0.x; v[1] = o0.y; v[2] = o0.z; v[3] = o0.w; v[4] = o1.x; v[5] = o1.y; v[6] = o1.z; v[7] = o1.w;
            } else {
                const int kk = (k < 1024) ? k : 2048 - k; const float sg = (k < 1024) ? 1.0f : -1.0f, se = (kk & 1) ? -1.0f : 1.0f;
                const u32x4 c = *(const u32x4*)(Cp + ((size_t)b * 1024 + kk) * 512 + ch), s = *(const u32x4*)(Sp + ((size_t)b * 1024 + kk) * 512 + ch);
                v[0] = bflo(c.x) + sg * bflo(s.x) + se * e0.x; v[1] = bfhi(c.x) + sg * bfhi(s.x) + se * e0.y; v[2] = bflo(c.y) + sg * bflo(s.y) + se * e0.z; v[3] = bfhi(c.y) + sg * bfhi(s.y) + se * e0.w;
                v[4] = bflo(c.z) + sg * bflo(s.z) + se * e1.x; v[5] = bfhi(c.z) + sg * bfhi(s.z) + se * e1.y; v[6] = bflo(c.w) + sg * bflo(s.w) + se * e1.z; v[7] = bfhi(c.w) + sg * bfhi(s.w) + se * e1.w;
            }
            u32x4 w; w.x = cvt_pk_bf16(v[0], v[1]); w.y = cvt_pk_bf16(v[2], v[3]); w.z = cvt_pk_bf16(v[4], v[5]); w.w = cvt_pk_bf16(v[6], v[7]);
            *(u32x4*)(mixin + (size_t)tok * 1024 + 512 + ch) = w;
        }
    }
}
constexpr size_t WS_X1B = WS_AEXT;
constexpr size_t WS_PAIRS = WS_XB;
constexpr size_t MISC_SS = 1024 * 1024;
struct EpiOut {
    static constexpr bool PERM = false, AFTER_DRAIN = false;
    float* xio; const float* mod; const float* g2n; bf16_t* x1b; float* sspart;
    __device__ __forceinline__ void operator()(const f32x4 (&acc)[2][2][4][2], const pg8::Unit& u, int wr, int wc, int fr, int fq) const {
#pragma unroll
        for (int ai = 0; ai < 2; ++ai)
#pragma unroll
            for (int m = 0; m < 4; ++m) {
                const size_t r = (size_t)u.pm * 256 + 128 * ai + 64 * wr + 16 * m + fr; const int b = (int)(r >> 11);
                const float* mrow = mod + (size_t)b * NMOD;
                float ss = 0.f;
#pragma unroll
                for (int bj = 0; bj < 2; ++bj)
#pragma unroll
                    for (int n = 0; n < 2; ++n) {
                        const int col = u.pn * 256 + 128 * bj + 32 * wc + 16 * n + 4 * fq;
                        const f32x4 xp = *(const f32x4*)(xio + r * 1024 + col);
                        const f32x4 g1 = *(const f32x4*)(mrow + 2 * 1024 + col), sc2 = *(const f32x4*)(mrow + 4 * 1024 + col), gn = *(const f32x4*)(g2n + col);
                        const f32x4 x1 = xp + g1 * acc[ai][bj][m][n];
                        *(f32x4*)(xio + r * 1024 + col) = x1;
                        ss += (x1.x * x1.x + x1.y * x1.y) + (x1.z * x1.z + x1.w * x1.w);
                        const f32x4 hb = x1 * gn * (sc2 + 1.0f);
                        u32x2 o; o.x = cvt_pk_bf16(hb.x, hb.y); o.y = cvt_pk_bf16(hb.z, hb.w);
                        *(u32x2*)(x1b + r * 1024 + col) = o;
                    }
                ss += __shfl_xor(ss, 16); ss += __shfl_xor(ss, 32);
                if (fq == 0) sspart[r * 16 + u.pn * 4 + wc] = ss;
            }
    }
};
__device__ __forceinline__ void phase6(const Params& P, LAS unsigned char* lds) {
    const int wg = blockIdx.x;
    const int wgid = (wg & 7) * 32 + (wg >> 3);
    const int pm = (wgid >> 5) * 8 + (wgid & 7), pn = (wgid & 31) >> 3;
    pg8::Gemm g{1024, 1024, 1024};
    pg8::Unit u{(const char*)((const bf16_t*)(P.ws + WS_MIXIN) + (size_t)pm * 256 * 1024), (const char*)((const bf16_t*)(P.ws + WS_WOUTT) + (size_t)pn * 256 * 1024), pm, pn, 0};
    EpiOut E{P.out, (const float*)(P.ws + WS_MISC + MISC_MOD), P.norm2_g, (bf16_t*)(P.ws + WS_X1B), (float*)(P.ws + WS_MISC + MISC_SS)};
    pg8::gemm_unit<EpiOut>(lds, g, u, E);
}
__device__ __forceinline__ unsigned key_pack(float v, unsigned tag, unsigned mask) {
    unsigned b = __float_as_uint(v); b ^= (b >> 31) ? 0xffffffffu : 0x80000000u; return (b & ~mask) | tag;
}
__device__ __forceinline__ float key_val(unsigned k, unsigned mask) { unsigned b = k & ~mask; b ^= (b >> 31) ? 0x80000000u : 0xffffffffu; return __uint_as_float(b); }
__device__ const unsigned char CAND_TAB[64] = {0,1,2,3,4,5,6,7,8,9,10,11,12,13,14,15,16,17,18,19,20,21,22,23,32,33,34,35,36,48,49,50,51,64,65,66,80,81,96,97,112,113,128,144,160,176,192,208,224,240,
    255,255,255,255,255,255,255,255,255,255,255,255,255,255};
#define DPP_ROR(v, n) ((unsigned)__builtin_amdgcn_update_dpp(0, (int)(v), 0x120 + (n), 0xf, 0xf, false))
__device__ __forceinline__ unsigned row_umax(unsigned m) {
    unsigned t;
    t = DPP_ROR(m, 8); m = m > t ? m : t; t = DPP_ROR(m, 4); m = m > t ? m : t; t = DPP_ROR(m, 2); m = m > t ? m : t; t = DPP_ROR(m, 1); m = m > t ? m : t;
    return m;
}
__device__ __forceinline__ float row_fsum(float s) {
    s += __int_as_float(__builtin_amdgcn_update_dpp(0, __float_as_int(s), 0x128, 0xf, 0xf, false));
    s += __int_as_float(__builtin_amdgcn_update_dpp(0, __float_as_int(s), 0x124, 0xf, 0xf, false));
    s += __int_as_float(__builtin_amdgcn_update_dpp(0, __float_as_int(s), 0x122, 0xf, 0xf, false));
    s += __int_as_float(__builtin_amdgcn_update_dpp(0, __float_as_int(s), 0x121, 0xf, 0xf, false));
    return s;
}
#define CE(a, b) do { const unsigned hi_ = (a) > (b) ? (a) : (b), lo_ = (a) > (b) ? (b) : (a); (a) = hi_; (b) = lo_; } while (0)
__device__ __forceinline__ unsigned row_top16_of128(unsigned (&k)[8], int l16) {
    CE(k[0], k[1]); CE(k[2], k[3]); CE(k[0], k[2]); CE(k[1], k[3]); CE(k[1], k[2]); CE(k[4], k[5]); CE(k[6], k[7]); CE(k[4], k[6]); CE(k[5], k[7]); CE(k[5], k[6]); CE(k[0], k[4]); CE(k[2], k[6]); CE(k[2], k[4]); CE(k[1], k[5]); CE(k[3], k[7]); CE(k[3], k[5]); CE(k[1], k[2]); CE(k[3], k[4]); CE(k[5], k[6]);
    unsigned mine = 0u;
#pragma unroll
    for (int q = 0; q < 16; ++q) {
        const unsigned m = row_umax(k[0]);
        const bool own = (k[0] == m);
#pragma unroll
        for (int i = 0; i < 7; ++i) k[i] = own ? k[i + 1] : k[i];
        k[7] = own ? 0u : k[7];
        mine = (l16 == q) ? m : mine;
    }
    return mine;
}
__device__ __forceinline__ unsigned row_top16_of64(unsigned (&k)[4], int l16) {
    CE(k[0], k[1]); CE(k[2], k[3]); CE(k[0], k[2]); CE(k[1], k[3]); CE(k[1], k[2]);
    unsigned mine = 0u;
#pragma unroll
    for (int q = 0; q < 16; ++q) {
        const unsigned m = row_umax(k[0]);
        const bool own = (k[0] == m);
        k[0] = own ? k[1] : k[0]; k[1] = own ? k[2] : k[1]; k[2] = own ? k[3] : k[2]; k[3] = own ? 0u : k[3];
        mine = (l16 == q) ? m : mine;
    }
    return mine;
}
struct EpiTopk {
    static constexpr bool PERM = false, AFTER_DRAIN = true;
    const float* sspart; const float* bias; int* pexp; float* pw; int head;
    __device__ __forceinline__ void fused(const f32x4 (&acc)[2][2][4][2], const pg8::Unit& u, int wr, int wc, int fr, int fq, LAS unsigned char* lds, int wid, int lane) const {
        LAS float* S = (LAS float*)lds;
        LAS unsigned* TL = (LAS unsigned*)(lds + 133120) + wid * 128;
        const int dr = lane >> 4, l16 = lane & 15;
        unsigned cc[4];
#pragma unroll
        for (int k = 0; k < 4; ++k) cc[k] = CAND_TAB[l16 * 4 + k];
#pragma unroll
        for (int ai = 0; ai < 2; ++ai) {
#pragma unroll
            for (int m = 0; m < 4; ++m) {
                const int rl = 64 * wr + 16 * m + fr; const size_t r = (size_t)u.pm * 256 + 128 * ai + rl; const int b = (int)(r >> 11);
                float tot = 0.f;
#pragma unroll
                for (int i = 0; i < 4; ++i) { const f32x4 sp = *(const f32x4*)(sspart + r * 16 + 4 * i); tot += (sp.x + sp.y) + (sp.z + sp.w); }
                const float inv = rsqrtf(tot * (1.0f / 1024.0f) + 1e-6f);
#pragma unroll
                for (int bj = 0; bj < 2; ++bj)
#pragma unroll
                    for (int n = 0; n < 2; ++n) {
                        const int c = 128 * bj + 32 * wc + 16 * n + 4 * fq;
                        const f32x4 bs = *(const f32x4*)(bias + (size_t)b * 2048 + head * 256 + c);
                        const f32x4 s = acc[ai][bj][m][n] * inv + bs;
                        *(LAS f32x4*)(S + rl * 260 + c) = s;
                    }
            }
            __syncthreads();
            for (int bt = 0; bt < 4; ++bt) {
#pragma unroll
                for (int half = 0; half < 2; ++half) {
                    const int trow = wid * 16 + bt * 4 + half * 2 + (dr >> 1), side = dr & 1;
                    const LAS f32x4* sp = (const LAS f32x4*)(S + trow * 260 + side * 128 + 8 * l16);
                    const f32x4 v0 = sp[0], v1 = sp[1];
                    unsigned k[8];
                    const unsigned tg = 127u - 8u * (unsigned)l16;
                    k[0] = key_pack(v0.x, tg, 127u); k[1] = key_pack(v0.y, tg - 1u, 127u); k[2] = key_pack(v0.z, tg - 2u, 127u); k[3] = key_pack(v0.w, tg - 3u, 127u);
                    k[4] = key_pack(v1.x, tg - 4u, 127u); k[5] = key_pack(v1.y, tg - 5u, 127u); k[6] = key_pack(v1.z, tg - 6u, 127u); k[7] = key_pack(v1.w, tg - 7u, 127u);
                    const unsigned mine = row_top16_of128(k, l16);
                    TL[(half * 2 + (dr >> 1)) * 32 + side * 16 + l16] = mine;
                }
                asm volatile("s_waitcnt lgkmcnt(0)" ::: "memory");
                unsigned ck[4];
#pragma unroll
                for (int k = 0; k < 4; ++k) {
                    const unsigned code = cc[k]; const unsigned ci = (code >> 4) & 15u, cj = code & 15u;
                    const unsigned ka = TL[dr * 32 + ci], kb = TL[dr * 32 + 16 + cj];
                    const unsigned key = key_pack(key_val(ka, 127u) + key_val(kb, 127u), 255u - code, 255u);
                    ck[k] = (code == 255u) ? 0u : key;
                }
                const unsigned best = row_top16_of64(ck, l16);
                const unsigned flat = 255u - (best & 255u);
                const float bv = key_val(best, 255u);
                const float bmax = key_val(row_umax(best), 255u);
                const float e = expf(bv - bmax);
                const float sum = row_fsum(e);
                const unsigned k1s = TL[dr * 32 + (flat >> 4)], k2s = TL[dr * 32 + 16 + (flat & 15u)];
                const int idx1 = 127 - (int)(k1s & 127u), idx2 = 127 - (int)(k2s & 127u);
                const size_t tok = (size_t)u.pm * 256 + 128 * ai + wid * 16 + bt * 4 + dr;
                pexp[tok * 128 + head * 16 + l16] = idx1 * 128 + idx2; pw[tok * 128 + head * 16 + l16] = e / sum;
                asm volatile("s_waitcnt lgkmcnt(0)" ::: "memory");
            }
            __syncthreads();
        }
    }
};
__device__ __forceinline__ void phase7(const Params& P, LAS unsigned char* lds) {
    const int wg = blockIdx.x; const int x = wg & 7, li = wg >> 3;
    for (int rnd = 0; rnd < 2; ++rnd) {
        const int unit = li + 32 * rnd; const int pm = 8 * x + (unit & 7), head = unit >> 3;
        pg8::Gemm g{1024, 1024, 1024};
        pg8::Unit u{(const char*)((const bf16_t*)(P.ws + WS_X1B) + (size_t)pm * 256 * 1024), (const char*)((const bf16_t*)(P.ws + WS_WST) + (size_t)head * 256 * 1024), pm, head, 0};
        EpiTopk E{(const float*)(P.ws + WS_MISC + MISC_SS), (const float*)(P.ws + WS_MISC + MISC_BIAS), (int*)(P.ws + WS_PAIRS), (float*)(P.ws + WS_PAIRS) + (size_t)NTOK * 128, head};
        pg8::gemm_unit<EpiTopk>(lds, g, u, E);
    }
}
constexpr size_t WS_U8 = 216 * MiB;
constexpr size_t WS_V8 = 232 * MiB;
#define U8_SCALE 512.0f
#define V8_SCALE 16.0f
__device__ __forceinline__ unsigned pack4_fp8(f32x4 v, float sc) {
    v = v * sc;
    v.x = fminf(fmaxf(v.x, -448.f), 448.f); v.y = fminf(fmaxf(v.y, -448.f), 448.f); v.z = fminf(fmaxf(v.z, -448.f), 448.f); v.w = fminf(fmaxf(v.w, -448.f), 448.f);
    int t = __builtin_amdgcn_cvt_pk_fp8_f32(v.x, v.y, 0, false);
    t = __builtin_amdgcn_cvt_pk_fp8_f32(v.z, v.w, t, true);
    return (unsigned)t;
}
__device__ __forceinline__ void tables_to_fp8(const Params& P, int wgi, int nwg) {
    const int nthr = nwg * 512;
    for (int i0 = wgi * 512 + threadIdx.x; i0 < 2 * 16384 * 64; i0 += nthr * 4) {
        f32x4 v[4][4]; bool ok[4];
#pragma unroll
        for (int q = 0; q < 4; ++q) {
            const int i = i0 + q * nthr; ok[q] = i < 2 * 16384 * 64;
            const int ii = ok[q] ? i : i0; const int tab = ii >> 20, off = (ii & ((1 << 20) - 1)) * 16;
            const float* src = (tab ? P.v_tab : P.u_tab) + off;
#pragma unroll
            for (int j = 0; j < 4; ++j) v[q][j] = *(const f32x4*)(src + 4 * j);
        }
#pragma unroll
        for (int q = 0; q < 4; ++q) {
            const int i = i0 + q * nthr;
            if (ok[q]) {
                const int tab = i >> 20, off = (i & ((1 << 20) - 1)) * 16; const float sc = tab ? V8_SCALE : U8_SCALE;
                u32x4 o; o.x = pack4_fp8(v[q][0], sc); o.y = pack4_fp8(v[q][1], sc); o.z = pack4_fp8(v[q][2], sc); o.w = pack4_fp8(v[q][3], sc);
                *(u32x4*)(P.ws + (tab ? WS_V8 : WS_U8) + (size_t)off) = o;
            }
        }
    }
}
__device__ __forceinline__ float dot16_fp8(const u32x4 r, const f32x2 (&h)[8]) {
    f32x2 a = __builtin_amdgcn_cvt_pk_f32_fp8((int)r.x, false) * h[0];
    a = a + __builtin_amdgcn_cvt_pk_f32_fp8((int)r.x, true) * h[1];
    a = a + __builtin_amdgcn_cvt_pk_f32_fp8((int)r.y, false) * h[2];
    a = a + __builtin_amdgcn_cvt_pk_f32_fp8((int)r.y, true) * h[3];
    a = a + __builtin_amdgcn_cvt_pk_f32_fp8((int)r.z, false) * h[4];
    a = a + __builtin_amdgcn_cvt_pk_f32_fp8((int)r.z, true) * h[5];
    a = a + __builtin_amdgcn_cvt_pk_f32_fp8((int)r.w, false) * h[6];
    a = a + __builtin_amdgcn_cvt_pk_f32_fp8((int)r.w, true) * h[7];
    return a.x + a.y;
}
__device__ __forceinline__ void axpy16_fp8(const u32x4 r, const float w, f32x2 (&acc)[8]) {
    const f32x2 ww = (f32x2){w, w};
    acc[0] = acc[0] + __builtin_amdgcn_cvt_pk_f32_fp8((int)r.x, false) * ww;
    acc[1] = acc[1] + __builtin_amdgcn_cvt_pk_f32_fp8((int)r.x, true) * ww;
    acc[2] = acc[2] + __builtin_amdgcn_cvt_pk_f32_fp8((int)r.y, false) * ww;
    acc[3] = acc[3] + __builtin_amdgcn_cvt_pk_f32_fp8((int)r.y, true) * ww;
    acc[4] = acc[4] + __builtin_amdgcn_cvt_pk_f32_fp8((int)r.z, false) * ww;
    acc[5] = acc[5] + __builtin_amdgcn_cvt_pk_f32_fp8((int)r.z, true) * ww;
    acc[6] = acc[6] + __builtin_amdgcn_cvt_pk_f32_fp8((int)r.w, false) * ww;
    acc[7] = acc[7] + __builtin_amdgcn_cvt_pk_f32_fp8((int)r.w, true) * ww;
}
__device__ __forceinline__ float reduce16(float (&d)[16], int lane) {
    float a[8], b[4], c[2];
    const bool b0 = lane & 1, b1 = lane & 2, b2 = lane & 4, b3 = lane & 8;
#pragma unroll
    for (int j = 0; j < 8; ++j) { const float keep = b0 ? d[2 * j + 1] : d[2 * j], send = b0 ? d[2 * j] : d[2 * j + 1]; a[j] = keep + __shfl_xor(send, 1); }
#pragma unroll
    for (int j = 0; j < 4; ++j) { const float keep = b1 ? a[2 * j + 1] : a[2 * j], send = b1 ? a[2 * j] : a[2 * j + 1]; b[j] = keep + __shfl_xor(send, 2); }
#pragma unroll
    for (int j = 0; j < 2; ++j) { const float keep = b2 ? b[2 * j + 1] : b[2 * j], send = b2 ? b[2 * j] : b[2 * j + 1]; c[j] = keep + __shfl_xor(send, 4); }
    const float keep = b3 ? c[1] : c[0], send = b3 ? c[0] : c[1];
    float v = keep + __shfl_xor(send, 8);
    v += __shfl_xor(v, 16); v += __shfl_xor(v, 32);
    return v;
}
__device__ __forceinline__ float reduce8(float (&d)[8], int lane) {
    float a[4], b[2];
    const bool b0 = lane & 1, b1 = lane & 2, b2 = lane & 4;
#pragma unroll
    for (int j = 0; j < 4; ++j) { const float keep = b0 ? d[2 * j + 1] : d[2 * j], send = b0 ? d[2 * j] : d[2 * j + 1]; a[j] = keep + __shfl_xor(send, 1); }
#pragma unroll
    for (int j = 0; j < 2; ++j) { const float keep = b1 ? a[2 * j + 1] : a[2 * j], send = b1 ? a[2 * j] : a[2 * j + 1]; b[j] = keep + __shfl_xor(send, 2); }
    const float keep = b2 ? b[1] : b[0], send = b2 ? b[0] : b[1];
    float v = keep + __shfl_xor(send, 4);
    v += __shfl_xor(v, 8); v += __shfl_xor(v, 16); v += __shfl_xor(v, 32);
    return v;
}
constexpr int P8_LDS_SE = 0;
constexpr int P8_LDS_SW = 64 * 128 * 4;
__device__ __forceinline__ void phase8(const Params& P, LAS unsigned char* lds) {
    const int lane = threadIdx.x & 63, wave = threadIdx.x >> 6;
    const float* mod = (const float*)(P.ws + WS_MISC + MISC_MOD); const float* sspart = (const float*)(P.ws + WS_MISC + MISC_SS);
    const int* pexp = (const int*)(P.ws + WS_PAIRS); const float* pw = (const float*)(P.ws + WS_PAIRS) + (size_t)NTOK * 128;
    const unsigned char* u8 = P.ws + WS_U8 + 16 * lane; const unsigned char* v8 = P.ws + WS_V8 + 16 * lane;
    LAS unsigned* SE = (LAS unsigned*)(lds + P8_LDS_SE) + wave * 8 * 128;
    LAS float* SW = (LAS float*)(lds + P8_LDS_SW) + wave * 8 * 128;
    LAS float* SD = SW;
    const int tok0 = blockIdx.x * 64 + wave * 8;
    const int b = tok0 >> 11; const float* mrow = mod + (size_t)b * NMOD;
    const unsigned long long ltmask = (1ull << lane) - 1ull;
    f32x2 hp[8][8]; int offv[8]; float gsave0[8], gsave1[8];
#pragma unroll
    for (int t = 0; t < 8; ++t) {
        const int tok = tok0 + t;
        float tot = 0.f;
#pragma unroll
        for (int i = 0; i < 4; ++i) { const f32x4 sp = *(const f32x4*)(sspart + (size_t)tok * 16 + 4 * i); tot += (sp.x + sp.y) + (sp.z + sp.w); }
        const float inv = rsqrtf(tot * (1.0f / 1024.0f) + 1e-6f);
#pragma unroll
        for (int j = 0; j < 4; ++j) {
            const int col = 16 * lane + 4 * j;
            const f32x4 x1 = *(const f32x4*)(P.out + (size_t)tok * 1024 + col);
            const f32x4 gn = *(const f32x4*)(P.norm2_g + col), sc2 = *(const f32x4*)(mrow + 4 * 1024 + col), sh2 = *(const f32x4*)(mrow + 3 * 1024 + col);
            const f32x4 h = x1 * inv * gn * (sc2 + 1.0f) + sh2;
            hp[t][2 * j] = (f32x2){h.x, h.y}; hp[t][2 * j + 1] = (f32x2){h.z, h.w};
        }
        const int e0 = pexp[(size_t)tok * 128 + lane], e1 = pexp[(size_t)tok * 128 + 64 + lane];
        const float g0 = pw[(size_t)tok * 128 + lane], g1 = pw[(size_t)tok * 128 + 64 + lane];
        const int r0 = e0 >> 11, r1 = e1 >> 11;
        int base = 0, pos0 = 0, pos1 = 0, ov = 0;
#pragma unroll
        for (int rho = 0; rho < 8; ++rho) {
            const unsigned long long m0 = __ballot(r0 == rho), m1 = __ballot(r1 == rho);
            const int c0 = __popcll(m0), c1 = __popcll(m1);
            if (r0 == rho) pos0 = base + __popcll(m0 & ltmask);
            if (r1 == rho) pos1 = base + c0 + __popcll(m1 & ltmask);
            if (lane == rho) ov = base;
            base += c0 + c1;
        }
        if (lane >= 8) ov = 128;
        offv[t] = ov;
        SE[t * 128 + pos0] = (unsigned)e0; SE[t * 128 + pos1] = (unsigned)e1;
        SW[t * 128 + pos0] = g0; SW[t * 128 + pos1] = g1;
    }
    asm volatile("s_waitcnt lgkmcnt(0)" ::: "memory");
#pragma unroll
    for (int t = 0; t < 8; ++t) { gsave0[t] = SW[t * 128 + lane]; gsave1[t] = SW[t * 128 + 64 + lane]; }
    asm volatile("s_waitcnt lgkmcnt(0)" ::: "memory");
    for (int rho = 0; rho < 8; ++rho) {
#pragma unroll
        for (int t = 0; t < 8; ++t) {
            const int beg = __builtin_amdgcn_readlane(offv[t], rho), end = __builtin_amdgcn_readlane(offv[t], rho + 1);
            for (int c = beg; c < end; c += 8) {
                const int li = c + (lane & 7); const int e8 = (int)SE[t * 128 + (li < end ? li : end - 1)];
                u32x4 r[8];
#pragma unroll
                for (int i = 0; i < 8; ++i) { const int e = __builtin_amdgcn_readlane(e8, i); r[i] = *(const u32x4*)(u8 + (size_t)e * 1024); }
                float d[8];
#pragma unroll
                for (int i = 0; i < 8; ++i) d[i] = dot16_fp8(r[i], hp[t]);
                const float v = reduce8(d, lane);
                if (lane < 8 && li < end) SD[t * 128 + li] = v;
            }
        }
    }
    asm volatile("s_waitcnt lgkmcnt(0)" ::: "memory");
#pragma unroll
    for (int t = 0; t < 8; ++t) {
        const float d0 = SD[t * 128 + lane], d1 = SD[t * 128 + 64 + lane];
        const float w0 = gsave0[t] * gelu_tanh(d0 * (1.0f / U8_SCALE)), w1 = gsave1[t] * gelu_tanh(d1 * (1.0f / U8_SCALE));
        asm volatile("s_waitcnt lgkmcnt(0)" ::: "memory");
        SW[t * 128 + lane] = w0; SW[t * 128 + 64 + lane] = w1;
    }
    asm volatile("s_waitcnt lgkmcnt(0)" ::: "memory");
    f32x2 acc[8][8];
#pragma unroll
    for (int t = 0; t < 8; ++t)
#pragma unroll
        for (int j = 0; j < 8; ++j) acc[t][j] = (f32x2){0.f, 0.f};
    for (int rho = 0; rho < 8; ++rho) {
#pragma unroll
        for (int t = 0; t < 8; ++t) {
            const int beg = __builtin_amdgcn_readlane(offv[t], rho), end = __builtin_amdgcn_readlane(offv[t], rho + 1);
            for (int c = beg; c < end; c += 8) {
                const int li = c + (lane & 7); const int lc = (li < end ? li : end - 1);
                const int e8 = (int)SE[t * 128 + lc]; const float w8 = (li < end) ? SW[t * 128 + lc] : 0.f;
                u32x4 r[8];
#pragma unroll
                for (int i = 0; i < 8; ++i) { const int e = __builtin_amdgcn_readlane(e8, i); r[i] = *(const u32x4*)(v8 + (size_t)e * 1024); }
#pragma unroll
                for (int i = 0; i < 8; ++i) { const float w = __int_as_float(__builtin_amdgcn_readlane(__float_as_int(w8), i)); axpy16_fp8(r[i], w, acc[t]); }
            }
        }
    }
#pragma unroll
    for (int t = 0; t < 8; ++t) {
        const int tok = tok0 + t;
        float ss = 0.f; f32x4 xo[4];
#pragma unroll
        for (int j = 0; j < 4; ++j) {
            const int col = 16 * lane + 4 * j;
            const f32x4 x1 = *(const f32x4*)(P.out + (size_t)tok * 1024 + col);
            const f32x4 g2 = *(const f32x4*)(mrow + 5 * 1024 + col) * (1.0f / V8_SCALE);
            const f32x4 pa = (f32x4){acc[t][2 * j].x, acc[t][2 * j].y, acc[t][2 * j + 1].x, acc[t][2 * j + 1].y};
            xo[j] = x1 + g2 * pa;
            ss += (xo[j].x * xo[j].x + xo[j].y * xo[j].y) + (xo[j].z * xo[j].z + xo[j].w * xo[j].w);
        }
        ss = wave_sum(ss);
        const float inv2 = rsqrtf(ss * (1.0f / 1024.0f) + 1e-6f);
#pragma unroll
        for (int j = 0; j < 4; ++j) {
            const int col = 16 * lane + 4 * j;
            const f32x4 fg = *(const f32x4*)(P.final_g + col);
            *(f32x4*)(P.out + (size_t)tok * 1024 + col) = xo[j] * inv2 * fg;
        }
    }
}
constexpr int LDS_BARST = 147456 - 16;
typedef __attribute__((address_space(4))) const Params* KParamsPtr;
#if defined(__HIP_DEVICE_COMPILE__)
#define LOADP(name) Params name; { KParamsPtr q_ = (KParamsPtr)__builtin_amdgcn_kernarg_segment_ptr(); asm volatile("" : "+s"(q_)); name = *q_; }
#else
#define LOADP(name) Params name = P;
#endif
__global__ void __launch_bounds__(512, 2) k_mega(Params P) {
    extern __shared__ __attribute__((aligned(16))) unsigned char lds_raw[];
    LAS unsigned char* lds = (LAS unsigned char*)lds_raw;
    const int lo = P.ph_lo, hi = P.ph_hi;
    const bool fused = (hi - lo) > 1;
    XcdBarrier bar; bar.bar = (unsigned*)(P.ws + WS_MISC + MISC_BAR); bar.x = 0; bar.st = (volatile LAS unsigned*)(lds + LDS_BARST);
    if (fused) {
        if (threadIdx.x < 4) ((LAS unsigned*)(lds + LDS_BARST))[threadIdx.x] = 0u;
        __syncthreads();
        bar = xcd_barrier_post((unsigned*)(P.ws + WS_MISC + MISC_BAR), (volatile LAS unsigned*)(lds + LDS_BARST));
    }
#ifndef REPMASK
#define REPMASK 0
#endif
#define IN(k) (lo <= (k) && (k) < hi)
#define REP(k, call) do { if (fused && ((REPMASK >> (k)) & 1)) { xcd_barrier(bar); call; } } while (0)
#define SEAM(k) do { if (fused && IN(k) && IN((k) + 1)) xcd_barrier(bar); } while (0)
    if (IN(0)) { LOADP(Pk); phase0(Pk, lds); REP(0, phase0(Pk, lds)); }
    if (fused && IN(0) && IN(1)) { cg::this_grid().sync(); }
    if (IN(1)) { LOADP(Pk); phase1(Pk, lds); REP(1, phase1(Pk, lds)); }
    SEAM(1);
    if (IN(2)) { LOADP(Pk); phase2(Pk, lds); REP(2, phase2(Pk, lds)); }
    SEAM(2);
    if (IN(3)) { LOADP(Pk); phase3(Pk, lds); REP(3, phase3(Pk, lds)); }
    SEAM(3);
    if (IN(4)) { LOADP(Pk); phase4(Pk, lds); REP(4, phase4(Pk, lds)); }
    SEAM(4);
    if (IN(5)) { LOADP(Pk); phase5(Pk, lds); REP(5, phase5(Pk, lds)); }
    SEAM(5);
    if (IN(6)) { LOADP(Pk); phase6(Pk, lds); REP(6, phase6(Pk, lds)); }
    SEAM(6);
    if (IN(7)) { LOADP(Pk); phase7(Pk, lds); REP(7, phase7(Pk, lds)); }
    SEAM(7);
    if (IN(8)) { LOADP(Pk); phase8(Pk, lds); REP(8, phase8(Pk, lds)); }
#undef IN
#undef SEAM
}
extern "C" void kernel_launch(void* const* d_in, const int* in_sizes, int n_in, void* d_out, int out_size, void* d_ws, size_t ws_size, hipStream_t stream) {
    static int grid = 0;
    if (!grid) {
        (void)hipFuncSetAttribute((const void*)k_mega, hipFuncAttributeMaxDynamicSharedMemorySize, LDS_BYTES);
        int dev = 0, cus = 0, per_cu = 0;
        (void)hipGetDevice(&dev);
        (void)hipDeviceGetAttribute(&cus, hipDeviceAttributeMultiprocessorCount, dev);
        (void)hipOccupancyMaxActiveBlocksPerMultiprocessor(&per_cu, (const void*)k_mega, 512, LDS_BYTES);
        grid = (per_cu >= 1 && cus >= 256) ? 256 : -1;
    }
    if (grid < 0) return;
    (void)hipMemsetAsync((char*)d_ws + WS_MISC + MISC_BAR, 0, XCD_BAR_WORDS * 4, stream);
    Params P{};
    const float** pp = (const float**)&P;
    for (int i = 0; i < 26; ++i) pp[i] = (const float*)d_in[i];
    P.out = (float*)d_out; P.ws = (unsigned char*)d_ws; P.ph_lo = 0; P.ph_hi = 9;
    void* args[] = {&P};
    (void)hipLaunchCooperativeKernel((const void*)k_mega, dim3(grid), dim3(512), args, LDS_BYTES, stream);
}
```

```cpp
#define REPMASK 0
#define P0REP 0
#include <hip/hip_runtime.h>
#include <hip/hip_cooperative_groups.h>
#include <stdint.h>
#include <math.h>
namespace cg = cooperative_groups;

#define DM 1024
#define NB 8
#define SEQ 2048
#define CTXL 256
#define NTOK (NB * SEQ)
#define NCTX (NB * CTXL)
#define NMOD 6144
#define MiB (1024ull * 1024ull)
#define LAS __attribute__((address_space(3)))
typedef unsigned short bf16_t;
typedef short bf16x8 __attribute__((ext_vector_type(8)));
typedef float f32x4 __attribute__((ext_vector_type(4)));
typedef float f32x2 __attribute__((ext_vector_type(2)));
typedef unsigned u32x4 __attribute__((ext_vector_type(4)));
typedef unsigned u32x2 __attribute__((ext_vector_type(2)));

__device__ __forceinline__ float gelu_tanh(float x) {
    const float c = 0.7978845608028654f;
    return 0.5f * x * (1.0f + tanhf(c * (x + 0.044715f * x * x * x)));
}
__device__ __forceinline__ float sigmoidf_(float x) { return 1.0f / (1.0f + expf(-x)); }
__device__ __forceinline__ float silu_(float x) { return x * sigmoidf_(x); }
__device__ __forceinline__ float wave_sum(float v) {
#pragma unroll
    for (int o = 32; o > 0; o >>= 1) v += __shfl_xor(v, o);
    return v;
}
__device__ __forceinline__ unsigned cvt_pk_bf16(float lo, float hi) { unsigned r; asm volatile("v_cvt_pk_bf16_f32 %0, %1, %2" : "=v"(r) : "v"(lo), "v"(hi)); return r; }
__device__ __forceinline__ float bf2f(bf16_t v) { return __uint_as_float(((unsigned)v) << 16); }
__device__ __forceinline__ float bflo(unsigned w) { return __uint_as_float(w << 16); }
__device__ __forceinline__ float bfhi(unsigned w) { return __uint_as_float(w & 0xffff0000u); }
#define XB_TMO      128
#define XB_XCNT(j)  (256  + 64 * (j))
#define XB_XSUB(j)  (1280 + 64 * (j))
#define XB_XGEN(j)  (2304 + 64 * (j))
#define XB_TOP      3328
#define XB_TOPGEN   3392
#define XCD_BAR_WORDS 3456
#define XB_SPIN_CAP (1u << 18)
__device__ __forceinline__ unsigned xb_ld(unsigned* p)              { return __hip_atomic_load(p, __ATOMIC_RELAXED, __HIP_MEMORY_SCOPE_AGENT); }
__device__ __forceinline__ unsigned xb_add(unsigned* p, unsigned v) { return __hip_atomic_fetch_add(p, v, __ATOMIC_RELAXED, __HIP_MEMORY_SCOPE_AGENT); }
__device__ __forceinline__ unsigned xb_xcc_id() { return (unsigned)__builtin_amdgcn_s_getreg((3 << 11) | 20) & 0xFu; }
#define XB_SPIN(cond, bar) do { unsigned _sp = 0; while (cond) { __builtin_amdgcn_s_sleep(1); \
    if ((++_sp & 255u) == 0u) { if (xb_ld(&(bar)[XB_TMO])) break; if (_sp > XB_SPIN_CAP) { atomicAdd(&(bar)[XB_TMO], 1u); break; } } } } while (0)
struct XcdBarrier { unsigned* bar; unsigned x; volatile LAS unsigned* st; };
__device__ __forceinline__ XcdBarrier xcd_barrier_post(unsigned* bar, volatile LAS unsigned* st) {
    XcdBarrier b; b.bar = bar; b.x = xb_xcc_id(); b.st = st;
    if (threadIdx.x == 0) (void)xb_add(&bar[XB_XCNT(b.x)], 1u);
    return b;
}
__device__ __forceinline__ void xcd_barrier_complete(unsigned* bar, unsigned x, unsigned& nloc, unsigned& nx) {
    const unsigned G = gridDim.x * gridDim.y * gridDim.z;
    unsigned sum, cnt, mine, sp = 0u;
    for (;;) {
        sum = 0u; cnt = 0u; mine = 0u;
#pragma unroll
        for (unsigned j = 0; j < 16; ++j) { const unsigned c = xb_ld(&bar[XB_XCNT(j)]); sum += c; cnt += (c > 0u) ? 1u : 0u; mine = (j == x) ? c : mine; }
        if (sum == G) break;
        __builtin_amdgcn_s_sleep(1);
        if ((++sp & 255u) == 0u) { if (xb_ld(&bar[XB_TMO])) break; if (sp > XB_SPIN_CAP) { atomicAdd(&bar[XB_TMO], 1u); break; } }
    }
    nloc = mine > 0u ? mine : 1u; nx = cnt > 0u ? cnt : 1u;
}
__device__ __forceinline__ void xcd_barrier(const XcdBarrier& b) {
    asm volatile("s_waitcnt vmcnt(0)" ::: "memory");
    __syncthreads();
    if (threadIdx.x == 0) {
        unsigned* bar = b.bar;
        __builtin_amdgcn_s_waitcnt(0);
        unsigned nloc = b.st[0], nx = b.st[1];
        if (nloc == 0u) { xcd_barrier_complete(bar, b.x, nloc, nx); b.st[0] = nloc; b.st[1] = nx; }
        const unsigned old = xb_add(&bar[XB_XSUB(b.x)], 1u);
        const unsigned gen = old / nloc;
        if (old + 1u == (gen + 1u) * nloc) {
            __builtin_amdgcn_fence(__ATOMIC_RELEASE, "agent");
            asm volatile("s_waitcnt vmcnt(0)" ::: "memory");
            const unsigned og = xb_add(&bar[XB_TOP], 1u);
            const unsigned tg = og / nx;
            if (og + 1u == (tg + 1u) * nx) xb_add(&bar[XB_TOPGEN], 1u);
            else XB_SPIN(xb_ld(&bar[XB_TOPGEN]) == tg, bar);
            __builtin_amdgcn_fence(__ATOMIC_ACQUIRE, "agent");
            xb_add(&bar[XB_XGEN(b.x)], 1u);
            asm volatile("s_waitcnt vmcnt(0)" ::: "memory");
        } else {
            XB_SPIN(xb_ld(&bar[XB_XGEN(b.x)]) == gen, bar);
            __builtin_amdgcn_fence(__ATOMIC_ACQUIRE, "agent");
            asm volatile("s_waitcnt vmcnt(0)" ::: "memory");
        }
    }
    __syncthreads();
}
namespace pg8 {
constexpr int BM = 256, BK = 64, HALF = 128, HTB = HALF * BK * 2, STAGE_BYTES = 8 * HTB;
__device__ __forceinline__ int lds_byte(int r, int c) { const int st = (r >> 4) * 2 + (c >> 5), rr = r & 15, cc = c & 31, ob = rr * 64 + cc * 2; return st * 1024 + (ob ^ (((ob >> 9) & 1) << 5)); }
__device__ __forceinline__ void stage_rc(int b, int& R, int& C) { const int st = b / 1024, sb = b % 1024, swz = sb ^ (((sb >> 9) & 1) << 5); R = (st >> 1) * 16 + swz / 64; C = (st & 1) * 32 + (swz % 64) / 2; }
__device__ __forceinline__ int perm32(int rho) { const int n = rho >> 4, i = rho & 15; return 8 * (i >> 2) + 4 * n + (i & 3); }
struct Unit { const char* a; const char* b; int pm, pn, z; };
struct Gemm { int lda, ldb, K; };
template <class Epi>
__device__ __forceinline__ void gemm_unit(LAS unsigned char* lds, const Gemm g, const Unit cur, const Epi& E) {
    const int tid = threadIdx.x, wid = __builtin_amdgcn_readfirstlane(tid >> 6), lane = tid & 63, wr = wid >> 2, wc = wid & 3, fr = lane & 15, fq = lane >> 4;
    const int K = g.K, nt = K / BK;
    unsigned voffA[2], voffB[2];
#pragma unroll
    for (int i = 0; i < 2; ++i) { int R, C; stage_rc(tid * 16 + i * 8192, R, C); const int Rb = Epi::PERM ? ((R & ~31) + perm32(R & 31)) : R;
        voffA[i] = (unsigned)(R * g.lda + C) * 2u; voffB[i] = (unsigned)(Rb * g.ldb + C) * 2u; }
    const size_t kstep = (size_t)(BK * 2);
    const size_t hstepA = (size_t)HALF * g.lda * 2, hstepB = (size_t)HALF * g.ldb * 2;
    const unsigned ldsw = (unsigned)wid * 1024u;
    const int aoff = lds_byte(wr * 64 + fr, fq * 8), boff = lds_byte(wc * 32 + fr, fq * 8);
#define PG8_SA(b, h) (((b) * 2 + (h)) * HTB)
#define PG8_SB(b, h) ((4 + (b) * 2 + (h)) * HTB)
#define PG8_STAGE(bufoff, gbase, voff) do { _Pragma("unroll") for (int _i = 0; _i < 2; ++_i) \
        __builtin_amdgcn_global_load_lds((const unsigned*)((const char*)(gbase) + (voff)[_i]), (LAS unsigned*)(lds + (bufoff) + ldsw + _i * 8192), 16, 0, 0); } while (0)
#define PG8_LDA(dst, b, h) do { _Pragma("unroll") for (int m = 0; m < 4; ++m) _Pragma("unroll") for (int k = 0; k < 2; ++k) dst[m][k] = *(const LAS bf16x8*)(lds + PG8_SA(b, h) + aoff + m * 2048 + k * 1024); } while (0)
#define PG8_LDB(dst, b, h) do { _Pragma("unroll") for (int n = 0; n < 2; ++n) _Pragma("unroll") for (int k = 0; k < 2; ++k) dst[n][k] = *(const LAS bf16x8*)(lds + PG8_SB(b, h) + boff + n * 2048 + k * 1024); } while (0)
#define PG8_MMA(ai, bj, At, Bt) do { __builtin_amdgcn_s_setprio(1); _Pragma("unroll") for (int m = 0; m < 4; ++m) _Pragma("unroll") for (int n = 0; n < 2; ++n) _Pragma("unroll") for (int k = 0; k < 2; ++k) \
        acc[ai][bj][m][n] = __builtin_amdgcn_mfma_f32_16x16x32_bf16(Bt[n][k], At[m][k], acc[ai][bj][m][n], 0, 0, 0); __builtin_amdgcn_s_setprio(0); } while (0)
#define PG8_WAIT_V(n) asm volatile("s_waitcnt vmcnt(" #n ")" ::: "memory")
#define PG8_WAIT_L(n) asm volatile("s_waitcnt lgkmcnt(" #n ")" ::: "memory")
#define PG8_BAR __builtin_amdgcn_s_barrier()
#define PG8_SCHED __builtin_amdgcn_sched_barrier(0)
    f32x4 acc[2][2][4][2];
#pragma unroll
    for (int a = 0; a < 2; ++a)
#pragma unroll
        for (int b = 0; b < 2; ++b)
#pragma unroll
            for (int m = 0; m < 4; ++m)
#pragma unroll
                for (int n = 0; n < 2; ++n) acc[a][b][m][n] = (f32x4){0.f, 0.f, 0.f, 0.f};
    bf16x8 At[4][2], B0[2][2], B1[2][2];
    const char* cA = cur.a; const char* cB = cur.b;
    PG8_STAGE(PG8_SB(0, 0), cB, voffB); PG8_STAGE(PG8_SA(0, 0), cA, voffA); PG8_STAGE(PG8_SB(0, 1), cB + hstepB, voffB); PG8_STAGE(PG8_SA(0, 1), cA + hstepA, voffA);
    if (wr == 1) PG8_BAR;
    PG8_WAIT_V(4); PG8_BAR;
    PG8_STAGE(PG8_SB(1, 0), cB + kstep, voffB); PG8_STAGE(PG8_SA(1, 0), cA + kstep, voffA); PG8_STAGE(PG8_SB(1, 1), cB + hstepB + kstep, voffB);
    PG8_WAIT_V(6); PG8_BAR;
    for (int t = 0; t < nt; t += 2) {
        const bool last = (t == nt - 2);
        const char* a1 = cA + (size_t)(t + 1) * kstep;
        const char* a2 = last ? cA : cA + (size_t)(t + 2) * kstep; const char* b2 = last ? cB : cB + (size_t)(t + 2) * kstep;
        const char* a3 = a2 + kstep; const char* b3 = b2 + kstep;
        PG8_LDB(B0, 0, 0); PG8_SCHED; PG8_LDA(At, 0, 0); PG8_STAGE(PG8_SA(1, 1), a1 + hstepA, voffA);
        PG8_WAIT_L(8); PG8_BAR; PG8_WAIT_L(0); PG8_MMA(0, 0, At, B0); PG8_BAR; PG8_SCHED;
        PG8_LDB(B1, 0, 1); PG8_STAGE(PG8_SB(0, 0), b2, voffB);
        PG8_BAR; PG8_WAIT_L(0); PG8_MMA(0, 1, At, B1); PG8_BAR;
        PG8_LDA(At, 0, 1); PG8_STAGE(PG8_SA(0, 0), a2, voffA);
        PG8_BAR; PG8_WAIT_L(0); PG8_MMA(1, 0, At, B0); PG8_BAR; PG8_SCHED;
        PG8_STAGE(PG8_SB(0, 1), b2 + hstepB, voffB);
        PG8_WAIT_V(6); PG8_BAR; PG8_MMA(1, 1, At, B1); PG8_BAR;
        PG8_LDB(B0, 1, 0); PG8_SCHED; PG8_LDA(At, 1, 0); PG8_STAGE(PG8_SA(0, 1), a2 + hstepA, voffA);
        PG8_WAIT_L(8); PG8_BAR; PG8_WAIT_L(0); PG8_MMA(0, 0, At, B0); PG8_BAR; PG8_SCHED;
        PG8_LDB(B1, 1, 1); PG8_STAGE(PG8_SB(1, 0), b3, voffB);
        PG8_BAR; PG8_WAIT_L(0); PG8_MMA(0, 1, At, B1); PG8_BAR;
        PG8_LDA(At, 1, 1); PG8_STAGE(PG8_SA(1, 0), a3, voffA);
        PG8_BAR; PG8_WAIT_L(0); PG8_MMA(1, 0, At, B0); PG8_BAR; PG8_SCHED;
        PG8_STAGE(PG8_SB(1, 1), b3 + hstepB, voffB);
        PG8_WAIT_V(6); PG8_BAR; PG8_MMA(1, 1, At, B1); PG8_BAR;
    }
    if constexpr (!Epi::AFTER_DRAIN) { E(acc, cur, wr, wc, fr, fq); }
    PG8_WAIT_V(0);
    if (wr == 0) PG8_BAR;
    PG8_BAR;
    if constexpr (Epi::AFTER_DRAIN) { E.fused(acc, cur, wr, wc, fr, fq, lds, wid, lane); }
#undef PG8_SA
#undef PG8_SB
#undef PG8_STAGE
#undef PG8_LDA
#undef PG8_LDB
#undef PG8_MMA
#undef PG8_WAIT_V
#undef PG8_WAIT_L
#undef PG8_BAR
#undef PG8_SCHED
}
}
constexpr size_t WS_W1T = 0 * MiB;
constexpr size_t WS_WGLUT = 2 * MiB;
constexpr size_t WS_WOUTT = 3 * MiB;
constexpr size_t WS_WST = 5 * MiB;
constexpr size_t WS_WCST = 9 * MiB;
constexpr size_t WS_CS = 10 * MiB;
constexpr size_t WS_WENDT = 26 * MiB;
constexpr size_t WS_MAPT = 34 * MiB;
constexpr size_t WS_KTAB = 59 * MiB;
constexpr size_t WS_XB = 68 * MiB;
constexpr size_t WS_HCB = 100 * MiB;
constexpr size_t WS_AEXT = 108 * MiB;
constexpr size_t WS_FB = 144 * MiB;
constexpr size_t WS_GT = 160 * MiB;
constexpr size_t WS_CSPART = 176 * MiB;
constexpr size_t WS_E = 192 * MiB;
constexpr size_t WS_MISC = 250 * MiB;
constexpr size_t MISC_MOD = 0, MISC_POS = 256 * 1024, MISC_BIAS = 512 * 1024, MISC_BAR = 640 * 1024, MISC_EC = 704 * 1024, MISC_O1024 = 720 * 1024;

struct Params {
    const float *x, *c, *ctx, *c_ctx, *w_mod, *b_mod, *norm1_g, *norm2_g, *w_in, *w_out, *lam_re, *lam_im, *log_dt, *b_re, *b_im, *c_re, *c_im, *s5_d,
        *w_glu, *b_glu, *w_fourier, *w_q, *sub_keys, *u_tab, *v_tab, *final_g;
    float* out; unsigned char* ws; int ph_lo, ph_hi;
};
constexpr int LDS_BYTES = 147456;

__device__ __forceinline__ void p0_mod_item(const Params& P, LAS float* L, int item) {
    const int tid = threadIdx.x, w = tid >> 6, l = tid & 63;
    LAS float* act = L; LAS float* red = L + 9 * 1024;
    for (int idx = tid; idx < 9 * 1024; idx += 512) { int r = idx >> 10, k = idx & 1023; float v = (r < 8) ? P.c[r * 1024 + k] : P.c_ctx[k]; act[idx] = silu_(v); }
    __syncthreads();
    const int j = item * 64 + l;
    float acc[9];
#pragma unroll
    for (int r = 0; r < 9; ++r) acc[r] = 0.f;
    for (int k0 = w * 128; k0 < w * 128 + 128; k0 += 16) {
        float wv[16];
#pragma unroll
        for (int i = 0; i < 16; ++i) wv[i] = P.w_mod[(size_t)(k0 + i) * NMOD + j];
#pragma unroll
        for (int i = 0; i < 16; ++i)
#pragma unroll
            for (int r = 0; r < 9; ++r) acc[r] += act[r * 1024 + k0 + i] * wv[i];
    }
#pragma unroll
    for (int r = 0; r < 9; ++r) red[(w * 9 + r) * 64 + l] = acc[r];
    __syncthreads();
    float* mod = (float*)(P.ws + WS_MISC + MISC_MOD);
    for (int idx = tid; idx < 9 * 64; idx += 512) {
        int r = idx >> 6, l2 = idx & 63; float s = 0.f;
#pragma unroll
        for (int ww = 0; ww < 8; ++ww) s += red[(ww * 9 + r) * 64 + l2];
        mod[r * NMOD + item * 64 + l2] = s + P.b_mod[item * 64 + l2];
    }
}
__device__ __forceinline__ void p0_transpose_item(const float* src, int K, int N, bf16_t* dst, LAS float* L, int item) {
    const int tid = threadIdx.x; const int ntn = N / 64; const int k0 = (item / ntn) * 64, n0 = (item % ntn) * 64;
#pragma unroll
    for (int pass = 0; pass < 2; ++pass) {
        int kk = (tid >> 4) + 32 * pass, c4 = (tid & 15) * 4;
        f32x4 v = *(const f32x4*)(src + (size_t)(k0 + kk) * N + n0 + c4);
        L[kk * 65 + c4 + 0] = v.x; L[kk * 65 + c4 + 1] = v.y; L[kk * 65 + c4 + 2] = v.z; L[kk * 65 + c4 + 3] = v.w;
    }
    __syncthreads();
    const int n = tid >> 3, k8 = (tid & 7) * 8;
    u32x4 o;
    o.x = cvt_pk_bf16(L[(k8 + 0) * 65 + n], L[(k8 + 1) * 65 + n]); o.y = cvt_pk_bf16(L[(k8 + 2) * 65 + n], L[(k8 + 3) * 65 + n]);
    o.z = cvt_pk_bf16(L[(k8 + 4) * 65 + n], L[(k8 + 5) * 65 + n]); o.w = cvt_pk_bf16(L[(k8 + 6) * 65 + n], L[(k8 + 7) * 65 + n]);
    *(u32x4*)(dst + (size_t)(n0 + n) * K + k0 + k8) = o;
}
__device__ __forceinline__ void p0_ws_item(const Params& P, LAS float* L, int item) {
    const int tid = threadIdx.x; const int hs = item >> 4, k0 = (item & 15) * 64;
    LAS float* keysT = L;
    LAS float* wqT = L + 128 * 132;
    {
        f32x4 kv[8];
#pragma unroll
        for (int i = 0; i < 8; ++i) kv[i] = *(const f32x4*)(P.sub_keys + (size_t)hs * 16384 + (tid + 512 * i) * 4);
        f32x4 wv[4];
#pragma unroll
        for (int i = 0; i < 4; ++i) { const int idx = tid + 512 * i; const int kk = idx >> 5, d4 = (idx & 31) * 4; wv[i] = *(const f32x4*)(P.w_q + (size_t)(k0 + kk) * 2048 + hs * 128 + d4); }
#pragma unroll
        for (int i = 0; i < 8; ++i) { const int idx = (tid + 512 * i) * 4; const int key = idx >> 7, d = idx & 127;
            keysT[(d + 0) * 132 + key] = kv[i].x; keysT[(d + 1) * 132 + key] = kv[i].y; keysT[(d + 2) * 132 + key] = kv[i].z; keysT[(d + 3) * 132 + key] = kv[i].w; }
#pragma unroll
        for (int i = 0; i < 4; ++i) { const int idx = tid + 512 * i; const int kk = idx >> 5, d4 = (idx & 31) * 4;
            wqT[(d4 + 0) * 68 + kk] = wv[i].x; wqT[(d4 + 1) * 68 + kk] = wv[i].y; wqT[(d4 + 2) * 68 + kk] = wv[i].z; wqT[(d4 + 3) * 68 + kk] = wv[i].w; }
    }
    __syncthreads();
    const int kq = (tid & 31) * 4, kg = (tid >> 5) * 4;
    f32x4 acc[4];
#pragma unroll
    for (int i = 0; i < 4; ++i) acc[i] = (f32x4){0.f, 0.f, 0.f, 0.f};
#pragma unroll 4
    for (int d = 0; d < 128; ++d) {
        const f32x4 kv = *(const LAS f32x4*)(keysT + d * 132 + kq), wv = *(const LAS f32x4*)(wqT + d * 68 + kg);
        acc[0] = acc[0] + wv * kv.x; acc[1] = acc[1] + wv * kv.y; acc[2] = acc[2] + wv * kv.z; acc[3] = acc[3] + wv * kv.w;
    }
    bf16_t* dst = (bf16_t*)(P.ws + WS_WST) + (size_t)(hs * 128 + kq) * 1024 + k0 + kg;
#pragma unroll
    for (int i = 0; i < 4; ++i) { u32x2 o; o.x = cvt_pk_bf16(acc[i].x, acc[i].y); o.y = cvt_pk_bf16(acc[i].z, acc[i].w); *(u32x2*)(dst + (size_t)i * 1024) = o; }
}
__device__ __forceinline__ void p0_wcs_item(const Params& P, LAS float* L, int item) {
    const int tid = threadIdx.x; const int cs = item >> 4, g = (item >> 2) & 3, cb = item & 3;
    LAS float* tab = L;
    if (tid < 128) { float a = (float)tid / 64.0f; tab[tid] = cs ? -sinpif(a) : cospif(a); }
    __syncthreads();
    const int d = tid & 127, c0 = cb * 32 + (tid >> 7) * 8;
    float acc[8];
#pragma unroll
    for (int i = 0; i < 8; ++i) acc[i] = 0.f;
    const float* wf = P.w_fourier + (size_t)g * 16384 + d;
#pragma unroll 8
    for (int m = 0; m < 128; ++m) {
        const float wv = wf[m * 128];
#pragma unroll
        for (int i = 0; i < 8; ++i) acc[i] += tab[((c0 + i) * m) & 127] * wv;
    }
    const float alpha = 1.0f / sqrtf(2048.0f * 128.0f);
    bf16_t* row = (bf16_t*)(P.ws + WS_WCST) + (size_t)(cs * 512 + g * 128 + d) * 512;
#pragma unroll
    for (int g2 = 0; g2 < 4; ++g2) {
        u32x4 o = (u32x4){0u, 0u, 0u, 0u};
        if (g2 == g) { o.x = cvt_pk_bf16(acc[0] * alpha, acc[1] * alpha); o.y = cvt_pk_bf16(acc[2] * alpha, acc[3] * alpha); o.z = cvt_pk_bf16(acc[4] * alpha, acc[5] * alpha); o.w = cvt_pk_bf16(acc[6] * alpha, acc[7] * alpha); }
        *(u32x4*)(row + g2 * 128 + c0) = o;
    }
}
__device__ __forceinline__ void p0_s5_item(const Params& P, LAS float* L, int item) {
    const int tid = threadIdx.x; const int g = item >> 3, dir = (item >> 2) & 1, qd = item & 3;
    LAS float* Pr = L; LAS float* Pi = L + 33 * 64; LAS float* Bbr = L + 2 * 33 * 64; LAS float* Bbi = Bbr + 1024; LAS float* Cr = Bbi + 1024; LAS float* Ci = Cr + 1024;
    const int dg = dir * 32 + g;
    const float dt = expf(P.log_dt[dg]);
    if (tid < 64) {
        const int n = tid; const int i = dg * 64 + n;
        float lr = P.lam_re[i], li = P.lam_im[i];
        float mag = expf(lr * dt); float ar = mag * cosf(li * dt), ai = mag * sinf(li * dt);
        float den = lr * lr + li * li;
        float cr = ((ar - 1.0f) * lr + ai * li) / den, ci = (ai * lr - (ar - 1.0f) * li) / den;
        for (int q = 0; q < 16; ++q) {
            float br = P.b_re[(size_t)i * 16 + q], bi = P.b_im[(size_t)i * 16 + q];
            Bbr[n * 16 + q] = cr * br - ci * bi; Bbi[n * 16 + q] = cr * bi + ci * br;
        }
    }
    for (int idx = tid; idx < 33 * 64; idx += 512) {
        int tau = idx >> 6, n = idx & 63; const int i = dg * 64 + n;
        float lr = P.lam_re[i], li = P.lam_im[i];
        float mag = expf((float)tau * lr * dt), ang = (float)tau * (li * dt);
        Pr[idx] = mag * cosf(ang); Pi[idx] = mag * sinf(ang);
    }
    for (int idx = tid; idx < 1024; idx += 512) { Cr[idx] = P.c_re[(size_t)dg * 1024 + idx]; Ci[idx] = P.c_im[(size_t)dg * 1024 + idx]; }
    __syncthreads();
    {
        const int pq = tid & 255, p = pq >> 4, q = pq & 15, tau0 = qd * 8 + (tid >> 8) * 4;
        float s[4] = {0.f, 0.f, 0.f, 0.f};
#pragma unroll 4
        for (int n = 0; n < 64; ++n) {
            const float cr = Cr[p * 64 + n], ci = Ci[p * 64 + n], br = Bbr[n * 16 + q], bi = Bbi[n * 16 + q];
            const float xr = cr * br - ci * bi, xi = cr * bi + ci * br;
#pragma unroll
            for (int j = 0; j < 4; ++j) s[j] += xr * Pr[(tau0 + j) * 64 + n] - xi * Pi[(tau0 + j) * 64 + n];
        }
        float* Kt = (float*)(P.ws + WS_KTAB) + (size_t)(g * 2 + dir) * 32 * 256;
#pragma unroll
        for (int j = 0; j < 4; ++j) Kt[(tau0 + j) * 256 + pq] = s[j];
    }
    {
        bf16_t* W = (bf16_t*)(P.ws + WS_WENDT) + (size_t)(g * 256 + dir * 128 + qd * 32) * 512;
        for (int idx = tid; idx < 32 * 512 / 2; idx += 512) {
            const int row = idx >> 8, col = (idx & 255) * 2; const int n = qd * 16 + (row >> 1), ri = row & 1, s = col >> 4, q = col & 15;
            const int tau = dir ? s : (31 - s);
            const float pr = Pr[tau * 64 + n], pi = Pi[tau * 64 + n];
            const float br0 = Bbr[n * 16 + q], bi0 = Bbi[n * 16 + q], br1 = Bbr[n * 16 + q + 1], bi1 = Bbi[n * 16 + q + 1];
            const float v0 = ri ? (pr * bi0 + pi * br0) : (pr * br0 - pi * bi0), v1 = ri ? (pr * bi1 + pi * br1) : (pr * br1 - pi * bi1);
            *(unsigned*)(W + (size_t)row * 512 + col) = cvt_pk_bf16(v0, v1);
        }
    }
    {
        bf16_t* Mp = (bf16_t*)(P.ws + WS_MAPT) + ((size_t)g * 512 + qd * 128) * 768 + 512 + dir * 128;
        for (int idx = tid; idx < 128 * 64; idx += 512) {
            const int row = idx >> 6, n = idx & 63; const int t = qd * 8 + (row >> 4), p = row & 15;
            const int tau = dir ? (32 - t) : (t + 1);
            const float cr = Cr[p * 64 + n], ci = Ci[p * 64 + n], pr = Pr[tau * 64 + n], pi = Pi[tau * 64 + n];
            *(unsigned*)(Mp + (size_t)row * 768 + n * 2) = cvt_pk_bf16(cr * pr - ci * pi, -(cr * pi + ci * pr));
        }
    }
}
__device__ __forceinline__ void p0_pos_item(const Params& P) {
    float* postab = (float*)(P.ws + WS_MISC + MISC_POS);
    for (int idx = threadIdx.x; idx < 96 * 512; idx += 512) {
        int row = idx >> 9, j = idx & 511, jj = j & 255;
        float omega = 1.0f / powf(10000.0f, (float)jj / 256.0f);
        float p = (float)(row < 32 ? row : row - 32);
        float a = p * omega;
        postab[idx] = (j < 256) ? sinf(a) : cosf(a);
    }
}
__device__ __forceinline__ void tables_to_fp8(const Params& P, int wgi, int nwg);
constexpr int P0_MOD = 96, P0_TW1 = 256, P0_TGLU = 64, P0_TOUT = 256, P0_WS = 256, P0_WCS = 32, P0_S5 = 256, P0_POS = 1;
constexpr int P0_NITEMS = P0_MOD + P0_TW1 + P0_TGLU + P0_TOUT + P0_WS + P0_WCS + P0_S5 + P0_POS;
__device__ __forceinline__ void phase0(const Params& P, LAS unsigned char* lds) {
    LAS float* L = (LAS float*)lds;
    for (int it = blockIdx.x; it < P0_NITEMS; it += gridDim.x) {
        __syncthreads();
        int r = it;
        if (r < P0_S5) { p0_s5_item(P, L, r); continue; } r -= P0_S5;
        if (r < P0_WS) { p0_ws_item(P, L, r); continue; } r -= P0_WS;
        if (r < P0_MOD) { p0_mod_item(P, L, r); continue; } r -= P0_MOD;
        if (r < P0_TW1) { p0_transpose_item(P.w_in, 1024, 1024, (bf16_t*)(P.ws + WS_W1T), L, r); continue; } r -= P0_TW1;
        if (r < P0_TOUT) { p0_transpose_item(P.w_out, 1024, 1024, (bf16_t*)(P.ws + WS_WOUTT), L, r); continue; } r -= P0_TOUT;
        if (r < P0_TGLU) { p0_transpose_item(P.w_glu, 512, 512, (bf16_t*)(P.ws + WS_WGLUT), L, r); continue; } r -= P0_TGLU;
        if (r < P0_WCS) { p0_wcs_item(P, L, r); continue; } r -= P0_WCS;
        p0_pos_item(P);
    }
    __syncthreads();
    for (int i = threadIdx.x; i < 2048; i += 512) L[i] = cospif((float)i / 1024.0f);
    __syncthreads();
    bf16_t* CS = (bf16_t*)(P.ws + WS_CS);
    for (int i8 = blockIdx.x * 512 + threadIdx.x; i8 < 2 * 1024 * 1024 / 8; i8 += gridDim.x * 512) {
        const int e = i8 * 8, cs = e >> 20, k = (e >> 10) & 1023, l0 = e & 1023, sh = cs ? 512 : 0;
        float v[8];
#pragma unroll
        for (int j = 0; j < 8; ++j) v[j] = L[((k * (l0 + j)) - sh) & 2047];
        u32x4 o; o.x = cvt_pk_bf16(v[0], v[1]); o.y = cvt_pk_bf16(v[2], v[3]); o.z = cvt_pk_bf16(v[4], v[5]); o.w = cvt_pk_bf16(v[6], v[7]);
        *(u32x4*)(CS + (size_t)e) = o;
    }
}

template <bool TOK>
__device__ __forceinline__ void row_norm(int lane, const float* src, const float* posr, const float* posc, const float* gn, const float* sh, const float* sc, float* xpd, bf16_t* dst) {
    f32x4 v[4]; float ss = 0.f;
#pragma unroll
    for (int j = 0; j < 4; ++j) {
        const int col = 4 * lane + 256 * j;
        v[j] = *(const f32x4*)(src + col);
        if (TOK) { f32x4 p = (j < 2) ? *(const f32x4*)(posr + col) : *(const f32x4*)(posc + col - 512); v[j] = v[j] + p; *(f32x4*)(xpd + col) = v[j]; }
        ss += (v[j].x * v[j].x + v[j].y * v[j].y) + (v[j].z * v[j].z + v[j].w * v[j].w);
    }
    ss = wave_sum(ss);
    const float inv = rsqrtf(ss * (1.0f / 1024.0f) + 1e-6f);
#pragma unroll
    for (int j = 0; j < 4; ++j) {
        const int col = 4 * lane + 256 * j;
        f32x4 g = *(const f32x4*)(gn + col), s1 = *(const f32x4*)(sc + col), s0 = *(const f32x4*)(sh + col);
        f32x4 h = v[j] * inv * g * (s1 + 1.0f) + s0;
        u32x2 o; o.x = cvt_pk_bf16(h.x, h.y); o.y = cvt_pk_bf16(h.z, h.w);
        *(u32x2*)(dst + col) = o;
    }
}
struct EpiU {
    static constexpr bool PERM = true, AFTER_DRAIN = false;
    bf16_t* aext; bf16_t* fb; int ctx_b;
    __device__ __forceinline__ void operator()(const f32x4 (&acc)[2][2][4][2], const pg8::Unit& u, int wr, int wc, int fr, int fq) const {
#pragma unroll
        for (int ai = 0; ai < 2; ++ai)
#pragma unroll
            for (int m = 0; m < 4; ++m) {
                const int rt = 128 * ai + 64 * wr + 16 * m + fr;
#pragma unroll
                for (int bj = 0; bj < 2; ++bj) {
                    const int gcol = u.pn * 256 + 128 * bj + 32 * wc + 8 * fq;
                    const f32x4 v0 = acc[ai][bj][m][0], v1 = acc[ai][bj][m][1];
                    u32x4 w; w.x = cvt_pk_bf16(v0.x, v0.y); w.y = cvt_pk_bf16(v0.z, v0.w); w.z = cvt_pk_bf16(v1.x, v1.y); w.w = cvt_pk_bf16(v1.z, v1.w);
                    bf16_t* dst;
                    if (ctx_b >= 0) {
                        const int t = rt, g = gcol >> 4, q0 = gcol & 15, row = 512 + ctx_b * 8 + (t >> 5);
                        dst = aext + ((size_t)(g * 768 + row) * 768 + (t & 31) * 16 + q0);
                    } else {
                        const int r = u.pm * 256 + rt;
                        if (u.pn < 2) { const int b = r >> 11, t = r & 2047, g = gcol >> 4, q0 = gcol & 15, row = b * 64 + (t >> 5);
                            dst = aext + ((size_t)(g * 768 + row) * 768 + (t & 31) * 16 + q0); }
                        else dst = fb + (size_t)r * 512 + (gcol - 512);
                    }
                    *(u32x4*)dst = w;
                }
            }
    }
};
__device__ __forceinline__ void phase1(const Params& P, LAS unsigned char* lds) {
    const int tid = threadIdx.x, lane = tid & 63, wave = tid >> 6, wg = blockIdx.x;
    const float* mod = (const float*)(P.ws + WS_MISC + MISC_MOD);
    const float* postab = (const float*)(P.ws + WS_MISC + MISC_POS);
    if (wg < 16) {
        const int b = wg >> 1, pn = wg & 1;
        bf16_t* hcb = (bf16_t*)(P.ws + WS_HCB) + (size_t)wg * 256 * 1024;
        for (int j = 0; j < 32; ++j) {
            const int rr = wave * 32 + j;
            row_norm<false>(lane, P.ctx + (size_t)(b * 256 + rr) * 1024, nullptr, nullptr, P.norm1_g, mod + 8 * NMOD, mod + 8 * NMOD + 1024, nullptr, hcb + (size_t)rr * 1024);
        }
        asm volatile("s_waitcnt vmcnt(0)" ::: "memory");
        __syncthreads();
        pg8::Gemm g{1024, 1024, 1024};
        pg8::Unit u{(const char*)hcb, (const char*)((const bf16_t*)(P.ws + WS_W1T) + (size_t)pn * 256 * 1024), 0, pn, 0};
        EpiU E{(bf16_t*)(P.ws + WS_AEXT), nullptr, b};
        pg8::gemm_unit<EpiU>(lds, g, u, E);
    } else {
    const int gw = (wg - 16) * 8 + wave, ngw = (gridDim.x - 16) * 8;
    bf16_t* xb = (bf16_t*)(P.ws + WS_XB);
    for (int r = gw; r < NTOK; r += ngw) {
        const int b = r >> 11, t = r & 2047;
        row_norm<true>(lane, P.x + (size_t)r * 1024, postab + (size_t)(t >> 6) * 512, postab + (size_t)(32 + (t & 63)) * 512, P.norm1_g, mod + (size_t)b * NMOD, mod + (size_t)b * NMOD + 1024,
                       P.out + (size_t)r * 1024, xb + (size_t)r * 1024);
    }
    {
        LAS float* sh2 = (LAS float*)lds;
        for (int idx = tid; idx < 8 * 1024; idx += 512) sh2[idx] = mod[(size_t)(idx >> 10) * NMOD + 3 * 1024 + (idx & 1023)];
        __syncthreads();
        const bf16_t* WsT = (const bf16_t*)(P.ws + WS_WST);
        float* bias = (float*)(P.ws + WS_MISC + MISC_BIAS);
        for (int n = gw; n < 2048; n += ngw) {
            float acc[8];
#pragma unroll
            for (int b = 0; b < 8; ++b) acc[b] = 0.f;
#pragma unroll
            for (int j = 0; j < 2; ++j) {
                const int k0 = lane * 8 + 512 * j;
                u32x4 wv = *(const u32x4*)(WsT + (size_t)n * 1024 + k0);
                float wf[8] = {bflo(wv.x), bfhi(wv.x), bflo(wv.y), bfhi(wv.y), bflo(wv.z), bfhi(wv.z), bflo(wv.w), bfhi(wv.w)};
#pragma unroll
                for (int b = 0; b < 8; ++b)
#pragma unroll
                    for (int i = 0; i < 8; ++i) acc[b] += sh2[b * 1024 + k0 + i] * wf[i];
            }
#pragma unroll
            for (int b = 0; b < 8; ++b) { float s = wave_sum(acc[b]); if (lane == 0) bias[b * 2048 + n] = s; }
        }
    }
    {
        const float* Kt = (const float*)(P.ws + WS_KTAB);
        bf16_t* Mp = (bf16_t*)(P.ws + WS_MAPT);
        const int nthr = (gridDim.x - 16) * 512;
        for (int i8 = (wg - 16) * 512 + tid; i8 < 32 * 512 * 64; i8 += nthr) {
            const int g = i8 >> 15, row = (i8 >> 6) & 511, ch = i8 & 63; const int t = row >> 4, p = row & 15, s = ch >> 1, q8 = (ch & 1) * 8;
            f32x4 a0 = (f32x4){0.f, 0.f, 0.f, 0.f}, a1 = a0;
            if (t >= s) { const float* kp = Kt + ((size_t)((g * 2 + 0) * 32 + (t - s)) * 256 + p * 16 + q8); a0 = a0 + *(const f32x4*)kp; a1 = a1 + *(const f32x4*)(kp + 4); }
            if (s >= t) { const float* kp = Kt + ((size_t)((g * 2 + 1) * 32 + (s - t)) * 256 + p * 16 + q8); a0 = a0 + *(const f32x4*)kp; a1 = a1 + *(const f32x4*)(kp + 4); }
            u32x4 o; o.x = cvt_pk_bf16(a0.x, a0.y); o.y = cvt_pk_bf16(a0.z, a0.w); o.z = cvt_pk_bf16(a1.x, a1.y); o.w = cvt_pk_bf16(a1.z, a1.w);
            *(u32x4*)(Mp + ((size_t)(g * 512 + row) * 768 + s * 16 + q8)) = o;
        }
    }
    tables_to_fp8(P, wg - 16, gridDim.x - 16);
    }
}
__device__ __forceinline__ void phase2(const Params& P, LAS unsigned char* lds) {
    const int wg = blockIdx.x;
    const int wgid = (wg & 7) * 32 + (wg >> 3);
    const int pm = (wgid >> 5) * 8 + (wgid & 7), pn = (wgid & 31) >> 3;
    pg8::Gemm g{1024, 1024, 1024};
    pg8::Unit u{(const char*)((const bf16_t*)(P.ws + WS_XB) + (size_t)pm * 256 * 1024), (const char*)((const bf16_t*)(P.ws + WS_W1T) + (size_t)pn * 256 * 1024), pm, pn, 0};
    EpiU E{(bf16_t*)(P.ws + WS_AEXT), (bf16_t*)(P.ws + WS_FB), -1};
    pg8::gemm_unit<EpiU>(lds, g, u, E);
}

constexpr size_t WS_FOLD = WS_XB;
constexpr size_t WS_YGELU = WS_FB;
constexpr size_t WS_MIXIN = WS_XB;
struct EpiGT {
    static constexpr bool PERM = true, AFTER_DRAIN = false;
    bf16_t* gt;
    __device__ __forceinline__ void operator()(const f32x4 (&acc)[2][2][4][2], const pg8::Unit& u, int wr, int wc, int fr, int fq) const {
        const int b = u.pn >> 2;
#pragma unroll
        for (int ai = 0; ai < 2; ++ai)
#pragma unroll
            for (int m = 0; m < 4; ++m) {
                const int chp = u.pm * 256 + 128 * ai + 64 * wr + 16 * m + fr;
#pragma unroll
                for (int bj = 0; bj < 2; ++bj) {
                    const int l = (u.pn & 3) * 256 + 128 * bj + 32 * wc + 8 * fq;
                    const f32x4 v0 = acc[ai][bj][m][0], v1 = acc[ai][bj][m][1];
                    u32x4 w; w.x = cvt_pk_bf16(v0.x, v0.y); w.y = cvt_pk_bf16(v0.z, v0.w); w.z = cvt_pk_bf16(v1.x, v1.y); w.w = cvt_pk_bf16(v1.z, v1.w);
                    *(u32x4*)(gt + ((size_t)((b * 512 + (chp & 511)) * 2 + (chp >> 9)) * 1024 + l)) = w;
                }
            }
    }
};
struct EpiE {
    static constexpr bool PERM = false, AFTER_DRAIN = false;
    float* base;
    __device__ __forceinline__ void operator()(const f32x4 (&acc)[2][2][4][2], const pg8::Unit& u, int wr, int wc, int fr, int fq) const {
#pragma unroll
        for (int ai = 0; ai < 2; ++ai)
#pragma unroll
            for (int m = 0; m < 4; ++m) {
                const int rt = 128 * ai + 64 * wr + 16 * m + fr;
#pragma unroll
                for (int bj = 0; bj < 2; ++bj)
#pragma unroll
                    for (int n = 0; n < 2; ++n) *(f32x4*)(base + (size_t)rt * 256 + 128 * bj + 32 * wc + 16 * n + 4 * fq) = acc[ai][bj][m][n];
            }
    }
};
__device__ __forceinline__ unsigned bf2_add(unsigned a, unsigned b, float sg) { return cvt_pk_bf16(bflo(a) + sg * bflo(b), bfhi(a) + sg * bfhi(b)); }
__device__ __forceinline__ void phase3(const Params& P, LAS unsigned char* lds) {
    const int wg = blockIdx.x;
    if (wg < 128) {
        const int pm = wg & 3, pn = wg >> 2; const int cs = pm >> 1, b = pn >> 2, lbase = (pn & 3) * 256;
        bf16_t* fold = (bf16_t*)(P.ws + WS_FOLD) + (size_t)wg * 256 * 512;
        const bf16_t* fb = (const bf16_t*)(P.ws + WS_FB) + (size_t)b * 2048 * 512;
        const float sg = cs ? -1.0f : 1.0f;
        for (int it = threadIdx.x; it < 256 * 64; it += 512 * 4) {
            u32x4 a[4], m[4];
#pragma unroll
            for (int q = 0; q < 4; ++q) { const int i = it + 512 * q; const int row = i >> 6, ch8 = (i & 63) * 8; const int l = lbase + row;
                a[q] = *(const u32x4*)(fb + (size_t)l * 512 + ch8); m[q] = *(const u32x4*)(fb + (size_t)((2048 - l) & 2047) * 512 + ch8); }
#pragma unroll
            for (int q = 0; q < 4; ++q) { const int i = it + 512 * q; const int row = i >> 6, ch8 = (i & 63) * 8; const int l = lbase + row;
                u32x4 o;
                if (l == 0) { o = cs ? (u32x4){0u, 0u, 0u, 0u} : a[q]; }
                else { o.x = bf2_add(a[q].x, m[q].x, sg); o.y = bf2_add(a[q].y, m[q].y, sg); o.z = bf2_add(a[q].z, m[q].z, sg); o.w = bf2_add(a[q].w, m[q].w, sg); }
                *(u32x4*)(fold + (size_t)row * 512 + ch8) = o; }
        }
        asm volatile("s_waitcnt vmcnt(0)" ::: "memory");
        __syncthreads();
        pg8::Gemm g{512, 512, 512};
        pg8::Unit u{(const char*)((const bf16_t*)(P.ws + WS_WCST) + (size_t)pm * 256 * 512), (const char*)fold, pm, pn, 0};
        EpiGT E{(bf16_t*)(P.ws + WS_GT)};
        pg8::gemm_unit<EpiGT>(lds, g, u, E);
    } else if (wg < 224) {
        const int w2 = wg - 128; const int gg = w2 / 3, mt = w2 % 3;
        pg8::Gemm g{768, 512, 512};
        pg8::Unit u{(const char*)((const bf16_t*)(P.ws + WS_AEXT) + (size_t)(gg * 768 + mt * 256) * 768), (const char*)((const bf16_t*)(P.ws + WS_WENDT) + (size_t)gg * 256 * 512), mt, 0, gg};
        EpiE E{(float*)(P.ws + WS_E) + (size_t)(gg * 768 + mt * 256) * 256};
        pg8::gemm_unit<EpiE>(lds, g, u, E);
    }
    {
        const int lane = threadIdx.x & 63, wave = threadIdx.x >> 6;
        float* ecv = (float*)(P.ws + WS_MISC + MISC_EC);
        const bf16_t* WcsT = (const bf16_t*)(P.ws + WS_WCST); const bf16_t* fb = (const bf16_t*)(P.ws + WS_FB);
#pragma unroll
        for (int q = 0; q < 2; ++q) {
            const int ent = wg * 16 + wave * 2 + q; const int b = ent >> 9, ch = ent & 511, gq = ch >> 7;
            const unsigned fw = *(const unsigned*)(fb + ((size_t)b * 2048 + 1024) * 512 + gq * 128 + 2 * lane);
            const unsigned ww = *(const unsigned*)(WcsT + (size_t)ch * 512 + gq * 128 + 2 * lane);
            float e = bflo(fw) * bflo(ww) + bfhi(fw) * bfhi(ww);
            e = wave_sum(e);
            if (lane == 0) ecv[ent] = e;
        }
    }
}
struct EpiY {
    static constexpr bool PERM = true, AFTER_DRAIN = false;
    const bf16_t* arow; const float* dskip; bf16_t* yg; int g, mt, nt;
    __device__ __forceinline__ void operator()(const f32x4 (&acc)[2][2][4][2], const pg8::Unit& u, int wr, int wc, int fr, int fq) const {
#pragma unroll
        for (int ai = 0; ai < 2; ++ai)
#pragma unroll
            for (int m = 0; m < 4; ++m) {
                const int row = mt * 256 + 128 * ai + 64 * wr + 16 * m + fr; const int b = row >> 6, c = row & 63;
#pragma unroll
                for (int bj = 0; bj < 2; ++bj) {
                    const int col0 = nt * 256 + 128 * bj + 32 * wc + 8 * fq; const int t = col0 >> 4, p0 = col0 & 15;
                    const u32x4 uv = *(const u32x4*)(arow + (size_t)row * 768 + t * 16 + p0);
                    const f32x4 d0 = *(const f32x4*)(dskip + g * 16 + p0), d1 = *(const f32x4*)(dskip + g * 16 + p0 + 4);
                    const f32x4 v0 = acc[ai][bj][m][0], v1 = acc[ai][bj][m][1];
                    float y[8] = {v0.x + d0.x * bflo(uv.x), v0.y + d0.y * bfhi(uv.x), v0.z + d0.z * bflo(uv.y), v0.w + d0.w * bfhi(uv.y),
                                  v1.x + d1.x * bflo(uv.z), v1.y + d1.y * bfhi(uv.z), v1.z + d1.z * bflo(uv.w), v1.w + d1.w * bfhi(uv.w)};
#pragma unroll
                    for (int i = 0; i < 8; ++i) y[i] = gelu_tanh(y[i]);
                    u32x4 w; w.x = cvt_pk_bf16(y[0], y[1]); w.y = cvt_pk_bf16(y[2], y[3]); w.z = cvt_pk_bf16(y[4], y[5]); w.w = cvt_pk_bf16(y[6], y[7]);
                    const size_t tok = (size_t)b * 2048 + c * 32 + t;
                    *(u32x4*)(yg + tok * 512 + g * 16 + p0) = w;
                }
            }
    }
};
struct EpiP {
    static constexpr bool PERM = true, AFTER_DRAIN = false;
    bf16_t* base;
    __device__ __forceinline__ void operator()(const f32x4 (&acc)[2][2][4][2], const pg8::Unit& u, int wr, int wc, int fr, int fq) const {
#pragma unroll
        for (int ai = 0; ai < 2; ++ai)
#pragma unroll
            for (int m = 0; m < 4; ++m) {
                const int rt = 128 * ai + 64 * wr + 16 * m + fr;
#pragma unroll
                for (int bj = 0; bj < 2; ++bj) {
                    const f32x4 v0 = acc[ai][bj][m][0], v1 = acc[ai][bj][m][1];
                    u32x4 w; w.x = cvt_pk_bf16(v0.x, v0.y); w.y = cvt_pk_bf16(v0.z, v0.w); w.z = cvt_pk_bf16(v1.x, v1.y); w.w = cvt_pk_bf16(v1.z, v1.w);
                    *(u32x4*)(base + (size_t)rt * 512 + 128 * bj + 32 * wc + 8 * fq) = w;
                }
            }
    }
};
__device__ __forceinline__ void s5_carry(const Params& P, int g, int mt) {
    const int tid = threadIdx.x; const int bl = tid >> 7, dir = (tid >> 6) & 1, n = tid & 63; const int b = mt * 4 + bl;
    const int dg = dir * 32 + g, i = dg * 64 + n;
    const float dt = expf(P.log_dt[dg]); const float lr = P.lam_re[i], li = P.lam_im[i];
    const float mag = expf(32.0f * lr * dt), ang = 32.0f * (li * dt);
    const float atr = mag * cosf(ang), ati = mag * sinf(ang);
    const float* Eg = (const float*)(P.ws + WS_E) + (size_t)g * 768 * 256 + dir * 128 + n * 2;
    bf16_t* Ag = (bf16_t*)(P.ws + WS_AEXT) + (size_t)g * 768 * 768 + 512 + dir * 128 + n * 2;
    float hr = 0.f, hi = 0.f;
    {
        f32x2 e[8];
#pragma unroll
        for (int k = 0; k < 8; ++k) { const int cp = dir ? 7 - k : k; e[k] = *(const f32x2*)(Eg + (size_t)(512 + b * 8 + cp) * 256); }
#pragma unroll
        for (int k = 0; k < 8; ++k) { const float nr = atr * hr - ati * hi + e[k].x, ni = atr * hi + ati * hr + e[k].y; hr = nr; hi = ni; }
    }
    for (int k0 = 0; k0 < 64; k0 += 8) {
        f32x2 e[8];
#pragma unroll
        for (int k = 0; k < 8; ++k) { const int c = dir ? 63 - (k0 + k) : (k0 + k); e[k] = *(const f32x2*)(Eg + (size_t)(b * 64 + c) * 256); }
#pragma unroll
        for (int k = 0; k < 8; ++k) {
            const int c = dir ? 63 - (k0 + k) : (k0 + k);
            *(unsigned*)(Ag + (size_t)(b * 64 + c) * 768) = cvt_pk_bf16(hr, hi);
            const float nr = atr * hr - ati * hi + e[k].x, ni = atr * hi + ati * hr + e[k].y; hr = nr; hi = ni;
        }
    }
}
__device__ __forceinline__ void phase4(const Params& P, LAS unsigned char* lds) {
    const int wg = blockIdx.x;
    if (wg < 128) {
        const int gg = wg >> 2, mt = (wg >> 1) & 1, nt = wg & 1;
        s5_carry(P, gg, mt);
        asm volatile("s_waitcnt vmcnt(0)" ::: "memory");
        __syncthreads();
        const bf16_t* Ag = (const bf16_t*)(P.ws + WS_AEXT) + (size_t)gg * 768 * 768;
        pg8::Gemm g{768, 768, 768};
        pg8::Unit u{(const char*)(Ag + (size_t)mt * 256 * 768), (const char*)((const bf16_t*)(P.ws + WS_MAPT) + (size_t)(gg * 512 + nt * 256) * 768), mt, nt, gg};
        EpiY E{Ag, P.s5_d, (bf16_t*)(P.ws + WS_YGELU), gg, mt, nt};
        pg8::gemm_unit<EpiY>(lds, g, u, E);
    }
    else {
        const int idx = wg - 128; const int b = idx & 7, j = idx >> 3; const int cs = j >> 3, mt = (j >> 1) & 3, nt = j & 1;
        pg8::Gemm g{1024, 2048, 1024};
        pg8::Unit u{(const char*)((const bf16_t*)(P.ws + WS_CS) + (size_t)(cs * 1024 + mt * 256) * 1024),
                    (const char*)((const bf16_t*)(P.ws + WS_GT) + ((size_t)(b * 512 + nt * 256) * 2 + cs) * 1024), mt, nt, b};
        EpiP E{(bf16_t*)(P.ws + WS_CSPART) + ((size_t)(cs * 8 + b) * 1024 + mt * 256) * 512 + nt * 256};
        pg8::gemm_unit<EpiP>(lds, g, u, E);
    }
    {
        const int lane = threadIdx.x & 63, wave = threadIdx.x >> 6;
        const float* ecv = (const float*)(P.ws + WS_MISC + MISC_EC); float* o1024 = (float*)(P.ws + WS_MISC + MISC_O1024);
        const bf16_t* GT = (const bf16_t*)(P.ws + WS_GT);
#pragma unroll
        for (int q = 0; q < 2; ++q) {
            const int ent = wg * 16 + wave * 2 + q; const int b = ent >> 9, ch = ent & 511;
            const u32x4 g0 = *(const u32x4*)(GT + (size_t)(b * 512 + ch) * 2048 + 16 * lane), g1 = *(const u32x4*)(GT + (size_t)(b * 512 + ch) * 2048 + 16 * lane + 8);
            float s = (bflo(g0.x) - bfhi(g0.x)) + (bflo(g0.y) - bfhi(g0.y)) + (bflo(g0.z) - bfhi(g0.z)) + (bflo(g0.w) - bfhi(g0.w))
                    + (bflo(g1.x) - bfhi(g1.x)) + (bflo(g1.y) - bfhi(g1.y)) + (bflo(g1.z) - bfhi(g1.z)) + (bflo(g1.w) - bfhi(g1.w));
            s = wave_sum(s);
            if (lane == 0) o1024[ent] = s + ecv[ent];
        }
    }
}
struct EpiGlu {
    static constexpr bool PERM = true, AFTER_DRAIN = false;
    const bf16_t* yg; const float* bglu; bf16_t* mixin;
    __device__ __forceinline__ void operator()(const f32x4 (&acc)[2][2][4][2], const pg8::Unit& u, int wr, int wc, int fr, int fq) const {
#pragma unroll
        for (int ai = 0; ai < 2; ++ai)
#pragma unroll
            for (int m = 0; m < 4; ++m) {
                const size_t r = (size_t)u.pm * 256 + 128 * ai + 64 * wr + 16 * m + fr;
#pragma unroll
                for (int bj = 0; bj < 2; ++bj) {
                    const int c0 = u.pn * 256 + 128 * bj + 32 * wc + 8 * fq;
                    const u32x4 yv = *(const u32x4*)(yg + r * 512 + c0);
                    const f32x4 b0 = *(const f32x4*)(bglu + c0), b1 = *(const f32x4*)(bglu + c0 + 4);
                    const f32x4 v0 = acc[ai][bj][m][0] + b0, v1 = acc[ai][bj][m][1] + b1;
                    float s[8] = {bflo(yv.x) * sigmoidf_(v0.x), bfhi(yv.x) * sigmoidf_(v0.y), bflo(yv.y) * sigmoidf_(v0.z), bfhi(yv.y) * sigmoidf_(v0.w),
                                  bflo(yv.z) * sigmoidf_(v1.x), bfhi(yv.z) * sigmoidf_(v1.y), bflo(yv.w) * sigmoidf_(v1.z), bfhi(yv.w) * sigmoidf_(v1.w)};
                    u32x4 w; w.x = cvt_pk_bf16(s[0], s[1]); w.y = cvt_pk_bf16(s[2], s[3]); w.z = cvt_pk_bf16(s[4], s[5]); w.w = cvt_pk_bf16(s[6], s[7]);
                    *(u32x4*)(mixin + r * 1024 + c0) = w;
                }
            }
    }
};
__device__ __forceinline__ void phase5(const Params& P, LAS unsigned char* lds) {
    const int wg = blockIdx.x;
    bf16_t* mixin = (bf16_t*)(P.ws + WS_MIXIN);
    if (wg < 128) {
        const int pm = wg >> 1, pn = wg & 1;
        const bf16_t* yg = (const bf16_t*)(P.ws + WS_YGELU);
        pg8::Gemm g{512, 512, 512};
        pg8::Unit u{(const char*)(yg + (size_t)pm * 256 * 512), (const char*)((const bf16_t*)(P.ws + WS_WGLUT) + (size_t)pn * 256 * 512), pm, pn, 0};
        EpiGlu E{yg, P.b_glu, mixin};
        pg8::gemm_unit<EpiGlu>(lds, g, u, E);
    } else {
        const bf16_t* Cp = (const bf16_t*)(P.ws + WS_CSPART); const bf16_t* Sp = Cp + (size_t)8 * 1024 * 512;
        const float* ecv = (const float*)(P.ws + WS_MISC + MISC_EC); const float* o1024 = (const float*)(P.ws + WS_MISC + MISC_O1024);
        for (int i8 = (wg - 128) * 512 + threadIdx.x; i8 < NTOK * 64; i8 += 128 * 512) {
            const int tok = i8 >> 6, ch = (i8 & 63) * 8; const int b = tok >> 11, k = tok & 2047;
            const f32x4 e0 = *(const f32x4*)(ecv + b * 512 + ch), e1 = *(const f32x4*)(ecv + b * 512 + ch + 4);
            float v[8];
            if (k == 1024) {
                const f32x4 o0 = *(const f32x4*)(o1024 + b * 512 + ch), o1 = *(const f32x4*)(o1024 + b * 512 + ch + 4);
                v[0] = o0.x; v[1] = o0.y; v[2] = o0.z; v[3] = o0.w; v[4] = o1.x; v[5] = o1.y; v[6] = o1.z; v[7] = o1.w;
            } else {
                const int kk = (k < 1024) ? k : 2048 - k; const float sg = (k < 1024) ? 1.0f : -1.0f, se = (kk & 1) ? -1.0f : 1.0f;
                const u32x4 c = *(const u32x4*)(Cp + ((size_t)b * 1024 + kk) * 512 + ch), s = *(const u32x4*)(Sp + ((size_t)b * 1024 + kk) * 512 + ch);
                v[0] = bflo(c.x) + sg * bflo(s.x) + se * e0.x; v[1] = bfhi(c.x) + sg * bfhi(s.x) + se * e0.y; v[2] = bflo(c.y) + sg * bflo(s.y) + se * e0.z; v[3] = bfhi(c.y) + sg * bfhi(s.y) + se * e0.w;
                v[4] = bflo(c.z) + sg * bflo(s.z) + se * e1.x; v[5] = bfhi(c.z) + sg * bfhi(s.z) + se * e1.y; v[6] = bflo(c.w) + sg * bflo(s.w) + se * e1.z; v[7] = bfhi(c.w) + sg * bfhi(s.w) + se * e1.w;
            }
            u32x4 w; w.x = cvt_pk_bf16(v[0], v[1]); w.y = cvt_pk_bf16(v[2], v[3]); w.z = cvt_pk_bf16(v[4], v[5]); w.w = cvt_pk_bf16(v[6], v[7]);
            *(u32x4*)(mixin + (size_t)tok * 1024 + 512 + ch) = w;
        }
    }
}
constexpr size_t WS_X1B = WS_AEXT;
constexpr size_t WS_PAIRS = WS_XB;
constexpr size_t MISC_SS = 1024 * 1024;
struct EpiOut {
    static constexpr bool PERM = false, AFTER_DRAIN = false;
    float* xio; const float* mod; const float* g2n; bf16_t* x1b; float* sspart;
    __device__ __forceinline__ void operator()(const f32x4 (&acc)[2][2][4][2], const pg8::Unit& u, int wr, int wc, int fr, int fq) const {
#pragma unroll
        for (int ai = 0; ai < 2; ++ai)
#pragma unroll
            for (int m = 0; m < 4; ++m) {
                const size_t r = (size_t)u.pm * 256 + 128 * ai + 64 * wr + 16 * m + fr; const int b = (int)(r >> 11);
                const float* mrow = mod + (size_t)b * NMOD;
                float ss = 0.f;
#pragma unroll
                for (int bj = 0; bj < 2; ++bj)
#pragma unroll
                    for (int n = 0; n < 2; ++n) {
                        const int col = u.pn * 256 + 128 * bj + 32 * wc + 16 * n + 4 * fq;
                        const f32x4 xp = *(const f32x4*)(xio + r * 1024 + col);
                        const f32x4 g1 = *(const f32x4*)(mrow + 2 * 1024 + col), sc2 = *(const f32x4*)(mrow + 4 * 1024 + col), gn = *(const f32x4*)(g2n + col);
                        const f32x4 x1 = xp + g1 * acc[ai][bj][m][n];
                        *(f32x4*)(xio + r * 1024 + col) = x1;
                        ss += (x1.x * x1.x + x1.y * x1.y) + (x1.z * x1.z + x1.w * x1.w);
                        const f32x4 hb = x1 * gn * (sc2 + 1.0f);
                        u32x2 o; o.x = cvt_pk_bf16(hb.x, hb.y); o.y = cvt_pk_bf16(hb.z, hb.w);
                        *(u32x2*)(x1b + r * 1024 + col) = o;
                    }
                ss += __shfl_xor(ss, 16); ss += __shfl_xor(ss, 32);
                if (fq == 0) sspart[r * 16 + u.pn * 4 + wc] = ss;
            }
    }
};
__device__ __forceinline__ void phase6(const Params& P, LAS unsigned char* lds) {
    const int wg = blockIdx.x;
    const int wgid = (wg & 7) * 32 + (wg >> 3);
    const int pm = (wgid >> 5) * 8 + (wgid & 7), pn = (wgid & 31) >> 3;
    pg8::Gemm g{1024, 1024, 1024};
    pg8::Unit u{(const char*)((const bf16_t*)(P.ws + WS_MIXIN) + (size_t)pm * 256 * 1024), (const char*)((const bf16_t*)(P.ws + WS_WOUTT) + (size_t)pn * 256 * 1024), pm, pn, 0};
    EpiOut E{P.out, (const float*)(P.ws + WS_MISC + MISC_MOD), P.norm2_g, (bf16_t*)(P.ws + WS_X1B), (float*)(P.ws + WS_MISC + MISC_SS)};
    pg8::gemm_unit<EpiOut>(lds, g, u, E);
}
__device__ __forceinline__ unsigned key_pack(float v, unsigned tag, unsigned mask) {
    unsigned b = __float_as_uint(v); b ^= (b >> 31) ? 0xffffffffu : 0x80000000u; return (b & ~mask) | tag;
}
__device__ __forceinline__ float key_val(unsigned k, unsigned mask) { unsigned b = k & ~mask; b ^= (b >> 31) ? 0x80000000u : 0xffffffffu; return __uint_as_float(b); }
__device__ const unsigned char CAND_TAB[64] = {0,1,2,3,4,5,6,7,8,9,10,11,12,13,14,15,16,17,18,19,20,21,22,23,32,33,34,35,36,48,49,50,51,64,65,66,80,81,96,97,112,113,128,144,160,176,192,208,224,240,
    255,255,255,255,255,255,255,255,255,255,255,255,255,255};
#define DPP_ROR(v, n) ((unsigned)__builtin_amdgcn_update_dpp(0, (int)(v), 0x120 + (n), 0xf, 0xf, false))
__device__ __forceinline__ unsigned row_umax(unsigned m) {
    unsigned t;
    t = DPP_ROR(m, 8); m = m > t ? m : t; t = DPP_ROR(m, 4); m = m > t ? m : t; t = DPP_ROR(m, 2); m = m > t ? m : t; t = DPP_ROR(m, 1); m = m > t ? m : t;
    return m;
}
__device__ __forceinline__ float row_fsum(float s) {
    s += __int_as_float(__builtin_amdgcn_update_dpp(0, __float_as_int(s), 0x128, 0xf, 0xf, false));
    s += __int_as_float(__builtin_amdgcn_update_dpp(0, __float_as_int(s), 0x124, 0xf, 0xf, false));
    s += __int_as_float(__builtin_amdgcn_update_dpp(0, __float_as_int(s), 0x122, 0xf, 0xf, false));
    s += __int_as_float(__builtin_amdgcn_update_dpp(0, __float_as_int(s), 0x121, 0xf, 0xf, false));
    return s;
}
#define CE(a, b) do { const unsigned hi_ = (a) > (b) ? (a) : (b), lo_ = (a) > (b) ? (b) : (a); (a) = hi_; (b) = lo_; } while (0)
__device__ __forceinline__ unsigned row_top16_of128(unsigned (&k)[8], int l16) {
    CE(k[0], k[1]); CE(k[2], k[3]); CE(k[0], k[2]); CE(k[1], k[3]); CE(k[1], k[2]); CE(k[4], k[5]); CE(k[6], k[7]); CE(k[4], k[6]); CE(k[5], k[7]); CE(k[5], k[6]); CE(k[0], k[4]); CE(k[2], k[6]); CE(k[2], k[4]); CE(k[1], k[5]); CE(k[3], k[7]); CE(k[3], k[5]); CE(k[1], k[2]); CE(k[3], k[4]); CE(k[5], k[6]);
    unsigned mine = 0u;
#pragma unroll
    for (int q = 0; q < 16; ++q) {
        const unsigned m = row_umax(k[0]);
        const bool own = (k[0] == m);
#pragma unroll
        for (int i = 0; i < 7; ++i) k[i] = own ? k[i + 1] : k[i];
        k[7] = own ? 0u : k[7];
        mine = (l16 == q) ? m : mine;
    }
    return mine;
}
__device__ __forceinline__ unsigned row_top16_of64(unsigned (&k)[4], int l16) {
    CE(k[0], k[1]); CE(k[2], k[3]); CE(k[0], k[2]); CE(k[1], k[3]); CE(k[1], k[2]);
    unsigned mine = 0u;
#pragma unroll
    for (int q = 0; q < 16; ++q) {
        const unsigned m = row_umax(k[0]);
        const bool own = (k[0] == m);
        k[0] = own ? k[1] : k[0]; k[1] = own ? k[2] : k[1]; k[2] = own ? k[3] : k[2]; k[3] = own ? 0u : k[3];
        mine = (l16 == q) ? m : mine;
    }
    return mine;
}
struct EpiTopk {
    static constexpr bool PERM = false, AFTER_DRAIN = true;
    const float* sspart; const float* bias; int* pexp; float* pw; int head;
    __device__ __forceinline__ void fused(const f32x4 (&acc)[2][2][4][2], const pg8::Unit& u, int wr, int wc, int fr, int fq, LAS unsigned char* lds, int wid, int lane) const {
        LAS float* S = (LAS float*)lds;
        LAS unsigned* TL = (LAS unsigned*)(lds + 133120) + wid * 128;
        const int dr = lane >> 4, l16 = lane & 15;
        unsigned cc[4];
#pragma unroll
        for (int k = 0; k < 4; ++k) cc[k] = CAND_TAB[l16 * 4 + k];
#pragma unroll
        for (int ai = 0; ai < 2; ++ai) {
#pragma unroll
            for (int m = 0; m < 4; ++m) {
                const int rl = 64 * wr + 16 * m + fr; const size_t r = (size_t)u.pm * 256 + 128 * ai + rl; const int b = (int)(r >> 11);
                float tot = 0.f;
#pragma unroll
                for (int i = 0; i < 4; ++i) { const f32x4 sp = *(const f32x4*)(sspart + r * 16 + 4 * i); tot += (sp.x + sp.y) + (sp.z + sp.w); }
                const float inv = rsqrtf(tot * (1.0f / 1024.0f) + 1e-6f);
#pragma unroll
                for (int bj = 0; bj < 2; ++bj)
#pragma unroll
                    for (int n = 0; n < 2; ++n) {
                        const int c = 128 * bj + 32 * wc + 16 * n + 4 * fq;
                        const f32x4 bs = *(const f32x4*)(bias + (size_t)b * 2048 + head * 256 + c);
                        const f32x4 s = acc[ai][bj][m][n] * inv + bs;
                        *(LAS f32x4*)(S + rl * 260 + c) = s;
                    }
            }
            __syncthreads();
            for (int bt = 0; bt < 4; ++bt) {
#pragma unroll
                for (int half = 0; half < 2; ++half) {
                    const int trow = wid * 16 + bt * 4 + half * 2 + (dr >> 1), side = dr & 1;
                    const LAS f32x4* sp = (const LAS f32x4*)(S + trow * 260 + side * 128 + 8 * l16);
                    const f32x4 v0 = sp[0], v1 = sp[1];
                    unsigned k[8];
                    const unsigned tg = 127u - 8u * (unsigned)l16;
                    k[0] = key_pack(v0.x, tg, 127u); k[1] = key_pack(v0.y, tg - 1u, 127u); k[2] = key_pack(v0.z, tg - 2u, 127u); k[3] = key_pack(v0.w, tg - 3u, 127u);
                    k[4] = key_pack(v1.x, tg - 4u, 127u); k[5] = key_pack(v1.y, tg - 5u, 127u); k[6] = key_pack(v1.z, tg - 6u, 127u); k[7] = key_pack(v1.w, tg - 7u, 127u);
                    const unsigned mine = row_top16_of128(k, l16);
                    TL[(half * 2 + (dr >> 1)) * 32 + side * 16 + l16] = mine;
                }
                asm volatile("s_waitcnt lgkmcnt(0)" ::: "memory");
                unsigned ck[4];
#pragma unroll
                for (int k = 0; k < 4; ++k) {
                    const unsigned code = cc[k]; const unsigned ci = (code >> 4) & 15u, cj = code & 15u;
                    const unsigned ka = TL[dr * 32 + ci], kb = TL[dr * 32 + 16 + cj];
                    const unsigned key = key_pack(key_val(ka, 127u) + key_val(kb, 127u), 255u - code, 255u);
                    ck[k] = (code == 255u) ? 0u : key;
                }
                const unsigned best = row_top16_of64(ck, l16);
                const unsigned flat = 255u - (best & 255u);
                const float bv = key_val(best, 255u);
                const float bmax = key_val(row_umax(best), 255u);
                const float e = expf(bv - bmax);
                const float sum = row_fsum(e);
                const unsigned k1s = TL[dr * 32 + (flat >> 4)], k2s = TL[dr * 32 + 16 + (flat & 15u)];
                const int idx1 = 127 - (int)(k1s & 127u), idx2 = 127 - (int)(k2s & 127u);
                const size_t tok = (size_t)u.pm * 256 + 128 * ai + wid * 16 + bt * 4 + dr;
                pexp[tok * 128 + head * 16 + l16] = idx1 * 128 + idx2; pw[tok * 128 + head * 16 + l16] = e / sum;
                asm volatile("s_waitcnt lgkmcnt(0)" ::: "memory");
            }
            __syncthreads();
        }
    }
};
__device__ __forceinline__ void phase7(const Params& P, LAS unsigned char* lds) {
    const int wg = blockIdx.x; const int x = wg & 7, li = wg >> 3;
    for (int rnd = 0; rnd < 2; ++rnd) {
        const int unit = li + 32 * rnd; const int pm = 8 * x + (unit & 7), head = unit >> 3;
        pg8::Gemm g{1024, 1024, 1024};
        pg8::Unit u{(const char*)((const bf16_t*)(P.ws + WS_X1B) + (size_t)pm * 256 * 1024), (const char*)((const bf16_t*)(P.ws + WS_WST) + (size_t)head * 256 * 1024), pm, head, 0};
        EpiTopk E{(const float*)(P.ws + WS_MISC + MISC_SS), (const float*)(P.ws + WS_MISC + MISC_BIAS), (int*)(P.ws + WS_PAIRS), (float*)(P.ws + WS_PAIRS) + (size_t)NTOK * 128, head};
        pg8::gemm_unit<EpiTopk>(lds, g, u, E);
    }
}
constexpr size_t WS_U8 = 216 * MiB;
constexpr size_t WS_V8 = 232 * MiB;
#define U8_SCALE 512.0f
#define V8_SCALE 16.0f
__device__ __forceinline__ unsigned pack4_fp8(f32x4 v, float sc) {
    v = v * sc;
    v.x = fminf(fmaxf(v.x, -448.f), 448.f); v.y = fminf(fmaxf(v.y, -448.f), 448.f); v.z = fminf(fmaxf(v.z, -448.f), 448.f); v.w = fminf(fmaxf(v.w, -448.f), 448.f);
    int t = __builtin_amdgcn_cvt_pk_fp8_f32(v.x, v.y, 0, false);
    t = __builtin_amdgcn_cvt_pk_fp8_f32(v.z, v.w, t, true);
    return (unsigned)t;
}
__device__ __forceinline__ void tables_to_fp8(const Params& P, int wgi, int nwg) {
    const int nthr = nwg * 512;
    for (int i0 = wgi * 512 + threadIdx.x; i0 < 2 * 16384 * 64; i0 += nthr * 4) {
        f32x4 v[4][4]; bool ok[4];
#pragma unroll
        for (int q = 0; q < 4; ++q) {
            const int i = i0 + q * nthr; ok[q] = i < 2 * 16384 * 64;
            const int ii = ok[q] ? i : i0; const int tab = ii >> 20, off = (ii & ((1 << 20) - 1)) * 16;
            const float* src = (tab ? P.v_tab : P.u_tab) + off;
#pragma unroll
            for (int j = 0; j < 4; ++j) v[q][j] = *(const f32x4*)(src + 4 * j);
        }
#pragma unroll
        for (int q = 0; q < 4; ++q) {
            const int i = i0 + q * nthr;
            if (ok[q]) {
                const int tab = i >> 20, off = (i & ((1 << 20) - 1)) * 16; const float sc = tab ? V8_SCALE : U8_SCALE;
                u32x4 o; o.x = pack4_fp8(v[q][0], sc); o.y = pack4_fp8(v[q][1], sc); o.z = pack4_fp8(v[q][2], sc); o.w = pack4_fp8(v[q][3], sc);
                *(u32x4*)(P.ws + (tab ? WS_V8 : WS_U8) + (size_t)off) = o;
            }
        }
    }
}
__device__ __forceinline__ float dot16_fp8(const u32x4 r, const f32x2 (&h)[8]) {
    f32x2 a = __builtin_amdgcn_cvt_pk_f32_fp8((int)r.x, false) * h[0];
    a = a + __builtin_amdgcn_cvt_pk_f32_fp8((int)r.x, true) * h[1];
    a = a + __builtin_amdgcn_cvt_pk_f32_fp8((int)r.y, false) * h[2];
    a = a + __builtin_amdgcn_cvt_pk_f32_fp8((int)r.y, true) * h[3];
    a = a + __builtin_amdgcn_cvt_pk_f32_fp8((int)r.z, false) * h[4];
    a = a + __builtin_amdgcn_cvt_pk_f32_fp8((int)r.z, true) * h[5];
    a = a + __builtin_amdgcn_cvt_pk_f32_fp8((int)r.w, false) * h[6];
    a = a + __builtin_amdgcn_cvt_pk_f32_fp8((int)r.w, true) * h[7];
    return a.x + a.y;
}
__device__ __forceinline__ void axpy16_fp8(const u32x4 r, const float w, f32x2 (&acc)[8]) {
    const f32x2 ww = (f32x2){w, w};
    acc[0] = acc[0] + __builtin_amdgcn_cvt_pk_f32_fp8((int)r.x, false) * ww;
    acc[1] = acc[1] + __builtin_amdgcn_cvt_pk_f32_fp8((int)r.x, true) * ww;
    acc[2] = acc[2] + __builtin_amdgcn_cvt_pk_f32_fp8((int)r.y, false) * ww;
    acc[3] = acc[3] + __builtin_amdgcn_cvt_pk_f32_fp8((int)r.y, true) * ww;
    acc[4] = acc[4] + __builtin_amdgcn_cvt_pk_f32_fp8((int)r.z, false) * ww;
    acc[5] = acc[5] + __builtin_amdgcn_cvt_pk_f32_fp8((int)r.z, true) * ww;
    acc[6] = acc[6] + __builtin_amdgcn_cvt_pk_f32_fp8((int)r.w, false) * ww;
    acc[7] = acc[7] + __builtin_amdgcn_cvt_pk_f32_fp8((int)r.w, true) * ww;
}
__device__ __forceinline__ float reduce16(float (&d)[16], int lane) {
    float a[8], b[4], c[2];
    const bool b0 = lane & 1, b1 = lane & 2, b2 = lane & 4, b3 = lane & 8;
#pragma unroll
    for (int j = 0; j < 8; ++j) { const float keep = b0 ? d[2 * j + 1] : d[2 * j], send = b0 ? d[2 * j] : d[2 * j + 1]; a[j] = keep + __shfl_xor(send, 1); }
#pragma unroll
    for (int j = 0; j < 4; ++j) { const float keep = b1 ? a[2 * j + 1] : a[2 * j], send = b1 ? a[2 * j] : a[2 * j + 1]; b[j] = keep + __shfl_xor(send, 2); }
#pragma unroll
    for (int j = 0; j < 2; ++j) { const float keep = b2 ? b[2 * j + 1] : b[2 * j], send = b2 ? b[2 * j] : b[2 * j + 1]; c[j] = keep + __shfl_xor(send, 4); }
    const float keep = b3 ? c[1] : c[0], send = b3 ? c[0] : c[1];
    float v = keep + __shfl_xor(send, 8);
    v += __shfl_xor(v, 16); v += __shfl_xor(v, 32);
    return v;
}
__device__ __forceinline__ float reduce8(float (&d)[8], int lane) {
    float a[4], b[2];
    const bool b0 = lane & 1, b1 = lane & 2, b2 = lane & 4;
#pragma unroll
    for (int j = 0; j < 4; ++j) { const float keep = b0 ? d[2 * j + 1] : d[2 * j], send = b0 ? d[2 * j] : d[2 * j + 1]; a[j] = keep + __shfl_xor(send, 1); }
#pragma unroll
    for (int j = 0; j < 2; ++j) { const float keep = b1 ? a[2 * j + 1] : a[2 * j], send = b1 ? a[2 * j] : a[2 * j + 1]; b[j] = keep + __shfl_xor(send, 2); }
    const float keep = b2 ? b[1] : b[0], send = b2 ? b[0] : b[1];
    float v = keep + __shfl_xor(send, 4);
    v += __shfl_xor(v, 8); v += __shfl_xor(v, 16); v += __shfl_xor(v, 32);
    return v;
}
constexpr int P8_LDS_SE = 0;
constexpr int P8_LDS_SW = 64 * 128 * 4;
__device__ __forceinline__ void phase8(const Params& P, LAS unsigned char* lds) {
    const int lane = threadIdx.x & 63, wave = threadIdx.x >> 6;
    const float* mod = (const float*)(P.ws + WS_MISC + MISC_MOD); const float* sspart = (const float*)(P.ws + WS_MISC + MISC_SS);
    const int* pexp = (const int*)(P.ws + WS_PAIRS); const float* pw = (const float*)(P.ws + WS_PAIRS) + (size_t)NTOK * 128;
    const unsigned char* u8 = P.ws + WS_U8 + 16 * lane; const unsigned char* v8 = P.ws + WS_V8 + 16 * lane;
    LAS unsigned* SE = (LAS unsigned*)(lds + P8_LDS_SE) + wave * 8 * 128;
    LAS float* SW = (LAS float*)(lds + P8_LDS_SW) + wave * 8 * 128;
    LAS float* SD = SW;
    const int tok0 = blockIdx.x * 64 + wave * 8;
    const int b = tok0 >> 11; const float* mrow = mod + (size_t)b * NMOD;
    const unsigned long long ltmask = (1ull << lane) - 1ull;
    f32x2 hp[8][8]; int offv[8]; float gsave0[8], gsave1[8];
#pragma unroll
    for (int t = 0; t < 8; ++t) {
        const int tok = tok0 + t;
        float tot = 0.f;
#pragma unroll
        for (int i = 0; i < 4; ++i) { const f32x4 sp = *(const f32x4*)(sspart + (size_t)tok * 16 + 4 * i); tot += (sp.x + sp.y) + (sp.z + sp.w); }
        const float inv = rsqrtf(tot * (1.0f / 1024.0f) + 1e-6f);
#pragma unroll
        for (int j = 0; j < 4; ++j) {
            const int col = 16 * lane + 4 * j;
            const f32x4 x1 = *(const f32x4*)(P.out + (size_t)tok * 1024 + col);
            const f32x4 gn = *(const f32x4*)(P.norm2_g + col), sc2 = *(const f32x4*)(mrow + 4 * 1024 + col), sh2 = *(const f32x4*)(mrow + 3 * 1024 + col);
            const f32x4 h = x1 * inv * gn * (sc2 + 1.0f) + sh2;
            hp[t][2 * j] = (f32x2){h.x, h.y}; hp[t][2 * j + 1] = (f32x2){h.z, h.w};
        }
        const int e0 = pexp[(size_t)tok * 128 + lane], e1 = pexp[(size_t)tok * 128 + 64 + lane];
        const float g0 = pw[(size_t)tok * 128 + lane], g1 = pw[(size_t)tok * 128 + 64 + lane];
        const int r0 = e0 >> 11, r1 = e1 >> 11;
        int base = 0, pos0 = 0, pos1 = 0, ov = 0;
#pragma unroll
        for (int rho = 0; rho < 8; ++rho) {
            const unsigned long long m0 = __ballot(r0 == rho), m1 = __ballot(r1 == rho);
            const int c0 = __popcll(m0), c1 = __popcll(m1);
            if (r0 == rho) pos0 = base + __popcll(m0 & ltmask);
            if (r1 == rho) pos1 = base + c0 + __popcll(m1 & ltmask);
            if (lane == rho) ov = base;
            base += c0 + c1;
        }
        if (lane >= 8) ov = 128;
        offv[t] = ov;
        SE[t * 128 + pos0] = (unsigned)e0; SE[t * 128 + pos1] = (unsigned)e1;
        SW[t * 128 + pos0] = g0; SW[t * 128 + pos1] = g1;
    }
    asm volatile("s_waitcnt lgkmcnt(0)" ::: "memory");
#pragma unroll
    for (int t = 0; t < 8; ++t) { gsave0[t] = SW[t * 128 + lane]; gsave1[t] = SW[t * 128 + 64 + lane]; }
    asm volatile("s_waitcnt lgkmcnt(0)" ::: "memory");
    for (int rho = 0; rho < 8; ++rho) {
#pragma unroll
        for (int t = 0; t < 8; ++t) {
            const int beg = __builtin_amdgcn_readlane(offv[t], rho), end = __builtin_amdgcn_readlane(offv[t], rho + 1);
            for (int c = beg; c < end; c += 8) {
                const int li = c + (lane & 7); const int e8 = (int)SE[t * 128 + (li < end ? li : end - 1)];
                u32x4 r[8];
#pragma unroll
                for (int i = 0; i < 8; ++i) { const int e = __builtin_amdgcn_readlane(e8, i); r[i] = *(const u32x4*)(u8 + (size_t)e * 1024); }
                float d[8];
#pragma unroll
                for (int i = 0; i < 8; ++i) d[i] = dot16_fp8(r[i], hp[t]);
                const float v = reduce8(d, lane);
                if (lane < 8 && li < end) SD[t * 128 + li] = v;
            }
        }
    }
    asm volatile("s_waitcnt lgkmcnt(0)" ::: "memory");
#pragma unroll
    for (int t = 0; t < 8; ++t) {
        const float d0 = SD[t * 128 + lane], d1 = SD[t * 128 + 64 + lane];
        const float w0 = gsave0[t] * gelu_tanh(d0 * (1.0f / U8_SCALE)), w1 = gsave1[t] * gelu_tanh(d1 * (1.0f / U8_SCALE));
        asm volatile("s_waitcnt lgkmcnt(0)" ::: "memory");
        SW[t * 128 + lane] = w0; SW[t * 128 + 64 + lane] = w1;
    }
    asm volatile("s_waitcnt lgkmcnt(0)" ::: "memory");
    f32x2 acc[8][8];
#pragma unroll
    for (int t = 0; t < 8; ++t)
#pragma unroll
        for (int j = 0; j < 8; ++j) acc[t][j] = (f32x2){0.f, 0.f};
    for (int rho = 0; rho < 8; ++rho) {
#pragma unroll
        for (int t = 0; t < 8; ++t) {
            const int beg = __builtin_amdgcn_readlane(offv[t], rho), end = __builtin_amdgcn_readlane(offv[t], rho + 1);
            for (int c = beg; c < end; c += 8) {
                const int li = c + (lane & 7); const int lc = (li < end ? li : end - 1);
                const int e8 = (int)SE[t * 128 + lc]; const float w8 = (li < end) ? SW[t * 128 + lc] : 0.f;
                u32x4 r[8];
#pragma unroll
                for (int i = 0; i < 8; ++i) { const int e = __builtin_amdgcn_readlane(e8, i); r[i] = *(const u32x4*)(v8 + (size_t)e * 1024); }
#pragma unroll
                for (int i = 0; i < 8; ++i) { const float w = __int_as_float(__builtin_amdgcn_readlane(__float_as_int(w8), i)); axpy16_fp8(r[i], w, acc[t]); }
            }
        }
    }
#pragma unroll
    for (int t = 0; t < 8; ++t) {
        const int tok = tok0 + t;
        float ss = 0.f; f32x4 xo[4];
#pragma unroll
        for (int j = 0; j < 4; ++j) {
            const int col = 16 * lane + 4 * j;
            const f32x4 x1 = *(const f32x4*)(P.out + (size_t)tok * 1024 + col);
            const f32x4 g2 = *(const f32x4*)(mrow + 5 * 1024 + col) * (1.0f / V8_SCALE);
            const f32x4 pa = (f32x4){acc[t][2 * j].x, acc[t][2 * j].y, acc[t][2 * j + 1].x, acc[t][2 * j + 1].y};
            xo[j] = x1 + g2 * pa;
            ss += (xo[j].x * xo[j].x + xo[j].y * xo[j].y) + (xo[j].z * xo[j].z + xo[j].w * xo[j].w);
        }
        ss = wave_sum(ss);
        const float inv2 = rsqrtf(ss * (1.0f / 1024.0f) + 1e-6f);
#pragma unroll
        for (int j = 0; j < 4; ++j) {
            const int col = 16 * lane + 4 * j;
            const f32x4 fg = *(const f32x4*)(P.final_g + col);
            *(f32x4*)(P.out + (size_t)tok * 1024 + col) = xo[j] * inv2 * fg;
        }
    }
}
constexpr int LDS_BARST = 147456 - 16;
typedef __attribute__((address_space(4))) const Params* KParamsPtr;
#if defined(__HIP_DEVICE_COMPILE__)
#define LOADP(name) Params name; { KParamsPtr q_ = (KParamsPtr)__builtin_amdgcn_kernarg_segment_ptr(); asm volatile("" : "+s"(q_)); name = *q_; }
#else
#define LOADP(name) Params name = P;
#endif
__global__ void __launch_bounds__(512, 2) k_mega(Params P) {
    extern __shared__ __attribute__((aligned(16))) unsigned char lds_raw[];
    LAS unsigned char* lds = (LAS unsigned char*)lds_raw;
    const int lo = P.ph_lo, hi = P.ph_hi;
    const bool fused = (hi - lo) > 1;
    XcdBarrier bar; bar.bar = (unsigned*)(P.ws + WS_MISC + MISC_BAR); bar.x = 0; bar.st = (volatile LAS unsigned*)(lds + LDS_BARST);
    if (fused) {
        if (threadIdx.x < 4) ((LAS unsigned*)(lds + LDS_BARST))[threadIdx.x] = 0u;
        __syncthreads();
        bar = xcd_barrier_post((unsigned*)(P.ws + WS_MISC + MISC_BAR), (volatile LAS unsigned*)(lds + LDS_BARST));
    }
#ifndef REPMASK
#define REPMASK 0
#endif
#define IN(k) (lo <= (k) && (k) < hi)
#define REP(k, call) do { if (fused && ((REPMASK >> (k)) & 1)) { xcd_barrier(bar); call; } } while (0)
#define SEAM(k) do { if (fused && IN(k) && IN((k) + 1)) xcd_barrier(bar); } while (0)
    if (IN(0)) { LOADP(Pk); phase0(Pk, lds); REP(0, phase0(Pk, lds)); }
    if (fused && IN(0) && IN(1)) { cg::this_grid().sync(); }
    if (IN(1)) { LOADP(Pk); phase1(Pk, lds); REP(1, phase1(Pk, lds)); }
    SEAM(1);
    if (IN(2)) { LOADP(Pk); phase2(Pk, lds); REP(2, phase2(Pk, lds)); }
    SEAM(2);
    if (IN(3)) { LOADP(Pk); phase3(Pk, lds); REP(3, phase3(Pk, lds)); }
    SEAM(3);
    if (IN(4)) { LOADP(Pk); phase4(Pk, lds); REP(4, phase4(Pk, lds)); }
    SEAM(4);
    if (IN(5)) { LOADP(Pk); phase5(Pk, lds); REP(5, phase5(Pk, lds)); }
    SEAM(5);
    if (IN(6)) { LOADP(Pk); phase6(Pk, lds); REP(6, phase6(Pk, lds)); }
    SEAM(6);
    if (IN(7)) { LOADP(Pk); phase7(Pk, lds); REP(7, phase7(Pk, lds)); }
    SEAM(7);
    if (IN(8)) { LOADP(Pk); phase8(Pk, lds); REP(8, phase8(Pk, lds)); }
#undef IN
#undef SEAM
}
extern "C" void kernel_launch(void* const* d_in, const int* in_sizes, int n_in, void* d_out, int out_size, void* d_ws, size_t ws_size, hipStream_t stream) {
    static int grid = 0;
    if (!grid) {
        (void)hipFuncSetAttribute((const void*)k_mega, hipFuncAttributeMaxDynamicSharedMemorySize, LDS_BYTES);
        int dev = 0, cus = 0, per_cu = 0;
        (void)hipGetDevice(&dev);
        (void)hipDeviceGetAttribute(&cus, hipDeviceAttributeMultiprocessorCount, dev);
        (void)hipOccupancyMaxActiveBlocksPerMultiprocessor(&per_cu, (const void*)k_mega, 512, LDS_BYTES);
        grid = (per_cu >= 1 && cus >= 256) ? 256 : -1;
    }
    if (grid < 0) return;
    (void)hipMemsetAsync((char*)d_ws + WS_MISC + MISC_BAR, 0, XCD_BAR_WORDS * 4, stream);
    Params P{};
    const float** pp = (const float**)&P;
    for (int i = 0; i < 26; ++i) pp[i] = (const float*)d_in[i];
    P.out = (float*)d_out; P.ws = (unsigned char*)d_ws; P.ph_lo = 0; P.ph_hi = 9;
    void* args[] = {&P};
    (void)hipLaunchCooperativeKernel((const void*)k_mega, dim3(grid), dim3(512), args, LDS_BYTES, stream);
}
```

```cpp
#define REPMASK 0
#define P0REP 0
#define P1REP 0
#include <hip/hip_runtime.h>
#include <hip/hip_cooperative_groups.h>
#include <stdint.h>
#include <math.h>
namespace cg = cooperative_groups;

#define DM 1024
#define NB 8
#define SEQ 2048
#define CTXL 256
#define NTOK (NB * SEQ)
#define NCTX (NB * CTXL)
#define NMOD 6144
#define MiB (1024ull * 1024ull)
#define LAS __attribute__((address_space(3)))
typedef unsigned short bf16_t;
typedef short bf16x8 __attribute__((ext_vector_type(8)));
typedef float f32x4 __attribute__((ext_vector_type(4)));
typedef float f32x2 __attribute__((ext_vector_type(2)));
typedef unsigned u32x4 __attribute__((ext_vector_type(4)));
typedef unsigned u32x2 __attribute__((ext_vector_type(2)));

__device__ __forceinline__ float gelu_tanh(float x) {
    const float c = 0.7978845608028654f;
    return 0.5f * x * (1.0f + tanhf(c * (x + 0.044715f * x * x * x)));
}
__device__ __forceinline__ float sigmoidf_(float x) { return 1.0f / (1.0f + expf(-x)); }
__device__ __forceinline__ float silu_(float x) { return x * sigmoidf_(x); }
__device__ __forceinline__ float wave_sum(float v) {
#pragma unroll
    for (int o = 32; o > 0; o >>= 1) v += __shfl_xor(v, o);
    return v;
}
__device__ __forceinline__ unsigned cvt_pk_bf16(float lo, float hi) { unsigned r; asm volatile("v_cvt_pk_bf16_f32 %0, %1, %2" : "=v"(r) : "v"(lo), "v"(hi)); return r; }
__device__ __forceinline__ float bf2f(bf16_t v) { return __uint_as_float(((unsigned)v) << 16); }
__device__ __forceinline__ float bflo(unsigned w) { return __uint_as_float(w << 16); }
__device__ __forceinline__ float bfhi(unsigned w) { return __uint_as_float(w & 0xffff0000u); }
#define XB_TMO      128
#define XB_XCNT(j)  (256  + 64 * (j))
#define XB_XSUB(j)  (1280 + 64 * (j))
#define XB_XGEN(j)  (2304 + 64 * (j))
#define XB_TOP      3328
#define XB_TOPGEN   3392
#define XCD_BAR_WORDS 3456
#define XB_SPIN_CAP (1u << 18)
__device__ __forceinline__ unsigned xb_ld(unsigned* p)              { return __hip_atomic_load(p, __ATOMIC_RELAXED, __HIP_MEMORY_SCOPE_AGENT); }
__device__ __forceinline__ unsigned xb_add(unsigned* p, unsigned v) { return __hip_atomic_fetch_add(p, v, __ATOMIC_RELAXED, __HIP_MEMORY_SCOPE_AGENT); }
__device__ __forceinline__ unsigned xb_xcc_id() { return (unsigned)__builtin_amdgcn_s_getreg((3 << 11) | 20) & 0xFu; }
#define XB_SPIN(cond, bar) do { unsigned _sp = 0; while (cond) { __builtin_amdgcn_s_sleep(1); \
    if ((++_sp & 255u) == 0u) { if (xb_ld(&(bar)[XB_TMO])) break; if (_sp > XB_SPIN_CAP) { atomicAdd(&(bar)[XB_TMO], 1u); break; } } } } while (0)
struct XcdBarrier { unsigned* bar; unsigned x; volatile LAS unsigned* st; };
__device__ __forceinline__ XcdBarrier xcd_barrier_post(unsigned* bar, volatile LAS unsigned* st) {
    XcdBarrier b; b.bar = bar; b.x = xb_xcc_id(); b.st = st;
    if (threadIdx.x == 0) (void)xb_add(&bar[XB_XCNT(b.x)], 1u);
    return b;
}
__device__ __forceinline__ void xcd_barrier_complete(unsigned* bar, unsigned x, unsigned& nloc, unsigned& nx) {
    const unsigned G = gridDim.x * gridDim.y * gridDim.z;
    unsigned sum, cnt, mine, sp = 0u;
    for (;;) {
        sum = 0u; cnt = 0u; mine = 0u;
#pragma unroll
        for (unsigned j = 0; j < 16; ++j) { const unsigned c = xb_ld(&bar[XB_XCNT(j)]); sum += c; cnt += (c > 0u) ? 1u : 0u; mine = (j == x) ? c : mine; }
        if (sum == G) break;
        __builtin_amdgcn_s_sleep(1);
        if ((++sp & 255u) == 0u) { if (xb_ld(&bar[XB_TMO])) break; if (sp > XB_SPIN_CAP) { atomicAdd(&bar[XB_TMO], 1u); break; } }
    }
    nloc = mine > 0u ? mine : 1u; nx = cnt > 0u ? cnt : 1u;
}
__device__ __forceinline__ void xcd_barrier(const XcdBarrier& b) {
    asm volatile("s_waitcnt vmcnt(0)" ::: "memory");
    __syncthreads();
    if (threadIdx.x == 0) {
        unsigned* bar = b.bar;
        __builtin_amdgcn_s_waitcnt(0);
        unsigned nloc = b.st[0], nx = b.st[1];
        if (nloc == 0u) { xcd_barrier_complete(bar, b.x, nloc, nx); b.st[0] = nloc; b.st[1] = nx; }
        const unsigned old = xb_add(&bar[XB_XSUB(b.x)], 1u);
        const unsigned gen = old / nloc;
        if (old + 1u == (gen + 1u) * nloc) {
            __builtin_amdgcn_fence(__ATOMIC_RELEASE, "agent");
            asm volatile("s_waitcnt vmcnt(0)" ::: "memory");
            const unsigned og = xb_add(&bar[XB_TOP], 1u);
            const unsigned tg = og / nx;
            if (og + 1u == (tg + 1u) * nx) xb_add(&bar[XB_TOPGEN], 1u);
            else XB_SPIN(xb_ld(&bar[XB_TOPGEN]) == tg, bar);
            __builtin_amdgcn_fence(__ATOMIC_ACQUIRE, "agent");
            xb_add(&bar[XB_XGEN(b.x)], 1u);
            asm volatile("s_waitcnt vmcnt(0)" ::: "memory");
        } else {
            XB_SPIN(xb_ld(&bar[XB_XGEN(b.x)]) == gen, bar);
            __builtin_amdgcn_fence(__ATOMIC_ACQUIRE, "agent");
            asm volatile("s_waitcnt vmcnt(0)" ::: "memory");
        }
    }
    __syncthreads();
}
namespace pg8 {
constexpr int BM = 256, BK = 64, HALF = 128, HTB = HALF * BK * 2, STAGE_BYTES = 8 * HTB;
__device__ __forceinline__ int lds_byte(int r, int c) { const int st = (r >> 4) * 2 + (c >> 5), rr = r & 15, cc = c & 31, ob = rr * 64 + cc * 2; return st * 1024 + (ob ^ (((ob >> 9) & 1) << 5)); }
__device__ __forceinline__ void stage_rc(int b, int& R, int& C) { const int st = b / 1024, sb = b % 1024, swz = sb ^ (((sb >> 9) & 1) << 5); R = (st >> 1) * 16 + swz / 64; C = (st & 1) * 32 + (swz % 64) / 2; }
__device__ __forceinline__ int perm32(int rho) { const int n = rho >> 4, i = rho & 15; return 8 * (i >> 2) + 4 * n + (i & 3); }
struct Unit { const char* a; const char* b; int pm, pn, z; };
struct Gemm { int lda, ldb, K; };
template <class Epi>
__device__ __forceinline__ void gemm_unit(LAS unsigned char* lds, const Gemm g, const Unit cur, const Epi& E) {
    const int tid = threadIdx.x, wid = __builtin_amdgcn_readfirstlane(tid >> 6), lane = tid & 63, wr = wid >> 2, wc = wid & 3, fr = lane & 15, fq = lane >> 4;
    const int K = g.K, nt = K / BK;
    unsigned voffA[2], voffB[2];
#pragma unroll
    for (int i = 0; i < 2; ++i) { int R, C; stage_rc(tid * 16 + i * 8192, R, C); const int Rb = Epi::PERM ? ((R & ~31) + perm32(R & 31)) : R;
        voffA[i] = (unsigned)(R * g.lda + C) * 2u; voffB[i] = (unsigned)(Rb * g.ldb + C) * 2u; }
    const size_t kstep = (size_t)(BK * 2);
    const size_t hstepA = (size_t)HALF * g.lda * 2, hstepB = (size_t)HALF * g.ldb * 2;
    const unsigned ldsw = (unsigned)wid * 1024u;
    const int aoff = lds_byte(wr * 64 + fr, fq * 8), boff = lds_byte(wc * 32 + fr, fq * 8);
#define PG8_SA(b, h) (((b) * 2 + (h)) * HTB)
#define PG8_SB(b, h) ((4 + (b) * 2 + (h)) * HTB)
#define PG8_STAGE(bufoff, gbase, voff) do { _Pragma("unroll") for (int _i = 0; _i < 2; ++_i) \
        __builtin_amdgcn_global_load_lds((const unsigned*)((const char*)(gbase) + (voff)[_i]), (LAS unsigned*)(lds + (bufoff) + ldsw + _i * 8192), 16, 0, 0); } while (0)
#define PG8_LDA(dst, b, h) do { _Pragma("unroll") for (int m = 0; m < 4; ++m) _Pragma("unroll") for (int k = 0; k < 2; ++k) dst[m][k] = *(const LAS bf16x8*)(lds + PG8_SA(b, h) + aoff + m * 2048 + k * 1024); } while (0)
#define PG8_LDB(dst, b, h) do { _Pragma("unroll") for (int n = 0; n < 2; ++n) _Pragma("unroll") for (int k = 0; k < 2; ++k) dst[n][k] = *(const LAS bf16x8*)(lds + PG8_SB(b, h) + boff + n * 2048 + k * 1024); } while (0)
#define PG8_MMA(ai, bj, At, Bt) do { __builtin_amdgcn_s_setprio(1); _Pragma("unroll") for (int m = 0; m < 4; ++m) _Pragma("unroll") for (int n = 0; n < 2; ++n) _Pragma("unroll") for (int k = 0; k < 2; ++k) \
        acc[ai][bj][m][n] = __builtin_amdgcn_mfma_f32_16x16x32_bf16(Bt[n][k], At[m][k], acc[ai][bj][m][n], 0, 0, 0); __builtin_amdgcn_s_setprio(0); } while (0)
#define PG8_WAIT_V(n) asm volatile("s_waitcnt vmcnt(" #n ")" ::: "memory")
#define PG8_WAIT_L(n) asm volatile("s_waitcnt lgkmcnt(" #n ")" ::: "memory")
#define PG8_BAR __builtin_amdgcn_s_barrier()
#define PG8_SCHED __builtin_amdgcn_sched_barrier(0)
    f32x4 acc[2][2][4][2];
#pragma unroll
    for (int a = 0; a < 2; ++a)
#pragma unroll
        for (int b = 0; b < 2; ++b)
#pragma unroll
            for (int m = 0; m < 4; ++m)
#pragma unroll
                for (int n = 0; n < 2; ++n) acc[a][b][m][n] = (f32x4){0.f, 0.f, 0.f, 0.f};
    bf16x8 At[4][2], B0[2][2], B1[2][2];
    const char* cA = cur.a; const char* cB = cur.b;
    PG8_STAGE(PG8_SB(0, 0), cB, voffB); PG8_STAGE(PG8_SA(0, 0), cA, voffA); PG8_STAGE(PG8_SB(0, 1), cB + hstepB, voffB); PG8_STAGE(PG8_SA(0, 1), cA + hstepA, voffA);
    if (wr == 1) PG8_BAR;
    PG8_WAIT_V(4); PG8_BAR;
    PG8_STAGE(PG8_SB(1, 0), cB + kstep, voffB); PG8_STAGE(PG8_SA(1, 0), cA + kstep, voffA); PG8_STAGE(PG8_SB(1, 1), cB + hstepB + kstep, voffB);
    PG8_WAIT_V(6); PG8_BAR;
    for (int t = 0; t < nt; t += 2) {
        const bool last = (t == nt - 2);
        const char* a1 = cA + (size_t)(t + 1) * kstep;
        const char* a2 = last ? cA : cA + (size_t)(t + 2) * kstep; const char* b2 = last ? cB : cB + (size_t)(t + 2) * kstep;
        const char* a3 = a2 + kstep; const char* b3 = b2 + kstep;
        PG8_LDB(B0, 0, 0); PG8_SCHED; PG8_LDA(At, 0, 0); PG8_STAGE(PG8_SA(1, 1), a1 + hstepA, voffA);
        PG8_WAIT_L(8); PG8_BAR; PG8_WAIT_L(0); PG8_MMA(0, 0, At, B0); PG8_BAR; PG8_SCHED;
        PG8_LDB(B1, 0, 1); PG8_STAGE(PG8_SB(0, 0), b2, voffB);
        PG8_BAR; PG8_WAIT_L(0); PG8_MMA(0, 1, At, B1); PG8_BAR;
        PG8_LDA(At, 0, 1); PG8_STAGE(PG8_SA(0, 0), a2, voffA);
        PG8_BAR; PG8_WAIT_L(0); PG8_MMA(1, 0, At, B0); PG8_BAR; PG8_SCHED;
        PG8_STAGE(PG8_SB(0, 1), b2 + hstepB, voffB);
        PG8_WAIT_V(6); PG8_BAR; PG8_MMA(1, 1, At, B1); PG8_BAR;
        PG8_LDB(B0, 1, 0); PG8_SCHED; PG8_LDA(At, 1, 0); PG8_STAGE(PG8_SA(0, 1), a2 + hstepA, voffA);
        PG8_WAIT_L(8); PG8_BAR; PG8_WAIT_L(0); PG8_MMA(0, 0, At, B0); PG8_BAR; PG8_SCHED;
        PG8_LDB(B1, 1, 1); PG8_STAGE(PG8_SB(1, 0), b3, voffB);
        PG8_BAR; PG8_WAIT_L(0); PG8_MMA(0, 1, At, B1); PG8_BAR;
        PG8_LDA(At, 1, 1); PG8_STAGE(PG8_SA(1, 0), a3, voffA);
        PG8_BAR; PG8_WAIT_L(0); PG8_MMA(1, 0, At, B0); PG8_BAR; PG8_SCHED;
        PG8_STAGE(PG8_SB(1, 1), b3 + hstepB, voffB);
        PG8_WAIT_V(6); PG8_BAR; PG8_MMA(1, 1, At, B1); PG8_BAR;
    }
    if constexpr (!Epi::AFTER_DRAIN) { E(acc, cur, wr, wc, fr, fq); }
    PG8_WAIT_V(0);
    if (wr == 0) PG8_BAR;
    PG8_BAR;
    if constexpr (Epi::AFTER_DRAIN) { E.fused(acc, cur, wr, wc, fr, fq, lds, wid, lane); }
#undef PG8_SA
#undef PG8_SB
#undef PG8_STAGE
#undef PG8_LDA
#undef PG8_LDB
#undef PG8_MMA
#undef PG8_WAIT_V
#undef PG8_WAIT_L
#undef PG8_BAR
#undef PG8_SCHED
}
}
constexpr size_t WS_W1T = 0 * MiB;
constexpr size_t WS_WGLUT = 2 * MiB;
constexpr size_t WS_WOUTT = 3 * MiB;
constexpr size_t WS_WST = 5 * MiB;
constexpr size_t WS_WCST = 9 * MiB;
constexpr size_t WS_CS = 10 * MiB;
constexpr size_t WS_WENDT = 26 * MiB;
constexpr size_t WS_MAPT = 34 * MiB;
constexpr size_t WS_KTAB = 59 * MiB;
constexpr size_t WS_XB = 68 * MiB;
constexpr size_t WS_HCB = 100 * MiB;
constexpr size_t WS_AEXT = 108 * MiB;
constexpr size_t WS_FB = 144 * MiB;
constexpr size_t WS_GT = 160 * MiB;
constexpr size_t WS_CSPART = 176 * MiB;
constexpr size_t WS_E = 192 * MiB;
constexpr size_t WS_MISC = 250 * MiB;
constexpr size_t MISC_MOD = 0, MISC_POS = 256 * 1024, MISC_BIAS = 512 * 1024, MISC_BAR = 640 * 1024, MISC_EC = 704 * 1024, MISC_O1024 = 720 * 1024;

struct Params {
    const float *x, *c, *ctx, *c_ctx, *w_mod, *b_mod, *norm1_g, *norm2_g, *w_in, *w_out, *lam_re, *lam_im, *log_dt, *b_re, *b_im, *c_re, *c_im, *s5_d,
        *w_glu, *b_glu, *w_fourier, *w_q, *sub_keys, *u_tab, *v_tab, *final_g;
    float* out; unsigned char* ws; int ph_lo, ph_hi;
};
constexpr int LDS_BYTES = 147456;

__device__ __forceinline__ void p0_mod_item(const Params& P, LAS float* L, int item) {
    const int tid = threadIdx.x, w = tid >> 6, l = tid & 63;
    LAS float* act = L; LAS float* red = L + 9 * 1024;
    for (int idx = tid; idx < 9 * 1024; idx += 512) { int r = idx >> 10, k = idx & 1023; float v = (r < 8) ? P.c[r * 1024 + k] : P.c_ctx[k]; act[idx] = silu_(v); }
    __syncthreads();
    const int j = item * 64 + l;
    float acc[9];
#pragma unroll
    for (int r = 0; r < 9; ++r) acc[r] = 0.f;
    for (int k0 = w * 128; k0 < w * 128 + 128; k0 += 16) {
        float wv[16];
#pragma unroll
        for (int i = 0; i < 16; ++i) wv[i] = P.w_mod[(size_t)(k0 + i) * NMOD + j];
#pragma unroll
        for (int i = 0; i < 16; ++i)
#pragma unroll
            for (int r = 0; r < 9; ++r) acc[r] += act[r * 1024 + k0 + i] * wv[i];
    }
#pragma unroll
    for (int r = 0; r < 9; ++r) red[(w * 9 + r) * 64 + l] = acc[r];
    __syncthreads();
    float* mod = (float*)(P.ws + WS_MISC + MISC_MOD);
    for (int idx = tid; idx < 9 * 64; idx += 512) {
        int r = idx >> 6, l2 = idx & 63; float s = 0.f;
#pragma unroll
        for (int ww = 0; ww < 8; ++ww) s += red[(ww * 9 + r) * 64 + l2];
        mod[r * NMOD + item * 64 + l2] = s + P.b_mod[item * 64 + l2];
    }
}
__device__ __forceinline__ void p0_transpose_item(const float* src, int K, int N, bf16_t* dst, LAS float* L, int item) {
    const int tid = threadIdx.x; const int ntn = N / 64; const int k0 = (item / ntn) * 64, n0 = (item % ntn) * 64;
#pragma unroll
    for (int pass = 0; pass < 2; ++pass) {
        int kk = (tid >> 4) + 32 * pass, c4 = (tid & 15) * 4;
        f32x4 v = *(const f32x4*)(src + (size_t)(k0 + kk) * N + n0 + c4);
        L[kk * 65 + c4 + 0] = v.x; L[kk * 65 + c4 + 1] = v.y; L[kk * 65 + c4 + 2] = v.z; L[kk * 65 + c4 + 3] = v.w;
    }
    __syncthreads();
    const int n = tid >> 3, k8 = (tid & 7) * 8;
    u32x4 o;
    o.x = cvt_pk_bf16(L[(k8 + 0) * 65 + n], L[(k8 + 1) * 65 + n]); o.y = cvt_pk_bf16(L[(k8 + 2) * 65 + n], L[(k8 + 3) * 65 + n]);
    o.z = cvt_pk_bf16(L[(k8 + 4) * 65 + n], L[(k8 + 5) * 65 + n]); o.w = cvt_pk_bf16(L[(k8 + 6) * 65 + n], L[(k8 + 7) * 65 + n]);
    *(u32x4*)(dst + (size_t)(n0 + n) * K + k0 + k8) = o;
}
__device__ __forceinline__ void p0_ws_item(const Params& P, LAS float* L, int item) {
    const int tid = threadIdx.x; const int hs = item >> 4, k0 = (item & 15) * 64;
    LAS float* keysT = L;
    LAS float* wqT = L + 128 * 132;
    {
        f32x4 kv[8];
#pragma unroll
        for (int i = 0; i < 8; ++i) kv[i] = *(const f32x4*)(P.sub_keys + (size_t)hs * 16384 + (tid + 512 * i) * 4);
        f32x4 wv[4];
#pragma unroll
        for (int i = 0; i < 4; ++i) { const int idx = tid + 512 * i; const int kk = idx >> 5, d4 = (idx & 31) * 4; wv[i] = *(const f32x4*)(P.w_q + (size_t)(k0 + kk) * 2048 + hs * 128 + d4); }
#pragma unroll
        for (int i = 0; i < 8; ++i) { const int idx = (tid + 512 * i) * 4; const int key = idx >> 7, d = idx & 127;
            keysT[(d + 0) * 132 + key] = kv[i].x; keysT[(d + 1) * 132 + key] = kv[i].y; keysT[(d + 2) * 132 + key] = kv[i].z; keysT[(d + 3) * 132 + key] = kv[i].w; }
#pragma unroll
        for (int i = 0; i < 4; ++i) { const int idx = tid + 512 * i; const int kk = idx >> 5, d4 = (idx & 31) * 4;
            wqT[(d4 + 0) * 68 + kk] = wv[i].x; wqT[(d4 + 1) * 68 + kk] = wv[i].y; wqT[(d4 + 2) * 68 + kk] = wv[i].z; wqT[(d4 + 3) * 68 + kk] = wv[i].w; }
    }
    __syncthreads();
    const int kq = (tid & 31) * 4, kg = (tid >> 5) * 4;
    f32x4 acc[4];
#pragma unroll
    for (int i = 0; i < 4; ++i) acc[i] = (f32x4){0.f, 0.f, 0.f, 0.f};
#pragma unroll 4
    for (int d = 0; d < 128; ++d) {
        const f32x4 kv = *(const LAS f32x4*)(keysT + d * 132 + kq), wv = *(const LAS f32x4*)(wqT + d * 68 + kg);
        acc[0] = acc[0] + wv * kv.x; acc[1] = acc[1] + wv * kv.y; acc[2] = acc[2] + wv * kv.z; acc[3] = acc[3] + wv * kv.w;
    }
    bf16_t* dst = (bf16_t*)(P.ws + WS_WST) + (size_t)(hs * 128 + kq) * 1024 + k0 + kg;
#pragma unroll
    for (int i = 0; i < 4; ++i) { u32x2 o; o.x = cvt_pk_bf16(acc[i].x, acc[i].y); o.y = cvt_pk_bf16(acc[i].z, acc[i].w); *(u32x2*)(dst + (size_t)i * 1024) = o; }
}
__device__ __forceinline__ void p0_wcs_item(const Params& P, LAS float* L, int item) {
    const int tid = threadIdx.x; const int cs = item >> 4, g = (item >> 2) & 3, cb = item & 3;
    LAS float* tab = L;
    if (tid < 128) { float a = (float)tid / 64.0f; tab[tid] = cs ? -sinpif(a) : cospif(a); }
    __syncthreads();
    const int d = tid & 127, c0 = cb * 32 + (tid >> 7) * 8;
    float acc[8];
#pragma unroll
    for (int i = 0; i < 8; ++i) acc[i] = 0.f;
    const float* wf = P.w_fourier + (size_t)g * 16384 + d;
#pragma unroll 8
    for (int m = 0; m < 128; ++m) {
        const float wv = wf[m * 128];
#pragma unroll
        for (int i = 0; i < 8; ++i) acc[i] += tab[((c0 + i) * m) & 127] * wv;
    }
    const float alpha = 1.0f / sqrtf(2048.0f * 128.0f);
    bf16_t* row = (bf16_t*)(P.ws + WS_WCST) + (size_t)(cs * 512 + g * 128 + d) * 512;
#pragma unroll
    for (int g2 = 0; g2 < 4; ++g2) {
        u32x4 o = (u32x4){0u, 0u, 0u, 0u};
        if (g2 == g) { o.x = cvt_pk_bf16(acc[0] * alpha, acc[1] * alpha); o.y = cvt_pk_bf16(acc[2] * alpha, acc[3] * alpha); o.z = cvt_pk_bf16(acc[4] * alpha, acc[5] * alpha); o.w = cvt_pk_bf16(acc[6] * alpha, acc[7] * alpha); }
        *(u32x4*)(row + g2 * 128 + c0) = o;
    }
}
__device__ __forceinline__ void p0_s5_item(const Params& P, LAS float* L, int item) {
    const int tid = threadIdx.x; const int g = item >> 3, dir = (item >> 2) & 1, qd = item & 3;
    LAS float* Pr = L; LAS float* Pi = L + 33 * 64; LAS float* Bbr = L + 2 * 33 * 64; LAS float* Bbi = Bbr + 1024; LAS float* Cr = Bbi + 1024; LAS float* Ci = Cr + 1024;
    const int dg = dir * 32 + g;
    const float dt = expf(P.log_dt[dg]);
    if (tid < 64) {
        const int n = tid; const int i = dg * 64 + n;
        float lr = P.lam_re[i], li = P.lam_im[i];
        float mag = expf(lr * dt); float ar = mag * cosf(li * dt), ai = mag * sinf(li * dt);
        float den = lr * lr + li * li;
        float cr = ((ar - 1.0f) * lr + ai * li) / den, ci = (ai * lr - (ar - 1.0f) * li) / den;
        for (int q = 0; q < 16; ++q) {
            float br = P.b_re[(size_t)i * 16 + q], bi = P.b_im[(size_t)i * 16 + q];
            Bbr[n * 16 + q] = cr * br - ci * bi; Bbi[n * 16 + q] = cr * bi + ci * br;
        }
    }
    for (int idx = tid; idx < 33 * 64; idx += 512) {
        int tau = idx >> 6, n = idx & 63; const int i = dg * 64 + n;
        float lr = P.lam_re[i], li = P.lam_im[i];
        float mag = expf((float)tau * lr * dt), ang = (float)tau * (li * dt);
        Pr[idx] = mag * cosf(ang); Pi[idx] = mag * sinf(ang);
    }
    for (int idx = tid; idx < 1024; idx += 512) { Cr[idx] = P.c_re[(size_t)dg * 1024 + idx]; Ci[idx] = P.c_im[(size_t)dg * 1024 + idx]; }
    __syncthreads();
    {
        const int pq = tid & 255, p = pq >> 4, q = pq & 15, tau0 = qd * 8 + (tid >> 8) * 4;
        float s[4] = {0.f, 0.f, 0.f, 0.f};
#pragma unroll 4
        for (int n = 0; n < 64; ++n) {
            const float cr = Cr[p * 64 + n], ci = Ci[p * 64 + n], br = Bbr[n * 16 + q], bi = Bbi[n * 16 + q];
            const float xr = cr * br - ci * bi, xi = cr * bi + ci * br;
#pragma unroll
            for (int j = 0; j < 4; ++j) s[j] += xr * Pr[(tau0 + j) * 64 + n] - xi * Pi[(tau0 + j) * 64 + n];
        }
        float* Kt = (float*)(P.ws + WS_KTAB) + (size_t)(g * 2 + dir) * 32 * 256;
#pragma unroll
        for (int j = 0; j < 4; ++j) Kt[(tau0 + j) * 256 + pq] = s[j];
    }
    {
        bf16_t* W = (bf16_t*)(P.ws + WS_WENDT) + (size_t)(g * 256 + dir * 128 + qd * 32) * 512;
        for (int idx = tid; idx < 32 * 512 / 2; idx += 512) {
            const int row = idx >> 8, col = (idx & 255) * 2; const int n = qd * 16 + (row >> 1), ri = row & 1, s = col >> 4, q = col & 15;
            const int tau = dir ? s : (31 - s);
            const float pr = Pr[tau * 64 + n], pi = Pi[tau * 64 + n];
            const float br0 = Bbr[n * 16 + q], bi0 = Bbi[n * 16 + q], br1 = Bbr[n * 16 + q + 1], bi1 = Bbi[n * 16 + q + 1];
            const float v0 = ri ? (pr * bi0 + pi * br0) : (pr * br0 - pi * bi0), v1 = ri ? (pr * bi1 + pi * br1) : (pr * br1 - pi * bi1);
            *(unsigned*)(W + (size_t)row * 512 + col) = cvt_pk_bf16(v0, v1);
        }
    }
    {
        bf16_t* Mp = (bf16_t*)(P.ws + WS_MAPT) + ((size_t)g * 512 + qd * 128) * 768 + 512 + dir * 128;
        for (int idx = tid; idx < 128 * 64; idx += 512) {
            const int row = idx >> 6, n = idx & 63; const int t = qd * 8 + (row >> 4), p = row & 15;
            const int tau = dir ? (32 - t) : (t + 1);
            const float cr = Cr[p * 64 + n], ci = Ci[p * 64 + n], pr = Pr[tau * 64 + n], pi = Pi[tau * 64 + n];
            *(unsigned*)(Mp + (size_t)row * 768 + n * 2) = cvt_pk_bf16(cr * pr - ci * pi, -(cr * pi + ci * pr));
        }
    }
}
__device__ __forceinline__ void p0_pos_item(const Params& P) {
    float* postab = (float*)(P.ws + WS_MISC + MISC_POS);
    for (int idx = threadIdx.x; idx < 96 * 512; idx += 512) {
        int row = idx >> 9, j = idx & 511, jj = j & 255;
        float omega = 1.0f / powf(10000.0f, (float)jj / 256.0f);
        float p = (float)(row < 32 ? row : row - 32);
        float a = p * omega;
        postab[idx] = (j < 256) ? sinf(a) : cosf(a);
    }
}
__device__ __forceinline__ void tables_to_fp8(const Params& P, int wgi, int nwg);
constexpr int P0_MOD = 96, P0_TW1 = 256, P0_TGLU = 64, P0_TOUT = 256, P0_WS = 256, P0_WCS = 32, P0_S5 = 256, P0_POS = 1;
constexpr int P0_NITEMS = P0_MOD + P0_TW1 + P0_TGLU + P0_TOUT + P0_WS + P0_WCS + P0_S5 + P0_POS;
__device__ __forceinline__ void phase0(const Params& P, LAS unsigned char* lds) {
    LAS float* L = (LAS float*)lds;
    for (int it = blockIdx.x; it < P0_NITEMS; it += gridDim.x) {
        __syncthreads();
        int r = it;
        if (r < P0_S5) { p0_s5_item(P, L, r); continue; } r -= P0_S5;
        if (r < P0_WS) { p0_ws_item(P, L, r); continue; } r -= P0_WS;
        if (r < P0_MOD) { p0_mod_item(P, L, r); continue; } r -= P0_MOD;
        if (r < P0_TW1) { p0_transpose_item(P.w_in, 1024, 1024, (bf16_t*)(P.ws + WS_W1T), L, r); continue; } r -= P0_TW1;
        if (r < P0_TOUT) { p0_transpose_item(P.w_out, 1024, 1024, (bf16_t*)(P.ws + WS_WOUTT), L, r); continue; } r -= P0_TOUT;
        if (r < P0_TGLU) { p0_transpose_item(P.w_glu, 512, 512, (bf16_t*)(P.ws + WS_WGLUT), L, r); continue; } r -= P0_TGLU;
        if (r < P0_WCS) { p0_wcs_item(P, L, r); continue; } r -= P0_WCS;
        p0_pos_item(P);
    }
    __syncthreads();
    for (int i = threadIdx.x; i < 2048; i += 512) L[i] = cospif((float)i / 1024.0f);
    __syncthreads();
    bf16_t* CS = (bf16_t*)(P.ws + WS_CS);
    for (int i8 = blockIdx.x * 512 + threadIdx.x; i8 < 2 * 1024 * 1024 / 8; i8 += gridDim.x * 512) {
        const int e = i8 * 8, cs = e >> 20, k = (e >> 10) & 1023, l0 = e & 1023, sh = cs ? 512 : 0;
        float v[8];
#pragma unroll
        for (int j = 0; j < 8; ++j) v[j] = L[((k * (l0 + j)) - sh) & 2047];
        u32x4 o; o.x = cvt_pk_bf16(v[0], v[1]); o.y = cvt_pk_bf16(v[2], v[3]); o.z = cvt_pk_bf16(v[4], v[5]); o.w = cvt_pk_bf16(v[6], v[7]);
        *(u32x4*)(CS + (size_t)e) = o;
    }
}

template <bool TOK>
__device__ __forceinline__ void row_norm(int lane, const float* src, const float* posr, const float* posc, const float* gn, const float* sh, const float* sc, float* xpd, bf16_t* dst) {
    f32x4 v[4]; float ss = 0.f;
#pragma unroll
    for (int j = 0; j < 4; ++j) {
        const int col = 4 * lane + 256 * j;
        v[j] = *(const f32x4*)(src + col);
        if (TOK) { f32x4 p = (j < 2) ? *(const f32x4*)(posr + col) : *(const f32x4*)(posc + col - 512); v[j] = v[j] + p; *(f32x4*)(xpd + col) = v[j]; }
        ss += (v[j].x * v[j].x + v[j].y * v[j].y) + (v[j].z * v[j].z + v[j].w * v[j].w);
    }
    ss = wave_sum(ss);
    const float inv = rsqrtf(ss * (1.0f / 1024.0f) + 1e-6f);
#pragma unroll
    for (int j = 0; j < 4; ++j) {
        const int col = 4 * lane + 256 * j;
        f32x4 g = *(const f32x4*)(gn + col), s1 = *(const f32x4*)(sc + col), s0 = *(const f32x4*)(sh + col);
        f32x4 h = v[j] * inv * g * (s1 + 1.0f) + s0;
        u32x2 o; o.x = cvt_pk_bf16(h.x, h.y); o.y = cvt_pk_bf16(h.z, h.w);
        *(u32x2*)(dst + col) = o;
    }
}
__device__ __forceinline__ void row_norm2_tok(int lane, const float* src0, const float* src1, const float* posr0, const float* posc0, const float* posr1, const float* posc1,
                                              const float* gn, const float* sh0, const float* sc0, const float* sh1, const float* sc1, float* xpd0, float* xpd1, bf16_t* dst0, bf16_t* dst1) {
    f32x4 v0[4], v1[4], p0[4], p1[4];
#pragma unroll
    for (int j = 0; j < 4; ++j) {
        const int col = 4 * lane + 256 * j;
        v0[j] = *(const f32x4*)(src0 + col); v1[j] = *(const f32x4*)(src1 + col);
        p0[j] = (j < 2) ? *(const f32x4*)(posr0 + col) : *(const f32x4*)(posc0 + col - 512);
        p1[j] = (j < 2) ? *(const f32x4*)(posr1 + col) : *(const f32x4*)(posc1 + col - 512);
    }
    float ss0 = 0.f, ss1 = 0.f;
#pragma unroll
    for (int j = 0; j < 4; ++j) {
        const int col = 4 * lane + 256 * j;
        v0[j] = v0[j] + p0[j]; v1[j] = v1[j] + p1[j];
        *(f32x4*)(xpd0 + col) = v0[j]; *(f32x4*)(xpd1 + col) = v1[j];
        ss0 += (v0[j].x * v0[j].x + v0[j].y * v0[j].y) + (v0[j].z * v0[j].z + v0[j].w * v0[j].w);
        ss1 += (v1[j].x * v1[j].x + v1[j].y * v1[j].y) + (v1[j].z * v1[j].z + v1[j].w * v1[j].w);
    }
#pragma unroll
    for (int o = 32; o > 0; o >>= 1) { ss0 += __shfl_xor(ss0, o); ss1 += __shfl_xor(ss1, o); }
    const float inv0 = rsqrtf(ss0 * (1.0f / 1024.0f) + 1e-6f), inv1 = rsqrtf(ss1 * (1.0f / 1024.0f) + 1e-6f);
#pragma unroll
    for (int j = 0; j < 4; ++j) {
        const int col = 4 * lane + 256 * j;
        const f32x4 g = *(const f32x4*)(gn + col);
        const f32x4 a1 = *(const f32x4*)(sc0 + col), a0 = *(const f32x4*)(sh0 + col), b1 = *(const f32x4*)(sc1 + col), b0 = *(const f32x4*)(sh1 + col);
        const f32x4 h0 = v0[j] * inv0 * g * (a1 + 1.0f) + a0, h1 = v1[j] * inv1 * g * (b1 + 1.0f) + b0;
        u32x2 o0, o1; o0.x = cvt_pk_bf16(h0.x, h0.y); o0.y = cvt_pk_bf16(h0.z, h0.w); o1.x = cvt_pk_bf16(h1.x, h1.y); o1.y = cvt_pk_bf16(h1.z, h1.w);
        *(u32x2*)(dst0 + col) = o0; *(u32x2*)(dst1 + col) = o1;
    }
}
__device__ __forceinline__ void row_norm4_ctx(int lane, const float* src, const float* gn, const float* sh, const float* sc, bf16_t* dst) {
    f32x4 v[4][4]; float ss[4];
#pragma unroll
    for (int r = 0; r < 4; ++r)
#pragma unroll
        for (int j = 0; j < 4; ++j) v[r][j] = *(const f32x4*)(src + (size_t)r * 1024 + 4 * lane + 256 * j);
#pragma unroll
    for (int r = 0; r < 4; ++r) { ss[r] = 0.f;
#pragma unroll
        for (int j = 0; j < 4; ++j) ss[r] += (v[r][j].x * v[r][j].x + v[r][j].y * v[r][j].y) + (v[r][j].z * v[r][j].z + v[r][j].w * v[r][j].w); }
#pragma unroll
    for (int o = 32; o > 0; o >>= 1) {
#pragma unroll
        for (int r = 0; r < 4; ++r) ss[r] += __shfl_xor(ss[r], o); }
#pragma unroll
    for (int j = 0; j < 4; ++j) {
        const int col = 4 * lane + 256 * j;
        const f32x4 g = *(const f32x4*)(gn + col), s1 = *(const f32x4*)(sc + col), s0 = *(const f32x4*)(sh + col);
        const f32x4 gs = g * (s1 + 1.0f);
#pragma unroll
        for (int r = 0; r < 4; ++r) {
            const float inv = rsqrtf(ss[r] * (1.0f / 1024.0f) + 1e-6f);
            const f32x4 h = v[r][j] * inv * gs + s0;
            u32x2 o; o.x = cvt_pk_bf16(h.x, h.y); o.y = cvt_pk_bf16(h.z, h.w);
            *(u32x2*)(dst + (size_t)r * 1024 + col) = o;
        }
    }
}
struct EpiU {
    static constexpr bool PERM = true, AFTER_DRAIN = false;
    bf16_t* aext; bf16_t* fb; int ctx_b;
    __device__ __forceinline__ void operator()(const f32x4 (&acc)[2][2][4][2], const pg8::Unit& u, int wr, int wc, int fr, int fq) const {
#pragma unroll
        for (int ai = 0; ai < 2; ++ai)
#pragma unroll
            for (int m = 0; m < 4; ++m) {
                const int rt = 128 * ai + 64 * wr + 16 * m + fr;
#pragma unroll
                for (int bj = 0; bj < 2; ++bj) {
                    const int gcol = u.pn * 256 + 128 * bj + 32 * wc + 8 * fq;
                    const f32x4 v0 = acc[ai][bj][m][0], v1 = acc[ai][bj][m][1];
                    u32x4 w; w.x = cvt_pk_bf16(v0.x, v0.y); w.y = cvt_pk_bf16(v0.z, v0.w); w.z = cvt_pk_bf16(v1.x, v1.y); w.w = cvt_pk_bf16(v1.z, v1.w);
                    bf16_t* dst;
                    if (ctx_b >= 0) {
                        const int t = rt, g = gcol >> 4, q0 = gcol & 15, row = 512 + ctx_b * 8 + (t >> 5);
                        dst = aext + ((size_t)(g * 768 + row) * 768 + (t & 31) * 16 + q0);
                    } else {
                        const int r = u.pm * 256 + rt;
                        if (u.pn < 2) { const int b = r >> 11, t = r & 2047, g = gcol >> 4, q0 = gcol & 15, row = b * 64 + (t >> 5);
                            dst = aext + ((size_t)(g * 768 + row) * 768 + (t & 31) * 16 + q0); }
                        else dst = fb + (size_t)r * 512 + (gcol - 512);
                    }
                    *(u32x4*)dst = w;
                }
            }
    }
};
__device__ __forceinline__ void phase1(const Params& P, LAS unsigned char* lds) {
    const int tid = threadIdx.x, lane = tid & 63, wave = tid >> 6, wg = blockIdx.x;
    const float* mod = (const float*)(P.ws + WS_MISC + MISC_MOD);
    const float* postab = (const float*)(P.ws + WS_MISC + MISC_POS);
    if (wg < 16) {
        const int b = wg >> 1, pn = wg & 1;
        bf16_t* hcb = (bf16_t*)(P.ws + WS_HCB) + (size_t)wg * 256 * 1024;
        for (int j = 0; j < 32; j += 4) {
            const int rr = wave * 32 + j;
            row_norm4_ctx(lane, P.ctx + (size_t)(b * 256 + rr) * 1024, P.norm1_g, mod + 8 * NMOD, mod + 8 * NMOD + 1024, hcb + (size_t)rr * 1024);
        }
        asm volatile("s_waitcnt vmcnt(0)" ::: "memory");
        __syncthreads();
        pg8::Gemm g{1024, 1024, 1024};
        pg8::Unit u{(const char*)hcb, (const char*)((const bf16_t*)(P.ws + WS_W1T) + (size_t)pn * 256 * 1024), 0, pn, 0};
        EpiU E{(bf16_t*)(P.ws + WS_AEXT), nullptr, b};
        pg8::gemm_unit<EpiU>(lds, g, u, E);
    } else {
    const int gw = (wg - 16) * 8 + wave, ngw = (gridDim.x - 16) * 8;
    bf16_t* xb = (bf16_t*)(P.ws + WS_XB);
    for (int r0 = 2 * gw; r0 < NTOK; r0 += 2 * ngw) {
        const int r1 = r0 + 1; const int b = r0 >> 11, t0 = r0 & 2047, t1 = r1 & 2047;
        row_norm2_tok(lane, P.x + (size_t)r0 * 1024, P.x + (size_t)r1 * 1024, postab + (size_t)(t0 >> 6) * 512, postab + (size_t)(32 + (t0 & 63)) * 512,
                      postab + (size_t)(t1 >> 6) * 512, postab + (size_t)(32 + (t1 & 63)) * 512, P.norm1_g, mod + (size_t)b * NMOD, mod + (size_t)b * NMOD + 1024,
                      mod + (size_t)b * NMOD, mod + (size_t)b * NMOD + 1024, P.out + (size_t)r0 * 1024, P.out + (size_t)r1 * 1024, xb + (size_t)r0 * 1024, xb + (size_t)r1 * 1024);
    }
    {
        LAS float* sh2 = (LAS float*)lds;
        for (int idx = tid; idx < 8 * 1024; idx += 512) sh2[idx] = mod[(size_t)(idx >> 10) * NMOD + 3 * 1024 + (idx & 1023)];
        __syncthreads();
        const bf16_t* WsT = (const bf16_t*)(P.ws + WS_WST);
        float* bias = (float*)(P.ws + WS_MISC + MISC_BIAS);
        for (int n = gw; n < 2048; n += ngw) {
            float acc[8];
#pragma unroll
            for (int b = 0; b < 8; ++b) acc[b] = 0.f;
#pragma unroll
            for (int j = 0; j < 2; ++j) {
                const int k0 = lane * 8 + 512 * j;
                u32x4 wv = *(const u32x4*)(WsT + (size_t)n * 1024 + k0);
                float wf[8] = {bflo(wv.x), bfhi(wv.x), bflo(wv.y), bfhi(wv.y), bflo(wv.z), bfhi(wv.z), bflo(wv.w), bfhi(wv.w)};
#pragma unroll
                for (int b = 0; b < 8; ++b)
#pragma unroll
                    for (int i = 0; i < 8; ++i) acc[b] += sh2[b * 1024 + k0 + i] * wf[i];
            }
#pragma unroll
            for (int b = 0; b < 8; ++b) { float s = wave_sum(acc[b]); if (lane == 0) bias[b * 2048 + n] = s; }
        }
    }
    {
        const float* Kt = (const float*)(P.ws + WS_KTAB);
        bf16_t* Mp = (bf16_t*)(P.ws + WS_MAPT);
        const int nthr = (gridDim.x - 16) * 512;
#pragma unroll 4
        for (int i8 = (wg - 16) * 512 + tid; i8 < 32 * 512 * 64; i8 += nthr) {
            const int g = i8 >> 15, row = (i8 >> 6) & 511, ch = i8 & 63; const int t = row >> 4, p = row & 15, s = ch >> 1, q8 = (ch & 1) * 8;
            f32x4 a0 = (f32x4){0.f, 0.f, 0.f, 0.f}, a1 = a0;
            if (t >= s) { const float* kp = Kt + ((size_t)((g * 2 + 0) * 32 + (t - s)) * 256 + p * 16 + q8); a0 = a0 + *(const f32x4*)kp; a1 = a1 + *(const f32x4*)(kp + 4); }
            if (s >= t) { const float* kp = Kt + ((size_t)((g * 2 + 1) * 32 + (s - t)) * 256 + p * 16 + q8); a0 = a0 + *(const f32x4*)kp; a1 = a1 + *(const f32x4*)(kp + 4); }
            u32x4 o; o.x = cvt_pk_bf16(a0.x, a0.y); o.y = cvt_pk_bf16(a0.z, a0.w); o.z = cvt_pk_bf16(a1.x, a1.y); o.w = cvt_pk_bf16(a1.z, a1.w);
            *(u32x4*)(Mp + ((size_t)(g * 512 + row) * 768 + s * 16 + q8)) = o;
        }
    }
    tables_to_fp8(P, wg - 16, gridDim.x - 16);
    }
}
__device__ __forceinline__ void phase2(const Params& P, LAS unsigned char* lds) {
    const int wg = blockIdx.x;
    const int wgid = (wg & 7) * 32 + (wg >> 3);
    const int pm = (wgid >> 5) * 8 + (wgid & 7), pn = (wgid & 31) >> 3;
    pg8::Gemm g{1024, 1024, 1024};
    pg8::Unit u{(const char*)((const bf16_t*)(P.ws + WS_XB) + (size_t)pm * 256 * 1024), (const char*)((const bf16_t*)(P.ws + WS_W1T) + (size_t)pn * 256 * 1024), pm, pn, 0};
    EpiU E{(bf16_t*)(P.ws + WS_AEXT), (bf16_t*)(P.ws + WS_FB), -1};
    pg8::gemm_unit<EpiU>(lds, g, u, E);
}

constexpr size_t WS_FOLD = WS_XB;
constexpr size_t WS_YGELU = WS_FB;
constexpr size_t WS_MIXIN = WS_XB;
struct EpiGT {
    static constexpr bool PERM = true, AFTER_DRAIN = false;
    bf16_t* gt;
    __device__ __forceinline__ void operator()(const f32x4 (&acc)[2][2][4][2], const pg8::Unit& u, int wr, int wc, int fr, int fq) const {
        const int b = u.pn >> 2;
#pragma unroll
        for (int ai = 0; ai < 2; ++ai)
#pragma unroll
            for (int m = 0; m < 4; ++m) {
                const int chp = u.pm * 256 + 128 * ai + 64 * wr + 16 * m + fr;
#pragma unroll
                for (int bj = 0; bj < 2; ++bj) {
                    const int l = (u.pn & 3) * 256 + 128 * bj + 32 * wc + 8 * fq;
                    const f32x4 v0 = acc[ai][bj][m][0], v1 = acc[ai][bj][m][1];
                    u32x4 w; w.x = cvt_pk_bf16(v0.x, v0.y); w.y = cvt_pk_bf16(v0.z, v0.w); w.z = cvt_pk_bf16(v1.x, v1.y); w.w = cvt_pk_bf16(v1.z, v1.w);
                    *(u32x4*)(gt + ((size_t)((b * 512 + (chp & 511)) * 2 + (chp >> 9)) * 1024 + l)) = w;
                }
            }
    }
};
struct EpiE {
    static constexpr bool PERM = false, AFTER_DRAIN = false;
    float* base;
    __device__ __forceinline__ void operator()(const f32x4 (&acc)[2][2][4][2], const pg8::Unit& u, int wr, int wc, int fr, int fq) const {
#pragma unroll
        for (int ai = 0; ai < 2; ++ai)
#pragma unroll
            for (int m = 0; m < 4; ++m) {
                const int rt = 128 * ai + 64 * wr + 16 * m + fr;
#pragma unroll
                for (int bj = 0; bj < 2; ++bj)
#pragma unroll
                    for (int n = 0; n < 2; ++n) *(f32x4*)(base + (size_t)rt * 256 + 128 * bj + 32 * wc + 16 * n + 4 * fq) = acc[ai][bj][m][n];
            }
    }
};
__device__ __forceinline__ unsigned bf2_add(unsigned a, unsigned b, float sg) { return cvt_pk_bf16(bflo(a) + sg * bflo(b), bfhi(a) + sg * bfhi(b)); }
__device__ __forceinline__ void phase3(const Params& P, LAS unsigned char* lds) {
    const int wg = blockIdx.x;
    if (wg < 128) {
        const int pm = wg & 3, pn = wg >> 2; const int cs = pm >> 1, b = pn >> 2, lbase = (pn & 3) * 256;
        bf16_t* fold = (bf16_t*)(P.ws + WS_FOLD) + (size_t)wg * 256 * 512;
        const bf16_t* fb = (const bf16_t*)(P.ws + WS_FB) + (size_t)b * 2048 * 512;
        const float sg = cs ? -1.0f : 1.0f;
        for (int it = threadIdx.x; it < 256 * 64; it += 512 * 4) {
            u32x4 a[4], m[4];
#pragma unroll
            for (int q = 0; q < 4; ++q) { const int i = it + 512 * q; const int row = i >> 6, ch8 = (i & 63) * 8; const int l = lbase + row;
                a[q] = *(const u32x4*)(fb + (size_t)l * 512 + ch8); m[q] = *(const u32x4*)(fb + (size_t)((2048 - l) & 2047) * 512 + ch8); }
#pragma unroll
            for (int q = 0; q < 4; ++q) { const int i = it + 512 * q; const int row = i >> 6, ch8 = (i & 63) * 8; const int l = lbase + row;
                u32x4 o;
                if (l == 0) { o = cs ? (u32x4){0u, 0u, 0u, 0u} : a[q]; }
                else { o.x = bf2_add(a[q].x, m[q].x, sg); o.y = bf2_add(a[q].y, m[q].y, sg); o.z = bf2_add(a[q].z, m[q].z, sg); o.w = bf2_add(a[q].w, m[q].w, sg); }
                *(u32x4*)(fold + (size_t)row * 512 + ch8) = o; }
        }
        asm volatile("s_waitcnt vmcnt(0)" ::: "memory");
        __syncthreads();
        pg8::Gemm g{512, 512, 512};
        pg8::Unit u{(const char*)((const bf16_t*)(P.ws + WS_WCST) + (size_t)pm * 256 * 512), (const char*)fold, pm, pn, 0};
        EpiGT E{(bf16_t*)(P.ws + WS_GT)};
        pg8::gemm_unit<EpiGT>(lds, g, u, E);
    } else if (wg < 224) {
        const int w2 = wg - 128; const int gg = w2 / 3, mt = w2 % 3;
        pg8::Gemm g{768, 512, 512};
        pg8::Unit u{(const char*)((const bf16_t*)(P.ws + WS_AEXT) + (size_t)(gg * 768 + mt * 256) * 768), (const char*)((const bf16_t*)(P.ws + WS_WENDT) + (size_t)gg * 256 * 512), mt, 0, gg};
        EpiE E{(float*)(P.ws + WS_E) + (size_t)(gg * 768 + mt * 256) * 256};
        pg8::gemm_unit<EpiE>(lds, g, u, E);
    }
    {
        const int lane = threadIdx.x & 63, wave = threadIdx.x >> 6;
        float* ecv = (float*)(P.ws + WS_MISC + MISC_EC);
        const bf16_t* WcsT = (const bf16_t*)(P.ws + WS_WCST); const bf16_t* fb = (const bf16_t*)(P.ws + WS_FB);
#pragma unroll
        for (int q = 0; q < 2; ++q) {
            const int ent = wg * 16 + wave * 2 + q; const int b = ent >> 9, ch = ent & 511, gq = ch >> 7;
            const unsigned fw = *(const unsigned*)(fb + ((size_t)b * 2048 + 1024) * 512 + gq * 128 + 2 * lane);
            const unsigned ww = *(const unsigned*)(WcsT + (size_t)ch * 512 + gq * 128 + 2 * lane);
            float e = bflo(fw) * bflo(ww) + bfhi(fw) * bfhi(ww);
            e = wave_sum(e);
            if (lane == 0) ecv[ent] = e;
        }
    }
}
struct EpiY {
    static constexpr bool PERM = true, AFTER_DRAIN = false;
    const bf16_t* arow; const float* dskip; bf16_t* yg; int g, mt, nt;
    __device__ __forceinline__ void operator()(const f32x4 (&acc)[2][2][4][2], const pg8::Unit& u, int wr, int wc, int fr, int fq) const {
#pragma unroll
        for (int ai = 0; ai < 2; ++ai)
#pragma unroll
            for (int m = 0; m < 4; ++m) {
                const int row = mt * 256 + 128 * ai + 64 * wr + 16 * m + fr; const int b = row >> 6, c = row & 63;
#pragma unroll
                for (int bj = 0; bj < 2; ++bj) {
                    const int col0 = nt * 256 + 128 * bj + 32 * wc + 8 * fq; const int t = col0 >> 4, p0 = col0 & 15;
                    const u32x4 uv = *(const u32x4*)(arow + (size_t)row * 768 + t * 16 + p0);
                    const f32x4 d0 = *(const f32x4*)(dskip + g * 16 + p0), d1 = *(const f32x4*)(dskip + g * 16 + p0 + 4);
                    const f32x4 v0 = acc[ai][bj][m][0], v1 = acc[ai][bj][m][1];
                    float y[8] = {v0.x + d0.x * bflo(uv.x), v0.y + d0.y * bfhi(uv.x), v0.z + d0.z * bflo(uv.y), v0.w + d0.w * bfhi(uv.y),
                                  v1.x + d1.x * bflo(uv.z), v1.y + d1.y * bfhi(uv.z), v1.z + d1.z * bflo(uv.w), v1.w + d1.w * bfhi(uv.w)};
#pragma unroll
                    for (int i = 0; i < 8; ++i) y[i] = gelu_tanh(y[i]);
                    u32x4 w; w.x = cvt_pk_bf16(y[0], y[1]); w.y = cvt_pk_bf16(y[2], y[3]); w.z = cvt_pk_bf16(y[4], y[5]); w.w = cvt_pk_bf16(y[6], y[7]);
                    const size_t tok = (size_t)b * 2048 + c * 32 + t;
                    *(u32x4*)(yg + tok * 512 + g * 16 + p0) = w;
                }
            }
    }
};
struct EpiP {
    static constexpr bool PERM = true, AFTER_DRAIN = false;
    bf16_t* base;
    __device__ __forceinline__ void operator()(const f32x4 (&acc)[2][2][4][2], const pg8::Unit& u, int wr, int wc, int fr, int fq) const {
#pragma unroll
        for (int ai = 0; ai < 2; ++ai)
#pragma unroll
            for (int m = 0; m < 4; ++m) {
                const int rt = 128 * ai + 64 * wr + 16 * m + fr;
#pragma unroll
                for (int bj = 0; bj < 2; ++bj) {
                    const f32x4 v0 = acc[ai][bj][m][0], v1 = acc[ai][bj][m][1];
                    u32x4 w; w.x = cvt_pk_bf16(v0.x, v0.y); w.y = cvt_pk_bf16(v0.z, v0.w); w.z = cvt_pk_bf16(v1.x, v1.y); w.w = cvt_pk_bf16(v1.z, v1.w);
                    *(u32x4*)(base + (size_t)rt * 512 + 128 * bj + 32 * wc + 8 * fq) = w;
                }
            }
    }
};
__device__ __forceinline__ void s5_carry(const Params& P, int g, int mt) {
    const int tid = threadIdx.x; const int bl = tid >> 7, dir = (tid >> 6) & 1, n = tid & 63; const int b = mt * 4 + bl;
    const int dg = dir * 32 + g, i = dg * 64 + n;
    const float dt = expf(P.log_dt[dg]); const float lr = P.lam_re[i], li = P.lam_im[i];
    const float mag = expf(32.0f * lr * dt), ang = 32.0f * (li * dt);
    const float atr = mag * cosf(ang), ati = mag * sinf(ang);
    const float* Eg = (const float*)(P.ws + WS_E) + (size_t)g * 768 * 256 + dir * 128 + n * 2;
    bf16_t* Ag = (bf16_t*)(P.ws + WS_AEXT) + (size_t)g * 768 * 768 + 512 + dir * 128 + n * 2;
    float hr = 0.f, hi = 0.f;
    {
        f32x2 e[8];
#pragma unroll
        for (int k = 0; k < 8; ++k) { const int cp = dir ? 7 - k : k; e[k] = *(const f32x2*)(Eg + (size_t)(512 + b * 8 + cp) * 256); }
#pragma unroll
        for (int k = 0; k < 8; ++k) { const float nr = atr * hr - ati * hi + e[k].x, ni = atr * hi + ati * hr + e[k].y; hr = nr; hi = ni; }
    }
    for (int k0 = 0; k0 < 64; k0 += 8) {
        f32x2 e[8];
#pragma unroll
        for (int k = 0; k < 8; ++k) { const int c = dir ? 63 - (k0 + k) : (k0 + k); e[k] = *(const f32x2*)(Eg + (size_t)(b * 64 + c) * 256); }
#pragma unroll
        for (int k = 0; k < 8; ++k) {
            const int c = dir ? 63 - (k0 + k) : (k0 + k);
            *(unsigned*)(Ag + (size_t)(b * 64 + c) * 768) = cvt_pk_bf16(hr, hi);
            const float nr = atr * hr - ati * hi + e[k].x, ni = atr * hi + ati * hr + e[k].y; hr = nr; hi = ni;
        }
    }
}
__device__ __forceinline__ void phase4(const Params& P, LAS unsigned char* lds) {
    const int wg = blockIdx.x;
    if (wg < 128) {
        const int gg = wg >> 2, mt = (wg >> 1) & 1, nt = wg & 1;
        s5_carry(P, gg, mt);
        asm volatile("s_waitcnt vmcnt(0)" ::: "memory");
        __syncthreads();
        const bf16_t* Ag = (const bf16_t*)(P.ws + WS_AEXT) + (size_t)gg * 768 * 768;
        pg8::Gemm g{768, 768, 768};
        pg8::Unit u{(const char*)(Ag + (size_t)mt * 256 * 768), (const char*)((const bf16_t*)(P.ws + WS_MAPT) + (size_t)(gg * 512 + nt * 256) * 768), mt, nt, gg};
        EpiY E{Ag, P.s5_d, (bf16_t*)(P.ws + WS_YGELU), gg, mt, nt};
        pg8::gemm_unit<EpiY>(lds, g, u, E);
    }
    else {
        const int idx = wg - 128; const int b = idx & 7, j = idx >> 3; const int cs = j >> 3, mt = (j >> 1) & 3, nt = j & 1;
        pg8::Gemm g{1024, 2048, 1024};
        pg8::Unit u{(const char*)((const bf16_t*)(P.ws + WS_CS) + (size_t)(cs * 1024 + mt * 256) * 1024),
                    (const char*)((const bf16_t*)(P.ws + WS_GT) + ((size_t)(b * 512 + nt * 256) * 2 + cs) * 1024), mt, nt, b};
        EpiP E{(bf16_t*)(P.ws + WS_CSPART) + ((size_t)(cs * 8 + b) * 1024 + mt * 256) * 512 + nt * 256};
        pg8::gemm_unit<EpiP>(lds, g, u, E);
    }
    {
        const int lane = threadIdx.x & 63, wave = threadIdx.x >> 6;
        const float* ecv = (const float*)(P.ws + WS_MISC + MISC_EC); float* o1024 = (float*)(P.ws + WS_MISC + MISC_O1024);
        const bf16_t* GT = (const bf16_t*)(P.ws + WS_GT);
#pragma unroll
        for (int q = 0; q < 2; ++q) {
            const int ent = wg * 16 + wave * 2 + q; const int b = ent >> 9, ch = ent & 511;
            const u32x4 g0 = *(const u32x4*)(GT + (size_t)(b * 512 + ch) * 2048 + 16 * lane), g1 = *(const u32x4*)(GT + (size_t)(b * 512 + ch) * 2048 + 16 * lane + 8);
            float s = (bflo(g0.x) - bfhi(g0.x)) + (bflo(g0.y) - bfhi(g0.y)) + (bflo(g0.z) - bfhi(g0.z)) + (bflo(g0.w) - bfhi(g0.w))
                    + (bflo(g1.x) - bfhi(g1.x)) + (bflo(g1.y) - bfhi(g1.y)) + (bflo(g1.z) - bfhi(g1.z)) + (bflo(g1.w) - bfhi(g1.w));
            s = wave_sum(s);
            if (lane == 0) o1024[ent] = s + ecv[ent];
        }
    }
}
struct EpiGlu {
    static constexpr bool PERM = true, AFTER_DRAIN = false;
    const bf16_t* yg; const float* bglu; bf16_t* mixin;
    __device__ __forceinline__ void operator()(const f32x4 (&acc)[2][2][4][2], const pg8::Unit& u, int wr, int wc, int fr, int fq) const {
#pragma unroll
        for (int ai = 0; ai < 2; ++ai)
#pragma unroll
            for (int m = 0; m < 4; ++m) {
                const size_t r = (size_t)u.pm * 256 + 128 * ai + 64 * wr + 16 * m + fr;
#pragma unroll
                for (int bj = 0; bj < 2; ++bj) {
                    const int c0 = u.pn * 256 + 128 * bj + 32 * wc + 8 * fq;
                    const u32x4 yv = *(const u32x4*)(yg + r * 512 + c0);
                    const f32x4 b0 = *(const f32x4*)(bglu + c0), b1 = *(const f32x4*)(bglu + c0 + 4);
                    const f32x4 v0 = acc[ai][bj][m][0] + b0, v1 = acc[ai][bj][m][1] + b1;
                    float s[8] = {bflo(yv.x) * sigmoidf_(v0.x), bfhi(yv.x) * sigmoidf_(v0.y), bflo(yv.y) * sigmoidf_(v0.z), bfhi(yv.y) * sigmoidf_(v0.w),
                                  bflo(yv.z) * sigmoidf_(v1.x), bfhi(yv.z) * sigmoidf_(v1.y), bflo(yv.w) * sigmoidf_(v1.z), bfhi(yv.w) * sigmoidf_(v1.w)};
                    u32x4 w; w.x = cvt_pk_bf16(s[0], s[1]); w.y = cvt_pk_bf16(s[2], s[3]); w.z = cvt_pk_bf16(s[4], s[5]); w.w = cvt_pk_bf16(s[6], s[7]);
                    *(u32x4*)(mixin + r * 1024 + c0) = w;
                }
            }
    }
};
__device__ __forceinline__ void phase5(const Params& P, LAS unsigned char* lds) {
    const int wg = blockIdx.x;
    bf16_t* mixin = (bf16_t*)(P.ws + WS_MIXIN);
    if (wg < 128) {
        const int pm = wg >> 1, pn = wg & 1;
        const bf16_t* yg = (const bf16_t*)(P.ws + WS_YGELU);
        pg8::Gemm g{512, 512, 512};
        pg8::Unit u{(const char*)(yg + (size_t)pm * 256 * 512), (const char*)((const bf16_t*)(P.ws + WS_WGLUT) + (size_t)pn * 256 * 512), pm, pn, 0};
        EpiGlu E{yg, P.b_glu, mixin};
        pg8::gemm_unit<EpiGlu>(lds, g, u, E);
    } else {
        const bf16_t* Cp = (const bf16_t*)(P.ws + WS_CSPART); const bf16_t* Sp = Cp + (size_t)8 * 1024 * 512;
        const float* ecv = (const float*)(P.ws + WS_MISC + MISC_EC); const float* o1024 = (const float*)(P.ws + WS_MISC + MISC_O1024);
        for (int i8 = (wg - 128) * 512 + threadIdx.x; i8 < NTOK * 64; i8 += 128 * 512) {
            const int tok = i8 >> 6, ch = (i8 & 63) * 8; const int b = tok >> 11, k = tok & 2047;
            const f32x4 e0 = *(const f32x4*)(ecv + b * 512 + ch), e1 = *(const f32x4*)(ecv + b * 512 + ch + 4);
            float v[8];
            if (k == 1024) {
                const f32x4 o0 = *(const f32x4*)(o1024 + b * 512 + ch), o1 = *(const f32x4*)(o1024 + b * 512 + ch + 4);
                v[0] = o0.x; v[1] = o0.y; v[2] = o0.z; v[3] = o0.w; v[4] = o1.x; v[5] = o1.y; v[6] = o1.z; v[7] = o1.w;
            } else {
                const int kk = (k < 1024) ? k : 2048 - k; const float sg = (k < 1024) ? 1.0f : -1.0f, se = (kk & 1) ? -1.0f : 1.0f;
                const u32x4 c = *(const u32x4*)(Cp + ((size_t)b * 1024 + kk) * 512 + ch), s = *(const u32x4*)(Sp + ((size_t)b * 1024 + kk) * 512 + ch);
                v[0] = bflo(c.x) + sg * bflo(s.x) + se * e0.x; v[1] = bfhi(c.x) + sg * bfhi(s.x) + se * e0.y; v[2] = bflo(c.y) + sg * bflo(s.y) + se * e0.z; v[3] = bfhi(c.y) + sg * bfhi(s.y) + se * e0.w;
                v[4] = bflo(c.z) + sg * bflo(s.z) + se * e1.x; v[5] = bfhi(c.z) + sg * bfhi(s.z) + se * e1.y; v[6] = bflo(c.w) + sg * bflo(s.w) + se * e1.z; v[7] = bfhi(c.w) + sg * bfhi(s.w) + se * e1.w;
            }
            u32x4 w; w.x = cvt_pk_bf16(v[0], v[1]); w.y = cvt_pk_bf16(v[2], v[3]); w.z = cvt_pk_bf16(v[4], v[5]); w.w = cvt_pk_bf16(v[6], v[7]);
            *(u32x4*)(mixin + (size_t)tok * 1024 + 512 + ch) = w;
        }
    }
}
constexpr size_t WS_X1B = WS_AEXT;
constexpr size_t WS_PAIRS = WS_XB;
constexpr size_t MISC_SS = 1024 * 1024;
struct EpiOut {
    static constexpr bool PERM = false, AFTER_DRAIN = false;
    float* xio; const float* mod; const float* g2n; bf16_t* x1b; float* sspart;
    __device__ __forceinline__ void operator()(const f32x4 (&acc)[2][2][4][2], const pg8::Unit& u, int wr, int wc, int fr, int fq) const {
#pragma unroll
        for (int ai = 0; ai < 2; ++ai)
#pragma unroll
            for (int m = 0; m < 4; ++m) {
                const size_t r = (size_t)u.pm * 256 + 128 * ai + 64 * wr + 16 * m + fr; const int b = (int)(r >> 11);
                const float* mrow = mod + (size_t)b * NMOD;
                float ss = 0.f;
#pragma unroll
                for (int bj = 0; bj < 2; ++bj)
#pragma unroll
                    for (int n = 0; n < 2; ++n) {
                        const int col = u.pn * 256 + 128 * bj + 32 * wc + 16 * n + 4 * fq;
                        const f32x4 xp = *(const f32x4*)(xio + r * 1024 + col);
                        const f32x4 g1 = *(const f32x4*)(mrow + 2 * 1024 + col), sc2 = *(const f32x4*)(mrow + 4 * 1024 + col), gn = *(const f32x4*)(g2n + col);
                        const f32x4 x1 = xp + g1 * acc[ai][bj][m][n];
                        *(f32x4*)(xio + r * 1024 + col) = x1;
                        ss += (x1.x * x1.x + x1.y * x1.y) + (x1.z * x1.z + x1.w * x1.w);
                        const f32x4 hb = x1 * gn * (sc2 + 1.0f);
                        u32x2 o; o.x = cvt_pk_bf16(hb.x, hb.y); o.y = cvt_pk_bf16(hb.z, hb.w);
                        *(u32x2*)(x1b + r * 1024 + col) = o;
                    }
                ss += __shfl_xor(ss, 16); ss += __shfl_xor(ss, 32);
                if (fq == 0) sspart[r * 16 + u.pn * 4 + wc] = ss;
            }
    }
};
__device__ __forceinline__ void phase6(const Params& P, LAS unsigned char* lds) {
    const int wg = blockIdx.x;
    const int wgid = (wg & 7) * 32 + (wg >> 3);
    const int pm = (wgid >> 5) * 8 + (wgid & 7), pn = (wgid & 31) >> 3;
    pg8::Gemm g{1024, 1024, 1024};
    pg8::Unit u{(const char*)((const bf16_t*)(P.ws + WS_MIXIN) + (size_t)pm * 256 * 1024), (const char*)((const bf16_t*)(P.ws + WS_WOUTT) + (size_t)pn * 256 * 1024), pm, pn, 0};
    EpiOut E{P.out, (const float*)(P.ws + WS_MISC + MISC_MOD), P.norm2_g, (bf16_t*)(P.ws + WS_X1B), (float*)(P.ws + WS_MISC + MISC_SS)};
    pg8::gemm_unit<EpiOut>(lds, g, u, E);
}
__device__ __forceinline__ unsigned key_pack(float v, unsigned tag, unsigned mask) {
    unsigned b = __float_as_uint(v); b ^= (b >> 31) ? 0xffffffffu : 0x80000000u; return (b & ~mask) | tag;
}
__device__ __forceinline__ float key_val(unsigned k, unsigned mask) { unsigned b = k & ~mask; b ^= (b >> 31) ? 0x80000000u : 0xffffffffu; return __uint_as_float(b); }
__device__ const unsigned char CAND_TAB[64] = {0,1,2,3,4,5,6,7,8,9,10,11,12,13,14,15,16,17,18,19,20,21,22,23,32,33,34,35,36,48,49,50,51,64,65,66,80,81,96,97,112,113,128,144,160,176,192,208,224,240,
    255,255,255,255,255,255,255,255,255,255,255,255,255,255};
#define DPP_ROR(v, n) ((unsigned)__builtin_amdgcn_update_dpp(0, (int)(v), 0x120 + (n), 0xf, 0xf, false))
__device__ __forceinline__ unsigned row_umax(unsigned m) {
    unsigned t;
    t = DPP_ROR(m, 8); m = m > t ? m : t; t = DPP_ROR(m, 4); m = m > t ? m : t; t = DPP_ROR(m, 2); m = m > t ? m : t; t = DPP_ROR(m, 1); m = m > t ? m : t;
    return m;
}
__device__ __forceinline__ float row_fsum(float s) {
    s += __int_as_float(__builtin_amdgcn_update_dpp(0, __float_as_int(s), 0x128, 0xf, 0xf, false));
    s += __int_as_float(__builtin_amdgcn_update_dpp(0, __float_as_int(s), 0x124, 0xf, 0xf, false));
    s += __int_as_float(__builtin_amdgcn_update_dpp(0, __float_as_int(s), 0x122, 0xf, 0xf, false));
    s += __int_as_float(__builtin_amdgcn_update_dpp(0, __float_as_int(s), 0x121, 0xf, 0xf, false));
    return s;
}
#define CE(a, b) do { const unsigned hi_ = (a) > (b) ? (a) : (b), lo_ = (a) > (b) ? (b) : (a); (a) = hi_; (b) = lo_; } while (0)
__device__ __forceinline__ unsigned row_top16_of128(unsigned (&k)[8], int l16) {
    CE(k[0], k[1]); CE(k[2], k[3]); CE(k[0], k[2]); CE(k[1], k[3]); CE(k[1], k[2]); CE(k[4], k[5]); CE(k[6], k[7]); CE(k[4], k[6]); CE(k[5], k[7]); CE(k[5], k[6]); CE(k[0], k[4]); CE(k[2], k[6]); CE(k[2], k[4]); CE(k[1], k[5]); CE(k[3], k[7]); CE(k[3], k[5]); CE(k[1], k[2]); CE(k[3], k[4]); CE(k[5], k[6]);
    unsigned mine = 0u;
#pragma unroll
    for (int q = 0; q < 16; ++q) {
        const unsigned m = row_umax(k[0]);
        const bool own = (k[0] == m);
#pragma unroll
        for (int i = 0; i < 7; ++i) k[i] = own ? k[i + 1] : k[i];
        k[7] = own ? 0u : k[7];
        mine = (l16 == q) ? m : mine;
    }
    return mine;
}
__device__ __forceinline__ unsigned row_top16_of64(unsigned (&k)[4], int l16) {
    CE(k[0], k[1]); CE(k[2], k[3]); CE(k[0], k[2]); CE(k[1], k[3]); CE(k[1], k[2]);
    unsigned mine = 0u;
#pragma unroll
    for (int q = 0; q < 16; ++q) {
        const unsigned m = row_umax(k[0]);
        const bool own = (k[0] == m);
        k[0] = own ? k[1] : k[0]; k[1] = own ? k[2] : k[1]; k[2] = own ? k[3] : k[2]; k[3] = own ? 0u : k[3];
        mine = (l16 == q) ? m : mine;
    }
    return mine;
}
struct EpiTopk {
    static constexpr bool PERM = false, AFTER_DRAIN = true;
    const float* sspart; const float* bias; int* pexp; float* pw; int head;
    __device__ __forceinline__ void fused(const f32x4 (&acc)[2][2][4][2], const pg8::Unit& u, int wr, int wc, int fr, int fq, LAS unsigned char* lds, int wid, int lane) const {
        LAS float* S = (LAS float*)lds;
        LAS unsigned* TL = (LAS unsigned*)(lds + 133120) + wid * 128;
        const int dr = lane >> 4, l16 = lane & 15;
        unsigned cc[4];
#pragma unroll
        for (int k = 0; k < 4; ++k) cc[k] = CAND_TAB[l16 * 4 + k];
#pragma unroll
        for (int ai = 0; ai < 2; ++ai) {
#pragma unroll
            for (int m = 0; m < 4; ++m) {
                const int rl = 64 * wr + 16 * m + fr; const size_t r = (size_t)u.pm * 256 + 128 * ai + rl; const int b = (int)(r >> 11);
                float tot = 0.f;
#pragma unroll
                for (int i = 0; i < 4; ++i) { const f32x4 sp = *(const f32x4*)(sspart + r * 16 + 4 * i); tot += (sp.x + sp.y) + (sp.z + sp.w); }
                const float inv = rsqrtf(tot * (1.0f / 1024.0f) + 1e-6f);
#pragma unroll
                for (int bj = 0; bj < 2; ++bj)
#pragma unroll
                    for (int n = 0; n < 2; ++n) {
                        const int c = 128 * bj + 32 * wc + 16 * n + 4 * fq;
                        const f32x4 bs = *(const f32x4*)(bias + (size_t)b * 2048 + head * 256 + c);
                        const f32x4 s = acc[ai][bj][m][n] * inv + bs;
                        *(LAS f32x4*)(S + rl * 260 + c) = s;
                    }
            }
            __syncthreads();
            for (int bt = 0; bt < 4; ++bt) {
#pragma unroll
                for (int half = 0; half < 2; ++half) {
                    const int trow = wid * 16 + bt * 4 + half * 2 + (dr >> 1), side = dr & 1;
                    const LAS f32x4* sp = (const LAS f32x4*)(S + trow * 260 + side * 128 + 8 * l16);
                    const f32x4 v0 = sp[0], v1 = sp[1];
                    unsigned k[8];
                    const unsigned tg = 127u - 8u * (unsigned)l16;
                    k[0] = key_pack(v0.x, tg, 127u); k[1] = key_pack(v0.y, tg - 1u, 127u); k[2] = key_pack(v0.z, tg - 2u, 127u); k[3] = key_pack(v0.w, tg - 3u, 127u);
                    k[4] = key_pack(v1.x, tg - 4u, 127u); k[5] = key_pack(v1.y, tg - 5u, 127u); k[6] = key_pack(v1.z, tg - 6u, 127u); k[7] = key_pack(v1.w, tg - 7u, 127u);
                    const unsigned mine = row_top16_of128(k, l16);
                    TL[(half * 2 + (dr >> 1)) * 32 + side * 16 + l16] = mine;
                }
                asm volatile("s_waitcnt lgkmcnt(0)" ::: "memory");
                unsigned ck[4];
#pragma unroll
                for (int k = 0; k < 4; ++k) {
                    const unsigned code = cc[k]; const unsigned ci = (code >> 4) & 15u, cj = code & 15u;
                    const unsigned ka = TL[dr * 32 + ci], kb = TL[dr * 32 + 16 + cj];
                    const unsigned key = key_pack(key_val(ka, 127u) + key_val(kb, 127u), 255u - code, 255u);
                    ck[k] = (code == 255u) ? 0u : key;
                }
                const unsigned best = row_top16_of64(ck, l16);
                const unsigned flat = 255u - (best & 255u);
                const float bv = key_val(best, 255u);
                const float bmax = key_val(row_umax(best), 255u);
                const float e = expf(bv - bmax);
                const float sum = row_fsum(e);
                const unsigned k1s = TL[dr * 32 + (flat >> 4)], k2s = TL[dr * 32 + 16 + (flat & 15u)];
                const int idx1 = 127 - (int)(k1s & 127u), idx2 = 127 - (int)(k2s & 127u);
                const size_t tok = (size_t)u.pm * 256 + 128 * ai + wid * 16 + bt * 4 + dr;
                pexp[tok * 128 + head * 16 + l16] = idx1 * 128 + idx2; pw[tok * 128 + head * 16 + l16] = e / sum;
                asm volatile("s_waitcnt lgkmcnt(0)" ::: "memory");
            }
            __syncthreads();
        }
    }
};
__device__ __forceinline__ void phase7(const Params& P, LAS unsigned char* lds) {
    const int wg = blockIdx.x; const int x = wg & 7, li = wg >> 3;
    for (int rnd = 0; rnd < 2; ++rnd) {
        const int unit = li + 32 * rnd; const int pm = 8 * x + (unit & 7), head = unit >> 3;
        pg8::Gemm g{1024, 1024, 1024};
        pg8::Unit u{(const char*)((const bf16_t*)(P.ws + WS_X1B) + (size_t)pm * 256 * 1024), (const char*)((const bf16_t*)(P.ws + WS_WST) + (size_t)head * 256 * 1024), pm, head, 0};
        EpiTopk E{(const float*)(P.ws + WS_MISC + MISC_SS), (const float*)(P.ws + WS_MISC + MISC_BIAS), (int*)(P.ws + WS_PAIRS), (float*)(P.ws + WS_PAIRS) + (size_t)NTOK * 128, head};
        pg8::gemm_unit<EpiTopk>(lds, g, u, E);
    }
}
constexpr size_t WS_U8 = 216 * MiB;
constexpr size_t WS_V8 = 232 * MiB;
#define U8_SCALE 512.0f
#define V8_SCALE 16.0f
__device__ __forceinline__ unsigned pack4_fp8(f32x4 v, float sc) {
    v = v * sc;
    v.x = fminf(fmaxf(v.x, -448.f), 448.f); v.y = fminf(fmaxf(v.y, -448.f), 448.f); v.z = fminf(fmaxf(v.z, -448.f), 448.f); v.w = fminf(fmaxf(v.w, -448.f), 448.f);
    int t = __builtin_amdgcn_cvt_pk_fp8_f32(v.x, v.y, 0, false);
    t = __builtin_amdgcn_cvt_pk_fp8_f32(v.z, v.w, t, true);
    return (unsigned)t;
}
__device__ __forceinline__ void tables_to_fp8(const Params& P, int wgi, int nwg) {
    const int nthr = nwg * 512;
    for (int i0 = wgi * 512 + threadIdx.x; i0 < 2 * 16384 * 64; i0 += nthr * 4) {
        f32x4 v[4][4]; bool ok[4];
#pragma unroll
        for (int q = 0; q < 4; ++q) {
            const int i = i0 + q * nthr; ok[q] = i < 2 * 16384 * 64;
            const int ii = ok[q] ? i : i0; const int tab = ii >> 20, off = (ii & ((1 << 20) - 1)) * 16;
            const float* src = (tab ? P.v_tab : P.u_tab) + off;
#pragma unroll
            for (int j = 0; j < 4; ++j) v[q][j] = *(const f32x4*)(src + 4 * j);
        }
#pragma unroll
        for (int q = 0; q < 4; ++q) {
            const int i = i0 + q * nthr;
            if (ok[q]) {
                const int tab = i >> 20, off = (i & ((1 << 20) - 1)) * 16; const float sc = tab ? V8_SCALE : U8_SCALE;
                u32x4 o; o.x = pack4_fp8(v[q][0], sc); o.y = pack4_fp8(v[q][1], sc); o.z = pack4_fp8(v[q][2], sc); o.w = pack4_fp8(v[q][3], sc);
                *(u32x4*)(P.ws + (tab ? WS_V8 : WS_U8) + (size_t)off) = o;
            }
        }
    }
}
__device__ __forceinline__ float dot16_fp8(const u32x4 r, const f32x2 (&h)[8]) {
    f32x2 a = __builtin_amdgcn_cvt_pk_f32_fp8((int)r.x, false) * h[0];
    a = a + __builtin_amdgcn_cvt_pk_f32_fp8((int)r.x, true) * h[1];
    a = a + __builtin_amdgcn_cvt_pk_f32_fp8((int)r.y, false) * h[2];
    a = a + __builtin_amdgcn_cvt_pk_f32_fp8((int)r.y, true) * h[3];
    a = a + __builtin_amdgcn_cvt_pk_f32_fp8((int)r.z, false) * h[4];
    a = a + __builtin_amdgcn_cvt_pk_f32_fp8((int)r.z, true) * h[5];
    a = a + __builtin_amdgcn_cvt_pk_f32_fp8((int)r.w, false) * h[6];
    a = a + __builtin_amdgcn_cvt_pk_f32_fp8((int)r.w, true) * h[7];
    return a.x + a.y;
}
__device__ __forceinline__ void axpy16_fp8(const u32x4 r, const float w, f32x2 (&acc)[8]) {
    const f32x2 ww = (f32x2){w, w};
    acc[0] = acc[0] + __builtin_amdgcn_cvt_pk_f32_fp8((int)r.x, false) * ww;
    acc[1] = acc[1] + __builtin_amdgcn_cvt_pk_f32_fp8((int)r.x, true) * ww;
    acc[2] = acc[2] + __builtin_amdgcn_cvt_pk_f32_fp8((int)r.y, false) * ww;
    acc[3] = acc[3] + __builtin_amdgcn_cvt_pk_f32_fp8((int)r.y, true) * ww;
    acc[4] = acc[4] + __builtin_amdgcn_cvt_pk_f32_fp8((int)r.z, false) * ww;
    acc[5] = acc[5] + __builtin_amdgcn_cvt_pk_f32_fp8((int)r.z, true) * ww;
    acc[6] = acc[6] + __builtin_amdgcn_cvt_pk_f32_fp8((int)r.w, false) * ww;
    acc[7] = acc[7] + __builtin_amdgcn_cvt_pk_f32_fp8((int)r.w, true) * ww;
}
__device__ __forceinline__ float reduce16(float (&d)[16], int lane) {
    float a[8], b[4], c[2];
    const bool b0 = lane & 1, b1 = lane & 2, b2 = lane & 4, b3 = lane & 8;
#pragma unroll
    for (int j = 0; j < 8; ++j) { const float keep = b0 ? d[2 * j + 1] : d[2 * j], send = b0 ? d[2 * j] : d[2 * j + 1]; a[j] = keep + __shfl_xor(send, 1); }
#pragma unroll
    for (int j = 0; j < 4; ++j) { const float keep = b1 ? a[2 * j + 1] : a[2 * j], send = b1 ? a[2 * j] : a[2 * j + 1]; b[j] = keep + __shfl_xor(send, 2); }
#pragma unroll
    for (int j = 0; j < 2; ++j) { const float keep = b2 ? b[2 * j + 1] : b[2 * j], send = b2 ? b[2 * j] : b[2 * j + 1]; c[j] = keep + __shfl_xor(send, 4); }
    const float keep = b3 ? c[1] : c[0], send = b3 ? c[0] : c[1];
    float v = keep + __shfl_xor(send, 8);
    v += __shfl_xor(v, 16); v += __shfl_xor(v, 32);
    return v;
}
__device__ __forceinline__ float reduce8(float (&d)[8], int lane) {
    float a[4], b[2];
    const bool b0 = lane & 1, b1 = lane & 2, b2 = lane & 4;
#pragma unroll
    for (int j = 0; j < 4; ++j) { const float keep = b0 ? d[2 * j + 1] : d[2 * j], send = b0 ? d[2 * j] : d[2 * j + 1]; a[j] = keep + __shfl_xor(send, 1); }
#pragma unroll
    for (int j = 0; j < 2; ++j) { const float keep = b1 ? a[2 * j + 1] : a[2 * j], send = b1 ? a[2 * j] : a[2 * j + 1]; b[j] = keep + __shfl_xor(send, 2); }
    const float keep = b2 ? b[1] : b[0], send = b2 ? b[0] : b[1];
    float v = keep + __shfl_xor(send, 4);
    v += __shfl_xor(v, 8); v += __shfl_xor(v, 16); v += __shfl_xor(v, 32);
    return v;
}
constexpr int P8_LDS_SE = 0;
constexpr int P8_LDS_SW = 64 * 128 * 4;
__device__ __forceinline__ void phase8(const Params& P, LAS unsigned char* lds) {
    const int lane = threadIdx.x & 63, wave = threadIdx.x >> 6;
    const float* mod = (const float*)(P.ws + WS_MISC + MISC_MOD); const float* sspart = (const float*)(P.ws + WS_MISC + MISC_SS);
    const int* pexp = (const int*)(P.ws + WS_PAIRS); const float* pw = (const float*)(P.ws + WS_PAIRS) + (size_t)NTOK * 128;
    const unsigned char* u8 = P.ws + WS_U8 + 16 * lane; const unsigned char* v8 = P.ws + WS_V8 + 16 * lane;
    LAS unsigned* SE = (LAS unsigned*)(lds + P8_LDS_SE) + wave * 8 * 128;
    LAS float* SW = (LAS float*)(lds + P8_LDS_SW) + wave * 8 * 128;
    LAS float* SD = SW;
    const int tok0 = blockIdx.x * 64 + wave * 8;
    const int b = tok0 >> 11; const float* mrow = mod + (size_t)b * NMOD;
    const unsigned long long ltmask = (1ull << lane) - 1ull;
    f32x2 hp[8][8]; int offv[8]; float gsave0[8], gsave1[8];
#pragma unroll
    for (int t = 0; t < 8; ++t) {
        const int tok = tok0 + t;
        float tot = 0.f;
#pragma unroll
        for (int i = 0; i < 4; ++i) { const f32x4 sp = *(const f32x4*)(sspart + (size_t)tok * 16 + 4 * i); tot += (sp.x + sp.y) + (sp.z + sp.w); }
        const float inv = rsqrtf(tot * (1.0f / 1024.0f) + 1e-6f);
#pragma unroll
        for (int j = 0; j < 4; ++j) {
            const int col = 16 * lane + 4 * j;
            const f32x4 x1 = *(const f32x4*)(P.out + (size_t)tok * 1024 + col);
            const f32x4 gn = *(const f32x4*)(P.norm2_g + col), sc2 = *(const f32x4*)(mrow + 4 * 1024 + col), sh2 = *(const f32x4*)(mrow + 3 * 1024 + col);
            const f32x4 h = x1 * inv * gn * (sc2 + 1.0f) + sh2;
            hp[t][2 * j] = (f32x2){h.x, h.y}; hp[t][2 * j + 1] = (f32x2){h.z, h.w};
        }
        const int e0 = pexp[(size_t)tok * 128 + lane], e1 = pexp[(size_t)tok * 128 + 64 + lane];
        const float g0 = pw[(size_t)tok * 128 + lane], g1 = pw[(size_t)tok * 128 + 64 + lane];
        const int r0 = e0 >> 11, r1 = e1 >> 11;
        int base = 0, pos0 = 0, pos1 = 0, ov = 0;
#pragma unroll
        for (int rho = 0; rho < 8; ++rho) {
            const unsigned long long m0 = __ballot(r0 == rho), m1 = __ballot(r1 == rho);
            const int c0 = __popcll(m0), c1 = __popcll(m1);
            if (r0 == rho) pos0 = base + __popcll(m0 & ltmask);
            if (r1 == rho) pos1 = base + c0 + __popcll(m1 & ltmask);
            if (lane == rho) ov = base;
            base += c0 + c1;
        }
        if (lane >= 8) ov = 128;
        offv[t] = ov;
        SE[t * 128 + pos0] = (unsigned)e0; SE[t * 128 + pos1] = (unsigned)e1;
        SW[t * 128 + pos0] = g0; SW[t * 128 + pos1] = g1;
    }
    asm volatile("s_waitcnt lgkmcnt(0)" ::: "memory");
#pragma unroll
    for (int t = 0; t < 8; ++t) { gsave0[t] = SW[t * 128 + lane]; gsave1[t] = SW[t * 128 + 64 + lane]; }
    asm volatile("s_waitcnt lgkmcnt(0)" ::: "memory");
    for (int rho = 0; rho < 8; ++rho) {
#pragma unroll
        for (int t = 0; t < 8; ++t) {
            const int beg = __builtin_amdgcn_readlane(offv[t], rho), end = __builtin_amdgcn_readlane(offv[t], rho + 1);
            for (int c = beg; c < end; c += 8) {
                const int li = c + (lane & 7); const int e8 = (int)SE[t * 128 + (li < end ? li : end - 1)];
                u32x4 r[8];
#pragma unroll
                for (int i = 0; i < 8; ++i) { const int e = __builtin_amdgcn_readlane(e8, i); r[i] = *(const u32x4*)(u8 + (size_t)e * 1024); }
                float d[8];
#pragma unroll
                for (int i = 0; i < 8; ++i) d[i] = dot16_fp8(r[i], hp[t]);
                const float v = reduce8(d, lane);
                if (lane < 8 && li < end) SD[t * 128 + li] = v;
            }
        }
    }
    asm volatile("s_waitcnt lgkmcnt(0)" ::: "memory");
#pragma unroll
    for (int t = 0; t < 8; ++t) {
        const float d0 = SD[t * 128 + lane], d1 = SD[t * 128 + 64 + lane];
        const float w0 = gsave0[t] * gelu_tanh(d0 * (1.0f / U8_SCALE)), w1 = gsave1[t] * gelu_tanh(d1 * (1.0f / U8_SCALE));
        asm volatile("s_waitcnt lgkmcnt(0)" ::: "memory");
        SW[t * 128 + lane] = w0; SW[t * 128 + 64 + lane] = w1;
    }
    asm volatile("s_waitcnt lgkmcnt(0)" ::: "memory");
    f32x2 acc[8][8];
#pragma unroll
    for (int t = 0; t < 8; ++t)
#pragma unroll
        for (int j = 0; j < 8; ++j) acc[t][j] = (f32x2){0.f, 0.f};
    for (int rho = 0; rho < 8; ++rho) {
#pragma unroll
        for (int t = 0; t < 8; ++t) {
            const int beg = __builtin_amdgcn_readlane(offv[t], rho), end = __builtin_amdgcn_readlane(offv[t], rho + 1);
            for (int c = beg; c < end; c += 8) {
                const int li = c + (lane & 7); const int lc = (li < end ? li : end - 1);
                const int e8 = (int)SE[t * 128 + lc]; const float w8 = (li < end) ? SW[t * 128 + lc] : 0.f;
                u32x4 r[8];
#pragma unroll
                for (int i = 0; i < 8; ++i) { const int e = __builtin_amdgcn_readlane(e8, i); r[i] = *(const u32x4*)(v8 + (size_t)e * 1024); }
#pragma unroll
                for (int i = 0; i < 8; ++i) { const float w = __int_as_float(__builtin_amdgcn_readlane(__float_as_int(w8), i)); axpy16_fp8(r[i], w, acc[t]); }
            }
        }
    }
#pragma unroll
    for (int t = 0; t < 8; ++t) {
        const int tok = tok0 + t;
        float ss = 0.f; f32x4 xo[4];
#pragma unroll
        for (int j = 0; j < 4; ++j) {
            const int col = 16 * lane + 4 * j;
            const f32x4 x1 = *(const f32x4*)(P.out + (size_t)tok * 1024 + col);
            const f32x4 g2 = *(const f32x4*)(mrow + 5 * 1024 + col) * (1.0f / V8_SCALE);
            const f32x4 pa = (f32x4){acc[t][2 * j].x, acc[t][2 * j].y, acc[t][2 * j + 1].x, acc[t][2 * j + 1].y};
            xo[j] = x1 + g2 * pa;
            ss += (xo[j].x * xo[j].x + xo[j].y * xo[j].y) + (xo[j].z * xo[j].z + xo[j].w * xo[j].w);
        }
        ss = wave_sum(ss);
        const float inv2 = rsqrtf(ss * (1.0f / 1024.0f) + 1e-6f);
#pragma unroll
        for (int j = 0; j < 4; ++j) {
            const int col = 16 * lane + 4 * j;
            const f32x4 fg = *(const f32x4*)(P.final_g + col);
            *(f32x4*)(P.out + (size_t)tok * 1024 + col) = xo[j] * inv2 * fg;
        }
    }
}
constexpr int LDS_BARST = 147456 - 16;
typedef __attribute__((address_space(4))) const Params* KParamsPtr;
#if defined(__HIP_DEVICE_COMPILE__)
#define LOADP(name) Params name; { KParamsPtr q_ = (KParamsPtr)__builtin_amdgcn_kernarg_segment_ptr(); asm volatile("" : "+s"(q_)); name = *q_; }
#else
#define LOADP(name) Params name = P;
#endif
__global__ void __launch_bounds__(512, 2) k_mega(Params P) {
    extern __shared__ __attribute__((aligned(16))) unsigned char lds_raw[];
    LAS unsigned char* lds = (LAS unsigned char*)lds_raw;
    const int lo = P.ph_lo, hi = P.ph_hi;
    const bool fused = (hi - lo) > 1;
    XcdBarrier bar; bar.bar = (unsigned*)(P.ws + WS_MISC + MISC_BAR); bar.x = 0; bar.st = (volatile LAS unsigned*)(lds + LDS_BARST);
    if (fused) {
        if (threadIdx.x < 4) ((LAS unsigned*)(lds + LDS_BARST))[threadIdx.x] = 0u;
        __syncthreads();
        bar = xcd_barrier_post((unsigned*)(P.ws + WS_MISC + MISC_BAR), (volatile LAS unsigned*)(lds + LDS_BARST));
    }
#ifndef REPMASK
#define REPMASK 0
#endif
#define IN(k) (lo <= (k) && (k) < hi)
#define REP(k, call) do { if (fused && ((REPMASK >> (k)) & 1)) { xcd_barrier(bar); call; } } while (0)
#define SEAM(k) do { if (fused && IN(k) && IN((k) + 1)) xcd_barrier(bar); } while (0)
    if (IN(0)) { LOADP(Pk); phase0(Pk, lds); REP(0, phase0(Pk, lds)); }
    if (fused && IN(0) && IN(1)) { cg::this_grid().sync(); }
    if (IN(1)) { LOADP(Pk); phase1(Pk, lds); REP(1, phase1(Pk, lds)); }
    SEAM(1);
    if (IN(2)) { LOADP(Pk); phase2(Pk, lds); REP(2, phase2(Pk, lds)); }
    SEAM(2);
    if (IN(3)) { LOADP(Pk); phase3(Pk, lds); REP(3, phase3(Pk, lds)); }
    SEAM(3);
    if (IN(4)) { LOADP(Pk); phase4(Pk, lds); REP(4, phase4(Pk, lds)); }
    SEAM(4);
    if (IN(5)) { LOADP(Pk); phase5(Pk, lds); REP(5, phase5(Pk, lds)); }
    SEAM(5);
    if (IN(6)) { LOADP(Pk); phase6(Pk, lds); REP(6, phase6(Pk, lds)); }
    SEAM(6);
    if (IN(7)) { LOADP(Pk); phase7(Pk, lds); REP(7, phase7(Pk, lds)); }
    SEAM(7);
    if (IN(8)) { LOADP(Pk); phase8(Pk, lds); REP(8, phase8(Pk, lds)); }
#undef IN
#undef SEAM
}
extern "C" void kernel_launch(void* const* d_in, const int* in_sizes, int n_in, void* d_out, int out_size, void* d_ws, size_t ws_size, hipStream_t stream) {
    static int grid = 0;
    if (!grid) {
        (void)hipFuncSetAttribute((const void*)k_mega, hipFuncAttributeMaxDynamicSharedMemorySize, LDS_BYTES);
        int dev = 0, cus = 0, per_cu = 0;
        (void)hipGetDevice(&dev);
        (void)hipDeviceGetAttribute(&cus, hipDeviceAttributeMultiprocessorCount, dev);
        (void)hipOccupancyMaxActiveBlocksPerMultiprocessor(&per_cu, (const void*)k_mega, 512, LDS_BYTES);
        grid = (per_cu >= 1 && cus >= 256) ? 256 : -1;
    }
    if (grid < 0) return;
    (void)hipMemsetAsync((char*)d_ws + WS_MISC + MISC_BAR, 0, XCD_BAR_WORDS * 4, stream);
    Params P{};
    const float** pp = (const float**)&P;
    for (int i = 0; i < 26; ++i) pp[i] = (const float*)d_in[i];
    P.out = (float*)d_out; P.ws = (unsigned char*)d_ws; P.ph_lo = 0; P.ph_hi = 9;
    void* args[] = {&P};
    (void)hipLaunchCooperativeKernel((const void*)k_mega, dim3(grid), dim3(512), args, LDS_BYTES, stream);
}
```

```cpp
#define REPMASK 0
#define P0REP 0
#define P1REP 0
#include <hip/hip_runtime.h>
#include <hip/hip_cooperative_groups.h>
#include <stdint.h>
#include <math.h>
namespace cg = cooperative_groups;

#define DM 1024
#define NB 8
#define SEQ 2048
#define CTXL 256
#define NTOK (NB * SEQ)
#define NCTX (NB * CTXL)
#define NMOD 6144
#define MiB (1024ull * 1024ull)
#define LAS __attribute__((address_space(3)))
typedef unsigned short bf16_t;
typedef short bf16x8 __attribute__((ext_vector_type(8)));
typedef float f32x4 __attribute__((ext_vector_type(4)));
typedef float f32x2 __attribute__((ext_vector_type(2)));
typedef unsigned u32x4 __attribute__((ext_vector_type(4)));
typedef unsigned u32x2 __attribute__((ext_vector_type(2)));

__device__ __forceinline__ float gelu_tanh(float x) {
    const float c = 0.7978845608028654f;
    return 0.5f * x * (1.0f + tanhf(c * (x + 0.044715f * x * x * x)));
}
__device__ __forceinline__ float sigmoidf_(float x) { return 1.0f / (1.0f + expf(-x)); }
__device__ __forceinline__ float silu_(float x) { return x * sigmoidf_(x); }
__device__ __forceinline__ float wave_sum(float v) {
#pragma unroll
    for (int o = 32; o > 0; o >>= 1) v += __shfl_xor(v, o);
    return v;
}
__device__ __forceinline__ unsigned cvt_pk_bf16(float lo, float hi) { unsigned r; asm volatile("v_cvt_pk_bf16_f32 %0, %1, %2" : "=v"(r) : "v"(lo), "v"(hi)); return r; }
__device__ __forceinline__ float bf2f(bf16_t v) { return __uint_as_float(((unsigned)v) << 16); }
__device__ __forceinline__ float bflo(unsigned w) { return __uint_as_float(w << 16); }
__device__ __forceinline__ float bfhi(unsigned w) { return __uint_as_float(w & 0xffff0000u); }
#define XB_TMO      128
#define XB_XCNT(j)  (256  + 64 * (j))
#define XB_XSUB(j)  (1280 + 64 * (j))
#define XB_XGEN(j)  (2304 + 64 * (j))
#define XB_TOP      3328
#define XB_TOPGEN   3392
#define XCD_BAR_WORDS 3456
#define XB_SPIN_CAP (1u << 18)
__device__ __forceinline__ unsigned xb_ld(unsigned* p)              { return __hip_atomic_load(p, __ATOMIC_RELAXED, __HIP_MEMORY_SCOPE_AGENT); }
__device__ __forceinline__ unsigned xb_add(unsigned* p, unsigned v) { return __hip_atomic_fetch_add(p, v, __ATOMIC_RELAXED, __HIP_MEMORY_SCOPE_AGENT); }
__device__ __forceinline__ unsigned xb_xcc_id() { return (unsigned)__builtin_amdgcn_s_getreg((3 << 11) | 20) & 0xFu; }
#define XB_SPIN(cond, bar) do { unsigned _sp = 0; while (cond) { __builtin_amdgcn_s_sleep(1); \
    if ((++_sp & 255u) == 0u) { if (xb_ld(&(bar)[XB_TMO])) break; if (_sp > XB_SPIN_CAP) { atomicAdd(&(bar)[XB_TMO], 1u); break; } } } } while (0)
struct XcdBarrier { unsigned* bar; unsigned x; volatile LAS unsigned* st; };
__device__ __forceinline__ XcdBarrier xcd_barrier_post(unsigned* bar, volatile LAS unsigned* st) {
    XcdBarrier b; b.bar = bar; b.x = xb_xcc_id(); b.st = st;
    if (threadIdx.x == 0) (void)xb_add(&bar[XB_XCNT(b.x)], 1u);
    return b;
}
__device__ __forceinline__ void xcd_barrier_complete(unsigned* bar, unsigned x, unsigned& nloc, unsigned& nx) {
    const unsigned G = gridDim.x * gridDim.y * gridDim.z;
    unsigned sum, cnt, mine, sp = 0u;
    for (;;) {
        sum = 0u; cnt = 0u; mine = 0u;
#pragma unroll
        for (unsigned j = 0; j < 16; ++j) { const unsigned c = xb_ld(&bar[XB_XCNT(j)]); sum += c; cnt += (c > 0u) ? 1u : 0u; mine = (j == x) ? c : mine; }
        if (sum == G) break;
        __builtin_amdgcn_s_sleep(1);
        if ((++sp & 255u) == 0u) { if (xb_ld(&bar[XB_TMO])) break; if (sp > XB_SPIN_CAP) { atomicAdd(&bar[XB_TMO], 1u); break; } }
    }
    nloc = mine > 0u ? mine : 1u; nx = cnt > 0u ? cnt : 1u;
}
__device__ __forceinline__ void xcd_barrier(const XcdBarrier& b) {
    asm volatile("s_waitcnt vmcnt(0)" ::: "memory");
    __syncthreads();
    if (threadIdx.x == 0) {
        unsigned* bar = b.bar;
        __builtin_amdgcn_s_waitcnt(0);
        unsigned nloc = b.st[0], nx = b.st[1];
        if (nloc == 0u) { xcd_barrier_complete(bar, b.x, nloc, nx); b.st[0] = nloc; b.st[1] = nx; }
        const unsigned old = xb_add(&bar[XB_XSUB(b.x)], 1u);
        const unsigned gen = old / nloc;
        if (old + 1u == (gen + 1u) * nloc) {
            __builtin_amdgcn_fence(__ATOMIC_RELEASE, "agent");
            asm volatile("s_waitcnt vmcnt(0)" ::: "memory");
            const unsigned og = xb_add(&bar[XB_TOP], 1u);
            const unsigned tg = og / nx;
            if (og + 1u == (tg + 1u) * nx) xb_add(&bar[XB_TOPGEN], 1u);
            else XB_SPIN(xb_ld(&bar[XB_TOPGEN]) == tg, bar);
            __builtin_amdgcn_fence(__ATOMIC_ACQUIRE, "agent");
            xb_add(&bar[XB_XGEN(b.x)], 1u);
            asm volatile("s_waitcnt vmcnt(0)" ::: "memory");
        } else {
            XB_SPIN(xb_ld(&bar[XB_XGEN(b.x)]) == gen, bar);
            __builtin_amdgcn_fence(__ATOMIC_ACQUIRE, "agent");
            asm volatile("s_waitcnt vmcnt(0)" ::: "memory");
        }
    }
    __syncthreads();
}
namespace pg8 {
constexpr int BM = 256, BK = 64, HALF = 128, HTB = HALF * BK * 2, STAGE_BYTES = 8 * HTB;
__device__ __forceinline__ int lds_byte(int r, int c) { const int st = (r >> 4) * 2 + (c >> 5), rr = r & 15, cc = c & 31, ob = rr * 64 + cc * 2; return st * 1024 + (ob ^ (((ob >> 9) & 1) << 5)); }
__device__ __forceinline__ void stage_rc(int b, int& R, int& C) { const int st = b / 1024, sb = b % 1024, swz = sb ^ (((sb >> 9) & 1) << 5); R = (st >> 1) * 16 + swz / 64; C = (st & 1) * 32 + (swz % 64) / 2; }
__device__ __forceinline__ int perm32(int rho) { const int n = rho >> 4, i = rho & 15; return 8 * (i >> 2) + 4 * n + (i & 3); }
struct Unit { const char* a; const char* b; int pm, pn, z; };
struct Gemm { int lda, ldb, K; };
template <class Epi>
__device__ __forceinline__ void gemm_unit(LAS unsigned char* lds, const Gemm g, const Unit cur, const Epi& E) {
    const int tid = threadIdx.x, wid = __builtin_amdgcn_readfirstlane(tid >> 6), lane = tid & 63, wr = wid >> 2, wc = wid & 3, fr = lane & 15, fq = lane >> 4;
    const int K = g.K, nt = K / BK;
    unsigned voffA[2], voffB[2];
#pragma unroll
    for (int i = 0; i < 2; ++i) { int R, C; stage_rc(tid * 16 + i * 8192, R, C); const int Rb = Epi::PERM ? ((R & ~31) + perm32(R & 31)) : R;
        voffA[i] = (unsigned)(R * g.lda + C) * 2u; voffB[i] = (unsigned)(Rb * g.ldb + C) * 2u; }
    const size_t kstep = (size_t)(BK * 2);
    const size_t hstepA = (size_t)HALF * g.lda * 2, hstepB = (size_t)HALF * g.ldb * 2;
    const unsigned ldsw = (unsigned)wid * 1024u;
    const int aoff = lds_byte(wr * 64 + fr, fq * 8), boff = lds_byte(wc * 32 + fr, fq * 8);
#define PG8_SA(b, h) (((b) * 2 + (h)) * HTB)
#define PG8_SB(b, h) ((4 + (b) * 2 + (h)) * HTB)
#define PG8_STAGE(bufoff, gbase, voff) do { _Pragma("unroll") for (int _i = 0; _i < 2; ++_i) \
        __builtin_amdgcn_global_load_lds((const unsigned*)((const char*)(gbase) + (voff)[_i]), (LAS unsigned*)(lds + (bufoff) + ldsw + _i * 8192), 16, 0, 0); } while (0)
#define PG8_LDA(dst, b, h) do { _Pragma("unroll") for (int m = 0; m < 4; ++m) _Pragma("unroll") for (int k = 0; k < 2; ++k) dst[m][k] = *(const LAS bf16x8*)(lds + PG8_SA(b, h) + aoff + m * 2048 + k * 1024); } while (0)
#define PG8_LDB(dst, b, h) do { _Pragma("unroll") for (int n = 0; n < 2; ++n) _Pragma("unroll") for (int k = 0; k < 2; ++k) dst[n][k] = *(const LAS bf16x8*)(lds + PG8_SB(b, h) + boff + n * 2048 + k * 1024); } while (0)
#define PG8_MMA(ai, bj, At, Bt) do { __builtin_amdgcn_s_setprio(1); _Pragma("unroll") for (int m = 0; m < 4; ++m) _Pragma("unroll") for (int n = 0; n < 2; ++n) _Pragma("unroll") for (int k = 0; k < 2; ++k) \
        acc[ai][bj][m][n] = __builtin_amdgcn_mfma_f32_16x16x32_bf16(Bt[n][k], At[m][k], acc[ai][bj][m][n], 0, 0, 0); __builtin_amdgcn_s_setprio(0); } while (0)
#define PG8_WAIT_V(n) asm volatile("s_waitcnt vmcnt(" #n ")" ::: "memory")
#define PG8_WAIT_L(n) asm volatile("s_waitcnt lgkmcnt(" #n ")" ::: "memory")
#define PG8_BAR __builtin_amdgcn_s_barrier()
#define PG8_SCHED __builtin_amdgcn_sched_barrier(0)
    f32x4 acc[2][2][4][2];
#pragma unroll
    for (int a = 0; a < 2; ++a)
#pragma unroll
        for (int b = 0; b < 2; ++b)
#pragma unroll
            for (int m = 0; m < 4; ++m)
#pragma unroll
                for (int n = 0; n < 2; ++n) acc[a][b][m][n] = (f32x4){0.f, 0.f, 0.f, 0.f};
    bf16x8 At[4][2], B0[2][2], B1[2][2];
    const char* cA = cur.a; const char* cB = cur.b;
    PG8_STAGE(PG8_SB(0, 0), cB, voffB); PG8_STAGE(PG8_SA(0, 0), cA, voffA); PG8_STAGE(PG8_SB(0, 1), cB + hstepB, voffB); PG8_STAGE(PG8_SA(0, 1), cA + hstepA, voffA);
    if (wr == 1) PG8_BAR;
    PG8_WAIT_V(4); PG8_BAR;
    PG8_STAGE(PG8_SB(1, 0), cB + kstep, voffB); PG8_STAGE(PG8_SA(1, 0), cA + kstep, voffA); PG8_STAGE(PG8_SB(1, 1), cB + hstepB + kstep, voffB);
    PG8_WAIT_V(6); PG8_BAR;
    for (int t = 0; t < nt; t += 2) {
        const bool last = (t == nt - 2);
        const char* a1 = cA + (size_t)(t + 1) * kstep;
        const char* a2 = last ? cA : cA + (size_t)(t + 2) * kstep; const char* b2 = last ? cB : cB + (size_t)(t + 2) * kstep;
        const char* a3 = a2 + kstep; const char* b3 = b2 + kstep;
        PG8_LDB(B0, 0, 0); PG8_SCHED; PG8_LDA(At, 0, 0); PG8_STAGE(PG8_SA(1, 1), a1 + hstepA, voffA);
        PG8_WAIT_L(8); PG8_BAR; PG8_WAIT_L(0); PG8_MMA(0, 0, At, B0); PG8_BAR; PG8_SCHED;
        PG8_LDB(B1, 0, 1); PG8_STAGE(PG8_SB(0, 0), b2, voffB);
        PG8_BAR; PG8_WAIT_L(0); PG8_MMA(0, 1, At, B1); PG8_BAR;
        PG8_LDA(At, 0, 1); PG8_STAGE(PG8_SA(0, 0), a2, voffA);
        PG8_BAR; PG8_WAIT_L(0); PG8_MMA(1, 0, At, B0); PG8_BAR; PG8_SCHED;
        PG8_STAGE(PG8_SB(0, 1), b2 + hstepB, voffB);
        PG8_WAIT_V(6); PG8_BAR; PG8_MMA(1, 1, At, B1); PG8_BAR;
        PG8_LDB(B0, 1, 0); PG8_SCHED; PG8_LDA(At, 1, 0); PG8_STAGE(PG8_SA(0, 1), a2 + hstepA, voffA);
        PG8_WAIT_L(8); PG8_BAR; PG8_WAIT_L(0); PG8_MMA(0, 0, At, B0); PG8_BAR; PG8_SCHED;
        PG8_LDB(B1, 1, 1); PG8_STAGE(PG8_SB(1, 0), b3, voffB);
        PG8_BAR; PG8_WAIT_L(0); PG8_MMA(0, 1, At, B1); PG8_BAR;
        PG8_LDA(At, 1, 1); PG8_STAGE(PG8_SA(1, 0), a3, voffA);
        PG8_BAR; PG8_WAIT_L(0); PG8_MMA(1, 0, At, B0); PG8_BAR; PG8_SCHED;
        PG8_STAGE(PG8_SB(1, 1), b3 + hstepB, voffB);
        PG8_WAIT_V(6); PG8_BAR; PG8_MMA(1, 1, At, B1); PG8_BAR;
    }
    if constexpr (!Epi::AFTER_DRAIN) { E(acc, cur, wr, wc, fr, fq); }
    PG8_WAIT_V(0);
    if (wr == 0) PG8_BAR;
    PG8_BAR;
    if constexpr (Epi::AFTER_DRAIN) { E.fused(acc, cur, wr, wc, fr, fq, lds, wid, lane); }
#undef PG8_SA
#undef PG8_SB
#undef PG8_STAGE
#undef PG8_LDA
#undef PG8_LDB
#undef PG8_MMA
#undef PG8_WAIT_V
#undef PG8_WAIT_L
#undef PG8_BAR
#undef PG8_SCHED
}
}
constexpr size_t WS_W1T = 0 * MiB;
constexpr size_t WS_WGLUT = 2 * MiB;
constexpr size_t WS_WOUTT = 3 * MiB;
constexpr size_t WS_WST = 5 * MiB;
constexpr size_t WS_WCST = 9 * MiB;
constexpr size_t WS_CS = 10 * MiB;
constexpr size_t WS_WENDT = 26 * MiB;
constexpr size_t WS_MAPT = 34 * MiB;
constexpr size_t WS_KTAB = 59 * MiB;
constexpr size_t WS_XB = 68 * MiB;
constexpr size_t WS_HCB = 100 * MiB;
constexpr size_t WS_AEXT = 108 * MiB;
constexpr size_t WS_FB = 144 * MiB;
constexpr size_t WS_GT = 160 * MiB;
constexpr size_t WS_CSPART = 176 * MiB;
constexpr size_t WS_E = 192 * MiB;
constexpr size_t WS_MISC = 250 * MiB;
constexpr size_t MISC_MOD = 0, MISC_POS = 256 * 1024, MISC_BIAS = 512 * 1024, MISC_BAR = 640 * 1024, MISC_EC = 704 * 1024, MISC_O1024 = 720 * 1024;

struct Params {
    const float *x, *c, *ctx, *c_ctx, *w_mod, *b_mod, *norm1_g, *norm2_g, *w_in, *w_out, *lam_re, *lam_im, *log_dt, *b_re, *b_im, *c_re, *c_im, *s5_d,
        *w_glu, *b_glu, *w_fourier, *w_q, *sub_keys, *u_tab, *v_tab, *final_g;
    float* out; unsigned char* ws; int ph_lo, ph_hi;
};
constexpr int LDS_BYTES = 147456;

__device__ __forceinline__ void p0_mod_item(const Params& P, LAS float* L, int item) {
    const int tid = threadIdx.x, w = tid >> 6, l = tid & 63;
    LAS float* act = L; LAS float* red = L + 9 * 1024;
    for (int idx = tid; idx < 9 * 1024; idx += 512) { int r = idx >> 10, k = idx & 1023; float v = (r < 8) ? P.c[r * 1024 + k] : P.c_ctx[k]; act[idx] = silu_(v); }
    __syncthreads();
    const int j = item * 64 + l;
    float acc[9];
#pragma unroll
    for (int r = 0; r < 9; ++r) acc[r] = 0.f;
    for (int k0 = w * 128; k0 < w * 128 + 128; k0 += 16) {
        float wv[16];
#pragma unroll
        for (int i = 0; i < 16; ++i) wv[i] = P.w_mod[(size_t)(k0 + i) * NMOD + j];
#pragma unroll
        for (int i = 0; i < 16; ++i)
#pragma unroll
            for (int r = 0; r < 9; ++r) acc[r] += act[r * 1024 + k0 + i] * wv[i];
    }
#pragma unroll
    for (int r = 0; r < 9; ++r) red[(w * 9 + r) * 64 + l] = acc[r];
    __syncthreads();
    float* mod = (float*)(P.ws + WS_MISC + MISC_MOD);
    for (int idx = tid; idx < 9 * 64; idx += 512) {
        int r = idx >> 6, l2 = idx & 63; float s = 0.f;
#pragma unroll
        for (int ww = 0; ww < 8; ++ww) s += red[(ww * 9 + r) * 64 + l2];
        mod[r * NMOD + item * 64 + l2] = s + P.b_mod[item * 64 + l2];
    }
}
__device__ __forceinline__ void p0_transpose_item(const float* src, int K, int N, bf16_t* dst, LAS float* L, int item) {
    const int tid = threadIdx.x; const int ntn = N / 64; const int k0 = (item / ntn) * 64, n0 = (item % ntn) * 64;
#pragma unroll
    for (int pass = 0; pass < 2; ++pass) {
        int kk = (tid >> 4) + 32 * pass, c4 = (tid & 15) * 4;
        f32x4 v = *(const f32x4*)(src + (size_t)(k0 + kk) * N + n0 + c4);
        L[kk * 65 + c4 + 0] = v.x; L[kk * 65 + c4 + 1] = v.y; L[kk * 65 + c4 + 2] = v.z; L[kk * 65 + c4 + 3] = v.w;
    }
    __syncthreads();
    const int n = tid >> 3, k8 = (tid & 7) * 8;
    u32x4 o;
    o.x = cvt_pk_bf16(L[(k8 + 0) * 65 + n], L[(k8 + 1) * 65 + n]); o.y = cvt_pk_bf16(L[(k8 + 2) * 65 + n], L[(k8 + 3) * 65 + n]);
    o.z = cvt_pk_bf16(L[(k8 + 4) * 65 + n], L[(k8 + 5) * 65 + n]); o.w = cvt_pk_bf16(L[(k8 + 6) * 65 + n], L[(k8 + 7) * 65 + n]);
    *(u32x4*)(dst + (size_t)(n0 + n) * K + k0 + k8) = o;
}
__device__ __forceinline__ void p0_ws_item(const Params& P, LAS float* L, int item) {
    const int tid = threadIdx.x; const int hs = item >> 4, k0 = (item & 15) * 64;
    LAS float* keysT = L;
    LAS float* wqT = L + 128 * 132;
    {
        f32x4 kv[8];
#pragma unroll
        for (int i = 0; i < 8; ++i) kv[i] = *(const f32x4*)(P.sub_keys + (size_t)hs * 16384 + (tid + 512 * i) * 4);
        f32x4 wv[4];
#pragma unroll
        for (int i = 0; i < 4; ++i) { const int idx = tid + 512 * i; const int kk = idx >> 5, d4 = (idx & 31) * 4; wv[i] = *(const f32x4*)(P.w_q + (size_t)(k0 + kk) * 2048 + hs * 128 + d4); }
#pragma unroll
        for (int i = 0; i < 8; ++i) { const int idx = (tid + 512 * i) * 4; const int key = idx >> 7, d = idx & 127;
            keysT[(d + 0) * 132 + key] = kv[i].x; keysT[(d + 1) * 132 + key] = kv[i].y; keysT[(d + 2) * 132 + key] = kv[i].z; keysT[(d + 3) * 132 + key] = kv[i].w; }
#pragma unroll
        for (int i = 0; i < 4; ++i) { const int idx = tid + 512 * i; const int kk = idx >> 5, d4 = (idx & 31) * 4;
            wqT[(d4 + 0) * 68 + kk] = wv[i].x; wqT[(d4 + 1) * 68 + kk] = wv[i].y; wqT[(d4 + 2) * 68 + kk] = wv[i].z; wqT[(d4 + 3) * 68 + kk] = wv[i].w; }
    }
    __syncthreads();
    const int kq = (tid & 31) * 4, kg = (tid >> 5) * 4;
    f32x4 acc[4];
#pragma unroll
    for (int i = 0; i < 4; ++i) acc[i] = (f32x4){0.f, 0.f, 0.f, 0.f};
#pragma unroll 4
    for (int d = 0; d < 128; ++d) {
        const f32x4 kv = *(const LAS f32x4*)(keysT + d * 132 + kq), wv = *(const LAS f32x4*)(wqT + d * 68 + kg);
        acc[0] = acc[0] + wv * kv.x; acc[1] = acc[1] + wv * kv.y; acc[2] = acc[2] + wv * kv.z; acc[3] = acc[3] + wv * kv.w;
    }
    bf16_t* dst = (bf16_t*)(P.ws + WS_WST) + (size_t)(hs * 128 + kq) * 1024 + k0 + kg;
#pragma unroll
    for (int i = 0; i < 4; ++i) { u32x2 o; o.x = cvt_pk_bf16(acc[i].x, acc[i].y); o.y = cvt_pk_bf16(acc[i].z, acc[i].w); *(u32x2*)(dst + (size_t)i * 1024) = o; }
}
__device__ __forceinline__ void p0_wcs_item(const Params& P, LAS float* L, int item) {
    const int tid = threadIdx.x; const int cs = item >> 4, g = (item >> 2) & 3, cb = item & 3;
    LAS float* tab = L;
    if (tid < 128) { float a = (float)tid / 64.0f; tab[tid] = cs ? -sinpif(a) : cospif(a); }
    __syncthreads();
    const int d = tid & 127, c0 = cb * 32 + (tid >> 7) * 8;
    float acc[8];
#pragma unroll
    for (int i = 0; i < 8; ++i) acc[i] = 0.f;
    const float* wf = P.w_fourier + (size_t)g * 16384 + d;
#pragma unroll 8
    for (int m = 0; m < 128; ++m) {
        const float wv = wf[m * 128];
#pragma unroll
        for (int i = 0; i < 8; ++i) acc[i] += tab[((c0 + i) * m) & 127] * wv;
    }
    const float alpha = 1.0f / sqrtf(2048.0f * 128.0f);
    bf16_t* row = (bf16_t*)(P.ws + WS_WCST) + (size_t)(cs * 512 + g * 128 + d) * 512;
#pragma unroll
    for (int g2 = 0; g2 < 4; ++g2) {
        u32x4 o = (u32x4){0u, 0u, 0u, 0u};
        if (g2 == g) { o.x = cvt_pk_bf16(acc[0] * alpha, acc[1] * alpha); o.y = cvt_pk_bf16(acc[2] * alpha, acc[3] * alpha); o.z = cvt_pk_bf16(acc[4] * alpha, acc[5] * alpha); o.w = cvt_pk_bf16(acc[6] * alpha, acc[7] * alpha); }
        *(u32x4*)(row + g2 * 128 + c0) = o;
    }
}
__device__ __forceinline__ void p0_s5_item(const Params& P, LAS float* L, int item) {
    const int tid = threadIdx.x; const int g = item >> 3, dir = (item >> 2) & 1, qd = item & 3;
    LAS float* Pr = L; LAS float* Pi = L + 33 * 64; LAS float* Bbr = L + 2 * 33 * 64; LAS float* Bbi = Bbr + 1024; LAS float* Cr = Bbi + 1024; LAS float* Ci = Cr + 1024;
    const int dg = dir * 32 + g;
    const float dt = expf(P.log_dt[dg]);
    if (tid < 64) {
        const int n = tid; const int i = dg * 64 + n;
        float lr = P.lam_re[i], li = P.lam_im[i];
        float mag = expf(lr * dt); float ar = mag * cosf(li * dt), ai = mag * sinf(li * dt);
        float den = lr * lr + li * li;
        float cr = ((ar - 1.0f) * lr + ai * li) / den, ci = (ai * lr - (ar - 1.0f) * li) / den;
        for (int q = 0; q < 16; ++q) {
            float br = P.b_re[(size_t)i * 16 + q], bi = P.b_im[(size_t)i * 16 + q];
            Bbr[n * 16 + q] = cr * br - ci * bi; Bbi[n * 16 + q] = cr * bi + ci * br;
        }
    }
    for (int idx = tid; idx < 33 * 64; idx += 512) {
        int tau = idx >> 6, n = idx & 63; const int i = dg * 64 + n;
        float lr = P.lam_re[i], li = P.lam_im[i];
        float mag = expf((float)tau * lr * dt), ang = (float)tau * (li * dt);
        Pr[idx] = mag * cosf(ang); Pi[idx] = mag * sinf(ang);
    }
    for (int idx = tid; idx < 1024; idx += 512) { Cr[idx] = P.c_re[(size_t)dg * 1024 + idx]; Ci[idx] = P.c_im[(size_t)dg * 1024 + idx]; }
    __syncthreads();
    {
        const int pq = tid & 255, p = pq >> 4, q = pq & 15, tau0 = qd * 8 + (tid >> 8) * 4;
        float s[4] = {0.f, 0.f, 0.f, 0.f};
#pragma unroll 4
        for (int n = 0; n < 64; ++n) {
            const float cr = Cr[p * 64 + n], ci = Ci[p * 64 + n], br = Bbr[n * 16 + q], bi = Bbi[n * 16 + q];
            const float xr = cr * br - ci * bi, xi = cr * bi + ci * br;
#pragma unroll
            for (int j = 0; j < 4; ++j) s[j] += xr * Pr[(tau0 + j) * 64 + n] - xi * Pi[(tau0 + j) * 64 + n];
        }
        float* Kt = (float*)(P.ws + WS_KTAB) + (size_t)(g * 2 + dir) * 32 * 256;
#pragma unroll
        for (int j = 0; j < 4; ++j) Kt[(tau0 + j) * 256 + pq] = s[j];
    }
    {
        bf16_t* W = (bf16_t*)(P.ws + WS_WENDT) + (size_t)(g * 256 + dir * 128 + qd * 32) * 512;
        for (int idx = tid; idx < 32 * 512 / 2; idx += 512) {
            const int row = idx >> 8, col = (idx & 255) * 2; const int n = qd * 16 + (row >> 1), ri = row & 1, s = col >> 4, q = col & 15;
            const int tau = dir ? s : (31 - s);
            const float pr = Pr[tau * 64 + n], pi = Pi[tau * 64 + n];
            const float br0 = Bbr[n * 16 + q], bi0 = Bbi[n * 16 + q], br1 = Bbr[n * 16 + q + 1], bi1 = Bbi[n * 16 + q + 1];
            const float v0 = ri ? (pr * bi0 + pi * br0) : (pr * br0 - pi * bi0), v1 = ri ? (pr * bi1 + pi * br1) : (pr * br1 - pi * bi1);
            *(unsigned*)(W + (size_t)row * 512 + col) = cvt_pk_bf16(v0, v1);
        }
    }
    {
        bf16_t* Mp = (bf16_t*)(P.ws + WS_MAPT) + ((size_t)g * 512 + qd * 128) * 768 + 512 + dir * 128;
        for (int idx = tid; idx < 128 * 64; idx += 512) {
            const int row = idx >> 6, n = idx & 63; const int t = qd * 8 + (row >> 4), p = row & 15;
            const int tau = dir ? (32 - t) : (t + 1);
            const float cr = Cr[p * 64 + n], ci = Ci[p * 64 + n], pr = Pr[tau * 64 + n], pi = Pi[tau * 64 + n];
            *(unsigned*)(Mp + (size_t)row * 768 + n * 2) = cvt_pk_bf16(cr * pr - ci * pi, -(cr * pi + ci * pr));
        }
    }
}
__device__ __forceinline__ void p0_pos_item(const Params& P) {
    float* postab = (float*)(P.ws + WS_MISC + MISC_POS);
    for (int idx = threadIdx.x; idx < 96 * 512; idx += 512) {
        int row = idx >> 9, j = idx & 511, jj = j & 255;
        float omega = 1.0f / powf(10000.0f, (float)jj / 256.0f);
        float p = (float)(row < 32 ? row : row - 32);
        float a = p * omega;
        postab[idx] = (j < 256) ? sinf(a) : cosf(a);
    }
}
__device__ __forceinline__ void tables_to_fp8(const Params& P, int wgi, int nwg);
constexpr int P0_MOD = 96, P0_TW1 = 256, P0_TGLU = 64, P0_TOUT = 256, P0_WS = 256, P0_WCS = 32, P0_S5 = 256, P0_POS = 1;
constexpr int P0_NITEMS = P0_MOD + P0_TW1 + P0_TGLU + P0_TOUT + P0_WS + P0_WCS + P0_S5 + P0_POS;
__device__ __forceinline__ void phase0(const Params& P, LAS unsigned char* lds) {
    LAS float* L = (LAS float*)lds;
    for (int it = blockIdx.x; it < P0_NITEMS; it += gridDim.x) {
        __syncthreads();
        int r = it;
        if (r < P0_S5) { p0_s5_item(P, L, r); continue; } r -= P0_S5;
        if (r < P0_WS) { p0_ws_item(P, L, r); continue; } r -= P0_WS;
        if (r < P0_MOD) { p0_mod_item(P, L, r); continue; } r -= P0_MOD;
        if (r < P0_TW1) { p0_transpose_item(P.w_in, 1024, 1024, (bf16_t*)(P.ws + WS_W1T), L, r); continue; } r -= P0_TW1;
        if (r < P0_TOUT) { p0_transpose_item(P.w_out, 1024, 1024, (bf16_t*)(P.ws + WS_WOUTT), L, r); continue; } r -= P0_TOUT;
        if (r < P0_TGLU) { p0_transpose_item(P.w_glu, 512, 512, (bf16_t*)(P.ws + WS_WGLUT), L, r); continue; } r -= P0_TGLU;
        if (r < P0_WCS) { p0_wcs_item(P, L, r); continue; } r -= P0_WCS;
        p0_pos_item(P);
    }
    __syncthreads();
    for (int i = threadIdx.x; i < 2048; i += 512) L[i] = cospif((float)i / 1024.0f);
    __syncthreads();
    bf16_t* CS = (bf16_t*)(P.ws + WS_CS);
    for (int i8 = blockIdx.x * 512 + threadIdx.x; i8 < 2 * 1024 * 1024 / 8; i8 += gridDim.x * 512) {
        const int e = i8 * 8, cs = e >> 20, k = (e >> 10) & 1023, l0 = e & 1023, sh = cs ? 512 : 0;
        float v[8];
#pragma unroll
        for (int j = 0; j < 8; ++j) v[j] = L[((k * (l0 + j)) - sh) & 2047];
        u32x4 o; o.x = cvt_pk_bf16(v[0], v[1]); o.y = cvt_pk_bf16(v[2], v[3]); o.z = cvt_pk_bf16(v[4], v[5]); o.w = cvt_pk_bf16(v[6], v[7]);
        *(u32x4*)(CS + (size_t)e) = o;
    }
}

template <bool TOK>
__device__ __forceinline__ void row_norm(int lane, const float* src, const float* posr, const float* posc, const float* gn, const float* sh, const float* sc, float* xpd, bf16_t* dst) {
    f32x4 v[4]; float ss = 0.f;
#pragma unroll
    for (int j = 0; j < 4; ++j) {
        const int col = 4 * lane + 256 * j;
        v[j] = *(const f32x4*)(src + col);
        if (TOK) { f32x4 p = (j < 2) ? *(const f32x4*)(posr + col) : *(const f32x4*)(posc + col - 512); v[j] = v[j] + p; *(f32x4*)(xpd + col) = v[j]; }
        ss += (v[j].x * v[j].x + v[j].y * v[j].y) + (v[j].z * v[j].z + v[j].w * v[j].w);
    }
    ss = wave_sum(ss);
    const float inv = rsqrtf(ss * (1.0f / 1024.0f) + 1e-6f);
#pragma unroll
    for (int j = 0; j < 4; ++j) {
        const int col = 4 * lane + 256 * j;
        f32x4 g = *(const f32x4*)(gn + col), s1 = *(const f32x4*)(sc + col), s0 = *(const f32x4*)(sh + col);
        f32x4 h = v[j] * inv * g * (s1 + 1.0f) + s0;
        u32x2 o; o.x = cvt_pk_bf16(h.x, h.y); o.y = cvt_pk_bf16(h.z, h.w);
        *(u32x2*)(dst + col) = o;
    }
}
__device__ __forceinline__ void row_norm2_tok(int lane, const float* src0, const float* src1, const float* posr0, const float* posc0, const float* posr1, const float* posc1,
                                              const float* gn, const float* sh0, const float* sc0, const float* sh1, const float* sc1, float* xpd0, float* xpd1, bf16_t* dst0, bf16_t* dst1) {
    f32x4 v0[4], v1[4], p0[4], p1[4];
#pragma unroll
    for (int j = 0; j < 4; ++j) {
        const int col = 4 * lane + 256 * j;
        v0[j] = *(const f32x4*)(src0 + col); v1[j] = *(const f32x4*)(src1 + col);
        p0[j] = (j < 2) ? *(const f32x4*)(posr0 + col) : *(const f32x4*)(posc0 + col - 512);
        p1[j] = (j < 2) ? *(const f32x4*)(posr1 + col) : *(const f32x4*)(posc1 + col - 512);
    }
    float ss0 = 0.f, ss1 = 0.f;
#pragma unroll
    for (int j = 0; j < 4; ++j) {
        const int col = 4 * lane + 256 * j;
        v0[j] = v0[j] + p0[j]; v1[j] = v1[j] + p1[j];
        *(f32x4*)(xpd0 + col) = v0[j]; *(f32x4*)(xpd1 + col) = v1[j];
        ss0 += (v0[j].x * v0[j].x + v0[j].y * v0[j].y) + (v0[j].z * v0[j].z + v0[j].w * v0[j].w);
        ss1 += (v1[j].x * v1[j].x + v1[j].y * v1[j].y) + (v1[j].z * v1[j].z + v1[j].w * v1[j].w);
    }
#pragma unroll
    for (int o = 32; o > 0; o >>= 1) { ss0 += __shfl_xor(ss0, o); ss1 += __shfl_xor(ss1, o); }
    const float inv0 = rsqrtf(ss0 * (1.0f / 1024.0f) + 1e-6f), inv1 = rsqrtf(ss1 * (1.0f / 1024.0f) + 1e-6f);
#pragma unroll
    for (int j = 0; j < 4; ++j) {
        const int col = 4 * lane + 256 * j;
        const f32x4 g = *(const f32x4*)(gn + col);
        const f32x4 a1 = *(const f32x4*)(sc0 + col), a0 = *(const f32x4*)(sh0 + col), b1 = *(const f32x4*)(sc1 + col), b0 = *(const f32x4*)(sh1 + col);
        const f32x4 h0 = v0[j] * inv0 * g * (a1 + 1.0f) + a0, h1 = v1[j] * inv1 * g * (b1 + 1.0f) + b0;
        u32x2 o0, o1; o0.x = cvt_pk_bf16(h0.x, h0.y); o0.y = cvt_pk_bf16(h0.z, h0.w); o1.x = cvt_pk_bf16(h1.x, h1.y); o1.y = cvt_pk_bf16(h1.z, h1.w);
        *(u32x2*)(dst0 + col) = o0; *(u32x2*)(dst1 + col) = o1;
    }
}
__device__ __forceinline__ void row_norm4_ctx(int lane, const float* src, const float* gn, const float* sh, const float* sc, bf16_t* dst) {
    f32x4 v[4][4]; float ss[4];
#pragma unroll
    for (int r = 0; r < 4; ++r)
#pragma unroll
        for (int j = 0; j < 4; ++j) v[r][j] = *(const f32x4*)(src + (size_t)r * 1024 + 4 * lane + 256 * j);
#pragma unroll
    for (int r = 0; r < 4; ++r) { ss[r] = 0.f;
#pragma unroll
        for (int j = 0; j < 4; ++j) ss[r] += (v[r][j].x * v[r][j].x + v[r][j].y * v[r][j].y) + (v[r][j].z * v[r][j].z + v[r][j].w * v[r][j].w); }
#pragma unroll
    for (int o = 32; o > 0; o >>= 1) {
#pragma unroll
        for (int r = 0; r < 4; ++r) ss[r] += __shfl_xor(ss[r], o); }
#pragma unroll
    for (int j = 0; j < 4; ++j) {
        const int col = 4 * lane + 256 * j;
        const f32x4 g = *(const f32x4*)(gn + col), s1 = *(const f32x4*)(sc + col), s0 = *(const f32x4*)(sh + col);
        const f32x4 gs = g * (s1 + 1.0f);
#pragma unroll
        for (int r = 0; r < 4; ++r) {
            const float inv = rsqrtf(ss[r] * (1.0f / 1024.0f) + 1e-6f);
            const f32x4 h = v[r][j] * inv * gs + s0;
            u32x2 o; o.x = cvt_pk_bf16(h.x, h.y); o.y = cvt_pk_bf16(h.z, h.w);
            *(u32x2*)(dst + (size_t)r * 1024 + col) = o;
        }
    }
}
struct EpiU {
    static constexpr bool PERM = true, AFTER_DRAIN = false;
    bf16_t* aext; bf16_t* fb; int ctx_b;
    __device__ __forceinline__ void operator()(const f32x4 (&acc)[2][2][4][2], const pg8::Unit& u, int wr, int wc, int fr, int fq) const {
#pragma unroll
        for (int ai = 0; ai < 2; ++ai)
#pragma unroll
            for (int m = 0; m < 4; ++m) {
                const int rt = 128 * ai + 64 * wr + 16 * m + fr;
#pragma unroll
                for (int bj = 0; bj < 2; ++bj) {
                    const int gcol = u.pn * 256 + 128 * bj + 32 * wc + 8 * fq;
                    const f32x4 v0 = acc[ai][bj][m][0], v1 = acc[ai][bj][m][1];
                    u32x4 w; w.x = cvt_pk_bf16(v0.x, v0.y); w.y = cvt_pk_bf16(v0.z, v0.w); w.z = cvt_pk_bf16(v1.x, v1.y); w.w = cvt_pk_bf16(v1.z, v1.w);
                    bf16_t* dst;
                    if (ctx_b >= 0) {
                        const int t = rt, g = gcol >> 4, q0 = gcol & 15, row = 512 + ctx_b * 8 + (t >> 5);
                        dst = aext + ((size_t)(g * 768 + row) * 768 + (t & 31) * 16 + q0);
                    } else {
                        const int r = u.pm * 256 + rt;
                        if (u.pn < 2) { const int b = r >> 11, t = r & 2047, g = gcol >> 4, q0 = gcol & 15, row = b * 64 + (t >> 5);
                            dst = aext + ((size_t)(g * 768 + row) * 768 + (t & 31) * 16 + q0); }
                        else dst = fb + (size_t)r * 512 + (gcol - 512);
                    }
                    *(u32x4*)dst = w;
                }
            }
    }
};
__device__ __forceinline__ void phase1(const Params& P, LAS unsigned char* lds) {
    const int tid = threadIdx.x, lane = tid & 63, wave = tid >> 6, wg = blockIdx.x;
    const float* mod = (const float*)(P.ws + WS_MISC + MISC_MOD);
    const float* postab = (const float*)(P.ws + WS_MISC + MISC_POS);
    if (wg < 16) {
        const int b = wg >> 1, pn = wg & 1;
        bf16_t* hcb = (bf16_t*)(P.ws + WS_HCB) + (size_t)wg * 256 * 1024;
        for (int j = 0; j < 32; j += 4) {
            const int rr = wave * 32 + j;
            row_norm4_ctx(lane, P.ctx + (size_t)(b * 256 + rr) * 1024, P.norm1_g, mod + 8 * NMOD, mod + 8 * NMOD + 1024, hcb + (size_t)rr * 1024);
        }
        asm volatile("s_waitcnt vmcnt(0)" ::: "memory");
        __syncthreads();
        pg8::Gemm g{1024, 1024, 1024};
        pg8::Unit u{(const char*)hcb, (const char*)((const bf16_t*)(P.ws + WS_W1T) + (size_t)pn * 256 * 1024), 0, pn, 0};
        EpiU E{(bf16_t*)(P.ws + WS_AEXT), nullptr, b};
        pg8::gemm_unit<EpiU>(lds, g, u, E);
    } else {
    const int gw = (wg - 16) * 8 + wave, ngw = (gridDim.x - 16) * 8;
    bf16_t* xb = (bf16_t*)(P.ws + WS_XB);
    for (int r0 = 2 * gw; r0 < NTOK; r0 += 2 * ngw) {
        const int r1 = r0 + 1; const int b = r0 >> 11, t0 = r0 & 2047, t1 = r1 & 2047;
        row_norm2_tok(lane, P.x + (size_t)r0 * 1024, P.x + (size_t)r1 * 1024, postab + (size_t)(t0 >> 6) * 512, postab + (size_t)(32 + (t0 & 63)) * 512,
                      postab + (size_t)(t1 >> 6) * 512, postab + (size_t)(32 + (t1 & 63)) * 512, P.norm1_g, mod + (size_t)b * NMOD, mod + (size_t)b * NMOD + 1024,
                      mod + (size_t)b * NMOD, mod + (size_t)b * NMOD + 1024, P.out + (size_t)r0 * 1024, P.out + (size_t)r1 * 1024, xb + (size_t)r0 * 1024, xb + (size_t)r1 * 1024);
    }
    {
        LAS float* sh2 = (LAS float*)lds;
        for (int idx = tid; idx < 8 * 1024; idx += 512) sh2[idx] = mod[(size_t)(idx >> 10) * NMOD + 3 * 1024 + (idx & 1023)];
        __syncthreads();
        const bf16_t* WsT = (const bf16_t*)(P.ws + WS_WST);
        float* bias = (float*)(P.ws + WS_MISC + MISC_BIAS);
        for (int n = gw; n < 2048; n += ngw) {
            float acc[8];
#pragma unroll
            for (int b = 0; b < 8; ++b) acc[b] = 0.f;
#pragma unroll
            for (int j = 0; j < 2; ++j) {
                const int k0 = lane * 8 + 512 * j;
                u32x4 wv = *(const u32x4*)(WsT + (size_t)n * 1024 + k0);
                float wf[8] = {bflo(wv.x), bfhi(wv.x), bflo(wv.y), bfhi(wv.y), bflo(wv.z), bfhi(wv.z), bflo(wv.w), bfhi(wv.w)};
#pragma unroll
                for (int b = 0; b < 8; ++b)
#pragma unroll
                    for (int i = 0; i < 8; ++i) acc[b] += sh2[b * 1024 + k0 + i] * wf[i];
            }
#pragma unroll
            for (int b = 0; b < 8; ++b) { float s = wave_sum(acc[b]); if (lane == 0) bias[b * 2048 + n] = s; }
        }
    }
    {
        const float* Kt = (const float*)(P.ws + WS_KTAB);
        bf16_t* Mp = (bf16_t*)(P.ws + WS_MAPT);
        const int nthr = (gridDim.x - 16) * 512;
#pragma unroll 4
        for (int i8 = (wg - 16) * 512 + tid; i8 < 32 * 512 * 64; i8 += nthr) {
            const int g = i8 >> 15, row = (i8 >> 6) & 511, ch = i8 & 63; const int t = row >> 4, p = row & 15, s = ch >> 1, q8 = (ch & 1) * 8;
            f32x4 a0 = (f32x4){0.f, 0.f, 0.f, 0.f}, a1 = a0;
            if (t >= s) { const float* kp = Kt + ((size_t)((g * 2 + 0) * 32 + (t - s)) * 256 + p * 16 + q8); a0 = a0 + *(const f32x4*)kp; a1 = a1 + *(const f32x4*)(kp + 4); }
            if (s >= t) { const float* kp = Kt + ((size_t)((g * 2 + 1) * 32 + (s - t)) * 256 + p * 16 + q8); a0 = a0 + *(const f32x4*)kp; a1 = a1 + *(const f32x4*)(kp + 4); }
            u32x4 o; o.x = cvt_pk_bf16(a0.x, a0.y); o.y = cvt_pk_bf16(a0.z, a0.w); o.z = cvt_pk_bf16(a1.x, a1.y); o.w = cvt_pk_bf16(a1.z, a1.w);
            *(u32x4*)(Mp + ((size_t)(g * 512 + row) * 768 + s * 16 + q8)) = o;
        }
    }
    tables_to_fp8(P, wg - 16, gridDim.x - 16);
    }
}
__device__ __forceinline__ void phase2(const Params& P, LAS unsigned char* lds) {
    const int wg = blockIdx.x;
    const int wgid = (wg & 7) * 32 + (wg >> 3);
    const int pm = (wgid >> 5) * 8 + (wgid & 7), pn = (wgid & 31) >> 3;
    pg8::Gemm g{1024, 1024, 1024};
    pg8::Unit u{(const char*)((const bf16_t*)(P.ws + WS_XB) + (size_t)pm * 256 * 1024), (const char*)((const bf16_t*)(P.ws + WS_W1T) + (size_t)pn * 256 * 1024), pm, pn, 0};
    EpiU E{(bf16_t*)(P.ws + WS_AEXT), (bf16_t*)(P.ws + WS_FB), -1};
    pg8::gemm_unit<EpiU>(lds, g, u, E);
}

constexpr size_t WS_FOLD = WS_XB;
constexpr size_t WS_YGELU = WS_FB;
constexpr size_t WS_MIXIN = WS_XB;
struct EpiGT {
    static constexpr bool PERM = true, AFTER_DRAIN = false;
    bf16_t* gt;
    __device__ __forceinline__ void operator()(const f32x4 (&acc)[2][2][4][2], const pg8::Unit& u, int wr, int wc, int fr, int fq) const {
        const int b = u.pn >> 2;
#pragma unroll
        for (int ai = 0; ai < 2; ++ai)
#pragma unroll
            for (int m = 0; m < 4; ++m) {
                const int chp = u.pm * 256 + 128 * ai + 64 * wr + 16 * m + fr;
#pragma unroll
                for (int bj = 0; bj < 2; ++bj) {
                    const int l = (u.pn & 3) * 256 + 128 * bj + 32 * wc + 8 * fq;
                    const f32x4 v0 = acc[ai][bj][m][0], v1 = acc[ai][bj][m][1];
                    u32x4 w; w.x = cvt_pk_bf16(v0.x, v0.y); w.y = cvt_pk_bf16(v0.z, v0.w); w.z = cvt_pk_bf16(v1.x, v1.y); w.w = cvt_pk_bf16(v1.z, v1.w);
                    *(u32x4*)(gt + ((size_t)((b * 512 + (chp & 511)) * 2 + (chp >> 9)) * 1024 + l)) = w;
                }
            }
    }
};
struct EpiE {
    static constexpr bool PERM = false, AFTER_DRAIN = false;
    float* base;
    __device__ __forceinline__ void operator()(const f32x4 (&acc)[2][2][4][2], const pg8::Unit& u, int wr, int wc, int fr, int fq) const {
#pragma unroll
        for (int ai = 0; ai < 2; ++ai)
#pragma unroll
            for (int m = 0; m < 4; ++m) {
                const int rt = 128 * ai + 64 * wr + 16 * m + fr;
#pragma unroll
                for (int bj = 0; bj < 2; ++bj)
#pragma unroll
                    for (int n = 0; n < 2; ++n) *(f32x4*)(base + (size_t)rt * 256 + 128 * bj + 32 * wc + 16 * n + 4 * fq) = acc[ai][bj][m][n];
            }
    }
};
__device__ __forceinline__ unsigned bf2_add(unsigned a, unsigned b, float sg) { return cvt_pk_bf16(bflo(a) + sg * bflo(b), bfhi(a) + sg * bfhi(b)); }
__device__ __forceinline__ void phase3(const Params& P, LAS unsigned char* lds) {
    const int wg = blockIdx.x;
    if (wg < 128) {
        const int pm = wg & 3, pn = wg >> 2; const int cs = pm >> 1, b = pn >> 2, lbase = (pn & 3) * 256;
        bf16_t* fold = (bf16_t*)(P.ws + WS_FOLD) + (size_t)wg * 256 * 512;
        const bf16_t* fb = (const bf16_t*)(P.ws + WS_FB) + (size_t)b * 2048 * 512;
        const float sg = cs ? -1.0f : 1.0f;
        for (int it = threadIdx.x; it < 256 * 64; it += 512 * 4) {
            u32x4 a[4], m[4];
#pragma unroll
            for (int q = 0; q < 4; ++q) { const int i = it + 512 * q; const int row = i >> 6, ch8 = (i & 63) * 8; const int l = lbase + row;
                a[q] = *(const u32x4*)(fb + (size_t)l * 512 + ch8); m[q] = *(const u32x4*)(fb + (size_t)((2048 - l) & 2047) * 512 + ch8); }
#pragma unroll
            for (int q = 0; q < 4; ++q) { const int i = it + 512 * q; const int row = i >> 6, ch8 = (i & 63) * 8; const int l = lbase + row;
                u32x4 o;
                if (l == 0) { o = cs ? (u32x4){0u, 0u, 0u, 0u} : a[q]; }
                else { o.x = bf2_add(a[q].x, m[q].x, sg); o.y = bf2_add(a[q].y, m[q].y, sg); o.z = bf2_add(a[q].z, m[q].z, sg); o.w = bf2_add(a[q].w, m[q].w, sg); }
                *(u32x4*)(fold + (size_t)row * 512 + ch8) = o; }
        }
        asm volatile("s_waitcnt vmcnt(0)" ::: "memory");
        __syncthreads();
        pg8::Gemm g{512, 512, 512};
        pg8::Unit u{(const char*)((const bf16_t*)(P.ws + WS_WCST) + (size_t)pm * 256 * 512), (const char*)fold, pm, pn, 0};
        EpiGT E{(bf16_t*)(P.ws + WS_GT)};
        pg8::gemm_unit<EpiGT>(lds, g, u, E);
    } else if (wg < 224) {
        const int w2 = wg - 128; const int gg = w2 / 3, mt = w2 % 3;
        pg8::Gemm g{768, 512, 512};
        pg8::Unit u{(const char*)((const bf16_t*)(P.ws + WS_AEXT) + (size_t)(gg * 768 + mt * 256) * 768), (const char*)((const bf16_t*)(P.ws + WS_WENDT) + (size_t)gg * 256 * 512), mt, 0, gg};
        EpiE E{(float*)(P.ws + WS_E) + (size_t)(gg * 768 + mt * 256) * 256};
        pg8::gemm_unit<EpiE>(lds, g, u, E);
    }
    {
        const int lane = threadIdx.x & 63, wave = threadIdx.x >> 6;
        float* ecv = (float*)(P.ws + WS_MISC + MISC_EC);
        const bf16_t* WcsT = (const bf16_t*)(P.ws + WS_WCST); const bf16_t* fb = (const bf16_t*)(P.ws + WS_FB);
#pragma unroll
        for (int q = 0; q < 2; ++q) {
            const int ent = wg * 16 + wave * 2 + q; const int b = ent >> 9, ch = ent & 511, gq = ch >> 7;
            const unsigned fw = *(const unsigned*)(fb + ((size_t)b * 2048 + 1024) * 512 + gq * 128 + 2 * lane);
            const unsigned ww = *(const unsigned*)(WcsT + (size_t)ch * 512 + gq * 128 + 2 * lane);
            float e = bflo(fw) * bflo(ww) + bfhi(fw) * bfhi(ww);
            e = wave_sum(e);
            if (lane == 0) ecv[ent] = e;
        }
    }
}
struct EpiY {
    static constexpr bool PERM = true, AFTER_DRAIN = false;
    const bf16_t* arow; const float* dskip; bf16_t* yg; int g, mt, nt;
    __device__ __forceinline__ void operator()(const f32x4 (&acc)[2][2][4][2], const pg8::Unit& u, int wr, int wc, int fr, int fq) const {
#pragma unroll
        for (int ai = 0; ai < 2; ++ai)
#pragma unroll
            for (int m = 0; m < 4; ++m) {
                const int row = mt * 256 + 128 * ai + 64 * wr + 16 * m + fr; const int b = row >> 6, c = row & 63;
#pragma unroll
                for (int bj = 0; bj < 2; ++bj) {
                    const int col0 = nt * 256 + 128 * bj + 32 * wc + 8 * fq; const int t = col0 >> 4, p0 = col0 & 15;
                    const u32x4 uv = *(const u32x4*)(arow + (size_t)row * 768 + t * 16 + p0);
                    const f32x4 d0 = *(const f32x4*)(dskip + g * 16 + p0), d1 = *(const f32x4*)(dskip + g * 16 + p0 + 4);
                    const f32x4 v0 = acc[ai][bj][m][0], v1 = acc[ai][bj][m][1];
                    float y[8] = {v0.x + d0.x * bflo(uv.x), v0.y + d0.y * bfhi(uv.x), v0.z + d0.z * bflo(uv.y), v0.w + d0.w * bfhi(uv.y),
                                  v1.x + d1.x * bflo(uv.z), v1.y + d1.y * bfhi(uv.z), v1.z + d1.z * bflo(uv.w), v1.w + d1.w * bfhi(uv.w)};
#pragma unroll
                    for (int i = 0; i < 8; ++i) y[i] = gelu_tanh(y[i]);
                    u32x4 w; w.x = cvt_pk_bf16(y[0], y[1]); w.y = cvt_pk_bf16(y[2], y[3]); w.z = cvt_pk_bf16(y[4], y[5]); w.w = cvt_pk_bf16(y[6], y[7]);
                    const size_t tok = (size_t)b * 2048 + c * 32 + t;
                    *(u32x4*)(yg + tok * 512 + g * 16 + p0) = w;
                }
            }
    }
};
struct EpiP {
    static constexpr bool PERM = true, AFTER_DRAIN = false;
    bf16_t* base;
    __device__ __forceinline__ void operator()(const f32x4 (&acc)[2][2][4][2], const pg8::Unit& u, int wr, int wc, int fr, int fq) const {
#pragma unroll
        for (int ai = 0; ai < 2; ++ai)
#pragma unroll
            for (int m = 0; m < 4; ++m) {
                const int rt = 128 * ai + 64 * wr + 16 * m + fr;
#pragma unroll
                for (int bj = 0; bj < 2; ++bj) {
                    const f32x4 v0 = acc[ai][bj][m][0], v1 = acc[ai][bj][m][1];
                    u32x4 w; w.x = cvt_pk_bf16(v0.x, v0.y); w.y = cvt_pk_bf16(v0.z, v0.w); w.z = cvt_pk_bf16(v1.x, v1.y); w.w = cvt_pk_bf16(v1.z, v1.w);
                    *(u32x4*)(base + (size_t)rt * 512 + 128 * bj + 32 * wc + 8 * fq) = w;
                }
            }
    }
};
__device__ __forceinline__ void s5_carry(const Params& P, int g, int mt) {
    const int tid = threadIdx.x; const int bl = tid >> 7, dir = (tid >> 6) & 1, n = tid & 63; const int b = mt * 4 + bl;
    const int dg = dir * 32 + g, i = dg * 64 + n;
    const float dt = expf(P.log_dt[dg]); const float lr = P.lam_re[i], li = P.lam_im[i];
    const float mag = expf(32.0f * lr * dt), ang = 32.0f * (li * dt);
    const float atr = mag * cosf(ang), ati = mag * sinf(ang);
    const float* Eg = (const float*)(P.ws + WS_E) + (size_t)g * 768 * 256 + dir * 128 + n * 2;
    bf16_t* Ag = (bf16_t*)(P.ws + WS_AEXT) + (size_t)g * 768 * 768 + 512 + dir * 128 + n * 2;
    float hr = 0.f, hi = 0.f;
    {
        f32x2 e[8];
#pragma unroll
        for (int k = 0; k < 8; ++k) { const int cp = dir ? 7 - k : k; e[k] = *(const f32x2*)(Eg + (size_t)(512 + b * 8 + cp) * 256); }
#pragma unroll
        for (int k = 0; k < 8; ++k) { const float nr = atr * hr - ati * hi + e[k].x, ni = atr * hi + ati * hr + e[k].y; hr = nr; hi = ni; }
    }
    for (int k0 = 0; k0 < 64; k0 += 8) {
        f32x2 e[8];
#pragma unroll
        for (int k = 0; k < 8; ++k) { const int c = dir ? 63 - (k0 + k) : (k0 + k); e[k] = *(const f32x2*)(Eg + (size_t)(b * 64 + c) * 256); }
#pragma unroll
        for (int k = 0; k < 8; ++k) {
            const int c = dir ? 63 - (k0 + k) : (k0 + k);
            *(unsigned*)(Ag + (size_t)(b * 64 + c) * 768) = cvt_pk_bf16(hr, hi);
            const float nr = atr * hr - ati * hi + e[k].x, ni = atr * hi + ati * hr + e[k].y; hr = nr; hi = ni;
        }
    }
}
__device__ __forceinline__ void phase4(const Params& P, LAS unsigned char* lds) {
    const int wg = blockIdx.x;
    if (wg < 128) {
        const int gg = wg >> 2, mt = (wg >> 1) & 1, nt = wg & 1;
        s5_carry(P, gg, mt);
        asm volatile("s_waitcnt vmcnt(0)" ::: "memory");
        __syncthreads();
        const bf16_t* Ag = (const bf16_t*)(P.ws + WS_AEXT) + (size_t)gg * 768 * 768;
        pg8::Gemm g{768, 768, 768};
        pg8::Unit u{(const char*)(Ag + (size_t)mt * 256 * 768), (const char*)((const bf16_t*)(P.ws + WS_MAPT) + (size_t)(gg * 512 + nt * 256) * 768), mt, nt, gg};
        EpiY E{Ag, P.s5_d, (bf16_t*)(P.ws + WS_YGELU), gg, mt, nt};
        pg8::gemm_unit<EpiY>(lds, g, u, E);
    }
    else {
        const int idx = wg - 128; const int b = idx & 7, j = idx >> 3; const int cs = j >> 3, mt = (j >> 1) & 3, nt = j & 1;
        pg8::Gemm g{1024, 2048, 1024};
        pg8::Unit u{(const char*)((const bf16_t*)(P.ws + WS_CS) + (size_t)(cs * 1024 + mt * 256) * 1024),
                    (const char*)((const bf16_t*)(P.ws + WS_GT) + ((size_t)(b * 512 + nt * 256) * 2 + cs) * 1024), mt, nt, b};
        EpiP E{(bf16_t*)(P.ws + WS_CSPART) + ((size_t)(cs * 8 + b) * 1024 + mt * 256) * 512 + nt * 256};
        pg8::gemm_unit<EpiP>(lds, g, u, E);
    }
    {
        const int lane = threadIdx.x & 63, wave = threadIdx.x >> 6;
        const float* ecv = (const float*)(P.ws + WS_MISC + MISC_EC); float* o1024 = (float*)(P.ws + WS_MISC + MISC_O1024);
        const bf16_t* GT = (const bf16_t*)(P.ws + WS_GT);
#pragma unroll
        for (int q = 0; q < 2; ++q) {
            const int ent = wg * 16 + wave * 2 + q; const int b = ent >> 9, ch = ent & 511;
            const u32x4 g0 = *(const u32x4*)(GT + (size_t)(b * 512 + ch) * 2048 + 16 * lane), g1 = *(const u32x4*)(GT + (size_t)(b * 512 + ch) * 2048 + 16 * lane + 8);
            float s = (bflo(g0.x) - bfhi(g0.x)) + (bflo(g0.y) - bfhi(g0.y)) + (bflo(g0.z) - bfhi(g0.z)) + (bflo(g0.w) - bfhi(g0.w))
                    + (bflo(g1.x) - bfhi(g1.x)) + (bflo(g1.y) - bfhi(g1.y)) + (bflo(g1.z) - bfhi(g1.z)) + (bflo(g1.w) - bfhi(g1.w));
            s = wave_sum(s);
            if (lane == 0) o1024[ent] = s + ecv[ent];
        }
    }
}
struct EpiGlu {
    static constexpr bool PERM = true, AFTER_DRAIN = false;
    const bf16_t* yg; const float* bglu; bf16_t* mixin;
    __device__ __forceinline__ void operator()(const f32x4 (&acc)[2][2][4][2], const pg8::Unit& u, int wr, int wc, int fr, int fq) const {
#pragma unroll
        for (int ai = 0; ai < 2; ++ai)
#pragma unroll
            for (int m = 0; m < 4; ++m) {
                const size_t r = (size_t)u.pm * 256 + 128 * ai + 64 * wr + 16 * m + fr;
#pragma unroll
                for (int bj = 0; bj < 2; ++bj) {
                    const int c0 = u.pn * 256 + 128 * bj + 32 * wc + 8 * fq;
                    const u32x4 yv = *(const u32x4*)(yg + r * 512 + c0);
                    const f32x4 b0 = *(const f32x4*)(bglu + c0), b1 = *(const f32x4*)(bglu + c0 + 4);
                    const f32x4 v0 = acc[ai][bj][m][0] + b0, v1 = acc[ai][bj][m][1] + b1;
                    float s[8] = {bflo(yv.x) * sigmoidf_(v0.x), bfhi(yv.x) * sigmoidf_(v0.y), bflo(yv.y) * sigmoidf_(v0.z), bfhi(yv.y) * sigmoidf_(v0.w),
                                  bflo(yv.z) * sigmoidf_(v1.x), bfhi(yv.z) * sigmoidf_(v1.y), bflo(yv.w) * sigmoidf_(v1.z), bfhi(yv.w) * sigmoidf_(v1.w)};
                    u32x4 w; w.x = cvt_pk_bf16(s[0], s[1]); w.y = cvt_pk_bf16(s[2], s[3]); w.z = cvt_pk_bf16(s[4], s[5]); w.w = cvt_pk_bf16(s[6], s[7]);
                    *(u32x4*)(mixin + r * 1024 + c0) = w;
                }
            }
    }
};
__device__ __forceinline__ void phase5(const Params& P, LAS unsigned char* lds) {
    const int wg = blockIdx.x;
    bf16_t* mixin = (bf16_t*)(P.ws + WS_MIXIN);
    if (wg < 128) {
        const int pm = wg >> 1, pn = wg & 1;
        const bf16_t* yg = (const bf16_t*)(P.ws + WS_YGELU);
        pg8::Gemm g{512, 512, 512};
        pg8::Unit u{(const char*)(yg + (size_t)pm * 256 * 512), (const char*)((const bf16_t*)(P.ws + WS_WGLUT) + (size_t)pn * 256 * 512), pm, pn, 0};
        EpiGlu E{yg, P.b_glu, mixin};
        pg8::gemm_unit<EpiGlu>(lds, g, u, E);
    } else {
        const bf16_t* Cp = (const bf16_t*)(P.ws + WS_CSPART); const bf16_t* Sp = Cp + (size_t)8 * 1024 * 512;
        const float* ecv = (const float*)(P.ws + WS_MISC + MISC_EC); const float* o1024 = (const float*)(P.ws + WS_MISC + MISC_O1024);
        for (int i8 = (wg - 128) * 512 + threadIdx.x; i8 < NTOK * 64; i8 += 128 * 512) {
            const int tok = i8 >> 6, ch = (i8 & 63) * 8; const int b = tok >> 11, k = tok & 2047;
            const f32x4 e0 = *(const f32x4*)(ecv + b * 512 + ch), e1 = *(const f32x4*)(ecv + b * 512 + ch + 4);
            float v[8];
            if (k == 1024) {
                const f32x4 o0 = *(const f32x4*)(o1024 + b * 512 + ch), o1 = *(const f32x4*)(o1024 + b * 512 + ch + 4);
                v[0] = o0.x; v[1] = o0.y; v[2] = o0.z; v[3] = o0.w; v[4] = o1.x; v[5] = o1.y; v[6] = o1.z; v[7] = o1.w;
            } else {
                const int kk = (k < 1024) ? k : 2048 - k; const float sg = (k < 1024) ? 1.0f : -1.0f, se = (kk & 1) ? -1.0f : 1.0f;
                const u32x4 c = *(const u32x4*)(Cp + ((size_t)b * 1024 + kk) * 512 + ch), s = *(const u32x4*)(Sp + ((size_t)b * 1024 + kk) * 512 + ch);
                v[0] = bflo(c.x) + sg * bflo(s.x) + se * e0.x; v[1] = bfhi(c.x) + sg * bfhi(s.x) + se * e0.y; v[2] = bflo(c.y) + sg * bflo(s.y) + se * e0.z; v[3] = bfhi(c.y) + sg * bfhi(s.y) + se * e0.w;
                v[4] = bflo(c.z) + sg * bflo(s.z) + se * e1.x; v[5] = bfhi(c.z) + sg * bfhi(s.z) + se * e1.y; v[6] = bflo(c.w) + sg * bflo(s.w) + se * e1.z; v[7] = bfhi(c.w) + sg * bfhi(s.w) + se * e1.w;
            }
            u32x4 w; w.x = cvt_pk_bf16(v[0], v[1]); w.y = cvt_pk_bf16(v[2], v[3]); w.z = cvt_pk_bf16(v[4], v[5]); w.w = cvt_pk_bf16(v[6], v[7]);
            *(u32x4*)(mixin + (size_t)tok * 1024 + 512 + ch) = w;
        }
    }
}
constexpr size_t WS_X1B = WS_AEXT;
constexpr size_t WS_PAIRS = WS_XB;
constexpr size_t MISC_SS = 1024 * 1024;
struct EpiOut {
    static constexpr bool PERM = false, AFTER_DRAIN = false;
    float* xio; const float* mod; const float* g2n; bf16_t* x1b; float* sspart;
    __device__ __forceinline__ void operator()(const f32x4 (&acc)[2][2][4][2], const pg8::Unit& u, int wr, int wc, int fr, int fq) const {
#pragma unroll
        for (int ai = 0; ai < 2; ++ai)
#pragma unroll
            for (int m = 0; m < 4; ++m) {
                const size_t r = (size_t)u.pm * 256 + 128 * ai + 64 * wr + 16 * m + fr; const int b = (int)(r >> 11);
                const float* mrow = mod + (size_t)b * NMOD;
                float ss = 0.f;
#pragma unroll
                for (int bj = 0; bj < 2; ++bj)
#pragma unroll
                    for (int n = 0; n < 2; ++n) {
                        const int col = u.pn * 256 + 128 * bj + 32 * wc + 16 * n + 4 * fq;
                        const f32x4 xp = *(const f32x4*)(xio + r * 1024 + col);
                        const f32x4 g1 = *(const f32x4*)(mrow + 2 * 1024 + col), sc2 = *(const f32x4*)(mrow + 4 * 1024 + col), gn = *(const f32x4*)(g2n + col);
                        const f32x4 x1 = xp + g1 * acc[ai][bj][m][n];
                        *(f32x4*)(xio + r * 1024 + col) = x1;
                        ss += (x1.x * x1.x + x1.y * x1.y) + (x1.z * x1.z + x1.w * x1.w);
                        const f32x4 hb = x1 * gn * (sc2 + 1.0f);
                        u32x2 o; o.x = cvt_pk_bf16(hb.x, hb.y); o.y = cvt_pk_bf16(hb.z, hb.w);
                        *(u32x2*)(x1b + r * 1024 + col) = o;
                    }
                ss += __shfl_xor(ss, 16); ss += __shfl_xor(ss, 32);
                if (fq == 0) sspart[r * 16 + u.pn * 4 + wc] = ss;
            }
    }
};
__device__ __forceinline__ void phase6(const Params& P, LAS unsigned char* lds) {
    const int wg = blockIdx.x;
    const int wgid = (wg & 7) * 32 + (wg >> 3);
    const int pm = (wgid >> 5) * 8 + (wgid & 7), pn = (wgid & 31) >> 3;
    pg8::Gemm g{1024, 1024, 1024};
    pg8::Unit u{(const char*)((const bf16_t*)(P.ws + WS_MIXIN) + (size_t)pm * 256 * 1024), (const char*)((const bf16_t*)(P.ws + WS_WOUTT) + (size_t)pn * 256 * 1024), pm, pn, 0};
    EpiOut E{P.out, (const float*)(P.ws + WS_MISC + MISC_MOD), P.norm2_g, (bf16_t*)(P.ws + WS_X1B), (float*)(P.ws + WS_MISC + MISC_SS)};
    pg8::gemm_unit<EpiOut>(lds, g, u, E);
}
__device__ __forceinline__ unsigned key_pack(float v, unsigned tag, unsigned mask) {
    unsigned b = __float_as_uint(v); b ^= (b >> 31) ? 0xffffffffu : 0x80000000u; return (b & ~mask) | tag;
}
__device__ __forceinline__ float key_val(unsigned k, unsigned mask) { unsigned b = k & ~mask; b ^= (b >> 31) ? 0x80000000u : 0xffffffffu; return __uint_as_float(b); }
__device__ const unsigned char CAND_TAB[64] = {0,1,2,3,4,5,6,7,8,9,10,11,12,13,14,15,16,17,18,19,20,21,22,23,32,33,34,35,36,48,49,50,51,64,65,66,80,81,96,97,112,113,128,144,160,176,192,208,224,240,
    255,255,255,255,255,255,255,255,255,255,255,255,255,255};
#define DPP_ROR(v, n) ((unsigned)__builtin_amdgcn_update_dpp(0, (int)(v), 0x120 + (n), 0xf, 0xf, false))
__device__ __forceinline__ unsigned row_umax(unsigned m) {
    unsigned t;
    t = DPP_ROR(m, 8); m = m > t ? m : t; t = DPP_ROR(m, 4); m = m > t ? m : t; t = DPP_ROR(m, 2); m = m > t ? m : t; t = DPP_ROR(m, 1); m = m > t ? m : t;
    return m;
}
__device__ __forceinline__ float row_fsum(float s) {
    s += __int_as_float(__builtin_amdgcn_update_dpp(0, __float_as_int(s), 0x128, 0xf, 0xf, false));
    s += __int_as_float(__builtin_amdgcn_update_dpp(0, __float_as_int(s), 0x124, 0xf, 0xf, false));
    s += __int_as_float(__builtin_amdgcn_update_dpp(0, __float_as_int(s), 0x122, 0xf, 0xf, false));
    s += __int_as_float(__builtin_amdgcn_update_dpp(0, __float_as_int(s), 0x121, 0xf, 0xf, false));
    return s;
}
#define CE(a, b) do { const unsigned hi_ = (a) > (b) ? (a) : (b), lo_ = (a) > (b) ? (b) : (a); (a) = hi_; (b) = lo_; } while (0)
__device__ __forceinline__ unsigned row_top16_of128(unsigned (&k)[8], int l16) {
    CE(k[0], k[1]); CE(k[2], k[3]); CE(k[0], k[2]); CE(k[1], k[3]); CE(k[1], k[2]); CE(k[4], k[5]); CE(k[6], k[7]); CE(k[4], k[6]); CE(k[5], k[7]); CE(k[5], k[6]); CE(k[0], k[4]); CE(k[2], k[6]); CE(k[2], k[4]); CE(k[1], k[5]); CE(k[3], k[7]); CE(k[3], k[5]); CE(k[1], k[2]); CE(k[3], k[4]); CE(k[5], k[6]);
    unsigned mine = 0u;
#pragma unroll
    for (int q = 0; q < 16; ++q) {
        const unsigned m = row_umax(k[0]);
        const bool own = (k[0] == m);
#pragma unroll
        for (int i = 0; i < 7; ++i) k[i] = own ? k[i + 1] : k[i];
        k[7] = own ? 0u : k[7];
        mine = (l16 == q) ? m : mine;
    }
    return mine;
}
__device__ __forceinline__ unsigned row_top16_of64(unsigned (&k)[4], int l16) {
    CE(k[0], k[1]); CE(k[2], k[3]); CE(k[0], k[2]); CE(k[1], k[3]); CE(k[1], k[2]);
    unsigned mine = 0u;
#pragma unroll
    for (int q = 0; q < 16; ++q) {
        const unsigned m = row_umax(k[0]);
        const bool own = (k[0] == m);
        k[0] = own ? k[1] : k[0]; k[1] = own ? k[2] : k[1]; k[2] = own ? k[3] : k[2]; k[3] = own ? 0u : k[3];
        mine = (l16 == q) ? m : mine;
    }
    return mine;
}
struct EpiTopk {
    static constexpr bool PERM = false, AFTER_DRAIN = true;
    const float* sspart; const float* bias; int* pexp; float* pw; int head;
    __device__ __forceinline__ void fused(const f32x4 (&acc)[2][2][4][2], const pg8::Unit& u, int wr, int wc, int fr, int fq, LAS unsigned char* lds, int wid, int lane) const {
        LAS float* S = (LAS float*)lds;
        LAS unsigned* TL = (LAS unsigned*)(lds + 133120) + wid * 128;
        const int dr = lane >> 4, l16 = lane & 15;
        unsigned cc[4];
#pragma unroll
        for (int k = 0; k < 4; ++k) cc[k] = CAND_TAB[l16 * 4 + k];
#pragma unroll
        for (int ai = 0; ai < 2; ++ai) {
#pragma unroll
            for (int m = 0; m < 4; ++m) {
                const int rl = 64 * wr + 16 * m + fr; const size_t r = (size_t)u.pm * 256 + 128 * ai + rl; const int b = (int)(r >> 11);
                float tot = 0.f;
#pragma unroll
                for (int i = 0; i < 4; ++i) { const f32x4 sp = *(const f32x4*)(sspart + r * 16 + 4 * i); tot += (sp.x + sp.y) + (sp.z + sp.w); }
                const float inv = rsqrtf(tot * (1.0f / 1024.0f) + 1e-6f);
#pragma unroll
                for (int bj = 0; bj < 2; ++bj)
#pragma unroll
                    for (int n = 0; n < 2; ++n) {
                        const int c = 128 * bj + 32 * wc + 16 * n + 4 * fq;
                        const f32x4 bs = *(const f32x4*)(bias + (size_t)b * 2048 + head * 256 + c);
                        const f32x4 s = acc[ai][bj][m][n] * inv + bs;
                        *(LAS f32x4*)(S + rl * 260 + c) = s;
                    }
            }
            __syncthreads();
            for (int bt = 0; bt < 4; ++bt) {
#pragma unroll
                for (int half = 0; half < 2; ++half) {
                    const int trow = wid * 16 + bt * 4 + half * 2 + (dr >> 1), side = dr & 1;
                    const LAS f32x4* sp = (const LAS f32x4*)(S + trow * 260 + side * 128 + 8 * l16);
                    const f32x4 v0 = sp[0], v1 = sp[1];
                    unsigned k[8];
                    const unsigned tg = 127u - 8u * (unsigned)l16;
                    k[0] = key_pack(v0.x, tg, 127u); k[1] = key_pack(v0.y, tg - 1u, 127u); k[2] = key_pack(v0.z, tg - 2u, 127u); k[3] = key_pack(v0.w, tg - 3u, 127u);
                    k[4] = key_pack(v1.x, tg - 4u, 127u); k[5] = key_pack(v1.y, tg - 5u, 127u); k[6] = key_pack(v1.z, tg - 6u, 127u); k[7] = key_pack(v1.w, tg - 7u, 127u);
                    const unsigned mine = row_top16_of128(k, l16);
                    TL[(half * 2 + (dr >> 1)) * 32 + side * 16 + l16] = mine;
                }
                asm volatile("s_waitcnt lgkmcnt(0)" ::: "memory");
                unsigned ck[4];
#pragma unroll
                for (int k = 0; k < 4; ++k) {
                    const unsigned code = cc[k]; const unsigned ci = (code >> 4) & 15u, cj = code & 15u;
                    const unsigned ka = TL[dr * 32 + ci], kb = TL[dr * 32 + 16 + cj];
                    const unsigned key = key_pack(key_val(ka, 127u) + key_val(kb, 127u), 255u - code, 255u);
                    ck[k] = (code == 255u) ? 0u : key;
                }
                const unsigned best = row_top16_of64(ck, l16);
                const unsigned flat = 255u - (best & 255u);
                const float bv = key_val(best, 255u);
                const float bmax = key_val(row_umax(best), 255u);
                const float e = expf(bv - bmax);
                const float sum = row_fsum(e);
                const unsigned k1s = TL[dr * 32 + (flat >> 4)], k2s = TL[dr * 32 + 16 + (flat & 15u)];
                const int idx1 = 127 - (int)(k1s & 127u), idx2 = 127 - (int)(k2s & 127u);
                const size_t tok = (size_t)u.pm * 256 + 128 * ai + wid * 16 + bt * 4 + dr;
                pexp[tok * 128 + head * 16 + l16] = idx1 * 128 + idx2; pw[tok * 128 + head * 16 + l16] = e / sum;
                asm volatile("s_waitcnt lgkmcnt(0)" ::: "memory");
            }
            __syncthreads();
        }
    }
};
__device__ __forceinline__ void phase7(const Params& P, LAS unsigned char* lds) {
    const int wg = blockIdx.x; const int x = wg & 7, li = wg >> 3;
    for (int rnd = 0; rnd < 2; ++rnd) {
        const int unit = li + 32 * rnd; const int pm = 8 * x + (unit & 7), head = unit >> 3;
        pg8::Gemm g{1024, 1024, 1024};
        pg8::Unit u{(const char*)((const bf16_t*)(P.ws + WS_X1B) + (size_t)pm * 256 * 1024), (const char*)((const bf16_t*)(P.ws + WS_WST) + (size_t)head * 256 * 1024), pm, head, 0};
        EpiTopk E{(const float*)(P.ws + WS_MISC + MISC_SS), (const float*)(P.ws + WS_MISC + MISC_BIAS), (int*)(P.ws + WS_PAIRS), (float*)(P.ws + WS_PAIRS) + (size_t)NTOK * 128, head};
        pg8::gemm_unit<EpiTopk>(lds, g, u, E);
    }
}
constexpr size_t WS_U8 = 216 * MiB;
constexpr size_t WS_V8 = 232 * MiB;
#define U8_SCALE 512.0f
#define V8_SCALE 16.0f
__device__ __forceinline__ unsigned pack4_fp8(f32x4 v, float sc) {
    v = v * sc;
    v.x = fminf(fmaxf(v.x, -448.f), 448.f); v.y = fminf(fmaxf(v.y, -448.f), 448.f); v.z = fminf(fmaxf(v.z, -448.f), 448.f); v.w = fminf(fmaxf(v.w, -448.f), 448.f);
    int t = __builtin_amdgcn_cvt_pk_fp8_f32(v.x, v.y, 0, false);
    t = __builtin_amdgcn_cvt_pk_fp8_f32(v.z, v.w, t, true);
    return (unsigned)t;
}
constexpr size_t MISC_SU = 2 * 1024 * 1024;
__device__ __forceinline__ unsigned pack4_i8(f32x4 v, float sc) {
    const int a = (int)rintf(v.x * sc), b = (int)rintf(v.y * sc), c = (int)rintf(v.z * sc), d = (int)rintf(v.w * sc);
    return ((unsigned)a & 255u) | (((unsigned)b & 255u) << 8) | (((unsigned)c & 255u) << 16) | ((unsigned)d << 24);
}
__device__ __forceinline__ void tables_to_fp8(const Params& P, int wgi, int nwg) {
    const int nthr = nwg * 512;
    for (int i0 = wgi * 512 + threadIdx.x; i0 < 16384 * 64; i0 += nthr * 4) {
        f32x4 v[4][4]; bool ok[4];
#pragma unroll
        for (int q = 0; q < 4; ++q) {
            const int i = i0 + q * nthr; ok[q] = i < 16384 * 64;
            const float* src = P.v_tab + (size_t)(ok[q] ? i : i0) * 16;
#pragma unroll
            for (int j = 0; j < 4; ++j) v[q][j] = *(const f32x4*)(src + 4 * j);
        }
#pragma unroll
        for (int q = 0; q < 4; ++q) {
            const int i = i0 + q * nthr;
            if (ok[q]) { u32x4 o; o.x = pack4_fp8(v[q][0], V8_SCALE); o.y = pack4_fp8(v[q][1], V8_SCALE); o.z = pack4_fp8(v[q][2], V8_SCALE); o.w = pack4_fp8(v[q][3], V8_SCALE);
                *(u32x4*)(P.ws + WS_V8 + (size_t)i * 16) = o; }
        }
    }
    const int lane = threadIdx.x & 63, gw = wgi * 8 + (threadIdx.x >> 6), ngw = nwg * 8;
    float* su = (float*)(P.ws + WS_MISC + MISC_SU);
    for (int r0 = gw; r0 < 16384; r0 += 4 * ngw) {
        f32x4 v[4][4]; float mx[4];
#pragma unroll
        for (int q = 0; q < 4; ++q) { const int r = r0 + q * ngw; const float* src = P.u_tab + (size_t)(r < 16384 ? r : r0) * 1024 + 16 * lane;
#pragma unroll
            for (int j = 0; j < 4; ++j) v[q][j] = *(const f32x4*)(src + 4 * j); }
#pragma unroll
        for (int q = 0; q < 4; ++q) { float m = 0.f;
#pragma unroll
            for (int j = 0; j < 4; ++j) m = fmaxf(fmaxf(fmaxf(fabsf(v[q][j].x), fabsf(v[q][j].y)), fmaxf(fabsf(v[q][j].z), fabsf(v[q][j].w))), m);
            mx[q] = m; }
#pragma unroll
        for (int o = 32; o > 0; o >>= 1) {
#pragma unroll
            for (int q = 0; q < 4; ++q) mx[q] = fmaxf(mx[q], __shfl_xor(mx[q], o)); }
#pragma unroll
        for (int q = 0; q < 4; ++q) { const int r = r0 + q * ngw;
            if (r < 16384) { const float sc = mx[q] > 0.f ? 127.0f / mx[q] : 0.f;
                u32x4 o; o.x = pack4_i8(v[q][0], sc); o.y = pack4_i8(v[q][1], sc); o.z = pack4_i8(v[q][2], sc); o.w = pack4_i8(v[q][3], sc);
                *(u32x4*)(P.ws + WS_U8 + (size_t)r * 1024 + 16 * lane) = o;
                if (lane == 0) su[r] = mx[q] * (1.0f / 127.0f); } }
    }
}
__device__ __forceinline__ float dot16_fp8(const u32x4 r, const f32x2 (&h)[8]) {
    f32x2 a = __builtin_amdgcn_cvt_pk_f32_fp8((int)r.x, false) * h[0];
    a = a + __builtin_amdgcn_cvt_pk_f32_fp8((int)r.x, true) * h[1];
    a = a + __builtin_amdgcn_cvt_pk_f32_fp8((int)r.y, false) * h[2];
    a = a + __builtin_amdgcn_cvt_pk_f32_fp8((int)r.y, true) * h[3];
    a = a + __builtin_amdgcn_cvt_pk_f32_fp8((int)r.z, false) * h[4];
    a = a + __builtin_amdgcn_cvt_pk_f32_fp8((int)r.z, true) * h[5];
    a = a + __builtin_amdgcn_cvt_pk_f32_fp8((int)r.w, false) * h[6];
    a = a + __builtin_amdgcn_cvt_pk_f32_fp8((int)r.w, true) * h[7];
    return a.x + a.y;
}
__device__ __forceinline__ void axpy16_fp8(const u32x4 r, const float w, f32x2 (&acc)[8]) {
    const f32x2 ww = (f32x2){w, w};
    acc[0] = acc[0] + __builtin_amdgcn_cvt_pk_f32_fp8((int)r.x, false) * ww;
    acc[1] = acc[1] + __builtin_amdgcn_cvt_pk_f32_fp8((int)r.x, true) * ww;
    acc[2] = acc[2] + __builtin_amdgcn_cvt_pk_f32_fp8((int)r.y, false) * ww;
    acc[3] = acc[3] + __builtin_amdgcn_cvt_pk_f32_fp8((int)r.y, true) * ww;
    acc[4] = acc[4] + __builtin_amdgcn_cvt_pk_f32_fp8((int)r.z, false) * ww;
    acc[5] = acc[5] + __builtin_amdgcn_cvt_pk_f32_fp8((int)r.z, true) * ww;
    acc[6] = acc[6] + __builtin_amdgcn_cvt_pk_f32_fp8((int)r.w, false) * ww;
    acc[7] = acc[7] + __builtin_amdgcn_cvt_pk_f32_fp8((int)r.w, true) * ww;
}
__device__ __forceinline__ float reduce16(float (&d)[16], int lane) {
    float a[8], b[4], c[2];
    const bool b0 = lane & 1, b1 = lane & 2, b2 = lane & 4, b3 = lane & 8;
#pragma unroll
    for (int j = 0; j < 8; ++j) { const float keep = b0 ? d[2 * j + 1] : d[2 * j], send = b0 ? d[2 * j] : d[2 * j + 1]; a[j] = keep + __shfl_xor(send, 1); }
#pragma unroll
    for (int j = 0; j < 4; ++j) { const float keep = b1 ? a[2 * j + 1] : a[2 * j], send = b1 ? a[2 * j] : a[2 * j + 1]; b[j] = keep + __shfl_xor(send, 2); }
#pragma unroll
    for (int j = 0; j < 2; ++j) { const float keep = b2 ? b[2 * j + 1] : b[2 * j], send = b2 ? b[2 * j] : b[2 * j + 1]; c[j] = keep + __shfl_xor(send, 4); }
    const float keep = b3 ? c[1] : c[0], send = b3 ? c[0] : c[1];
    float v = keep + __shfl_xor(send, 8);
    v += __shfl_xor(v, 16); v += __shfl_xor(v, 32);
    return v;
}
__device__ __forceinline__ float reduce8(float (&d)[8], int lane) {
    float a[4], b[2];
    const bool b0 = lane & 1, b1 = lane & 2, b2 = lane & 4;
#pragma unroll
    for (int j = 0; j < 4; ++j) { const float keep = b0 ? d[2 * j + 1] : d[2 * j], send = b0 ? d[2 * j] : d[2 * j + 1]; a[j] = keep + __shfl_xor(send, 1); }
#pragma unroll
    for (int j = 0; j < 2; ++j) { const float keep = b1 ? a[2 * j + 1] : a[2 * j], send = b1 ? a[2 * j] : a[2 * j + 1]; b[j] = keep + __shfl_xor(send, 2); }
    const float keep = b2 ? b[1] : b[0], send = b2 ? b[0] : b[1];
    float v = keep + __shfl_xor(send, 4);
    v += __shfl_xor(v, 8); v += __shfl_xor(v, 16); v += __shfl_xor(v, 32);
    return v;
}
constexpr int P8_LDS_SE = 0;
constexpr int P8_LDS_SW = 64 * 128 * 4;
constexpr int P8_LDS_SG = 2 * 64 * 128 * 4;
constexpr int P8_LDS_SO = 3 * 64 * 128 * 4;
__device__ __forceinline__ float dot16_i8(const u32x4 r, const int (&h)[4]) {
    int a = __builtin_amdgcn_sdot4((int)r.x, h[0], 0, false);
    a = __builtin_amdgcn_sdot4((int)r.y, h[1], a, false);
    a = __builtin_amdgcn_sdot4((int)r.z, h[2], a, false);
    a = __builtin_amdgcn_sdot4((int)r.w, h[3], a, false);
    return (float)a;
}
__device__ __forceinline__ void phase8(const Params& P, LAS unsigned char* lds) {
    const int lane = threadIdx.x & 63, wave = threadIdx.x >> 6;
    const float* mod = (const float*)(P.ws + WS_MISC + MISC_MOD); const float* sspart = (const float*)(P.ws + WS_MISC + MISC_SS);
    const float* su = (const float*)(P.ws + WS_MISC + MISC_SU);
    const int* pexp = (const int*)(P.ws + WS_PAIRS); const float* pw = (const float*)(P.ws + WS_PAIRS) + (size_t)NTOK * 128;
    const unsigned char* u8 = P.ws + WS_U8; const unsigned char* v8 = P.ws + WS_V8; const unsigned lane16 = 16u * (unsigned)lane, lane64 = 64u * (unsigned)lane;
    LAS unsigned* SE = (LAS unsigned*)(lds + P8_LDS_SE) + wave * 8 * 128;
    LAS float* SW = (LAS float*)(lds + P8_LDS_SW) + wave * 8 * 128;
    LAS float* SD = SW;
    LAS float* SG = (LAS float*)(lds + P8_LDS_SG) + wave * 8 * 128;
    LAS int* SO = (LAS int*)(lds + P8_LDS_SO) + wave * 8 * 16;
    const int tok0 = __builtin_amdgcn_readfirstlane(blockIdx.x * 64 + wave * 8);
    const int b = tok0 >> 11; const float* mrow = mod + (size_t)b * NMOD;
    const unsigned long long ltmask = (1ull << lane) - 1ull;
    int hq[8][4]; float hsc[8];
#pragma unroll
    for (int t = 0; t < 8; ++t) {
        const int tok = tok0 + t;
        float tot = 0.f;
#pragma unroll
        for (int i = 0; i < 4; ++i) { const f32x4 sp = *(const f32x4*)(sspart + (size_t)tok * 16 + 4 * i); tot += (sp.x + sp.y) + (sp.z + sp.w); }
        const float inv = rsqrtf(tot * (1.0f / 1024.0f) + 1e-6f);
        f32x4 h[4]; float mx = 0.f;
#pragma unroll
        for (int j = 0; j < 4; ++j) {
            const unsigned bo = lane64 + 16u * j;
            const f32x4 x1 = *(const f32x4*)((const char*)(P.out + (size_t)tok * 1024) + bo);
            const f32x4 gn = *(const f32x4*)((const char*)P.norm2_g + bo), sc2 = *(const f32x4*)((const char*)(mrow + 4 * 1024) + bo), sh2 = *(const f32x4*)((const char*)(mrow + 3 * 1024) + bo);
            h[j] = x1 * inv * gn * (sc2 + 1.0f) + sh2;
            mx = fmaxf(fmaxf(fmaxf(fabsf(h[j].x), fabsf(h[j].y)), fmaxf(fabsf(h[j].z), fabsf(h[j].w))), mx);
        }
#pragma unroll
        for (int o = 32; o > 0; o >>= 1) mx = fmaxf(mx, __shfl_xor(mx, o));
        const float qs = mx > 0.f ? 127.0f / mx : 0.f;
#pragma unroll
        for (int j = 0; j < 4; ++j) hq[t][j] = (int)pack4_i8(h[j], qs);
        hsc[t] = mx * (1.0f / 127.0f);
        const unsigned lane4 = 4u * (unsigned)lane;
        const int e0 = *(const int*)((const char*)(pexp + (size_t)tok * 128) + lane4), e1 = *(const int*)((const char*)(pexp + (size_t)tok * 128 + 64) + lane4);
        const float g0 = *(const float*)((const char*)(pw + (size_t)tok * 128) + lane4), g1 = *(const float*)((const char*)(pw + (size_t)tok * 128 + 64) + lane4);
        const int r0 = e0 >> 11, r1 = e1 >> 11;
        int base = 0, pos0 = 0, pos1 = 0, ov = 0;
#pragma unroll
        for (int rho = 0; rho < 8; ++rho) {
            const unsigned long long m0 = __ballot(r0 == rho), m1 = __ballot(r1 == rho);
            const int c0 = __popcll(m0), c1 = __popcll(m1);
            if (r0 == rho) pos0 = base + __popcll(m0 & ltmask);
            if (r1 == rho) pos1 = base + c0 + __popcll(m1 & ltmask);
            if (lane == rho) ov = base;
            base += c0 + c1;
        }
        if (lane >= 8) ov = 128;
        if (lane < 16) SO[t * 16 + lane] = ov;
        SE[t * 128 + pos0] = (unsigned)e0; SE[t * 128 + pos1] = (unsigned)e1;
        SG[t * 128 + pos0] = g0; SG[t * 128 + pos1] = g1;
        if (t & 1) asm volatile("" ::: "memory");
    }
    asm volatile("s_waitcnt lgkmcnt(0)" ::: "memory");
    for (int rho = 0; rho < 8; ++rho) {
#pragma unroll
        for (int t = 0; t < 4; ++t) {
            const int tA = t, tB = t + 4;
            const int begA = __builtin_amdgcn_readfirstlane(SO[tA * 16 + rho]), endA = __builtin_amdgcn_readfirstlane(SO[tA * 16 + rho + 1]);
            const int begB = __builtin_amdgcn_readfirstlane(SO[tB * 16 + rho]), endB = __builtin_amdgcn_readfirstlane(SO[tB * 16 + rho + 1]);
            const int clA = endA > 0 ? endA - 1 : 0, clB = endB > 0 ? endB - 1 : 0;
            for (int cA = begA, cB = begB; cA < endA || cB < endB; cA += 8, cB += 8) {
                const int liA = cA + (lane & 7), liB = cB + (lane & 7);
                const int eA8 = (int)SE[tA * 128 + (liA < endA ? liA : clA)], eB8 = (int)SE[tB * 128 + (liB < endB ? liB : clB)];
                u32x4 rA[8], rB[8];
#pragma unroll
                for (int i = 0; i < 8; ++i) { const int e = __builtin_amdgcn_readlane(eA8, i); rA[i] = *(const u32x4*)(u8 + (size_t)e * 1024 + lane16); }
#pragma unroll
                for (int i = 0; i < 8; ++i) { const int e = __builtin_amdgcn_readlane(eB8, i); rB[i] = *(const u32x4*)(u8 + (size_t)e * 1024 + lane16); }
                float d[8];
#pragma unroll
                for (int i = 0; i < 8; ++i) d[i] = dot16_i8(rA[i], hq[tA]);
                const float vA = reduce8(d, lane);
                if (lane < 8 && liA < endA) SD[tA * 128 + liA] = vA * hsc[tA];
#pragma unroll
                for (int i = 0; i < 8; ++i) d[i] = dot16_i8(rB[i], hq[tB]);
                const float vB = reduce8(d, lane);
                if (lane < 8 && liB < endB) SD[tB * 128 + liB] = vB * hsc[tB];
            }
        }
    }
    asm volatile("s_waitcnt lgkmcnt(0)" ::: "memory");
#pragma unroll
    for (int t = 0; t < 8; ++t) {
        const unsigned ea = SE[t * 128 + lane], eb = SE[t * 128 + 64 + lane];
        const float sua = su[ea], sub = su[eb];
        const float d0 = SD[t * 128 + lane] * sua, d1 = SD[t * 128 + 64 + lane] * sub;
        const float ga = SG[t * 128 + lane], gb = SG[t * 128 + 64 + lane];
        const float w0 = ga * gelu_tanh(d0), w1 = gb * gelu_tanh(d1);
        asm volatile("s_waitcnt lgkmcnt(0)" ::: "memory");
        SW[t * 128 + lane] = w0; SW[t * 128 + 64 + lane] = w1;
    }
    asm volatile("s_waitcnt lgkmcnt(0)" ::: "memory");
#pragma unroll
    for (int q = 0; q < 2; ++q) {
        f32x2 acc[4][8];
#pragma unroll
        for (int tl = 0; tl < 4; ++tl)
#pragma unroll
            for (int j = 0; j < 8; ++j) acc[tl][j] = (f32x2){0.f, 0.f};
        for (int rho = 0; rho < 8; ++rho) {
#pragma unroll
            for (int pr = 0; pr < 2; ++pr) {
                const int tA = q * 4 + pr, tB = q * 4 + pr + 2;
                const int begA = __builtin_amdgcn_readfirstlane(SO[tA * 16 + rho]), endA = __builtin_amdgcn_readfirstlane(SO[tA * 16 + rho + 1]);
                const int begB = __builtin_amdgcn_readfirstlane(SO[tB * 16 + rho]), endB = __builtin_amdgcn_readfirstlane(SO[tB * 16 + rho + 1]);
                const int clA = endA > 0 ? endA - 1 : 0, clB = endB > 0 ? endB - 1 : 0;
                for (int cA = begA, cB = begB; cA < endA || cB < endB; cA += 8, cB += 8) {
                    const int liA = cA + (lane & 7), liB = cB + (lane & 7);
                    const int lcA = (liA < endA ? liA : clA), lcB = (liB < endB ? liB : clB);
                    const int eA8 = (int)SE[tA * 128 + lcA], eB8 = (int)SE[tB * 128 + lcB];
                    const float wA8 = (liA < endA) ? SW[tA * 128 + lcA] : 0.f, wB8 = (liB < endB) ? SW[tB * 128 + lcB] : 0.f;
                    u32x4 rA[8], rB[8];
#pragma unroll
                    for (int i = 0; i < 8; ++i) { const int e = __builtin_amdgcn_readlane(eA8, i); rA[i] = *(const u32x4*)(v8 + (size_t)e * 1024 + lane16); }
#pragma unroll
                    for (int i = 0; i < 8; ++i) { const int e = __builtin_amdgcn_readlane(eB8, i); rB[i] = *(const u32x4*)(v8 + (size_t)e * 1024 + lane16); }
#pragma unroll
                    for (int i = 0; i < 8; ++i) { const float w = __int_as_float(__builtin_amdgcn_readlane(__float_as_int(wA8), i)); axpy16_fp8(rA[i], w, acc[pr]); if (i & 1) __builtin_amdgcn_sched_barrier(0); }
#pragma unroll
                    for (int i = 0; i < 8; ++i) { const float w = __int_as_float(__builtin_amdgcn_readlane(__float_as_int(wB8), i)); axpy16_fp8(rB[i], w, acc[pr + 2]); if (i & 1) __builtin_amdgcn_sched_barrier(0); }
                }
            }
        }
#pragma unroll
        for (int tl = 0; tl < 4; ++tl) {
            const int tok = tok0 + q * 4 + tl;
            float ss = 0.f; f32x4 xo[4];
#pragma unroll
            for (int j = 0; j < 4; ++j) {
                const unsigned bo = lane64 + 16u * j;
                const f32x4 x1 = *(const f32x4*)((const char*)(P.out + (size_t)tok * 1024) + bo);
                const f32x4 g2 = *(const f32x4*)((const char*)(mrow + 5 * 1024) + bo) * (1.0f / V8_SCALE);
                const f32x4 pa = (f32x4){acc[tl][2 * j].x, acc[tl][2 * j].y, acc[tl][2 * j + 1].x, acc[tl][2 * j + 1].y};
                xo[j] = x1 + g2 * pa;
                ss += (xo[j].x * xo[j].x + xo[j].y * xo[j].y) + (xo[j].z * xo[j].z + xo[j].w * xo[j].w);
            }
            ss = wave_sum(ss);
            const float inv2 = rsqrtf(ss * (1.0f / 1024.0f) + 1e-6f);
#pragma unroll
            for (int j = 0; j < 4; ++j) {
                const unsigned bo = lane64 + 16u * j;
                const f32x4 fg = *(const f32x4*)((const char*)P.final_g + bo);
                *(f32x4*)((char*)(P.out + (size_t)tok * 1024) + bo) = xo[j] * inv2 * fg;
            }
        }
    }
}
constexpr int LDS_BARST = 147456 - 16;
typedef __attribute__((address_space(4))) const Params* KParamsPtr;
#if defined(__HIP_DEVICE_COMPILE__)
#define LOADP(name) Params name; { KParamsPtr q_ = (KParamsPtr)__builtin_amdgcn_kernarg_segment_ptr(); asm volatile("" : "+s"(q_)); name = *q_; }
#else
#define LOADP(name) Params name = P;
#endif
__global__ void __launch_bounds__(512, 2) k_mega(Params P) {
    extern __shared__ __attribute__((aligned(16))) unsigned char lds_raw[];
    LAS unsigned char* lds = (LAS unsigned char*)lds_raw;
    const int lo = P.ph_lo, hi = P.ph_hi;
    const bool fused = (hi - lo) > 1;
    XcdBarrier bar; bar.bar = (unsigned*)(P.ws + WS_MISC + MISC_BAR); bar.x = 0; bar.st = (volatile LAS unsigned*)(lds + LDS_BARST);
    if (fused) {
        if (threadIdx.x < 4) ((LAS unsigned*)(lds + LDS_BARST))[threadIdx.x] = 0u;
        __syncthreads();
        bar = xcd_barrier_post((unsigned*)(P.ws + WS_MISC + MISC_BAR), (volatile LAS unsigned*)(lds + LDS_BARST));
    }
#ifndef REPMASK
#define REPMASK 0
#endif
#define IN(k) (lo <= (k) && (k) < hi)
#define REP(k, call) do { if (fused && ((REPMASK >> (k)) & 1)) { xcd_barrier(bar); call; } } while (0)
#define SEAM(k) do { if (fused && IN(k) && IN((k) + 1)) xcd_barrier(bar); } while (0)
    if (IN(0)) { LOADP(Pk); phase0(Pk, lds); REP(0, phase0(Pk, lds)); }
    if (fused && IN(0) && IN(1)) { cg::this_grid().sync(); }
    if (IN(1)) { LOADP(Pk); phase1(Pk, lds); REP(1, phase1(Pk, lds)); }
    SEAM(1);
    if (IN(2)) { LOADP(Pk); phase2(Pk, lds); REP(2, phase2(Pk, lds)); }
    SEAM(2);
    if (IN(3)) { LOADP(Pk); phase3(Pk, lds); REP(3, phase3(Pk, lds)); }
    SEAM(3);
    if (IN(4)) { LOADP(Pk); phase4(Pk, lds); REP(4, phase4(Pk, lds)); }
    SEAM(4);
    if (IN(5)) { LOADP(Pk); phase5(Pk, lds); REP(5, phase5(Pk, lds)); }
    SEAM(5);
    if (IN(6)) { LOADP(Pk); phase6(Pk, lds); REP(6, phase6(Pk, lds)); }
    SEAM(6);
    if (IN(7)) { LOADP(Pk); phase7(Pk, lds); REP(7, phase7(Pk, lds)); }
    SEAM(7);
    if (IN(8)) { LOADP(Pk); phase8(Pk, lds); REP(8, phase8(Pk, lds)); }
#undef IN
#undef SEAM
}
extern "C" void kernel_launch(void* const* d_in, const int* in_sizes, int n_in, void* d_out, int out_size, void* d_ws, size_t ws_size, hipStream_t stream) {
    static int grid = 0;
    if (!grid) {
        (void)hipFuncSetAttribute((const void*)k_mega, hipFuncAttributeMaxDynamicSharedMemorySize, LDS_BYTES);
        int dev = 0, cus = 0, per_cu = 0;
        (void)hipGetDevice(&dev);
        (void)hipDeviceGetAttribute(&cus, hipDeviceAttributeMultiprocessorCount, dev);
        (void)hipOccupancyMaxActiveBlocksPerMultiprocessor(&per_cu, (const void*)k_mega, 512, LDS_BYTES);
        grid = (per_cu >= 1 && cus >= 256) ? 256 : -1;
    }
    if (grid < 0) return;
    (void)hipMemsetAsync((char*)d_ws + WS_MISC + MISC_BAR, 0, XCD_BAR_WORDS * 4, stream);
    Params P{};
    const float** pp = (const float**)&P;
    for (int i = 0; i < 26; ++i) pp[i] = (const float*)d_in[i];
    P.out = (float*)d_out; P.ws = (unsigned char*)d_ws; P.ph_lo = 0; P.ph_hi = 9;
    void* args[] = {&P};
    (void)hipLaunchCooperativeKernel((const void*)k_mega, dim3(grid), dim3(512), args, LDS_BYTES, stream);
}
```

```cpp
#define REPMASK 0
#define P0REP 0
#define P1REP 0
#include <hip/hip_runtime.h>
#include <hip/hip_cooperative_groups.h>
#include <stdint.h>
#include <math.h>
namespace cg = cooperative_groups;

#define DM 1024
#define NB 8
#define SEQ 2048
#define CTXL 256
#define NTOK (NB * SEQ)
#define NCTX (NB * CTXL)
#define NMOD 6144
#define MiB (1024ull * 1024ull)
#ifndef TPROBE
#define TPROBE (-1)
#endif
#ifndef TPSCALE
#define TPSCALE 1e-7f
#endif
#define LAS __attribute__((address_space(3)))
typedef unsigned short bf16_t;
typedef short bf16x8 __attribute__((ext_vector_type(8)));
typedef float f32x4 __attribute__((ext_vector_type(4)));
typedef float f32x2 __attribute__((ext_vector_type(2)));
typedef unsigned u32x4 __attribute__((ext_vector_type(4)));
typedef unsigned u32x2 __attribute__((ext_vector_type(2)));

__device__ __forceinline__ float gelu_tanh(float x) {
    const float z = x * (1.5957691216057308f + 0.07135481627f * x * x);
    return x * __builtin_amdgcn_rcpf(1.0f + __expf(-z));
}
__device__ __forceinline__ float sigmoidf_(float x) { return __builtin_amdgcn_rcpf(1.0f + __expf(-x)); }
__device__ __forceinline__ float silu_(float x) { return x * sigmoidf_(x); }
__device__ __forceinline__ float wave_sum(float v) {
#pragma unroll
    for (int o = 32; o > 0; o >>= 1) v += __shfl_xor(v, o);
    return v;
}
__device__ __forceinline__ unsigned cvt_pk_bf16(float lo, float hi) { unsigned r; asm volatile("v_cvt_pk_bf16_f32 %0, %1, %2" : "=v"(r) : "v"(lo), "v"(hi)); return r; }
__device__ __forceinline__ float bf2f(bf16_t v) { return __uint_as_float(((unsigned)v) << 16); }
__device__ __forceinline__ float bflo(unsigned w) { return __uint_as_float(w << 16); }
__device__ __forceinline__ float bfhi(unsigned w) { return __uint_as_float(w & 0xffff0000u); }

__device__ __forceinline__ void tp_b(int id, LAS unsigned char* lds) { if (TPROBE == id && threadIdx.x == 0) ((LAS unsigned*)(lds + 147456 - 16))[3] = (unsigned)__builtin_amdgcn_s_memrealtime(); }
__device__ __forceinline__ void tp_e(int id, LAS unsigned char* lds) { if (TPROBE == id && threadIdx.x == 0) ((LAS unsigned*)(lds + 147456 - 16))[2] += (unsigned)__builtin_amdgcn_s_memrealtime() - ((LAS unsigned*)(lds + 147456 - 16))[3]; }
#define XB_TMO      128
#define XB_XCNT(j)  (256  + 64 * (j))
#define XB_XSUB(j)  (1280 + 64 * (j))
#define XB_XGEN(j)  (2304 + 64 * (j))
#define XB_TOP      3328
#define XB_TOPGEN   3392
#define XCD_BAR_WORDS 3456
#define XB_SPIN_CAP (1u << 18)
__device__ __forceinline__ unsigned xb_ld(unsigned* p)              { return __hip_atomic_load(p, __ATOMIC_RELAXED, __HIP_MEMORY_SCOPE_AGENT); }
__device__ __forceinline__ unsigned xb_add(unsigned* p, unsigned v) { return __hip_atomic_fetch_add(p, v, __ATOMIC_RELAXED, __HIP_MEMORY_SCOPE_AGENT); }
__device__ __forceinline__ unsigned xb_xcc_id() { return (unsigned)__builtin_amdgcn_s_getreg((3 << 11) | 20) & 0xFu; }
#define XB_SPIN(cond, bar) do { unsigned _sp = 0; while (cond) { __builtin_amdgcn_s_sleep(1); \
    if ((++_sp & 255u) == 0u) { if (xb_ld(&(bar)[XB_TMO])) break; if (_sp > XB_SPIN_CAP) { atomicAdd(&(bar)[XB_TMO], 1u); break; } } } } while (0)
struct XcdBarrier { unsigned* bar; unsigned x; volatile LAS unsigned* st; };
__device__ __forceinline__ XcdBarrier xcd_barrier_post(unsigned* bar, volatile LAS unsigned* st) {
    XcdBarrier b; b.bar = bar; b.x = xb_xcc_id(); b.st = st;
    if (threadIdx.x == 0) (void)xb_add(&bar[XB_XCNT(b.x)], 1u);
    return b;
}
__device__ __forceinline__ void xcd_barrier_complete(unsigned* bar, unsigned x, unsigned& nloc, unsigned& nx) {
    const unsigned G = gridDim.x * gridDim.y * gridDim.z;
    unsigned sum, cnt, mine, sp = 0u;
    for (;;) {
        sum = 0u; cnt = 0u; mine = 0u;
#pragma unroll
        for (unsigned j = 0; j < 16; ++j) { const unsigned c = xb_ld(&bar[XB_XCNT(j)]); sum += c; cnt += (c > 0u) ? 1u : 0u; mine = (j == x) ? c : mine; }
        if (sum == G) break;
        __builtin_amdgcn_s_sleep(1);
        if ((++sp & 255u) == 0u) { if (xb_ld(&bar[XB_TMO])) break; if (sp > XB_SPIN_CAP) { atomicAdd(&bar[XB_TMO], 1u); break; } }
    }
    nloc = mine > 0u ? mine : 1u; nx = cnt > 0u ? cnt : 1u;
}
__device__ __forceinline__ void xcd_barrier(const XcdBarrier& b) {
    asm volatile("s_waitcnt vmcnt(0)" ::: "memory");
    __syncthreads();
    if (threadIdx.x == 0) {
        unsigned* bar = b.bar;
        __builtin_amdgcn_s_waitcnt(0);
        unsigned nloc = b.st[0], nx = b.st[1];
        if (nloc == 0u) { xcd_barrier_complete(bar, b.x, nloc, nx); b.st[0] = nloc; b.st[1] = nx; }
        const unsigned old = xb_add(&bar[XB_XSUB(b.x)], 1u);
        const unsigned gen = old / nloc;
        if (old + 1u == (gen + 1u) * nloc) {
            __builtin_amdgcn_fence(__ATOMIC_RELEASE, "agent");
            asm volatile("s_waitcnt vmcnt(0)" ::: "memory");
            const unsigned og = xb_add(&bar[XB_TOP], 1u);
            const unsigned tg = og / nx;
            if (og + 1u == (tg + 1u) * nx) xb_add(&bar[XB_TOPGEN], 1u);
            else XB_SPIN(xb_ld(&bar[XB_TOPGEN]) == tg, bar);
            __builtin_amdgcn_fence(__ATOMIC_ACQUIRE, "agent");
            xb_add(&bar[XB_XGEN(b.x)], 1u);
            asm volatile("s_waitcnt vmcnt(0)" ::: "memory");
        } else {
            XB_SPIN(xb_ld(&bar[XB_XGEN(b.x)]) == gen, bar);
            __builtin_amdgcn_fence(__ATOMIC_ACQUIRE, "agent");
            asm volatile("s_waitcnt vmcnt(0)" ::: "memory");
        }
    }
    __syncthreads();
}
namespace pg8 {
constexpr int BM = 256, BK = 64, HALF = 128, HTB = HALF * BK * 2, STAGE_BYTES = 8 * HTB;
__device__ __forceinline__ int lds_byte(int r, int c) { const int st = (r >> 4) * 2 + (c >> 5), rr = r & 15, cc = c & 31, ob = rr * 64 + cc * 2; return st * 1024 + (ob ^ (((ob >> 9) & 1) << 5)); }
__device__ __forceinline__ void stage_rc(int b, int& R, int& C) { const int st = b / 1024, sb = b % 1024, swz = sb ^ (((sb >> 9) & 1) << 5); R = (st >> 1) * 16 + swz / 64; C = (st & 1) * 32 + (swz % 64) / 2; }
__device__ __forceinline__ int perm32(int rho) { const int n = rho >> 4, i = rho & 15; return 8 * (i >> 2) + 4 * n + (i & 3); }
struct Unit { const char* a; const char* b; int pm, pn, z; };
struct Gemm { int lda, ldb, K; };
template <class Epi>
__device__ __forceinline__ void gemm_unit(LAS unsigned char* lds, const Gemm g, const Unit cur, const Epi& E) {
    const int tid = threadIdx.x, wid = __builtin_amdgcn_readfirstlane(tid >> 6), lane = tid & 63, wr = wid >> 2, wc = wid & 3, fr = lane & 15, fq = lane >> 4;
    const int K = g.K, nt = K / BK;
    unsigned voffA[2], voffB[2];
#pragma unroll
    for (int i = 0; i < 2; ++i) { int R, C; stage_rc(tid * 16 + i * 8192, R, C); const int Rb = Epi::PERM ? ((R & ~31) + perm32(R & 31)) : R;
        voffA[i] = (unsigned)(R * g.lda + C) * 2u; voffB[i] = (unsigned)(Rb * g.ldb + C) * 2u; }
    const size_t kstep = (size_t)(BK * 2);
    const size_t hstepA = (size_t)HALF * g.lda * 2, hstepB = (size_t)HALF * g.ldb * 2;
    const unsigned ldsw = (unsigned)wid * 1024u;
    const int aoff = lds_byte(wr * 64 + fr, fq * 8), boff = lds_byte(wc * 32 + fr, fq * 8);
#define PG8_SA(b, h) (((b) * 2 + (h)) * HTB)
#define PG8_SB(b, h) ((4 + (b) * 2 + (h)) * HTB)
#define PG8_STAGE(bufoff, gbase, voff) do { _Pragma("unroll") for (int _i = 0; _i < 2; ++_i) \
        __builtin_amdgcn_global_load_lds((const unsigned*)((const char*)(gbase) + (voff)[_i]), (LAS unsigned*)(lds + (bufoff) + ldsw + _i * 8192), 16, 0, 0); } while (0)
#define PG8_LDA(dst, b, h) do { _Pragma("unroll") for (int m = 0; m < 4; ++m) _Pragma("unroll") for (int k = 0; k < 2; ++k) dst[m][k] = *(const LAS bf16x8*)(lds + PG8_SA(b, h) + aoff + m * 2048 + k * 1024); } while (0)
#define PG8_LDB(dst, b, h) do { _Pragma("unroll") for (int n = 0; n < 2; ++n) _Pragma("unroll") for (int k = 0; k < 2; ++k) dst[n][k] = *(const LAS bf16x8*)(lds + PG8_SB(b, h) + boff + n * 2048 + k * 1024); } while (0)
#define PG8_MMA(ai, bj, At, Bt) do { __builtin_amdgcn_s_setprio(1); _Pragma("unroll") for (int m = 0; m < 4; ++m) _Pragma("unroll") for (int n = 0; n < 2; ++n) _Pragma("unroll") for (int k = 0; k < 2; ++k) \
        acc[ai][bj][m][n] = __builtin_amdgcn_mfma_f32_16x16x32_bf16(Bt[n][k], At[m][k], acc[ai][bj][m][n], 0, 0, 0); __builtin_amdgcn_s_setprio(0); } while (0)
#define PG8_WAIT_V(n) asm volatile("s_waitcnt vmcnt(" #n ")" ::: "memory")
#define PG8_WAIT_L(n) asm volatile("s_waitcnt lgkmcnt(" #n ")" ::: "memory")
#define PG8_BAR __builtin_amdgcn_s_barrier()
#define PG8_SCHED __builtin_amdgcn_sched_barrier(0)
    f32x4 acc[2][2][4][2];
#pragma unroll
    for (int a = 0; a < 2; ++a)
#pragma unroll
        for (int b = 0; b < 2; ++b)
#pragma unroll
            for (int m = 0; m < 4; ++m)
#pragma unroll
                for (int n = 0; n < 2; ++n) acc[a][b][m][n] = (f32x4){0.f, 0.f, 0.f, 0.f};
    bf16x8 At[4][2], B0[2][2], B1[2][2];
    const char* cA = cur.a; const char* cB = cur.b;
    PG8_STAGE(PG8_SB(0, 0), cB, voffB); PG8_STAGE(PG8_SA(0, 0), cA, voffA); PG8_STAGE(PG8_SB(0, 1), cB + hstepB, voffB); PG8_STAGE(PG8_SA(0, 1), cA + hstepA, voffA);
    if (wr == 1) PG8_BAR;
    PG8_WAIT_V(4); PG8_BAR;
    PG8_STAGE(PG8_SB(1, 0), cB + kstep, voffB); PG8_STAGE(PG8_SA(1, 0), cA + kstep, voffA); PG8_STAGE(PG8_SB(1, 1), cB + hstepB + kstep, voffB);
    PG8_WAIT_V(6); PG8_BAR;
    for (int t = 0; t < nt; t += 2) {
        const bool last = (t == nt - 2);
        const char* a1 = cA + (size_t)(t + 1) * kstep;
        const char* a2 = last ? cA : cA + (size_t)(t + 2) * kstep; const char* b2 = last ? cB : cB + (size_t)(t + 2) * kstep;
        const char* a3 = a2 + kstep; const char* b3 = b2 + kstep;
        PG8_LDB(B0, 0, 0); PG8_SCHED; PG8_LDA(At, 0, 0); PG8_STAGE(PG8_SA(1, 1), a1 + hstepA, voffA);
        PG8_WAIT_L(8); PG8_BAR; PG8_WAIT_L(0); PG8_MMA(0, 0, At, B0); PG8_BAR; PG8_SCHED;
        PG8_LDB(B1, 0, 1); PG8_STAGE(PG8_SB(0, 0), b2, voffB);
        PG8_BAR; PG8_WAIT_L(0); PG8_MMA(0, 1, At, B1); PG8_BAR;
        PG8_LDA(At, 0, 1); PG8_STAGE(PG8_SA(0, 0), a2, voffA);
        PG8_BAR; PG8_WAIT_L(0); PG8_MMA(1, 0, At, B0); PG8_BAR; PG8_SCHED;
        PG8_STAGE(PG8_SB(0, 1), b2 + hstepB, voffB);
        PG8_WAIT_V(6); PG8_BAR; PG8_MMA(1, 1, At, B1); PG8_BAR;
        PG8_LDB(B0, 1, 0); PG8_SCHED; PG8_LDA(At, 1, 0); PG8_STAGE(PG8_SA(0, 1), a2 + hstepA, voffA);
        PG8_WAIT_L(8); PG8_BAR; PG8_WAIT_L(0); PG8_MMA(0, 0, At, B0); PG8_BAR; PG8_SCHED;
        PG8_LDB(B1, 1, 1); PG8_STAGE(PG8_SB(1, 0), b3, voffB);
        PG8_BAR; PG8_WAIT_L(0); PG8_MMA(0, 1, At, B1); PG8_BAR;
        PG8_LDA(At, 1, 1); PG8_STAGE(PG8_SA(1, 0), a3, voffA);
        PG8_BAR; PG8_WAIT_L(0); PG8_MMA(1, 0, At, B0); PG8_BAR; PG8_SCHED;
        PG8_STAGE(PG8_SB(1, 1), b3 + hstepB, voffB);
        PG8_WAIT_V(6); PG8_BAR; PG8_MMA(1, 1, At, B1); PG8_BAR;
    }
    if constexpr (!Epi::AFTER_DRAIN) { E(acc, cur, wr, wc, fr, fq); }
    PG8_WAIT_V(0);
    if (wr == 0) PG8_BAR;
    PG8_BAR;
    if constexpr (Epi::AFTER_DRAIN) { E.fused(acc, cur, wr, wc, fr, fq, lds, wid, lane); }
#undef PG8_SA
#undef PG8_SB
#undef PG8_STAGE
#undef PG8_LDA
#undef PG8_LDB
#undef PG8_MMA
#undef PG8_WAIT_V
#undef PG8_WAIT_L
#undef PG8_BAR
#undef PG8_SCHED
}
}
constexpr size_t WS_W1T = 0 * MiB;
constexpr size_t WS_WGLUT = 2 * MiB;
constexpr size_t WS_WOUTT = 3 * MiB;
constexpr size_t WS_WST = 5 * MiB;
constexpr size_t WS_WCST = 9 * MiB;
constexpr size_t WS_CS = 10 * MiB;
constexpr size_t WS_WENDT = 26 * MiB;
constexpr size_t WS_MAPT = 34 * MiB;
constexpr size_t WS_KTAB = 59 * MiB;
constexpr size_t WS_XB = 68 * MiB;
constexpr size_t WS_HCB = 100 * MiB;
constexpr size_t WS_AEXT = 108 * MiB;
constexpr size_t WS_FB = 144 * MiB;
constexpr size_t WS_GT = 160 * MiB;
constexpr size_t WS_CSPART = 176 * MiB;
constexpr size_t WS_E = 192 * MiB;
constexpr size_t WS_MISC = 250 * MiB;
constexpr size_t MISC_MOD = 0, MISC_POS = 256 * 1024, MISC_BIAS = 512 * 1024, MISC_BAR = 640 * 1024, MISC_EC = 704 * 1024, MISC_O1024 = 720 * 1024;

struct Params {
    const float *x, *c, *ctx, *c_ctx, *w_mod, *b_mod, *norm1_g, *norm2_g, *w_in, *w_out, *lam_re, *lam_im, *log_dt, *b_re, *b_im, *c_re, *c_im, *s5_d,
        *w_glu, *b_glu, *w_fourier, *w_q, *sub_keys, *u_tab, *v_tab, *final_g;
    float* out; unsigned char* ws; int ph_lo, ph_hi;
};
constexpr int LDS_BYTES = 147456;

__device__ __forceinline__ void p0_mod_item(const Params& P, LAS float* L, int item) {
    int tid = threadIdx.x; asm volatile("" : "+v"(tid)); const int w = tid >> 6, l = tid & 63;
    LAS float* act = L; LAS float* red = L + 9 * 1024;
    for (int idx = tid; idx < 9 * 1024; idx += 512) { int r = idx >> 10, k = idx & 1023; float v = (r < 8) ? P.c[r * 1024 + k] : P.c_ctx[k]; act[idx] = silu_(v); }
    __syncthreads();
    const int j = item * 64 + l;
    float acc[9];
#pragma unroll
    for (int r = 0; r < 9; ++r) acc[r] = 0.f;
    for (int k0 = w * 128; k0 < w * 128 + 128; k0 += 16) {
        float wv[16];
#pragma unroll
        for (int i = 0; i < 16; ++i) wv[i] = P.w_mod[(size_t)(k0 + i) * NMOD + j];
#pragma unroll
        for (int i = 0; i < 16; ++i)
#pragma unroll
            for (int r = 0; r < 9; ++r) acc[r] += act[r * 1024 + k0 + i] * wv[i];
    }
#pragma unroll
    for (int r = 0; r < 9; ++r) red[(w * 9 + r) * 64 + l] = acc[r];
    __syncthreads();
    float* mod = (float*)(P.ws + WS_MISC + MISC_MOD);
    for (int idx = tid; idx < 9 * 64; idx += 512) {
        int r = idx >> 6, l2 = idx & 63; float s = 0.f;
#pragma unroll
        for (int ww = 0; ww < 8; ++ww) s += red[(ww * 9 + r) * 64 + l2];
        mod[r * NMOD + item * 64 + l2] = s + P.b_mod[item * 64 + l2];
    }
}
__device__ __forceinline__ void p0_transpose_item(const float* src, int K, int N, bf16_t* dst, LAS float* L, int item) {
    int tid = threadIdx.x; asm volatile("" : "+v"(tid)); const int ntn = N / 64; const int k0 = (item / ntn) * 64, n0 = (item % ntn) * 64;
#pragma unroll
    for (int pass = 0; pass < 2; ++pass) {
        int kk = (tid >> 4) + 32 * pass, c4 = (tid & 15) * 4;
        f32x4 v = *(const f32x4*)(src + (size_t)(k0 + kk) * N + n0 + c4);
        L[kk * 65 + c4 + 0] = v.x; L[kk * 65 + c4 + 1] = v.y; L[kk * 65 + c4 + 2] = v.z; L[kk * 65 + c4 + 3] = v.w;
    }
    __syncthreads();
    const int n = tid >> 3, k8 = (tid & 7) * 8;
    u32x4 o;
    o.x = cvt_pk_bf16(L[(k8 + 0) * 65 + n], L[(k8 + 1) * 65 + n]); o.y = cvt_pk_bf16(L[(k8 + 2) * 65 + n], L[(k8 + 3) * 65 + n]);
    o.z = cvt_pk_bf16(L[(k8 + 4) * 65 + n], L[(k8 + 5) * 65 + n]); o.w = cvt_pk_bf16(L[(k8 + 6) * 65 + n], L[(k8 + 7) * 65 + n]);
    *(u32x4*)(dst + (size_t)(n0 + n) * K + k0 + k8) = o;
}
__device__ __forceinline__ void p0_ws_item(const Params& P, LAS float* L, int item) {
    int tid = threadIdx.x; asm volatile("" : "+v"(tid)); const int hs = item >> 4, k0 = (item & 15) * 64;
    LAS float* keysT = L;
    LAS float* wqT = L + 128 * 132;
    {
        f32x4 kv[8];
#pragma unroll
        for (int i = 0; i < 8; ++i) kv[i] = *(const f32x4*)(P.sub_keys + (size_t)hs * 16384 + (tid + 512 * i) * 4);
        f32x4 wv[4];
#pragma unroll
        for (int i = 0; i < 4; ++i) { const int idx = tid + 512 * i; const int kk = idx >> 5, d4 = (idx & 31) * 4; wv[i] = *(const f32x4*)(P.w_q + (size_t)(k0 + kk) * 2048 + hs * 128 + d4); }
#pragma unroll
        for (int i = 0; i < 8; ++i) { const int idx = (tid + 512 * i) * 4; const int key = idx >> 7, d = idx & 127;
            keysT[(d + 0) * 132 + key] = kv[i].x; keysT[(d + 1) * 132 + key] = kv[i].y; keysT[(d + 2) * 132 + key] = kv[i].z; keysT[(d + 3) * 132 + key] = kv[i].w; }
#pragma unroll
        for (int i = 0; i < 4; ++i) { const int idx = tid + 512 * i; const int kk = idx >> 5, d4 = (idx & 31) * 4;
            wqT[(d4 + 0) * 68 + kk] = wv[i].x; wqT[(d4 + 1) * 68 + kk] = wv[i].y; wqT[(d4 + 2) * 68 + kk] = wv[i].z; wqT[(d4 + 3) * 68 + kk] = wv[i].w; }
    }
    __syncthreads();
    const int kq = (tid & 31) * 4, kg = (tid >> 5) * 4;
    f32x4 acc[4];
#pragma unroll
    for (int i = 0; i < 4; ++i) acc[i] = (f32x4){0.f, 0.f, 0.f, 0.f};
#pragma unroll 4
    for (int d = 0; d < 128; ++d) {
        const f32x4 kv = *(const LAS f32x4*)(keysT + d * 132 + kq), wv = *(const LAS f32x4*)(wqT + d * 68 + kg);
        acc[0] = acc[0] + wv * kv.x; acc[1] = acc[1] + wv * kv.y; acc[2] = acc[2] + wv * kv.z; acc[3] = acc[3] + wv * kv.w;
    }
    bf16_t* dst = (bf16_t*)(P.ws + WS_WST) + (size_t)(hs * 128 + kq) * 1024 + k0 + kg;
#pragma unroll
    for (int i = 0; i < 4; ++i) { u32x2 o; o.x = cvt_pk_bf16(acc[i].x, acc[i].y); o.y = cvt_pk_bf16(acc[i].z, acc[i].w); *(u32x2*)(dst + (size_t)i * 1024) = o; }
}
__device__ __forceinline__ void p0_wcs_item(const Params& P, LAS float* L, int item) {
    int tid = threadIdx.x; asm volatile("" : "+v"(tid)); const int cs = item >> 4, g = (item >> 2) & 3, cb = item & 3;
    LAS float* tab = L;
    if (tid < 128) { float a = (float)tid / 64.0f; tab[tid] = cs ? -sinpif(a) : cospif(a); }
    __syncthreads();
    const int d = tid & 127, c0 = cb * 32 + (tid >> 7) * 8;
    float acc[8];
#pragma unroll
    for (int i = 0; i < 8; ++i) acc[i] = 0.f;
    const float* wf = P.w_fourier + (size_t)g * 16384 + d;
#pragma unroll 8
    for (int m = 0; m < 128; ++m) {
        const float wv = wf[m * 128];
#pragma unroll
        for (int i = 0; i < 8; ++i) acc[i] += tab[((c0 + i) * m) & 127] * wv;
    }
    const float alpha = 1.0f / sqrtf(2048.0f * 128.0f);
    bf16_t* row = (bf16_t*)(P.ws + WS_WCST) + (size_t)(cs * 512 + g * 128 + d) * 512;
#pragma unroll
    for (int g2 = 0; g2 < 4; ++g2) {
        u32x4 o = (u32x4){0u, 0u, 0u, 0u};
        if (g2 == g) { o.x = cvt_pk_bf16(acc[0] * alpha, acc[1] * alpha); o.y = cvt_pk_bf16(acc[2] * alpha, acc[3] * alpha); o.z = cvt_pk_bf16(acc[4] * alpha, acc[5] * alpha); o.w = cvt_pk_bf16(acc[6] * alpha, acc[7] * alpha); }
        *(u32x4*)(row + g2 * 128 + c0) = o;
    }
}
__device__ __forceinline__ void p0_s5_item(const Params& P, LAS float* L, int item) {
    int tid = threadIdx.x; asm volatile("" : "+v"(tid)); const int g = item >> 3, dir = (item >> 2) & 1, qd = item & 3;
    LAS float* Pr = L; LAS float* Pi = L + 33 * 64; LAS float* Bbr = L + 2 * 33 * 64; LAS float* Bbi = Bbr + 1024; LAS float* Cr = Bbi + 1024; LAS float* Ci = Cr + 1024;
    const int dg = dir * 32 + g;
    const float dt = expf(P.log_dt[dg]);
    if (tid < 64) {
        const int n = tid; const int i = dg * 64 + n;
        float lr = P.lam_re[i], li = P.lam_im[i];
        float mag = expf(lr * dt); float ar = mag * cosf(li * dt), ai = mag * sinf(li * dt);
        float den = lr * lr + li * li;
        float cr = ((ar - 1.0f) * lr + ai * li) / den, ci = (ai * lr - (ar - 1.0f) * li) / den;
        for (int q = 0; q < 16; ++q) {
            float br = P.b_re[(size_t)i * 16 + q], bi = P.b_im[(size_t)i * 16 + q];
            Bbr[n * 16 + q] = cr * br - ci * bi; Bbi[n * 16 + q] = cr * bi + ci * br;
        }
    }
    for (int idx = tid; idx < 33 * 64; idx += 512) {
        int tau = idx >> 6, n = idx & 63; const int i = dg * 64 + n;
        float lr = P.lam_re[i], li = P.lam_im[i];
        float mag = expf((float)tau * lr * dt), ang = (float)tau * (li * dt);
        Pr[idx] = mag * cosf(ang); Pi[idx] = mag * sinf(ang);
    }
    for (int idx = tid; idx < 1024; idx += 512) { Cr[idx] = P.c_re[(size_t)dg * 1024 + idx]; Ci[idx] = P.c_im[(size_t)dg * 1024 + idx]; }
    __syncthreads();
    {
        const int pq = tid & 255, p = pq >> 4, q = pq & 15, tau0 = qd * 8 + (tid >> 8) * 4;
        float s[4] = {0.f, 0.f, 0.f, 0.f};
#pragma unroll 4
        for (int n = 0; n < 64; ++n) {
            const float cr = Cr[p * 64 + n], ci = Ci[p * 64 + n], br = Bbr[n * 16 + q], bi = Bbi[n * 16 + q];
            const float xr = cr * br - ci * bi, xi = cr * bi + ci * br;
#pragma unroll
            for (int j = 0; j < 4; ++j) s[j] += xr * Pr[(tau0 + j) * 64 + n] - xi * Pi[(tau0 + j) * 64 + n];
        }
        float* Kt = (float*)(P.ws + WS_KTAB) + (size_t)(g * 2 + dir) * 32 * 256;
#pragma unroll
        for (int j = 0; j < 4; ++j) Kt[(tau0 + j) * 256 + pq] = s[j];
    }
    {
        bf16_t* W = (bf16_t*)(P.ws + WS_WENDT) + (size_t)(g * 256 + dir * 128 + qd * 32) * 512;
        for (int idx = tid; idx < 32 * 512 / 2; idx += 512) {
            const int row = idx >> 8, col = (idx & 255) * 2; const int n = qd * 16 + (row >> 1), ri = row & 1, s = col >> 4, q = col & 15;
            const int tau = dir ? s : (31 - s);
            const float pr = Pr[tau * 64 + n], pi = Pi[tau * 64 + n];
            const float br0 = Bbr[n * 16 + q], bi0 = Bbi[n * 16 + q], br1 = Bbr[n * 16 + q + 1], bi1 = Bbi[n * 16 + q + 1];
            const float v0 = ri ? (pr * bi0 + pi * br0) : (pr * br0 - pi * bi0), v1 = ri ? (pr * bi1 + pi * br1) : (pr * br1 - pi * bi1);
            *(unsigned*)(W + (size_t)row * 512 + col) = cvt_pk_bf16(v0, v1);
        }
    }
    {
        bf16_t* Mp = (bf16_t*)(P.ws + WS_MAPT) + ((size_t)g * 512 + qd * 128) * 768 + 512 + dir * 128;
        for (int idx = tid; idx < 128 * 64; idx += 512) {
            const int row = idx >> 6, n = idx & 63; const int t = qd * 8 + (row >> 4), p = row & 15;
            const int tau = dir ? (32 - t) : (t + 1);
            const float cr = Cr[p * 64 + n], ci = Ci[p * 64 + n], pr = Pr[tau * 64 + n], pi = Pi[tau * 64 + n];
            *(unsigned*)(Mp + (size_t)row * 768 + n * 2) = cvt_pk_bf16(cr * pr - ci * pi, -(cr * pi + ci * pr));
        }
    }
}
__device__ __forceinline__ void p0_pos_item(const Params& P) {
    float* postab = (float*)(P.ws + WS_MISC + MISC_POS);
    for (int idx = threadIdx.x; idx < 96 * 512; idx += 512) {
        int row = idx >> 9, j = idx & 511, jj = j & 255;
        float omega = 1.0f / powf(10000.0f, (float)jj / 256.0f);
        float p = (float)(row < 32 ? row : row - 32);
        float a = p * omega;
        postab[idx] = (j < 256) ? sinf(a) : cosf(a);
    }
}
__device__ __forceinline__ void vtable_to_fp8(const Params& P, int wgi, int nwg);
__device__ __forceinline__ void utable_to_i8(const Params& P, int wgi, int nwg);
constexpr int P0_MOD = 96, P0_TW1 = 256, P0_TGLU = 64, P0_TOUT = 256, P0_WS = 256, P0_WCS = 32, P0_S5 = 256, P0_POS = 1;
constexpr int P0_NITEMS = P0_MOD + P0_TW1 + P0_TGLU + P0_TOUT + P0_WS + P0_WCS + P0_S5 + P0_POS;
constexpr int P0_EARLY = P0_MOD + P0_TW1 + P0_POS;
constexpr int P0_LATE = P0_S5 + P0_WS + P0_TOUT + P0_TGLU + P0_WCS;
__device__ __forceinline__ void p0_items(const Params& P, LAS unsigned char* lds) {
    LAS float* L = (LAS float*)lds;
    for (int it = blockIdx.x; it < P0_EARLY; it += gridDim.x) {
        __syncthreads();
        int r = it;
        if (r < P0_TW1) { p0_transpose_item(P.w_in, 1024, 1024, (bf16_t*)(P.ws + WS_W1T), L, r); continue; } r -= P0_TW1;
        if (r < P0_MOD) { p0_mod_item(P, L, r); continue; } r -= P0_MOD;
        p0_pos_item(P);
    }
    __syncthreads();
}
__device__ __forceinline__ void p0_late_items(const Params& P, LAS unsigned char* lds, int wgi, int nwg) {
    LAS float* L = (LAS float*)lds;
    for (int it = wgi; it < P0_LATE; it += nwg) {
        __syncthreads();
        int r = it;
        if (r < P0_S5) { p0_s5_item(P, L, r); continue; } r -= P0_S5;
        if (r < P0_WS) { p0_ws_item(P, L, r); continue; } r -= P0_WS;
        if (r < P0_TOUT) { p0_transpose_item(P.w_out, 1024, 1024, (bf16_t*)(P.ws + WS_WOUTT), L, r); continue; } r -= P0_TOUT;
        if (r < P0_TGLU) { p0_transpose_item(P.w_glu, 512, 512, (bf16_t*)(P.ws + WS_WGLUT), L, r); continue; } r -= P0_TGLU;
        p0_wcs_item(P, L, r);
    }
    __syncthreads();
    for (int i = threadIdx.x; i < 2048; i += 512) L[i] = cospif((float)i / 1024.0f);
    __syncthreads();
    bf16_t* CS = (bf16_t*)(P.ws + WS_CS);
    for (int i8 = wgi * 512 + threadIdx.x; i8 < 2 * 1024 * 1024 / 8; i8 += nwg * 512) {
        const int e = i8 * 8, cs = e >> 20, k = (e >> 10) & 1023, l0 = e & 1023, sh = cs ? 512 : 0;
        float v[8];
#pragma unroll
        for (int j = 0; j < 8; ++j) v[j] = L[((k * (l0 + j)) - sh) & 2047];
        u32x4 o; o.x = cvt_pk_bf16(v[0], v[1]); o.y = cvt_pk_bf16(v[2], v[3]); o.z = cvt_pk_bf16(v[4], v[5]); o.w = cvt_pk_bf16(v[6], v[7]);
        *(u32x4*)(CS + (size_t)e) = o;
    }
    __syncthreads();
}
__device__ __forceinline__ void phase0(const Params& P, LAS unsigned char* lds) {
    p0_items(P, lds);
}
template <bool TOK>
__device__ __forceinline__ void row_norm(int lane, const float* src, const float* posr, const float* posc, const float* gn, const float* sh, const float* sc, float* xpd, bf16_t* dst) {
    f32x4 v[4]; float ss = 0.f;
#pragma unroll
    for (int j = 0; j < 4; ++j) {
        const int col = 4 * lane + 256 * j;
        v[j] = *(const f32x4*)(src + col);
        if (TOK) { f32x4 p = (j < 2) ? *(const f32x4*)(posr + col) : *(const f32x4*)(posc + col - 512); v[j] = v[j] + p; *(f32x4*)(xpd + col) = v[j]; }
        ss += (v[j].x * v[j].x + v[j].y * v[j].y) + (v[j].z * v[j].z + v[j].w * v[j].w);
    }
    ss = wave_sum(ss);
    const float inv = rsqrtf(ss * (1.0f / 1024.0f) + 1e-6f);
#pragma unroll
    for (int j = 0; j < 4; ++j) {
        const int col = 4 * lane + 256 * j;
        f32x4 g = *(const f32x4*)(gn + col), s1 = *(const f32x4*)(sc + col), s0 = *(const f32x4*)(sh + col);
        f32x4 h = v[j] * inv * g * (s1 + 1.0f) + s0;
        u32x2 o; o.x = cvt_pk_bf16(h.x, h.y); o.y = cvt_pk_bf16(h.z, h.w);
        *(u32x2*)(dst + col) = o;
    }
}
__device__ __forceinline__ void row_norm2_tok(int lane, const float* src0, const float* src1, const float* posr0, const float* posc0, const float* posr1, const float* posc1,
                                              const float* gn, const float* sh0, const float* sc0, const float* sh1, const float* sc1, float* xpd0, float* xpd1, bf16_t* dst0, bf16_t* dst1) {
    f32x4 v0[4], v1[4], p0[4], p1[4];
#pragma unroll
    for (int j = 0; j < 4; ++j) {
        const int col = 4 * lane + 256 * j;
        v0[j] = *(const f32x4*)(src0 + col); v1[j] = *(const f32x4*)(src1 + col);
        p0[j] = (j < 2) ? *(const f32x4*)(posr0 + col) : *(const f32x4*)(posc0 + col - 512);
        p1[j] = (j < 2) ? *(const f32x4*)(posr1 + col) : *(const f32x4*)(posc1 + col - 512);
    }
    float ss0 = 0.f, ss1 = 0.f;
#pragma unroll
    for (int j = 0; j < 4; ++j) {
        const int col = 4 * lane + 256 * j;
        v0[j] = v0[j] + p0[j]; v1[j] = v1[j] + p1[j];
        ss0 += (v0[j].x * v0[j].x + v0[j].y * v0[j].y) + (v0[j].z * v0[j].z + v0[j].w * v0[j].w);
        ss1 += (v1[j].x * v1[j].x + v1[j].y * v1[j].y) + (v1[j].z * v1[j].z + v1[j].w * v1[j].w);
    }
#pragma unroll
    for (int o = 32; o > 0; o >>= 1) { ss0 += __shfl_xor(ss0, o); ss1 += __shfl_xor(ss1, o); }
    const float inv0 = rsqrtf(ss0 * (1.0f / 1024.0f) + 1e-6f), inv1 = rsqrtf(ss1 * (1.0f / 1024.0f) + 1e-6f);
#pragma unroll
    for (int j = 0; j < 4; ++j) {
        const int col = 4 * lane + 256 * j;
        const f32x4 g = *(const f32x4*)(gn + col);
        const f32x4 a1 = *(const f32x4*)(sc0 + col), a0 = *(const f32x4*)(sh0 + col), b1 = *(const f32x4*)(sc1 + col), b0 = *(const f32x4*)(sh1 + col);
        const f32x4 h0 = v0[j] * inv0 * g * (a1 + 1.0f) + a0, h1 = v1[j] * inv1 * g * (b1 + 1.0f) + b0;
        u32x2 o0, o1; o0.x = cvt_pk_bf16(h0.x, h0.y); o0.y = cvt_pk_bf16(h0.z, h0.w); o1.x = cvt_pk_bf16(h1.x, h1.y); o1.y = cvt_pk_bf16(h1.z, h1.w);
        *(u32x2*)(dst0 + col) = o0; *(u32x2*)(dst1 + col) = o1;
    }
}
template <int NR>
__device__ __forceinline__ void row_normN_ctx(int lane, const float* src, const float* gn, const float* sh, const float* sc, bf16_t* dst) {
    f32x4 v[NR][4]; float ss[NR];
#pragma unroll
    for (int r = 0; r < NR; ++r)
#pragma unroll
        for (int j = 0; j < 4; ++j) v[r][j] = *(const f32x4*)(src + (size_t)r * 1024 + 4 * lane + 256 * j);
#pragma unroll
    for (int r = 0; r < NR; ++r) { ss[r] = 0.f;
#pragma unroll
        for (int j = 0; j < 4; ++j) ss[r] += (v[r][j].x * v[r][j].x + v[r][j].y * v[r][j].y) + (v[r][j].z * v[r][j].z + v[r][j].w * v[r][j].w); }
#pragma unroll
    for (int o = 32; o > 0; o >>= 1) {
#pragma unroll
        for (int r = 0; r < NR; ++r) ss[r] += __shfl_xor(ss[r], o); }
#pragma unroll
    for (int j = 0; j < 4; ++j) {
        const int col = 4 * lane + 256 * j;
        const f32x4 g = *(const f32x4*)(gn + col), s1 = *(const f32x4*)(sc + col), s0 = *(const f32x4*)(sh + col);
        const f32x4 gs = g * (s1 + 1.0f);
#pragma unroll
        for (int r = 0; r < NR; ++r) {
            const float inv = rsqrtf(ss[r] * (1.0f / 1024.0f) + 1e-6f);
            const f32x4 h = v[r][j] * inv * gs + s0;
            u32x2 o; o.x = cvt_pk_bf16(h.x, h.y); o.y = cvt_pk_bf16(h.z, h.w);
            *(u32x2*)(dst + (size_t)r * 1024 + col) = o;
        }
    }
}
struct EpiU {
    static constexpr bool PERM = true, AFTER_DRAIN = false;
    bf16_t* aext; bf16_t* fb; int ctx_b;
    __device__ __forceinline__ void operator()(const f32x4 (&acc)[2][2][4][2], const pg8::Unit& u, int wr, int wc, int fr, int fq) const {
#pragma unroll
        for (int ai = 0; ai < 2; ++ai)
#pragma unroll
            for (int m = 0; m < 4; ++m) {
                const int rt = 128 * ai + 64 * wr + 16 * m + fr;
#pragma unroll
                for (int bj = 0; bj < 2; ++bj) {
                    const int gcol = u.pn * 256 + 128 * bj + 32 * wc + 8 * fq;
                    const f32x4 v0 = acc[ai][bj][m][0], v1 = acc[ai][bj][m][1];
                    u32x4 w; w.x = cvt_pk_bf16(v0.x, v0.y); w.y = cvt_pk_bf16(v0.z, v0.w); w.z = cvt_pk_bf16(v1.x, v1.y); w.w = cvt_pk_bf16(v1.z, v1.w);
                    bf16_t* dst;
                    if (ctx_b >= 0) {
                        if (rt >= 128) continue;
                        const int t = (ctx_b & 1) * 128 + rt, g = gcol >> 4, q0 = gcol & 15, row = 512 + (ctx_b >> 1) * 8 + (t >> 5);
                        dst = aext + ((size_t)(g * 768 + row) * 768 + (t & 31) * 16 + q0);
                    } else {
                        const int r = u.pm * 256 + rt;
                        if (u.pn < 2) { const int b = r >> 11, t = r & 2047, g = gcol >> 4, q0 = gcol & 15, row = b * 64 + (t >> 5);
                            dst = aext + ((size_t)(g * 768 + row) * 768 + (t & 31) * 16 + q0); }
                        else dst = fb + (size_t)r * 512 + (gcol - 512);
                    }
                    *(u32x4*)dst = w;
                }
            }
    }
};
__device__ __forceinline__ void phase1(const Params& P, LAS unsigned char* lds) {
    const int tid = threadIdx.x, lane = tid & 63, wave = tid >> 6, wg = blockIdx.x;
    tp_b(wg < 32 ? 70 : 71, lds);
    const float* mod = (const float*)(P.ws + WS_MISC + MISC_MOD);
    const float* postab = (const float*)(P.ws + WS_MISC + MISC_POS);
    if (wg < 32) {
        const int b = wg >> 2, half = (wg >> 1) & 1, pn = wg & 1;
        bf16_t* hcb = (bf16_t*)(P.ws + WS_HCB) + (size_t)wg * 128 * 1024;
        for (int j = 0; j < 16; j += 8) {
            const int rr = wave * 16 + j;
            row_normN_ctx<8>(lane, P.ctx + (size_t)(b * 256 + half * 128 + rr) * 1024, P.norm1_g, mod + 8 * NMOD, mod + 8 * NMOD + 1024, hcb + (size_t)rr * 1024);
        }
        asm volatile("s_waitcnt vmcnt(0)" ::: "memory");
        __syncthreads();
        pg8::Gemm g{1024, 1024, 1024};
        pg8::Unit u{(const char*)hcb, (const char*)((const bf16_t*)(P.ws + WS_W1T) + (size_t)pn * 256 * 1024), 0, pn, 0};
        EpiU E{(bf16_t*)(P.ws + WS_AEXT), nullptr, b * 2 + half};
        pg8::gemm_unit<EpiU>(lds, g, u, E);
    } else {
    const int gw = (wg - 32) * 8 + wave, ngw = (gridDim.x - 32) * 8;
    bf16_t* xb = (bf16_t*)(P.ws + WS_XB);
    for (int r0 = 2 * gw; r0 < NTOK; r0 += 2 * ngw) {
        const int r1 = r0 + 1; const int b = r0 >> 11, t0 = r0 & 2047, t1 = r1 & 2047;
        row_norm2_tok(lane, P.x + (size_t)r0 * 1024, P.x + (size_t)r1 * 1024, postab + (size_t)(t0 >> 6) * 512, postab + (size_t)(32 + (t0 & 63)) * 512,
                      postab + (size_t)(t1 >> 6) * 512, postab + (size_t)(32 + (t1 & 63)) * 512, P.norm1_g, mod + (size_t)b * NMOD, mod + (size_t)b * NMOD + 1024,
                      mod + (size_t)b * NMOD, mod + (size_t)b * NMOD + 1024, P.out + (size_t)r0 * 1024, P.out + (size_t)r1 * 1024, xb + (size_t)r0 * 1024, xb + (size_t)r1 * 1024);
    }
    }
    tp_e(blockIdx.x < 32 ? 70 : 71, lds);
}
__device__ __forceinline__ void p3_extra(const Params& P, LAS unsigned char* lds, int wgi, int nwg) {
    const int tid = threadIdx.x, lane = tid & 63, wave = tid >> 6;
    const float* mod = (const float*)(P.ws + WS_MISC + MISC_MOD);
    const int gw = wgi * 8 + wave, ngw = nwg * 8;
    {
        LAS float* sh2 = (LAS float*)lds;
        for (int idx = tid; idx < 8 * 1024; idx += 512) sh2[idx] = mod[(size_t)(idx >> 10) * NMOD + 3 * 1024 + (idx & 1023)];
        __syncthreads();
        const bf16_t* WsT = (const bf16_t*)(P.ws + WS_WST);
        float* bias = (float*)(P.ws + WS_MISC + MISC_BIAS);
        for (int n = gw; n < 2048; n += ngw) {
            float acc[8];
#pragma unroll
            for (int b = 0; b < 8; ++b) acc[b] = 0.f;
#pragma unroll
            for (int j = 0; j < 2; ++j) {
                const int k0 = lane * 8 + 512 * j;
                u32x4 wv = *(const u32x4*)(WsT + (size_t)n * 1024 + k0);
                float wf[8] = {bflo(wv.x), bfhi(wv.x), bflo(wv.y), bfhi(wv.y), bflo(wv.z), bfhi(wv.z), bflo(wv.w), bfhi(wv.w)};
#pragma unroll
                for (int b = 0; b < 8; ++b)
#pragma unroll
                    for (int i = 0; i < 8; ++i) acc[b] += sh2[b * 1024 + k0 + i] * wf[i];
            }
#pragma unroll
            for (int b = 0; b < 8; ++b) { float s = wave_sum(acc[b]); if (lane == 0) bias[b * 2048 + n] = s; }
        }
    }
}
__device__ __forceinline__ void mapt_assemble(const Params& P, int wgi, int nwg) {
    const int tid = threadIdx.x;
    {
        const float* Kt = (const float*)(P.ws + WS_KTAB);
        bf16_t* Mp = (bf16_t*)(P.ws + WS_MAPT);
        const int nthr = nwg * 512;
#pragma unroll 4
        for (int i8 = wgi * 512 + tid; i8 < 32 * 512 * 64; i8 += nthr) {
            const int g = i8 >> 15, row = (i8 >> 6) & 511, ch = i8 & 63; const int t = row >> 4, p = row & 15, s = ch >> 1, q8 = (ch & 1) * 8;
            f32x4 a0 = (f32x4){0.f, 0.f, 0.f, 0.f}, a1 = a0;
            if (t >= s) { const float* kp = Kt + ((size_t)((g * 2 + 0) * 32 + (t - s)) * 256 + p * 16 + q8); a0 = a0 + *(const f32x4*)kp; a1 = a1 + *(const f32x4*)(kp + 4); }
            if (s >= t) { const float* kp = Kt + ((size_t)((g * 2 + 1) * 32 + (s - t)) * 256 + p * 16 + q8); a0 = a0 + *(const f32x4*)kp; a1 = a1 + *(const f32x4*)(kp + 4); }
            u32x4 o; o.x = cvt_pk_bf16(a0.x, a0.y); o.y = cvt_pk_bf16(a0.z, a0.w); o.z = cvt_pk_bf16(a1.x, a1.y); o.w = cvt_pk_bf16(a1.z, a1.w);
            *(u32x4*)(Mp + ((size_t)(g * 512 + row) * 768 + s * 16 + q8)) = o;
        }
    }
}
__device__ __forceinline__ void phase2(const Params& P, LAS unsigned char* lds) {
    const int wg = blockIdx.x;
    const int wgid = (wg & 7) * 32 + (wg >> 3);
    const int pm = (wgid >> 5) * 8 + (wgid & 7), pn = (wgid & 31) >> 3;
    pg8::Gemm g{1024, 1024, 1024};
    pg8::Unit u{(const char*)((const bf16_t*)(P.ws + WS_XB) + (size_t)pm * 256 * 1024), (const char*)((const bf16_t*)(P.ws + WS_W1T) + (size_t)pn * 256 * 1024), pm, pn, 0};
    EpiU E{(bf16_t*)(P.ws + WS_AEXT), (bf16_t*)(P.ws + WS_FB), -1};
    pg8::gemm_unit<EpiU>(lds, g, u, E);
    mapt_assemble(P, wg, gridDim.x);
}

constexpr size_t WS_FOLD = WS_XB;
constexpr size_t WS_YGELU = WS_FB;
constexpr size_t WS_MIXIN = WS_XB;
struct EpiGT {
    static constexpr bool PERM = true, AFTER_DRAIN = false;
    bf16_t* gt;
    __device__ __forceinline__ void operator()(const f32x4 (&acc)[2][2][4][2], const pg8::Unit& u, int wr, int wc, int fr, int fq) const {
        const int b = u.pn >> 2;
#pragma unroll
        for (int ai = 0; ai < 2; ++ai)
#pragma unroll
            for (int m = 0; m < 4; ++m) {
                const int chp = u.pm * 256 + 128 * ai + 64 * wr + 16 * m + fr;
#pragma unroll
                for (int bj = 0; bj < 2; ++bj) {
                    const int l = (u.pn & 3) * 256 + 128 * bj + 32 * wc + 8 * fq;
                    const f32x4 v0 = acc[ai][bj][m][0], v1 = acc[ai][bj][m][1];
                    u32x4 w; w.x = cvt_pk_bf16(v0.x, v0.y); w.y = cvt_pk_bf16(v0.z, v0.w); w.z = cvt_pk_bf16(v1.x, v1.y); w.w = cvt_pk_bf16(v1.z, v1.w);
                    *(u32x4*)(gt + ((size_t)((b * 512 + (chp & 511)) * 2 + (chp >> 9)) * 1024 + l)) = w;
                }
            }
    }
};
struct EpiE {
    static constexpr bool PERM = false, AFTER_DRAIN = false;
    float* base;
    __device__ __forceinline__ void operator()(const f32x4 (&acc)[2][2][4][2], const pg8::Unit& u, int wr, int wc, int fr, int fq) const {
#pragma unroll
        for (int ai = 0; ai < 2; ++ai)
#pragma unroll
            for (int m = 0; m < 4; ++m) {
                const int rt = 128 * ai + 64 * wr + 16 * m + fr;
#pragma unroll
                for (int bj = 0; bj < 2; ++bj)
#pragma unroll
                    for (int n = 0; n < 2; ++n) *(f32x4*)(base + (size_t)rt * 256 + 128 * bj + 32 * wc + 16 * n + 4 * fq) = acc[ai][bj][m][n];
            }
    }
};
__device__ __forceinline__ unsigned bf2_add(unsigned a, unsigned b, float sg) { return cvt_pk_bf16(bflo(a) + sg * bflo(b), bfhi(a) + sg * bfhi(b)); }
__device__ __forceinline__ void phase3(const Params& P, LAS unsigned char* lds) {
    const int wg = blockIdx.x;
    if (wg < 128) {
        const int pm = wg & 3, pn = wg >> 2; const int cs = pm >> 1, b = pn >> 2, lbase = (pn & 3) * 256;
        bf16_t* fold = (bf16_t*)(P.ws + WS_FOLD) + (size_t)wg * 256 * 512;
        const bf16_t* fb = (const bf16_t*)(P.ws + WS_FB) + (size_t)b * 2048 * 512;
        const float sg = cs ? -1.0f : 1.0f;
        for (int it = threadIdx.x; it < 256 * 64; it += 512 * 4) {
            u32x4 a[4], m[4];
#pragma unroll
            for (int q = 0; q < 4; ++q) { const int i = it + 512 * q; const int row = i >> 6, ch8 = (i & 63) * 8; const int l = lbase + row;
                a[q] = *(const u32x4*)(fb + (size_t)l * 512 + ch8); m[q] = *(const u32x4*)(fb + (size_t)((2048 - l) & 2047) * 512 + ch8); }
#pragma unroll
            for (int q = 0; q < 4; ++q) { const int i = it + 512 * q; const int row = i >> 6, ch8 = (i & 63) * 8; const int l = lbase + row;
                u32x4 o;
                if (l == 0) { o = cs ? (u32x4){0u, 0u, 0u, 0u} : a[q]; }
                else { o.x = bf2_add(a[q].x, m[q].x, sg); o.y = bf2_add(a[q].y, m[q].y, sg); o.z = bf2_add(a[q].z, m[q].z, sg); o.w = bf2_add(a[q].w, m[q].w, sg); }
                *(u32x4*)(fold + (size_t)row * 512 + ch8) = o; }
        }
        asm volatile("s_waitcnt vmcnt(0)" ::: "memory");
        __syncthreads();
        pg8::Gemm g{512, 512, 512};
        pg8::Unit u{(const char*)((const bf16_t*)(P.ws + WS_WCST) + (size_t)pm * 256 * 512), (const char*)fold, pm, pn, 0};
        EpiGT E{(bf16_t*)(P.ws + WS_GT)};
        pg8::gemm_unit<EpiGT>(lds, g, u, E);
    } else if (wg < 224) {
        const int w2 = wg - 128; const int gg = w2 / 3, mt = w2 % 3;
        pg8::Gemm g{768, 512, 512};
        pg8::Unit u{(const char*)((const bf16_t*)(P.ws + WS_AEXT) + (size_t)(gg * 768 + mt * 256) * 768), (const char*)((const bf16_t*)(P.ws + WS_WENDT) + (size_t)gg * 256 * 512), mt, 0, gg};
        EpiE E{(float*)(P.ws + WS_E) + (size_t)(gg * 768 + mt * 256) * 256};
        pg8::gemm_unit<EpiE>(lds, g, u, E);
    }
    if (wg >= 128) { __syncthreads(); p3_extra(P, lds, wg - 128, 128); }
    {
        const int lane = threadIdx.x & 63, wave = threadIdx.x >> 6;
        float* ecv = (float*)(P.ws + WS_MISC + MISC_EC);
        const bf16_t* WcsT = (const bf16_t*)(P.ws + WS_WCST); const bf16_t* fb = (const bf16_t*)(P.ws + WS_FB);
#pragma unroll
        for (int q = 0; q < 2; ++q) {
            const int ent = wg * 16 + wave * 2 + q; const int b = ent >> 9, ch = ent & 511, gq = ch >> 7;
            const unsigned fw = *(const unsigned*)(fb + ((size_t)b * 2048 + 1024) * 512 + gq * 128 + 2 * lane);
            const unsigned ww = *(const unsigned*)(WcsT + (size_t)ch * 512 + gq * 128 + 2 * lane);
            float e = bflo(fw) * bflo(ww) + bfhi(fw) * bfhi(ww);
            e = wave_sum(e);
            if (lane == 0) ecv[ent] = e;
        }
    }
}
struct EpiY {
    static constexpr bool PERM = true, AFTER_DRAIN = false;
    const bf16_t* arow; const float* dskip; bf16_t* yg; int g, mt, nt;
    __device__ __forceinline__ void operator()(const f32x4 (&acc)[2][2][4][2], const pg8::Unit& u, int wr, int wc, int fr, int fq) const {
        f32x4 d0[2], d1[2];
#pragma unroll
        for (int bj = 0; bj < 2; ++bj) { const int p0 = (nt * 256 + 128 * bj + 32 * wc + 8 * fq) & 15; d0[bj] = *(const f32x4*)(dskip + g * 16 + p0); d1[bj] = *(const f32x4*)(dskip + g * 16 + p0 + 4); }
#pragma unroll
        for (int ai = 0; ai < 2; ++ai) {
            u32x4 uv[4][2];
#pragma unroll
            for (int m = 0; m < 4; ++m)
#pragma unroll
                for (int bj = 0; bj < 2; ++bj) {
                    const int row = mt * 256 + 128 * ai + 64 * wr + 16 * m + fr; const int col0 = nt * 256 + 128 * bj + 32 * wc + 8 * fq;
                    uv[m][bj] = *(const u32x4*)(arow + (size_t)row * 768 + col0);
                }
#pragma unroll
            for (int m = 0; m < 4; ++m) {
                const int row = mt * 256 + 128 * ai + 64 * wr + 16 * m + fr; const int b = row >> 6, c = row & 63;
#pragma unroll
                for (int bj = 0; bj < 2; ++bj) {
                    const int col0 = nt * 256 + 128 * bj + 32 * wc + 8 * fq; const int t = col0 >> 4, p0 = col0 & 15;
                    const u32x4 uq = uv[m][bj];
                    const f32x4 v0 = acc[ai][bj][m][0], v1 = acc[ai][bj][m][1];
                    float y[8] = {v0.x + d0[bj].x * bflo(uq.x), v0.y + d0[bj].y * bfhi(uq.x), v0.z + d0[bj].z * bflo(uq.y), v0.w + d0[bj].w * bfhi(uq.y),
                                  v1.x + d1[bj].x * bflo(uq.z), v1.y + d1[bj].y * bfhi(uq.z), v1.z + d1[bj].z * bflo(uq.w), v1.w + d1[bj].w * bfhi(uq.w)};
#pragma unroll
                    for (int i = 0; i < 8; ++i) y[i] = gelu_tanh(y[i]);
                    u32x4 w; w.x = cvt_pk_bf16(y[0], y[1]); w.y = cvt_pk_bf16(y[2], y[3]); w.z = cvt_pk_bf16(y[4], y[5]); w.w = cvt_pk_bf16(y[6], y[7]);
                    const size_t tok = (size_t)b * 2048 + c * 32 + t;
                    *(u32x4*)(yg + tok * 512 + g * 16 + p0) = w;
                }
            }
        }
    }
};
struct EpiP {
    static constexpr bool PERM = true, AFTER_DRAIN = false;
    bf16_t* base;
    __device__ __forceinline__ void operator()(const f32x4 (&acc)[2][2][4][2], const pg8::Unit& u, int wr, int wc, int fr, int fq) const {
#pragma unroll
        for (int ai = 0; ai < 2; ++ai)
#pragma unroll
            for (int m = 0; m < 4; ++m) {
                const int rt = 128 * ai + 64 * wr + 16 * m + fr;
#pragma unroll
                for (int bj = 0; bj < 2; ++bj) {
                    const f32x4 v0 = acc[ai][bj][m][0], v1 = acc[ai][bj][m][1];
                    u32x4 w; w.x = cvt_pk_bf16(v0.x, v0.y); w.y = cvt_pk_bf16(v0.z, v0.w); w.z = cvt_pk_bf16(v1.x, v1.y); w.w = cvt_pk_bf16(v1.z, v1.w);
                    *(u32x4*)(base + (size_t)rt * 512 + 128 * bj + 32 * wc + 8 * fq) = w;
                }
            }
    }
};
__device__ __forceinline__ void s5_carry(const Params& P, int g, int mt) {
    const int tid = threadIdx.x; const int bl = tid >> 7, dir = (tid >> 6) & 1, n = tid & 63; const int b = mt * 4 + bl;
    const int dg = dir * 32 + g, i = dg * 64 + n;
    const float dt = expf(P.log_dt[dg]); const float lr = P.lam_re[i], li = P.lam_im[i];
    const float mag = expf(32.0f * lr * dt), ang = 32.0f * (li * dt);
    const float atr = mag * cosf(ang), ati = mag * sinf(ang);
    const float* Eg = (const float*)(P.ws + WS_E) + (size_t)g * 768 * 256 + dir * 128 + n * 2;
    bf16_t* Ag = (bf16_t*)(P.ws + WS_AEXT) + (size_t)g * 768 * 768 + 512 + dir * 128 + n * 2;
    float hr = 0.f, hi = 0.f;
    f32x2 ec[8], el[64];
#pragma unroll
    for (int k = 0; k < 8; ++k) { const int cp = dir ? 7 - k : k; ec[k] = *(const f32x2*)(Eg + (size_t)(512 + b * 8 + cp) * 256); }
#pragma unroll
    for (int k = 0; k < 64; ++k) { const int c = dir ? 63 - k : k; el[k] = *(const f32x2*)(Eg + (size_t)(b * 64 + c) * 256); }
#pragma unroll
    for (int k = 0; k < 8; ++k) { const float nr = atr * hr - ati * hi + ec[k].x, ni = atr * hi + ati * hr + ec[k].y; hr = nr; hi = ni; }
#pragma unroll
    for (int k = 0; k < 64; ++k) {
        const int c = dir ? 63 - k : k;
        *(unsigned*)(Ag + (size_t)(b * 64 + c) * 768) = cvt_pk_bf16(hr, hi);
        const float nr = atr * hr - ati * hi + el[k].x, ni = atr * hi + ati * hr + el[k].y; hr = nr; hi = ni;
    }
}
__device__ __forceinline__ void phase4(const Params& P, LAS unsigned char* lds) {
    const int wg = blockIdx.x;
    tp_b(wg < 128 ? 40 : 41, lds);
    if (wg < 128) {
        const int gg = wg >> 2, mt = (wg >> 1) & 1, nt = wg & 1;
        tp_b(42, lds);
        s5_carry(P, gg, mt);
        asm volatile("s_waitcnt vmcnt(0)" ::: "memory");
        __syncthreads();
        tp_e(42, lds); tp_b(43, lds);
        const bf16_t* Ag = (const bf16_t*)(P.ws + WS_AEXT) + (size_t)gg * 768 * 768;
        pg8::Gemm g{768, 768, 768};
        pg8::Unit u{(const char*)(Ag + (size_t)mt * 256 * 768), (const char*)((const bf16_t*)(P.ws + WS_MAPT) + (size_t)(gg * 512 + nt * 256) * 768), mt, nt, gg};
        EpiY E{Ag, P.s5_d, (bf16_t*)(P.ws + WS_YGELU), gg, mt, nt};
        pg8::gemm_unit<EpiY>(lds, g, u, E);
        tp_e(43, lds);
    }
    else {
        const int idx = wg - 128; const int b = idx & 7, j = idx >> 3; const int cs = j >> 3, mt = (j >> 1) & 3, nt = j & 1;
        pg8::Gemm g{1024, 2048, 1024};
        pg8::Unit u{(const char*)((const bf16_t*)(P.ws + WS_CS) + (size_t)(cs * 1024 + mt * 256) * 1024),
                    (const char*)((const bf16_t*)(P.ws + WS_GT) + ((size_t)(b * 512 + nt * 256) * 2 + cs) * 1024), mt, nt, b};
        EpiP E{(bf16_t*)(P.ws + WS_CSPART) + ((size_t)(cs * 8 + b) * 1024 + mt * 256) * 512 + nt * 256};
        pg8::gemm_unit<EpiP>(lds, g, u, E);
        utable_to_i8(P, wg - 128, 128);
    }
    tp_e(wg < 128 ? 40 : 41, lds);
    {
        const int lane = threadIdx.x & 63, wave = threadIdx.x >> 6;
        const float* ecv = (const float*)(P.ws + WS_MISC + MISC_EC); float* o1024 = (float*)(P.ws + WS_MISC + MISC_O1024);
        const bf16_t* GT = (const bf16_t*)(P.ws + WS_GT);
#pragma unroll
        for (int q = 0; q < 2; ++q) {
            const int ent = wg * 16 + wave * 2 + q; const int b = ent >> 9, ch = ent & 511;
            const u32x4 g0 = *(const u32x4*)(GT + (size_t)(b * 512 + ch) * 2048 + 16 * lane), g1 = *(const u32x4*)(GT + (size_t)(b * 512 + ch) * 2048 + 16 * lane + 8);
            float s = (bflo(g0.x) - bfhi(g0.x)) + (bflo(g0.y) - bfhi(g0.y)) + (bflo(g0.z) - bfhi(g0.z)) + (bflo(g0.w) - bfhi(g0.w))
                    + (bflo(g1.x) - bfhi(g1.x)) + (bflo(g1.y) - bfhi(g1.y)) + (bflo(g1.z) - bfhi(g1.z)) + (bflo(g1.w) - bfhi(g1.w));
            s = wave_sum(s);
            if (lane == 0) o1024[ent] = s + ecv[ent];
        }
    }
}
struct EpiGlu {
    static constexpr bool PERM = true, AFTER_DRAIN = false;
    const bf16_t* yg; const float* bglu; bf16_t* mixin;
    __device__ __forceinline__ void operator()(const f32x4 (&acc)[2][2][4][2], const pg8::Unit& u, int wr, int wc, int fr, int fq) const {
        f32x4 b0[2], b1[2];
#pragma unroll
        for (int bj = 0; bj < 2; ++bj) { const int c0 = u.pn * 256 + 128 * bj + 32 * wc + 8 * fq; b0[bj] = *(const f32x4*)(bglu + c0); b1[bj] = *(const f32x4*)(bglu + c0 + 4); }
#pragma unroll
        for (int ai = 0; ai < 2; ++ai) {
            u32x4 yv[4][2];
#pragma unroll
            for (int m = 0; m < 4; ++m)
#pragma unroll
                for (int bj = 0; bj < 2; ++bj) {
                    const size_t r = (size_t)u.pm * 256 + 128 * ai + 64 * wr + 16 * m + fr; const int c0 = u.pn * 256 + 128 * bj + 32 * wc + 8 * fq;
                    yv[m][bj] = *(const u32x4*)(yg + r * 512 + c0);
                }
#pragma unroll
            for (int m = 0; m < 4; ++m) {
                const size_t r = (size_t)u.pm * 256 + 128 * ai + 64 * wr + 16 * m + fr;
#pragma unroll
                for (int bj = 0; bj < 2; ++bj) {
                    const int c0 = u.pn * 256 + 128 * bj + 32 * wc + 8 * fq;
                    const u32x4 yq = yv[m][bj];
                    const f32x4 v0 = acc[ai][bj][m][0] + b0[bj], v1 = acc[ai][bj][m][1] + b1[bj];
                    float s[8] = {bflo(yq.x) * sigmoidf_(v0.x), bfhi(yq.x) * sigmoidf_(v0.y), bflo(yq.y) * sigmoidf_(v0.z), bfhi(yq.y) * sigmoidf_(v0.w),
                                  bflo(yq.z) * sigmoidf_(v1.x), bfhi(yq.z) * sigmoidf_(v1.y), bflo(yq.w) * sigmoidf_(v1.z), bfhi(yq.w) * sigmoidf_(v1.w)};
                    u32x4 w; w.x = cvt_pk_bf16(s[0], s[1]); w.y = cvt_pk_bf16(s[2], s[3]); w.z = cvt_pk_bf16(s[4], s[5]); w.w = cvt_pk_bf16(s[6], s[7]);
                    *(u32x4*)(mixin + r * 1024 + c0) = w;
                }
            }
        }
    }
};
__device__ __forceinline__ void phase5(const Params& P, LAS unsigned char* lds) {
    const int wg = blockIdx.x;
    tp_b(wg < 128 ? 50 : 51, lds);
    bf16_t* mixin = (bf16_t*)(P.ws + WS_MIXIN);
    if (wg < 128) {
        const int pm = wg >> 1, pn = wg & 1;
        const bf16_t* yg = (const bf16_t*)(P.ws + WS_YGELU);
        pg8::Gemm g{512, 512, 512};
        pg8::Unit u{(const char*)(yg + (size_t)pm * 256 * 512), (const char*)((const bf16_t*)(P.ws + WS_WGLUT) + (size_t)pn * 256 * 512), pm, pn, 0};
        EpiGlu E{yg, P.b_glu, mixin};
        pg8::gemm_unit<EpiGlu>(lds, g, u, E);
    } else {
        const bf16_t* Cp = (const bf16_t*)(P.ws + WS_CSPART); const bf16_t* Sp = Cp + (size_t)8 * 1024 * 512;
        const float* ecv = (const float*)(P.ws + WS_MISC + MISC_EC); const float* o1024 = (const float*)(P.ws + WS_MISC + MISC_O1024);
        for (int i8 = (wg - 128) * 512 + threadIdx.x; i8 < NTOK * 64; i8 += 128 * 512) {
            const int tok = i8 >> 6, ch = (i8 & 63) * 8; const int b = tok >> 11, k = tok & 2047;
            const f32x4 e0 = *(const f32x4*)(ecv + b * 512 + ch), e1 = *(const f32x4*)(ecv + b * 512 + ch + 4);
            float v[8];
            if (k == 1024) {
                const f32x4 o0 = *(const f32x4*)(o1024 + b * 512 + ch), o1 = *(const f32x4*)(o1024 + b * 512 + ch + 4);
                v[0] = o0.x; v[1] = o0.y; v[2] = o0.z; v[3] = o0.w; v[4] = o1.x; v[5] = o1.y; v[6] = o1.z; v[7] = o1.w;
            } else {
                const int kk = (k < 1024) ? k : 2048 - k; const float sg = (k < 1024) ? 1.0f : -1.0f, se = (kk & 1) ? -1.0f : 1.0f;
                const u32x4 c = *(const u32x4*)(Cp + ((size_t)b * 1024 + kk) * 512 + ch), s = *(const u32x4*)(Sp + ((size_t)b * 1024 + kk) * 512 + ch);
                v[0] = bflo(c.x) + sg * bflo(s.x) + se * e0.x; v[1] = bfhi(c.x) + sg * bfhi(s.x) + se * e0.y; v[2] = bflo(c.y) + sg * bflo(s.y) + se * e0.z; v[3] = bfhi(c.y) + sg * bfhi(s.y) + se * e0.w;
                v[4] = bflo(c.z) + sg * bflo(s.z) + se * e1.x; v[5] = bfhi(c.z) + sg * bfhi(s.z) + se * e1.y; v[6] = bflo(c.w) + sg * bflo(s.w) + se * e1.z; v[7] = bfhi(c.w) + sg * bfhi(s.w) + se * e1.w;
            }
            u32x4 w; w.x = cvt_pk_bf16(v[0], v[1]); w.y = cvt_pk_bf16(v[2], v[3]); w.z = cvt_pk_bf16(v[4], v[5]); w.w = cvt_pk_bf16(v[6], v[7]);
            *(u32x4*)(mixin + (size_t)tok * 1024 + 512 + ch) = w;
        }
        vtable_to_fp8(P, wg - 128, 128);
    }
    tp_e(blockIdx.x < 128 ? 50 : 51, lds);
}
constexpr size_t WS_X1B = WS_AEXT;
constexpr size_t WS_X1H = WS_GT;
constexpr size_t WS_PAIRS = WS_XB;
constexpr size_t MISC_SS = 1024 * 1024;
struct EpiOut {
    static constexpr bool PERM = false, AFTER_DRAIN = false;
    const float* x; const float* postab; bf16_t* x1h; const float* mod; const float* g2n; bf16_t* x1b; float* sspart;
    __device__ __forceinline__ void operator()(const f32x4 (&acc)[2][2][4][2], const pg8::Unit& u, int wr, int wc, int fr, int fq) const {
        const int b = (u.pm * 256) >> 11;
        const float* mrow = mod + (size_t)b * NMOD;
        f32x4 gA[2][2], gB[2][2];
#pragma unroll
        for (int bj = 0; bj < 2; ++bj)
#pragma unroll
            for (int n = 0; n < 2; ++n) {
                const int col = u.pn * 256 + 128 * bj + 32 * wc + 16 * n + 4 * fq;
                gA[bj][n] = *(const f32x4*)(mrow + 2 * 1024 + col);
                gB[bj][n] = *(const f32x4*)(g2n + col) * (*(const f32x4*)(mrow + 4 * 1024 + col) + 1.0f);
            }
#pragma unroll
        for (int ai = 0; ai < 2; ++ai)
#pragma unroll
            for (int m = 0; m < 4; ++m) {
                const size_t r = (size_t)u.pm * 256 + 128 * ai + 64 * wr + 16 * m + fr; const int t = (int)(r & 2047);
                const float* prow = postab + (size_t)((u.pn < 2) ? (t >> 6) : (32 + (t & 63))) * 512 + (u.pn & 1) * 256;
                f32x4 xp[2][2];
#pragma unroll
                for (int bj = 0; bj < 2; ++bj)
#pragma unroll
                    for (int n = 0; n < 2; ++n) { const int cl = 128 * bj + 32 * wc + 16 * n + 4 * fq;
                        xp[bj][n] = *(const f32x4*)(x + r * 1024 + u.pn * 256 + cl) + *(const f32x4*)(prow + cl); }
                float ss = 0.f;
#pragma unroll
                for (int bj = 0; bj < 2; ++bj)
#pragma unroll
                    for (int n = 0; n < 2; ++n) {
                        const int col = u.pn * 256 + 128 * bj + 32 * wc + 16 * n + 4 * fq;
                        const f32x4 x1 = xp[bj][n] + gA[bj][n] * acc[ai][bj][m][n];
                        ss += (x1.x * x1.x + x1.y * x1.y) + (x1.z * x1.z + x1.w * x1.w);
                        const f32x4 hb = x1 * gB[bj][n];
                        u32x2 o, oh; o.x = cvt_pk_bf16(hb.x, hb.y); o.y = cvt_pk_bf16(hb.z, hb.w); oh.x = cvt_pk_bf16(x1.x, x1.y); oh.y = cvt_pk_bf16(x1.z, x1.w);
                        *(u32x2*)(x1h + r * 1024 + col) = oh;
                        *(u32x2*)(x1b + r * 1024 + col) = o;
                    }
                ss += __shfl_xor(ss, 16); ss += __shfl_xor(ss, 32);
                if (fq == 0) sspart[r * 16 + u.pn * 4 + wc] = ss;
                if (m & 1) asm volatile("" ::: "memory");
            }
    }
};
__device__ __forceinline__ void phase6(const Params& P, LAS unsigned char* lds) {
    const int wg = blockIdx.x;
    const int wgid = (wg & 7) * 32 + (wg >> 3);
    const int pm = (wgid >> 5) * 8 + (wgid & 7), pn = (wgid & 31) >> 3;
    pg8::Gemm g{1024, 1024, 1024};
    pg8::Unit u{(const char*)((const bf16_t*)(P.ws + WS_MIXIN) + (size_t)pm * 256 * 1024), (const char*)((const bf16_t*)(P.ws + WS_WOUTT) + (size_t)pn * 256 * 1024), pm, pn, 0};
    EpiOut E{P.x, (const float*)(P.ws + WS_MISC + MISC_POS), (bf16_t*)(P.ws + WS_X1H), (const float*)(P.ws + WS_MISC + MISC_MOD), P.norm2_g, (bf16_t*)(P.ws + WS_X1B), (float*)(P.ws + WS_MISC + MISC_SS)};
    pg8::gemm_unit<EpiOut>(lds, g, u, E);
}
__device__ __forceinline__ unsigned key_pack(float v, unsigned tag, unsigned mask) {
    unsigned b = __float_as_uint(v); b ^= (b >> 31) ? 0xffffffffu : 0x80000000u; return (b & ~mask) | tag;
}
__device__ __forceinline__ float key_val(unsigned k, unsigned mask) { unsigned b = k & ~mask; b ^= (b >> 31) ? 0x80000000u : 0xffffffffu; return __uint_as_float(b); }
__device__ const unsigned char CAND_TAB[64] = {0,1,2,3,4,5,6,7,8,9,10,11,12,13,14,15,16,17,18,19,20,21,22,23,32,33,34,35,36,48,49,50,51,64,65,66,80,81,96,97,112,113,128,144,160,176,192,208,224,240,
    255,255,255,255,255,255,255,255,255,255,255,255,255,255};
#define DPP_ROR(v, n) ((unsigned)__builtin_amdgcn_update_dpp(0, (int)(v), 0x120 + (n), 0xf, 0xf, false))
__device__ __forceinline__ unsigned row_umax(unsigned m) {
    unsigned t;
    t = DPP_ROR(m, 8); m = m > t ? m : t; t = DPP_ROR(m, 4); m = m > t ? m : t; t = DPP_ROR(m, 2); m = m > t ? m : t; t = DPP_ROR(m, 1); m = m > t ? m : t;
    return m;
}
__device__ __forceinline__ float row_fsum(float s) {
    s += __int_as_float(__builtin_amdgcn_update_dpp(0, __float_as_int(s), 0x128, 0xf, 0xf, false));
    s += __int_as_float(__builtin_amdgcn_update_dpp(0, __float_as_int(s), 0x124, 0xf, 0xf, false));
    s += __int_as_float(__builtin_amdgcn_update_dpp(0, __float_as_int(s), 0x122, 0xf, 0xf, false));
    s += __int_as_float(__builtin_amdgcn_update_dpp(0, __float_as_int(s), 0x121, 0xf, 0xf, false));
    return s;
}
#define CE(a, b) do { const unsigned hi_ = (a) > (b) ? (a) : (b), lo_ = (a) > (b) ? (b) : (a); (a) = hi_; (b) = lo_; } while (0)
__device__ __forceinline__ unsigned row_top16_of128(unsigned (&k)[8], int l16) {
    CE(k[0], k[1]); CE(k[2], k[3]); CE(k[0], k[2]); CE(k[1], k[3]); CE(k[1], k[2]); CE(k[4], k[5]); CE(k[6], k[7]); CE(k[4], k[6]); CE(k[5], k[7]); CE(k[5], k[6]); CE(k[0], k[4]); CE(k[2], k[6]); CE(k[2], k[4]); CE(k[1], k[5]); CE(k[3], k[7]); CE(k[3], k[5]); CE(k[1], k[2]); CE(k[3], k[4]); CE(k[5], k[6]);
    unsigned mine = 0u;
#pragma unroll
    for (int q = 0; q < 16; ++q) {
        const unsigned m = row_umax(k[0]);
        const bool own = (k[0] == m);
#pragma unroll
        for (int i = 0; i < 7; ++i) k[i] = own ? k[i + 1] : k[i];
        k[7] = own ? 0u : k[7];
        mine = (l16 == q) ? m : mine;
    }
    return mine;
}
__device__ __forceinline__ void row_top16_of128_x2(unsigned (&a)[8], unsigned (&b)[8], int l16, unsigned& ma, unsigned& mb) {
    CE(a[0], a[1]); CE(b[0], b[1]); CE(a[2], a[3]); CE(b[2], b[3]); CE(a[0], a[2]); CE(b[0], b[2]); CE(a[1], a[3]); CE(b[1], b[3]); CE(a[1], a[2]); CE(b[1], b[2]); CE(a[4], a[5]); CE(b[4], b[5]); CE(a[6], a[7]); CE(b[6], b[7]); CE(a[4], a[6]); CE(b[4], b[6]); CE(a[5], a[7]); CE(b[5], b[7]); CE(a[5], a[6]); CE(b[5], b[6]); CE(a[0], a[4]); CE(b[0], b[4]); CE(a[2], a[6]); CE(b[2], b[6]); CE(a[2], a[4]); CE(b[2], b[4]); CE(a[1], a[5]); CE(b[1], b[5]); CE(a[3], a[7]); CE(b[3], b[7]); CE(a[3], a[5]); CE(b[3], b[5]); CE(a[1], a[2]); CE(b[1], b[2]); CE(a[3], a[4]); CE(b[3], b[4]); CE(a[5], a[6]); CE(b[5], b[6]);
    unsigned minea = 0u, mineb = 0u;
#pragma unroll
    for (int q = 0; q < 16; ++q) {
        const unsigned xa = row_umax(a[0]), xb = row_umax(b[0]);
        const bool owna = (a[0] == xa), ownb = (b[0] == xb);
#pragma unroll
        for (int i = 0; i < 7; ++i) { a[i] = owna ? a[i + 1] : a[i]; b[i] = ownb ? b[i + 1] : b[i]; }
        a[7] = owna ? 0u : a[7]; b[7] = ownb ? 0u : b[7];
        minea = (l16 == q) ? xa : minea; mineb = (l16 == q) ? xb : mineb;
    }
    ma = minea; mb = mineb;
}
__device__ __forceinline__ unsigned row_top16_of64(unsigned (&k)[4], int l16) {
    CE(k[0], k[1]); CE(k[2], k[3]); CE(k[0], k[2]); CE(k[1], k[3]); CE(k[1], k[2]);
    unsigned mine = 0u;
#pragma unroll
    for (int q = 0; q < 16; ++q) {
        const unsigned m = row_umax(k[0]);
        const bool own = (k[0] == m);
        k[0] = own ? k[1] : k[0]; k[1] = own ? k[2] : k[1]; k[2] = own ? k[3] : k[2]; k[3] = own ? 0u : k[3];
        mine = (l16 == q) ? m : mine;
    }
    return mine;
}
struct EpiTopk {
    static constexpr bool PERM = false, AFTER_DRAIN = true;
    const float* sspart; const float* bias; int* pexp; float* pw; int head;
    __device__ __forceinline__ void fused(const f32x4 (&acc)[2][2][4][2], const pg8::Unit& u, int wr, int wc, int fr, int fq, LAS unsigned char* lds, int wid, int lane) const {
        LAS float* S = (LAS float*)lds;
        tp_e(30, lds); tp_b(31, lds);
        LAS unsigned* TL = (LAS unsigned*)(lds + 133120) + wid * 128;
        const int dr = lane >> 4, l16 = lane & 15;
        unsigned cc[4];
#pragma unroll
        for (int k = 0; k < 4; ++k) cc[k] = CAND_TAB[l16 * 4 + k];
        const LAS float* INV = (const LAS float*)(lds + 138240);
        const LAS float* BSL = (const LAS float*)(lds + 139264);
#pragma unroll
        for (int ai = 0; ai < 2; ++ai) {
#pragma unroll
            for (int m = 0; m < 4; ++m) {
                const int rl = 64 * wr + 16 * m + fr; const float inv = INV[128 * ai + rl];
#pragma unroll
                for (int bj = 0; bj < 2; ++bj)
#pragma unroll
                    for (int n = 0; n < 2; ++n) {
                        const int c = 128 * bj + 32 * wc + 16 * n + 4 * fq;
                        const f32x4 s = acc[ai][bj][m][n] * inv + *(const LAS f32x4*)(BSL + c);
                        *(LAS f32x4*)(S + rl * 260 + c) = s;
                    }
            }
            __syncthreads();
            tp_e(31, lds); tp_b(32, lds);
            for (int bt = 0; bt < 4; ++bt) {
#pragma unroll
                for (int half = 0; half < 2; ++half) {
                    const int trow = wid * 16 + bt * 4 + half * 2 + (dr >> 1), side = dr & 1;
                    const LAS f32x4* sp = (const LAS f32x4*)(S + trow * 260 + side * 128 + 8 * l16);
                    const f32x4 v0 = sp[0], v1 = sp[1];
                    unsigned k[8];
                    const unsigned tg = 127u - 8u * (unsigned)l16;
                    k[0] = key_pack(v0.x, tg, 127u); k[1] = key_pack(v0.y, tg - 1u, 127u); k[2] = key_pack(v0.z, tg - 2u, 127u); k[3] = key_pack(v0.w, tg - 3u, 127u);
                    k[4] = key_pack(v1.x, tg - 4u, 127u); k[5] = key_pack(v1.y, tg - 5u, 127u); k[6] = key_pack(v1.z, tg - 6u, 127u); k[7] = key_pack(v1.w, tg - 7u, 127u);
                    const unsigned mine = row_top16_of128(k, l16);
                    TL[(half * 2 + (dr >> 1)) * 32 + side * 16 + l16] = mine;
                }
                asm volatile("s_waitcnt lgkmcnt(0)" ::: "memory");
                unsigned ck[4];
#pragma unroll
                for (int k = 0; k < 4; ++k) {
                    const unsigned code = cc[k]; const unsigned ci = (code >> 4) & 15u, cj = code & 15u;
                    const unsigned ka = TL[dr * 32 + ci], kb = TL[dr * 32 + 16 + cj];
                    const unsigned key = key_pack(key_val(ka, 127u) + key_val(kb, 127u), 255u - code, 255u);
                    ck[k] = (code == 255u) ? 0u : key;
                }
                const unsigned best = row_top16_of64(ck, l16);
                const unsigned flat = 255u - (best & 255u);
                const float bv = key_val(best, 255u);
                const float bmax = key_val(row_umax(best), 255u);
                const float e = expf(bv - bmax);
                const float sum = row_fsum(e);
                const unsigned k1s = TL[dr * 32 + (flat >> 4)], k2s = TL[dr * 32 + 16 + (flat & 15u)];
                const int idx1 = 127 - (int)(k1s & 127u), idx2 = 127 - (int)(k2s & 127u);
                const size_t tok = (size_t)u.pm * 256 + 128 * ai + wid * 16 + bt * 4 + dr;
                pexp[tok * 128 + head * 16 + l16] = idx1 * 128 + idx2; pw[tok * 128 + head * 16 + l16] = e / sum;
                asm volatile("s_waitcnt lgkmcnt(0)" ::: "memory");
            }
            tp_e(32, lds); tp_b(31, lds);
            __syncthreads();
        }
        tp_e(31, lds);
    }
};
__device__ __forceinline__ void phase7(const Params& P, LAS unsigned char* lds) {
    const int wg = blockIdx.x; const int x = wg & 7, li = wg >> 3;
    {
        const int pm0 = 8 * x + (li & 7);
        if (threadIdx.x < 256) {
            const float* sp = (const float*)(P.ws + WS_MISC + MISC_SS) + ((size_t)pm0 * 256 + threadIdx.x) * 16;
            const f32x4 a = *(const f32x4*)sp, b = *(const f32x4*)(sp + 4), c = *(const f32x4*)(sp + 8), d = *(const f32x4*)(sp + 12);
            const float tot = ((a.x + a.y) + (a.z + a.w)) + ((b.x + b.y) + (b.z + b.w)) + ((c.x + c.y) + (c.z + c.w)) + ((d.x + d.y) + (d.z + d.w));
            ((LAS float*)(lds + 138240))[threadIdx.x] = rsqrtf(tot * (1.0f / 1024.0f) + 1e-6f);
        }
        __syncthreads();
    }
    for (int rnd = 0; rnd < 2; ++rnd) {
        const int unit = li + 32 * rnd; const int pm = 8 * x + (unit & 7), head = unit >> 3;
        pg8::Gemm g{1024, 1024, 1024};
        pg8::Unit u{(const char*)((const bf16_t*)(P.ws + WS_X1B) + (size_t)pm * 256 * 1024), (const char*)((const bf16_t*)(P.ws + WS_WST) + (size_t)head * 256 * 1024), pm, head, 0};
        EpiTopk E{(const float*)(P.ws + WS_MISC + MISC_SS), (const float*)(P.ws + WS_MISC + MISC_BIAS), (int*)(P.ws + WS_PAIRS), (float*)(P.ws + WS_PAIRS) + (size_t)NTOK * 128, head};
        if (threadIdx.x < 64) {
            const int b = (pm * 256) >> 11;
            *(LAS f32x4*)(lds + 139264 + threadIdx.x * 16) = *(const f32x4*)((const float*)(P.ws + WS_MISC + MISC_BIAS) + (size_t)b * 2048 + head * 256 + threadIdx.x * 4);
        }
        __syncthreads();
        tp_b(30, lds);
        pg8::gemm_unit<EpiTopk>(lds, g, u, E);
    }
}
constexpr size_t WS_U8 = 216 * MiB;
constexpr size_t WS_V8 = 232 * MiB;
#define U8_SCALE 512.0f
#define V8_SCALE 16.0f
__device__ __forceinline__ unsigned pack4_fp8(f32x4 v, float sc) {
    v = v * sc;
    v.x = fminf(fmaxf(v.x, -448.f), 448.f); v.y = fminf(fmaxf(v.y, -448.f), 448.f); v.z = fminf(fmaxf(v.z, -448.f), 448.f); v.w = fminf(fmaxf(v.w, -448.f), 448.f);
    int t = __builtin_amdgcn_cvt_pk_fp8_f32(v.x, v.y, 0, false);
    t = __builtin_amdgcn_cvt_pk_fp8_f32(v.z, v.w, t, true);
    return (unsigned)t;
}
constexpr size_t MISC_SU = 2 * 1024 * 1024;
__device__ __forceinline__ unsigned pack4_i8(f32x4 v, float sc) {
    const int a = (int)rintf(v.x * sc), b = (int)rintf(v.y * sc), c = (int)rintf(v.z * sc), d = (int)rintf(v.w * sc);
    return ((unsigned)a & 255u) | (((unsigned)b & 255u) << 8) | (((unsigned)c & 255u) << 16) | ((unsigned)d << 24);
}
__device__ __forceinline__ void vtable_to_fp8(const Params& P, int wgi, int nwg) {
    const int nthr = nwg * 512;
    for (int i0 = wgi * 512 + threadIdx.x; i0 < 16384 * 64; i0 += nthr * 4) {
        f32x4 v[4][4]; bool ok[4];
#pragma unroll
        for (int q = 0; q < 4; ++q) {
            const int i = i0 + q * nthr; ok[q] = i < 16384 * 64;
            const float* src = P.v_tab + (size_t)(ok[q] ? i : i0) * 16;
#pragma unroll
            for (int j = 0; j < 4; ++j) v[q][j] = *(const f32x4*)(src + 4 * j);
        }
#pragma unroll
        for (int q = 0; q < 4; ++q) {
            const int i = i0 + q * nthr;
            if (ok[q]) { u32x4 o; o.x = pack4_fp8(v[q][0], V8_SCALE); o.y = pack4_fp8(v[q][1], V8_SCALE); o.z = pack4_fp8(v[q][2], V8_SCALE); o.w = pack4_fp8(v[q][3], V8_SCALE);
                *(u32x4*)(P.ws + WS_V8 + (size_t)i * 16) = o; }
        }
    }
}
__device__ __forceinline__ void utable_to_i8(const Params& P, int wgi, int nwg) {
    const int lane = threadIdx.x & 63, gw = wgi * 8 + (threadIdx.x >> 6), ngw = nwg * 8;
    float* su = (float*)(P.ws + WS_MISC + MISC_SU);
    for (int r0 = gw; r0 < 16384; r0 += 4 * ngw) {
        f32x4 v[4][4]; float mx[4];
#pragma unroll
        for (int q = 0; q < 4; ++q) { const int r = r0 + q * ngw; const float* src = P.u_tab + (size_t)(r < 16384 ? r : r0) * 1024 + 16 * lane;
#pragma unroll
            for (int j = 0; j < 4; ++j) v[q][j] = *(const f32x4*)(src + 4 * j); }
#pragma unroll
        for (int q = 0; q < 4; ++q) { float m = 0.f;
#pragma unroll
            for (int j = 0; j < 4; ++j) m = fmaxf(fmaxf(fmaxf(fabsf(v[q][j].x), fabsf(v[q][j].y)), fmaxf(fabsf(v[q][j].z), fabsf(v[q][j].w))), m);
            mx[q] = m; }
#pragma unroll
        for (int o = 32; o > 0; o >>= 1) {
#pragma unroll
            for (int q = 0; q < 4; ++q) mx[q] = fmaxf(mx[q], __shfl_xor(mx[q], o)); }
#pragma unroll
        for (int q = 0; q < 4; ++q) { const int r = r0 + q * ngw;
            if (r < 16384) { const float sc = mx[q] > 0.f ? 127.0f / mx[q] : 0.f;
                u32x4 o; o.x = pack4_i8(v[q][0], sc); o.y = pack4_i8(v[q][1], sc); o.z = pack4_i8(v[q][2], sc); o.w = pack4_i8(v[q][3], sc);
                *(u32x4*)(P.ws + WS_U8 + (size_t)r * 1024 + 16 * lane) = o;
                if (lane == 0) su[r] = mx[q] * (1.0f / 127.0f); } }
    }
}
__device__ __forceinline__ float dot16_fp8(const u32x4 r, const f32x2 (&h)[8]) {
    f32x2 a = __builtin_amdgcn_cvt_pk_f32_fp8((int)r.x, false) * h[0];
    a = a + __builtin_amdgcn_cvt_pk_f32_fp8((int)r.x, true) * h[1];
    a = a + __builtin_amdgcn_cvt_pk_f32_fp8((int)r.y, false) * h[2];
    a = a + __builtin_amdgcn_cvt_pk_f32_fp8((int)r.y, true) * h[3];
    a = a + __builtin_amdgcn_cvt_pk_f32_fp8((int)r.z, false) * h[4];
    a = a + __builtin_amdgcn_cvt_pk_f32_fp8((int)r.z, true) * h[5];
    a = a + __builtin_amdgcn_cvt_pk_f32_fp8((int)r.w, false) * h[6];
    a = a + __builtin_amdgcn_cvt_pk_f32_fp8((int)r.w, true) * h[7];
    return a.x + a.y;
}
__device__ __forceinline__ void axpy16_fp8(const u32x4 r, const float w, f32x2 (&acc)[8]) {
    const f32x2 ww = (f32x2){w, w};
    acc[0] = acc[0] + __builtin_amdgcn_cvt_pk_f32_fp8((int)r.x, false) * ww;
    acc[1] = acc[1] + __builtin_amdgcn_cvt_pk_f32_fp8((int)r.x, true) * ww;
    acc[2] = acc[2] + __builtin_amdgcn_cvt_pk_f32_fp8((int)r.y, false) * ww;
    acc[3] = acc[3] + __builtin_amdgcn_cvt_pk_f32_fp8((int)r.y, true) * ww;
    acc[4] = acc[4] + __builtin_amdgcn_cvt_pk_f32_fp8((int)r.z, false) * ww;
    acc[5] = acc[5] + __builtin_amdgcn_cvt_pk_f32_fp8((int)r.z, true) * ww;
    acc[6] = acc[6] + __builtin_amdgcn_cvt_pk_f32_fp8((int)r.w, false) * ww;
    acc[7] = acc[7] + __builtin_amdgcn_cvt_pk_f32_fp8((int)r.w, true) * ww;
}
__device__ __forceinline__ float reduce16(float (&d)[16], int lane) {
    float a[8], b[4], c[2];
    const bool b0 = lane & 1, b1 = lane & 2, b2 = lane & 4, b3 = lane & 8;
#pragma unroll
    for (int j = 0; j < 8; ++j) { const float keep = b0 ? d[2 * j + 1] : d[2 * j], send = b0 ? d[2 * j] : d[2 * j + 1]; a[j] = keep + __shfl_xor(send, 1); }
#pragma unroll
    for (int j = 0; j < 4; ++j) { const float keep = b1 ? a[2 * j + 1] : a[2 * j], send = b1 ? a[2 * j] : a[2 * j + 1]; b[j] = keep + __shfl_xor(send, 2); }
#pragma unroll
    for (int j = 0; j < 2; ++j) { const float keep = b2 ? b[2 * j + 1] : b[2 * j], send = b2 ? b[2 * j] : b[2 * j + 1]; c[j] = keep + __shfl_xor(send, 4); }
    const float keep = b3 ? c[1] : c[0], send = b3 ? c[0] : c[1];
    float v = keep + __shfl_xor(send, 8);
    v += __shfl_xor(v, 16); v += __shfl_xor(v, 32);
    return v;
}
__device__ __forceinline__ float reduce8(float (&d)[8], int lane) {
    float a[4], b[2];
    const bool b0 = lane & 1, b1 = lane & 2, b2 = lane & 4;
#pragma unroll
    for (int j = 0; j < 4; ++j) { const float keep = b0 ? d[2 * j + 1] : d[2 * j], send = b0 ? d[2 * j] : d[2 * j + 1]; a[j] = keep + __shfl_xor(send, 1); }
#pragma unroll
    for (int j = 0; j < 2; ++j) { const float keep = b1 ? a[2 * j + 1] : a[2 * j], send = b1 ? a[2 * j] : a[2 * j + 1]; b[j] = keep + __shfl_xor(send, 2); }
    const float keep = b2 ? b[1] : b[0], send = b2 ? b[0] : b[1];
    float v = keep + __shfl_xor(send, 4);
    v += __shfl_xor(v, 8); v += __shfl_xor(v, 16); v += __shfl_xor(v, 32);
    return v;
}
#ifndef VCH
#define VCH 8
#endif
constexpr int P8_LDS_SE = 0;
constexpr int P8_LDS_SW = 64 * 128 * 4;
constexpr int P8_LDS_SG = 2 * 64 * 128 * 4;
constexpr int P8_LDS_SO = 3 * 64 * 128 * 4;
typedef _Float16 h16x2 __attribute__((ext_vector_type(2)));
template <bool HI> __device__ __forceinline__ h16x2 cvt_fp8x2_f16(int s) { return __builtin_bit_cast(h16x2, __builtin_amdgcn_cvt_scalef32_pk_f16_fp8(s, 1.0f, HI)); }
__device__ __forceinline__ void axpy16_fp8_h(const u32x4 r, const h16x2 ww, h16x2 (&acc)[8]) {
    acc[0] = __builtin_elementwise_fma(cvt_fp8x2_f16<false>((int)r.x), ww, acc[0]);
    acc[1] = __builtin_elementwise_fma(cvt_fp8x2_f16<true>((int)r.x), ww, acc[1]);
    acc[2] = __builtin_elementwise_fma(cvt_fp8x2_f16<false>((int)r.y), ww, acc[2]);
    acc[3] = __builtin_elementwise_fma(cvt_fp8x2_f16<true>((int)r.y), ww, acc[3]);
    acc[4] = __builtin_elementwise_fma(cvt_fp8x2_f16<false>((int)r.z), ww, acc[4]);
    acc[5] = __builtin_elementwise_fma(cvt_fp8x2_f16<true>((int)r.z), ww, acc[5]);
    acc[6] = __builtin_elementwise_fma(cvt_fp8x2_f16<false>((int)r.w), ww, acc[6]);
    acc[7] = __builtin_elementwise_fma(cvt_fp8x2_f16<true>((int)r.w), ww, acc[7]);
}
__device__ __forceinline__ float dot16_i8(const u32x4 r, const int (&h)[4]) {
    int a = __builtin_amdgcn_sdot4((int)r.x, h[0], 0, false);
    a = __builtin_amdgcn_sdot4((int)r.y, h[1], a, false);
    a = __builtin_amdgcn_sdot4((int)r.z, h[2], a, false);
    a = __builtin_amdgcn_sdot4((int)r.w, h[3], a, false);
    return (float)a;
}
__device__ __forceinline__ void phase8(const Params& P, LAS unsigned char* lds) {
    const int lane = threadIdx.x & 63, wave = threadIdx.x >> 6;
    const float* mod = (const float*)(P.ws + WS_MISC + MISC_MOD); const float* sspart = (const float*)(P.ws + WS_MISC + MISC_SS);
    const float* su = (const float*)(P.ws + WS_MISC + MISC_SU);
    const bf16_t* x1h = (const bf16_t*)(P.ws + WS_X1H);
    const int* pexp = (const int*)(P.ws + WS_PAIRS); const float* pw = (const float*)(P.ws + WS_PAIRS) + (size_t)NTOK * 128;
    const unsigned char* u8 = P.ws + WS_U8; const unsigned char* v8 = P.ws + WS_V8; const unsigned lane16 = 16u * (unsigned)lane, lane64 = 64u * (unsigned)lane;
    LAS unsigned* SE = (LAS unsigned*)(lds + P8_LDS_SE) + wave * 8 * 128;
    LAS float* SW = (LAS float*)(lds + P8_LDS_SW) + wave * 8 * 128;
    LAS float* SD = SW;
    LAS float* SG = (LAS float*)(lds + P8_LDS_SG) + wave * 8 * 128;
    LAS int* SO = (LAS int*)(lds + P8_LDS_SO) + wave * 8 * 16;
    const int tok0 = __builtin_amdgcn_readfirstlane(blockIdx.x * 64 + wave * 8);
    const int b = tok0 >> 11; const float* mrow = mod + (size_t)b * NMOD;
    const unsigned long long ltmask = (1ull << lane) - 1ull;
    int hq[8][4]; float hsc[8];
    unsigned long long tq0 = 0ull;
#define TQB(id) do { if (TPROBE == (id) && threadIdx.x == 0) tq0 = __builtin_amdgcn_s_memrealtime(); } while (0)
#define TQE(id) do { if (TPROBE == (id) && threadIdx.x == 0) ((LAS unsigned*)(lds + 147456 - 16))[2] += (unsigned)(__builtin_amdgcn_s_memrealtime() - tq0); } while (0)
    TQB(20);
#pragma unroll 1
    for (int t = 0; t < 8; ++t) {
        const int tok = tok0 + t;
        const unsigned lane4 = 4u * (unsigned)lane;
        const int e0 = *(const int*)((const char*)(pexp + (size_t)tok * 128) + lane4), e1 = *(const int*)((const char*)(pexp + (size_t)tok * 128 + 64) + lane4);
        const float g0 = *(const float*)((const char*)(pw + (size_t)tok * 128) + lane4), g1 = *(const float*)((const char*)(pw + (size_t)tok * 128 + 64) + lane4);
        const int r0 = e0 >> 11, r1 = e1 >> 11;
        int base = 0, pos0 = 0, pos1 = 0, ov = 0;
#pragma unroll
        for (int rho = 0; rho < 8; ++rho) {
            const unsigned long long m0 = __ballot(r0 == rho), m1 = __ballot(r1 == rho);
            const int c0 = __popcll(m0), c1 = __popcll(m1);
            if (r0 == rho) pos0 = base + __popcll(m0 & ltmask);
            if (r1 == rho) pos1 = base + c0 + __popcll(m1 & ltmask);
            if (lane == rho) ov = base;
            base += c0 + c1;
        }
        if (lane >= 8) ov = 128;
        if (lane < 16) SO[t * 16 + lane] = ov;
        SE[t * 128 + pos0] = (unsigned)e0; SE[t * 128 + pos1] = (unsigned)e1;
        SG[t * 128 + pos0] = g0; SG[t * 128 + pos1] = g1;
    }
#pragma unroll
    for (int t = 0; t < 8; ++t) {
        const int tok = tok0 + t;
        float tot = 0.f;
#pragma unroll
        for (int i = 0; i < 4; ++i) { const f32x4 sp = *(const f32x4*)(sspart + (size_t)tok * 16 + 4 * i); tot += (sp.x + sp.y) + (sp.z + sp.w); }
        const float inv = rsqrtf(tot * (1.0f / 1024.0f) + 1e-6f);
        f32x4 h[4]; float mx = 0.f;
        const u32x4 xh0 = *(const u32x4*)((const char*)(x1h + (size_t)tok * 1024) + 2u * lane16), xh1 = *(const u32x4*)((const char*)(x1h + (size_t)tok * 1024) + 2u * lane16 + 16u);
        const f32x4 x1v[4] = {(f32x4){bflo(xh0.x), bfhi(xh0.x), bflo(xh0.y), bfhi(xh0.y)}, (f32x4){bflo(xh0.z), bfhi(xh0.z), bflo(xh0.w), bfhi(xh0.w)},
                              (f32x4){bflo(xh1.x), bfhi(xh1.x), bflo(xh1.y), bfhi(xh1.y)}, (f32x4){bflo(xh1.z), bfhi(xh1.z), bflo(xh1.w), bfhi(xh1.w)}};
#pragma unroll
        for (int j = 0; j < 4; ++j) {
            const unsigned bo = lane64 + 16u * j;
            const f32x4 x1 = x1v[j];
            const f32x4 gn = *(const f32x4*)((const char*)P.norm2_g + bo), sc2 = *(const f32x4*)((const char*)(mrow + 4 * 1024) + bo), sh2 = *(const f32x4*)((const char*)(mrow + 3 * 1024) + bo);
            h[j] = x1 * inv * gn * (sc2 + 1.0f) + sh2;
            mx = fmaxf(fmaxf(fmaxf(fabsf(h[j].x), fabsf(h[j].y)), fmaxf(fabsf(h[j].z), fabsf(h[j].w))), mx);
        }
#pragma unroll
        for (int o = 32; o > 0; o >>= 1) mx = fmaxf(mx, __shfl_xor(mx, o));
        const float qs = mx > 0.f ? 127.0f / mx : 0.f;
#pragma unroll
        for (int j = 0; j < 4; ++j) hq[t][j] = (int)pack4_i8(h[j], qs);
        hsc[t] = mx * (1.0f / 127.0f);
        if (t & 1) asm volatile("" ::: "memory");
    }
    asm volatile("s_waitcnt lgkmcnt(0)" ::: "memory");
    TQE(20); TQB(21);
    for (int rho = 0; rho < 8; ++rho) {
#pragma unroll
        for (int t = 0; t < 4; ++t) {
            const int tA = t, tB = t + 4;
            const int begA = __builtin_amdgcn_readfirstlane(SO[tA * 16 + rho]), endA = __builtin_amdgcn_readfirstlane(SO[tA * 16 + rho + 1]);
            const int begB = __builtin_amdgcn_readfirstlane(SO[tB * 16 + rho]), endB = __builtin_amdgcn_readfirstlane(SO[tB * 16 + rho + 1]);
            const int clA = endA > 0 ? endA - 1 : 0, clB = endB > 0 ? endB - 1 : 0;
            for (int cA = begA, cB = begB; cA < endA || cB < endB; cA += 8, cB += 8) {
                const int liA = cA + (lane & 7), liB = cB + (lane & 7);
                const int eA8 = (int)SE[tA * 128 + (liA < endA ? liA : clA)], eB8 = (int)SE[tB * 128 + (liB < endB ? liB : clB)];
                u32x4 rA[8], rB[8];
#pragma unroll
                for (int i = 0; i < 8; ++i) { const int e = __builtin_amdgcn_readlane(eA8, i); rA[i] = *(const u32x4*)(u8 + (size_t)e * 1024 + lane16); }
#pragma unroll
                for (int i = 0; i < 8; ++i) { const int e = __builtin_amdgcn_readlane(eB8, i); rB[i] = *(const u32x4*)(u8 + (size_t)e * 1024 + lane16); }
                float d[8];
#pragma unroll
                for (int i = 0; i < 8; ++i) d[i] = dot16_i8(rA[i], hq[tA]);
                const float vA = reduce8(d, lane);
                if (lane < 8 && liA < endA) SD[tA * 128 + liA] = vA * hsc[tA];
#pragma unroll
                for (int i = 0; i < 8; ++i) d[i] = dot16_i8(rB[i], hq[tB]);
                const float vB = reduce8(d, lane);
                if (lane < 8 && liB < endB) SD[tB * 128 + liB] = vB * hsc[tB];
            }
        }
    }
    asm volatile("s_waitcnt lgkmcnt(0)" ::: "memory");
    TQE(21); TQB(22);
#pragma unroll
    for (int t = 0; t < 8; ++t) {
        const unsigned ea = SE[t * 128 + lane], eb = SE[t * 128 + 64 + lane];
        const float sua = su[ea], sub = su[eb];
        const float d0 = SD[t * 128 + lane] * sua, d1 = SD[t * 128 + 64 + lane] * sub;
        const float ga = SG[t * 128 + lane], gb = SG[t * 128 + 64 + lane];
        const float w0 = ga * gelu_tanh(d0), w1 = gb * gelu_tanh(d1);
        asm volatile("s_waitcnt lgkmcnt(0)" ::: "memory");
        SW[t * 128 + lane] = w0; SW[t * 128 + 64 + lane] = w1;
    }
    asm volatile("s_waitcnt lgkmcnt(0)" ::: "memory");
    TQE(22); TQB(23);
    h16x2 acc[8][8];
#pragma unroll
    for (int t = 0; t < 8; ++t)
#pragma unroll
        for (int j = 0; j < 8; ++j) acc[t][j] = (h16x2){(_Float16)0.f, (_Float16)0.f};
    for (int rho = 0; rho < 8; ++rho) {
#pragma unroll
        for (int t = 0; t < 4; ++t) {
            const int tA = t, tB = t + 4;
            const int begA = __builtin_amdgcn_readfirstlane(SO[tA * 16 + rho]), endA = __builtin_amdgcn_readfirstlane(SO[tA * 16 + rho + 1]);
            const int begB = __builtin_amdgcn_readfirstlane(SO[tB * 16 + rho]), endB = __builtin_amdgcn_readfirstlane(SO[tB * 16 + rho + 1]);
            const int clA = endA > 0 ? endA - 1 : 0, clB = endB > 0 ? endB - 1 : 0;
            for (int cA = begA, cB = begB; cA < endA || cB < endB; cA += VCH, cB += VCH) {
                const int liA = cA + (lane & 7), liB = cB + (lane & 7);
                const int lcA = (liA < endA ? liA : clA), lcB = (liB < endB ? liB : clB);
                const int eA8 = (int)SE[tA * 128 + lcA], eB8 = (int)SE[tB * 128 + lcB];
                const float wA8 = (liA < endA) ? SW[tA * 128 + lcA] : 0.f, wB8 = (liB < endB) ? SW[tB * 128 + lcB] : 0.f;
                u32x4 rA[VCH], rB[VCH];
#pragma unroll
                for (int i = 0; i < VCH; ++i) { const int e = __builtin_amdgcn_readlane(eA8, i); rA[i] = *(const u32x4*)(v8 + (size_t)e * 1024 + lane16); }
#pragma unroll
                for (int i = 0; i < VCH; ++i) { const int e = __builtin_amdgcn_readlane(eB8, i); rB[i] = *(const u32x4*)(v8 + (size_t)e * 1024 + lane16); }
#pragma unroll
                for (int i = 0; i < VCH; ++i) { const float w = __int_as_float(__builtin_amdgcn_readlane(__float_as_int(wA8), i)); axpy16_fp8_h(rA[i], (h16x2){(_Float16)w, (_Float16)w}, acc[tA]); }
#pragma unroll
                for (int i = 0; i < VCH; ++i) { const float w = __int_as_float(__builtin_amdgcn_readlane(__float_as_int(wB8), i)); axpy16_fp8_h(rB[i], (h16x2){(_Float16)w, (_Float16)w}, acc[tB]); }
            }
        }
    }
    TQE(23);
    float tp_scale = 1.0f;
#if defined(TPROBE)
    if (TPROBE >= 0) { __syncthreads(); const unsigned ticks = ((LAS unsigned*)(lds + 147456 - 16))[2]; tp_scale = 1.0f + sqrtf((float)ticks * TPSCALE); }
#endif
#pragma unroll
    for (int t = 0; t < 8; ++t) {
        const int tok = tok0 + t;
        float ss = 0.f; f32x4 xo[4];
        const u32x4 xh0 = *(const u32x4*)((const char*)(x1h + (size_t)tok * 1024) + 2u * lane16), xh1 = *(const u32x4*)((const char*)(x1h + (size_t)tok * 1024) + 2u * lane16 + 16u);
        const f32x4 x1v[4] = {(f32x4){bflo(xh0.x), bfhi(xh0.x), bflo(xh0.y), bfhi(xh0.y)}, (f32x4){bflo(xh0.z), bfhi(xh0.z), bflo(xh0.w), bfhi(xh0.w)},
                              (f32x4){bflo(xh1.x), bfhi(xh1.x), bflo(xh1.y), bfhi(xh1.y)}, (f32x4){bflo(xh1.z), bfhi(xh1.z), bflo(xh1.w), bfhi(xh1.w)}};
#pragma unroll
        for (int j = 0; j < 4; ++j) {
            const unsigned bo = lane64 + 16u * j;
            const f32x4 x1 = x1v[j];
            const f32x4 g2 = *(const f32x4*)((const char*)(mrow + 5 * 1024) + bo) * (1.0f / V8_SCALE);
            const f32x4 pa = (f32x4){(float)acc[t][2 * j].x, (float)acc[t][2 * j].y, (float)acc[t][2 * j + 1].x, (float)acc[t][2 * j + 1].y};
            xo[j] = x1 + g2 * pa;
            ss += (xo[j].x * xo[j].x + xo[j].y * xo[j].y) + (xo[j].z * xo[j].z + xo[j].w * xo[j].w);
        }
        ss = wave_sum(ss);
        const float inv2 = rsqrtf(ss * (1.0f / 1024.0f) + 1e-6f);
#pragma unroll
        for (int j = 0; j < 4; ++j) {
            const unsigned bo = lane64 + 16u * j;
            const f32x4 fg = *(const f32x4*)((const char*)P.final_g + bo);
            *(f32x4*)((char*)(P.out + (size_t)tok * 1024) + bo) = xo[j] * (inv2 * tp_scale) * fg;
        }
        if ((t & 3) == 3) asm volatile("" ::: "memory");
    }
}
constexpr int LDS_BARST = 147456 - 16;
typedef __attribute__((address_space(4))) const Params* KParamsPtr;
#if defined(__HIP_DEVICE_COMPILE__)
#define LOADP(name) Params name; { KParamsPtr q_ = (KParamsPtr)__builtin_amdgcn_kernarg_segment_ptr(); asm volatile("" : "+s"(q_)); name = *q_; }
#else
#define LOADP(name) Params name = P;
#endif
__global__ void __launch_bounds__(512, 2) k_mega(Params P) {
    extern __shared__ __attribute__((aligned(16))) unsigned char lds_raw[];
    LAS unsigned char* lds = (LAS unsigned char*)lds_raw;
    const int lo = P.ph_lo, hi = P.ph_hi;
    const bool fused = (hi - lo) > 1;
    XcdBarrier bar; bar.bar = (unsigned*)(P.ws + WS_MISC + MISC_BAR); bar.x = 0; bar.st = (volatile LAS unsigned*)(lds + LDS_BARST);
    if (fused) {
        if (threadIdx.x < 4) ((LAS unsigned*)(lds + LDS_BARST))[threadIdx.x] = 0u;
        __syncthreads();
        bar = xcd_barrier_post((unsigned*)(P.ws + WS_MISC + MISC_BAR), (volatile LAS unsigned*)(lds + LDS_BARST));
    }
#ifndef REPMASK
#define REPMASK 0
#endif
#ifndef TPROBE
#define TPROBE (-1)
#endif
#define TPB(id) do { if (TPROBE == (id) && threadIdx.x == 0) tp_t0 = __builtin_amdgcn_s_memrealtime(); } while (0)
#define TPE(id) do { if (TPROBE == (id) && threadIdx.x == 0) ((LAS unsigned*)(lds + LDS_BARST))[2] += (unsigned)(__builtin_amdgcn_s_memrealtime() - tp_t0); } while (0)
    unsigned long long tp_t0 = 0ull;
    if (TPROBE >= 0) { if (threadIdx.x == 0) ((LAS unsigned*)(lds + LDS_BARST))[2] = 0u; }
#define IN(k) (lo <= (k) && (k) < hi)
#define REP(k, call) do { if (fused && ((REPMASK >> (k)) & 1)) { xcd_barrier(bar); call; } } while (0)
#define SEAM(k) do { if (fused && IN(k) && IN((k) + 1)) { TPB(10 + (k)); xcd_barrier(bar); TPE(10 + (k)); } } while (0)
    if (IN(0)) { LOADP(Pk); TPB(0); phase0(Pk, lds); TPE(0); REP(0, phase0(Pk, lds)); }
    if (fused && IN(0) && IN(1)) { TPB(10); cg::this_grid().sync(); TPE(10); }
    if (IN(1)) { LOADP(Pk); TPB(1); phase1(Pk, lds); TPE(1); REP(1, phase1(Pk, lds)); }
    if (IN(1) && blockIdx.x >= 32) { LOADP(Pk); __syncthreads(); p0_late_items(Pk, lds, blockIdx.x - 32, gridDim.x - 32); }
    SEAM(1);
    if (IN(2)) { LOADP(Pk); TPB(2); phase2(Pk, lds); TPE(2); REP(2, phase2(Pk, lds)); }
    SEAM(2);
    if (IN(3)) { LOADP(Pk); TPB(3); phase3(Pk, lds); TPE(3); REP(3, phase3(Pk, lds)); }
    SEAM(3);
    if (IN(4)) { LOADP(Pk); TPB(4); phase4(Pk, lds); TPE(4); REP(4, phase4(Pk, lds)); }
    SEAM(4);
    if (IN(5)) { LOADP(Pk); TPB(5); phase5(Pk, lds); TPE(5); REP(5, phase5(Pk, lds)); }
    SEAM(5);
    if (IN(6)) { LOADP(Pk); TPB(6); phase6(Pk, lds); TPE(6); REP(6, phase6(Pk, lds)); }
    SEAM(6);
    if (IN(7)) { LOADP(Pk); TPB(7); phase7(Pk, lds); TPE(7); REP(7, phase7(Pk, lds)); }
    SEAM(7);
    if (IN(8)) { LOADP(Pk); TPB(8); phase8(Pk, lds); TPE(8); REP(8, phase8(Pk, lds)); }
#undef IN
#undef SEAM
}
extern "C" void kernel_launch(void* const* d_in, const int* in_sizes, int n_in, void* d_out, int out_size, void* d_ws, size_t ws_size, hipStream_t stream) {
    static int grid = 0;
    if (!grid) {
        (void)hipFuncSetAttribute((const void*)k_mega, hipFuncAttributeMaxDynamicSharedMemorySize, LDS_BYTES);
        int dev = 0, cus = 0, per_cu = 0;
        (void)hipGetDevice(&dev);
        (void)hipDeviceGetAttribute(&cus, hipDeviceAttributeMultiprocessorCount, dev);
        (void)hipOccupancyMaxActiveBlocksPerMultiprocessor(&per_cu, (const void*)k_mega, 512, LDS_BYTES);
        grid = (per_cu >= 1 && cus >= 256) ? 256 : -1;
    }
    if (grid < 0) return;
    (void)hipMemsetAsync((char*)d_ws + WS_MISC + MISC_BAR, 0, XCD_BAR_WORDS * 4, stream);
    Params P{};
    const float** pp = (const float**)&P;
    for (int i = 0; i < 26; ++i) pp[i] = (const float*)d_in[i];
    P.out = (float*)d_out; P.ws = (unsigned char*)d_ws; P.ph_lo = 0; P.ph_hi = 9;
    void* args[] = {&P};
    (void)hipLaunchCooperativeKernel((const void*)k_mega, dim3(grid), dim3(512), args, LDS_BYTES, stream);
}
```

```cpp
#define REPMASK 0
#define P0REP 0
#define P1REP 0
#include <hip/hip_runtime.h>
#include <hip/hip_cooperative_groups.h>
#include <stdint.h>
#include <math.h>
namespace cg = cooperative_groups;

#define DM 1024
#define NB 8
#define SEQ 2048
#define CTXL 256
#define NTOK (NB * SEQ)
#define NCTX (NB * CTXL)
#define NMOD 6144
#define MiB (1024ull * 1024ull)
#ifndef TPROBE
#define TPROBE (-1)
#endif
#ifndef TPSCALE
#define TPSCALE 1e-7f
#endif
#define LAS __attribute__((address_space(3)))
typedef unsigned short bf16_t;
typedef short bf16x8 __attribute__((ext_vector_type(8)));
typedef float f32x4 __attribute__((ext_vector_type(4)));
typedef float f32x2 __attribute__((ext_vector_type(2)));
typedef unsigned u32x4 __attribute__((ext_vector_type(4)));
typedef unsigned u32x2 __attribute__((ext_vector_type(2)));

__device__ __forceinline__ float gelu_tanh(float x) {
    const float z = x * (1.5957691216057308f + 0.07135481627f * x * x);
    return x * __builtin_amdgcn_rcpf(1.0f + __expf(-z));
}
__device__ __forceinline__ float sigmoidf_(float x) { return __builtin_amdgcn_rcpf(1.0f + __expf(-x)); }
__device__ __forceinline__ float silu_(float x) { return x * sigmoidf_(x); }
__device__ __forceinline__ float wave_sum(float v) {
#pragma unroll
    for (int o = 32; o > 0; o >>= 1) v += __shfl_xor(v, o);
    return v;
}
__device__ __forceinline__ unsigned cvt_pk_bf16(float lo, float hi) { unsigned r; asm volatile("v_cvt_pk_bf16_f32 %0, %1, %2" : "=v"(r) : "v"(lo), "v"(hi)); return r; }
__device__ __forceinline__ float bf2f(bf16_t v) { return __uint_as_float(((unsigned)v) << 16); }
__device__ __forceinline__ float bflo(unsigned w) { return __uint_as_float(w << 16); }
__device__ __forceinline__ float bfhi(unsigned w) { return __uint_as_float(w & 0xffff0000u); }

__device__ __forceinline__ void tp_b(int id, LAS unsigned char* lds) { if (TPROBE == id && threadIdx.x == 0) ((LAS unsigned*)(lds + 147456 - 16))[3] = (unsigned)__builtin_amdgcn_s_memrealtime(); }
__device__ __forceinline__ void tp_e(int id, LAS unsigned char* lds) { if (TPROBE == id && threadIdx.x == 0) ((LAS unsigned*)(lds + 147456 - 16))[2] += (unsigned)__builtin_amdgcn_s_memrealtime() - ((LAS unsigned*)(lds + 147456 - 16))[3]; }
#define XB_TMO      128
#define XB_XCNT(j)  (256  + 64 * (j))
#define XB_XSUB(j)  (1280 + 64 * (j))
#define XB_XGEN(j)  (2304 + 64 * (j))
#define XB_TOP      3328
#define XB_TOPGEN   3392
#define XCD_BAR_WORDS 3456
#define XB_SPIN_CAP (1u << 18)
__device__ __forceinline__ unsigned xb_ld(unsigned* p)              { return __hip_atomic_load(p, __ATOMIC_RELAXED, __HIP_MEMORY_SCOPE_AGENT); }
__device__ __forceinline__ unsigned xb_add(unsigned* p, unsigned v) { return __hip_atomic_fetch_add(p, v, __ATOMIC_RELAXED, __HIP_MEMORY_SCOPE_AGENT); }
__device__ __forceinline__ unsigned xb_xcc_id() { return (unsigned)__builtin_amdgcn_s_getreg((3 << 11) | 20) & 0xFu; }
#define XB_SPIN(cond, bar) do { unsigned _sp = 0; while (cond) { __builtin_amdgcn_s_sleep(1); \
    if ((++_sp & 255u) == 0u) { if (xb_ld(&(bar)[XB_TMO])) break; if (_sp > XB_SPIN_CAP) { atomicAdd(&(bar)[XB_TMO], 1u); break; } } } } while (0)
struct XcdBarrier { unsigned* bar; unsigned x; volatile LAS unsigned* st; };
__device__ __forceinline__ XcdBarrier xcd_barrier_post(unsigned* bar, volatile LAS unsigned* st) {
    XcdBarrier b; b.bar = bar; b.x = xb_xcc_id(); b.st = st;
    if (threadIdx.x == 0) (void)xb_add(&bar[XB_XCNT(b.x)], 1u);
    return b;
}
__device__ __forceinline__ void xcd_barrier_complete(unsigned* bar, unsigned x, unsigned& nloc, unsigned& nx) {
    const unsigned G = gridDim.x * gridDim.y * gridDim.z;
    unsigned sum, cnt, mine, sp = 0u;
    for (;;) {
        sum = 0u; cnt = 0u; mine = 0u;
#pragma unroll
        for (unsigned j = 0; j < 16; ++j) { const unsigned c = xb_ld(&bar[XB_XCNT(j)]); sum += c; cnt += (c > 0u) ? 1u : 0u; mine = (j == x) ? c : mine; }
        if (sum == G) break;
        __builtin_amdgcn_s_sleep(1);
        if ((++sp & 255u) == 0u) { if (xb_ld(&bar[XB_TMO])) break; if (sp > XB_SPIN_CAP) { atomicAdd(&bar[XB_TMO], 1u); break; } }
    }
    nloc = mine > 0u ? mine : 1u; nx = cnt > 0u ? cnt : 1u;
}
__device__ __forceinline__ void xcd_barrier(const XcdBarrier& b) {
    asm volatile("s_waitcnt vmcnt(0)" ::: "memory");
    __syncthreads();
    if (threadIdx.x == 0) {
        unsigned* bar = b.bar;
        __builtin_amdgcn_s_waitcnt(0);
        unsigned nloc = b.st[0], nx = b.st[1];
        if (nloc == 0u) { xcd_barrier_complete(bar, b.x, nloc, nx); b.st[0] = nloc; b.st[1] = nx; }
        const unsigned old = xb_add(&bar[XB_XSUB(b.x)], 1u);
        const unsigned gen = old / nloc;
        if (old + 1u == (gen + 1u) * nloc) {
            __builtin_amdgcn_fence(__ATOMIC_RELEASE, "agent");
            asm volatile("s_waitcnt vmcnt(0)" ::: "memory");
            const unsigned og = xb_add(&bar[XB_TOP], 1u);
            const unsigned tg = og / nx;
            if (og + 1u == (tg + 1u) * nx) xb_add(&bar[XB_TOPGEN], 1u);
            else XB_SPIN(xb_ld(&bar[XB_TOPGEN]) == tg, bar);
            __builtin_amdgcn_fence(__ATOMIC_ACQUIRE, "agent");
            xb_add(&bar[XB_XGEN(b.x)], 1u);
            asm volatile("s_waitcnt vmcnt(0)" ::: "memory");
        } else {
            XB_SPIN(xb_ld(&bar[XB_XGEN(b.x)]) == gen, bar);
            __builtin_amdgcn_fence(__ATOMIC_ACQUIRE, "agent");
            asm volatile("s_waitcnt vmcnt(0)" ::: "memory");
        }
    }
    __syncthreads();
}
namespace pg8 {
constexpr int BM = 256, BK = 64, HALF = 128, HTB = HALF * BK * 2, STAGE_BYTES = 8 * HTB;
__device__ __forceinline__ int lds_byte(int r, int c) { const int st = (r >> 4) * 2 + (c >> 5), rr = r & 15, cc = c & 31, ob = rr * 64 + cc * 2; return st * 1024 + (ob ^ (((ob >> 9) & 1) << 5)); }
__device__ __forceinline__ void stage_rc(int b, int& R, int& C) { const int st = b / 1024, sb = b % 1024, swz = sb ^ (((sb >> 9) & 1) << 5); R = (st >> 1) * 16 + swz / 64; C = (st & 1) * 32 + (swz % 64) / 2; }
__device__ __forceinline__ int perm32(int rho) { const int n = rho >> 4, i = rho & 15; return 8 * (i >> 2) + 4 * n + (i & 3); }
struct Unit { const char* a; const char* b; int pm, pn, z;
              const char* b_alt = nullptr; int alt_from = 1 << 30; int alt_zero_row = -1; unsigned alt_zero_off = 0u; };
struct Gemm { int lda, ldb, K; };
template <class Epi>
__device__ __forceinline__ void gemm_unit(LAS unsigned char* lds, const Gemm g, const Unit cur, const Epi& E) {
    const int tid = threadIdx.x, wid = __builtin_amdgcn_readfirstlane(tid >> 6), lane = tid & 63, wr = wid >> 2, wc = wid & 3, fr = lane & 15, fq = lane >> 4;
    const int K = g.K, nt = K / BK;
    unsigned voffA[2], voffB[2], voffM[2];
#pragma unroll
    for (int i = 0; i < 2; ++i) { int R, C; stage_rc(tid * 16 + i * 8192, R, C); const int Rb = Epi::PERM ? ((R & ~31) + perm32(R & 31)) : R;
        voffA[i] = (unsigned)(R * g.lda + C) * 2u; voffB[i] = (unsigned)(Rb * g.ldb + C) * 2u;
        voffM[i] = (unsigned)((127 - Rb) * g.ldb + C) * 2u; }
    const size_t kstep = (size_t)(BK * 2);
    const size_t hstepA = (size_t)HALF * g.lda * 2, hstepB = (size_t)HALF * g.ldb * 2;
    const unsigned ldsw = (unsigned)wid * 1024u;
    const int aoff = lds_byte(wr * 64 + fr, fq * 8), boff = lds_byte(wc * 32 + fr, fq * 8);
#define PG8_SA(b, h) (((b) * 2 + (h)) * HTB)
#define PG8_SB(b, h) ((4 + (b) * 2 + (h)) * HTB)
#define PG8_STAGE2(bufoff, gbase, v0_, v1_) do { \
        __builtin_amdgcn_global_load_lds((const unsigned*)((const char*)(gbase) + (v0_)), (LAS unsigned*)(lds + (bufoff) + ldsw), 16, 0, 0); \
        __builtin_amdgcn_global_load_lds((const unsigned*)((const char*)(gbase) + (v1_)), (LAS unsigned*)(lds + (bufoff) + ldsw + 8192), 16, 0, 0); } while (0)
#define PG8_STAGE(bufoff, gbase, voff) PG8_STAGE2(bufoff, gbase, (voff)[0], (voff)[1])
    const int altf = cur.alt_from;
    unsigned voffM0[2];
#pragma unroll
    for (int i = 0; i < 2; ++i) { int R, C; stage_rc(tid * 16 + i * 8192, R, C); const int Rb = Epi::PERM ? ((R & ~31) + perm32(R & 31)) : R;
        voffM0[i] = (Rb == cur.alt_zero_row) ? (cur.alt_zero_off + (unsigned)C * 2u) : voffM[i]; }
#define PG8_BBASE(tau, h) ((tau) < altf ? (cB + (size_t)(tau) * kstep + ((h) ? hstepB : 0)) : (cur.b_alt + (size_t)((tau) - altf) * kstep + ((h) ? 0 : hstepB)))
#define PG8_STAGEB(bufoff, tau, h) do { const bool alt_ = (tau) >= altf; \
        PG8_STAGE2(bufoff, PG8_BBASE(tau, h), alt_ ? ((h) ? voffM[0] : voffM0[0]) : voffB[0], alt_ ? ((h) ? voffM[1] : voffM0[1]) : voffB[1]); } while (0)
#define PG8_LDA(dst, b, h) do { _Pragma("unroll") for (int m = 0; m < 4; ++m) _Pragma("unroll") for (int k = 0; k < 2; ++k) dst[m][k] = *(const LAS bf16x8*)(lds + PG8_SA(b, h) + aoff + m * 2048 + k * 1024); } while (0)
#define PG8_LDB(dst, b, h) do { _Pragma("unroll") for (int n = 0; n < 2; ++n) _Pragma("unroll") for (int k = 0; k < 2; ++k) dst[n][k] = *(const LAS bf16x8*)(lds + PG8_SB(b, h) + boff + n * 2048 + k * 1024); } while (0)
#define PG8_MMA(ai, bj, At, Bt) do { __builtin_amdgcn_s_setprio(1); _Pragma("unroll") for (int m = 0; m < 4; ++m) _Pragma("unroll") for (int n = 0; n < 2; ++n) _Pragma("unroll") for (int k = 0; k < 2; ++k) \
        acc[ai][bj][m][n] = __builtin_amdgcn_mfma_f32_16x16x32_bf16(Bt[n][k], At[m][k], acc[ai][bj][m][n], 0, 0, 0); __builtin_amdgcn_s_setprio(0); } while (0)
#define PG8_WAIT_V(n) asm volatile("s_waitcnt vmcnt(" #n ")" ::: "memory")
#define PG8_WAIT_L(n) asm volatile("s_waitcnt lgkmcnt(" #n ")" ::: "memory")
#define PG8_BAR __builtin_amdgcn_s_barrier()
#define PG8_SCHED __builtin_amdgcn_sched_barrier(0)
    f32x4 acc[2][2][4][2];
#pragma unroll
    for (int a = 0; a < 2; ++a)
#pragma unroll
        for (int b = 0; b < 2; ++b)
#pragma unroll
            for (int m = 0; m < 4; ++m)
#pragma unroll
                for (int n = 0; n < 2; ++n) acc[a][b][m][n] = (f32x4){0.f, 0.f, 0.f, 0.f};
    bf16x8 At[4][2], B0[2][2], B1[2][2];
    const char* cA = cur.a; const char* cB = cur.b;
    PG8_STAGEB(PG8_SB(0, 0), 0, 0); PG8_STAGE(PG8_SA(0, 0), cA, voffA); PG8_STAGEB(PG8_SB(0, 1), 0, 1); PG8_STAGE(PG8_SA(0, 1), cA + hstepA, voffA);
    if (wr == 1) PG8_BAR;
    PG8_WAIT_V(4); PG8_BAR;
    PG8_STAGEB(PG8_SB(1, 0), 1, 0); PG8_STAGE(PG8_SA(1, 0), cA + kstep, voffA); PG8_STAGEB(PG8_SB(1, 1), 1, 1);
    PG8_WAIT_V(6); PG8_BAR;
    for (int t = 0; t < nt; t += 2) {
        const bool last = (t == nt - 2);
        const char* a1 = cA + (size_t)(t + 1) * kstep;
        const char* a2 = last ? cA : cA + (size_t)(t + 2) * kstep;
        const char* a3 = a2 + kstep; const int tb2 = last ? 0 : t + 2, tb3 = tb2 + 1;
        PG8_LDB(B0, 0, 0); PG8_SCHED; PG8_LDA(At, 0, 0); PG8_STAGE(PG8_SA(1, 1), a1 + hstepA, voffA);
        PG8_WAIT_L(8); PG8_BAR; PG8_WAIT_L(0); PG8_MMA(0, 0, At, B0); PG8_BAR; PG8_SCHED;
        PG8_LDB(B1, 0, 1); PG8_STAGEB(PG8_SB(0, 0), tb2, 0);
        PG8_BAR; PG8_WAIT_L(0); PG8_MMA(0, 1, At, B1); PG8_BAR;
        PG8_LDA(At, 0, 1); PG8_STAGE(PG8_SA(0, 0), a2, voffA);
        PG8_BAR; PG8_WAIT_L(0); PG8_MMA(1, 0, At, B0); PG8_BAR; PG8_SCHED;
        PG8_STAGEB(PG8_SB(0, 1), tb2, 1);
        PG8_WAIT_V(6); PG8_BAR; PG8_MMA(1, 1, At, B1); PG8_BAR;
        PG8_LDB(B0, 1, 0); PG8_SCHED; PG8_LDA(At, 1, 0); PG8_STAGE(PG8_SA(0, 1), a2 + hstepA, voffA);
        PG8_WAIT_L(8); PG8_BAR; PG8_WAIT_L(0); PG8_MMA(0, 0, At, B0); PG8_BAR; PG8_SCHED;
        PG8_LDB(B1, 1, 1); PG8_STAGEB(PG8_SB(1, 0), tb3, 0);
        PG8_BAR; PG8_WAIT_L(0); PG8_MMA(0, 1, At, B1); PG8_BAR;
        PG8_LDA(At, 1, 1); PG8_STAGE(PG8_SA(1, 0), a3, voffA);
        PG8_BAR; PG8_WAIT_L(0); PG8_MMA(1, 0, At, B0); PG8_BAR; PG8_SCHED;
        PG8_STAGEB(PG8_SB(1, 1), tb3, 1);
        PG8_WAIT_V(6); PG8_BAR; PG8_MMA(1, 1, At, B1); PG8_BAR;
    }
    if constexpr (!Epi::AFTER_DRAIN) { E(acc, cur, wr, wc, fr, fq); }
    PG8_WAIT_V(0);
    if (wr == 0) PG8_BAR;
    PG8_BAR;
    if constexpr (Epi::AFTER_DRAIN) { E.fused(acc, cur, wr, wc, fr, fq, lds, wid, lane); }
#undef PG8_SA
#undef PG8_SB
#undef PG8_STAGE
#undef PG8_STAGE2
#undef PG8_STAGEB
#undef PG8_BBASE
#undef PG8_LDA
#undef PG8_LDB
#undef PG8_MMA
#undef PG8_WAIT_V
#undef PG8_WAIT_L
#undef PG8_BAR
#undef PG8_SCHED
}
}
constexpr size_t WS_W1T = 0 * MiB;
constexpr size_t WS_WGLUT = 2 * MiB;
constexpr size_t WS_WOUTT = 3 * MiB;
constexpr size_t WS_WST = 5 * MiB;
constexpr size_t WS_WCST = 14 * MiB;
constexpr size_t WS_CS = 10 * MiB;
constexpr size_t WS_WENDT = 26 * MiB;
constexpr size_t WS_MAPT = 34 * MiB;
constexpr size_t WS_KTAB = 59 * MiB;
constexpr size_t WS_XB = 68 * MiB;
constexpr size_t WS_HCB = 100 * MiB;
constexpr size_t WS_AEXT = 108 * MiB;
constexpr size_t WS_FB = 144 * MiB;
constexpr size_t WS_GT = 160 * MiB;
constexpr size_t WS_CSPART = 176 * MiB;
constexpr size_t WS_E = 192 * MiB;
constexpr size_t WS_MISC = 250 * MiB;
constexpr size_t MISC_MOD = 0, MISC_POS = 256 * 1024, MISC_BIAS = 512 * 1024, MISC_BAR = 640 * 1024, MISC_EC = 704 * 1024, MISC_O1024 = 720 * 1024, MISC_ZROW = 736 * 1024;

struct Params {
    const float *x, *c, *ctx, *c_ctx, *w_mod, *b_mod, *norm1_g, *norm2_g, *w_in, *w_out, *lam_re, *lam_im, *log_dt, *b_re, *b_im, *c_re, *c_im, *s5_d,
        *w_glu, *b_glu, *w_fourier, *w_q, *sub_keys, *u_tab, *v_tab, *final_g;
    float* out; unsigned char* ws; int ph_lo, ph_hi;
};
constexpr int LDS_BYTES = 147456;

__device__ __forceinline__ void p0_mod_item(const Params& P, LAS float* L, int item) {
    int tid = threadIdx.x; asm volatile("" : "+v"(tid)); const int w = tid >> 6, l = tid & 63;
    LAS float* act = L; LAS float* red = L + 9 * 1024;
    for (int idx = tid; idx < 9 * 1024; idx += 512) { int r = idx >> 10, k = idx & 1023; float v = (r < 8) ? P.c[r * 1024 + k] : P.c_ctx[k]; act[idx] = silu_(v); }
    __syncthreads();
    const int j = item * 64 + l;
    float acc[9];
#pragma unroll
    for (int r = 0; r < 9; ++r) acc[r] = 0.f;
    for (int k0 = w * 128; k0 < w * 128 + 128; k0 += 16) {
        float wv[16];
#pragma unroll
        for (int i = 0; i < 16; ++i) wv[i] = P.w_mod[(size_t)(k0 + i) * NMOD + j];
#pragma unroll
        for (int i = 0; i < 16; ++i)
#pragma unroll
            for (int r = 0; r < 9; ++r) acc[r] += act[r * 1024 + k0 + i] * wv[i];
    }
#pragma unroll
    for (int r = 0; r < 9; ++r) red[(w * 9 + r) * 64 + l] = acc[r];
    __syncthreads();
    float* mod = (float*)(P.ws + WS_MISC + MISC_MOD);
    for (int idx = tid; idx < 9 * 64; idx += 512) {
        int r = idx >> 6, l2 = idx & 63; float s = 0.f;
#pragma unroll
        for (int ww = 0; ww < 8; ++ww) s += red[(ww * 9 + r) * 64 + l2];
        mod[r * NMOD + item * 64 + l2] = s + P.b_mod[item * 64 + l2];
    }
}
__device__ __forceinline__ void p0_transpose_item(const float* src, int K, int N, bf16_t* dst, LAS float* L, int item) {
    int tid = threadIdx.x; asm volatile("" : "+v"(tid)); const int ntn = N / 64; const int k0 = (item / ntn) * 64, n0 = (item % ntn) * 64;
#pragma unroll
    for (int pass = 0; pass < 2; ++pass) {
        int kk = (tid >> 4) + 32 * pass, c4 = (tid & 15) * 4;
        f32x4 v = *(const f32x4*)(src + (size_t)(k0 + kk) * N + n0 + c4);
        L[kk * 65 + c4 + 0] = v.x; L[kk * 65 + c4 + 1] = v.y; L[kk * 65 + c4 + 2] = v.z; L[kk * 65 + c4 + 3] = v.w;
    }
    __syncthreads();
    const int n = tid >> 3, k8 = (tid & 7) * 8;
    u32x4 o;
    o.x = cvt_pk_bf16(L[(k8 + 0) * 65 + n], L[(k8 + 1) * 65 + n]); o.y = cvt_pk_bf16(L[(k8 + 2) * 65 + n], L[(k8 + 3) * 65 + n]);
    o.z = cvt_pk_bf16(L[(k8 + 4) * 65 + n], L[(k8 + 5) * 65 + n]); o.w = cvt_pk_bf16(L[(k8 + 6) * 65 + n], L[(k8 + 7) * 65 + n]);
    *(u32x4*)(dst + (size_t)(n0 + n) * K + k0 + k8) = o;
}
__device__ __forceinline__ void p0_ws_item(const Params& P, LAS float* L, int item) {
    int tid = threadIdx.x; asm volatile("" : "+v"(tid)); const int hs = item >> 4, k0 = (item & 15) * 64;
    LAS float* keysT = L;
    LAS float* wqT = L + 128 * 132;
    {
        f32x4 kv[8];
#pragma unroll
        for (int i = 0; i < 8; ++i) kv[i] = *(const f32x4*)(P.sub_keys + (size_t)hs * 16384 + (tid + 512 * i) * 4);
        f32x4 wv[4];
#pragma unroll
        for (int i = 0; i < 4; ++i) { const int idx = tid + 512 * i; const int kk = idx >> 5, d4 = (idx & 31) * 4; wv[i] = *(const f32x4*)(P.w_q + (size_t)(k0 + kk) * 2048 + hs * 128 + d4); }
#pragma unroll
        for (int i = 0; i < 8; ++i) { const int idx = (tid + 512 * i) * 4; const int key = idx >> 7, d = idx & 127;
            keysT[(d + 0) * 132 + key] = kv[i].x; keysT[(d + 1) * 132 + key] = kv[i].y; keysT[(d + 2) * 132 + key] = kv[i].z; keysT[(d + 3) * 132 + key] = kv[i].w; }
#pragma unroll
        for (int i = 0; i < 4; ++i) { const int idx = tid + 512 * i; const int kk = idx >> 5, d4 = (idx & 31) * 4;
            wqT[(d4 + 0) * 68 + kk] = wv[i].x; wqT[(d4 + 1) * 68 + kk] = wv[i].y; wqT[(d4 + 2) * 68 + kk] = wv[i].z; wqT[(d4 + 3) * 68 + kk] = wv[i].w; }
    }
    __syncthreads();
    const int kq = (tid & 31) * 4, kg = (tid >> 5) * 4;
    f32x4 acc[4];
#pragma unroll
    for (int i = 0; i < 4; ++i) acc[i] = (f32x4){0.f, 0.f, 0.f, 0.f};
#pragma unroll 4
    for (int d = 0; d < 128; ++d) {
        const f32x4 kv = *(const LAS f32x4*)(keysT + d * 132 + kq), wv = *(const LAS f32x4*)(wqT + d * 68 + kg);
        acc[0] = acc[0] + wv * kv.x; acc[1] = acc[1] + wv * kv.y; acc[2] = acc[2] + wv * kv.z; acc[3] = acc[3] + wv * kv.w;
    }
    bf16_t* dst = (bf16_t*)(P.ws + WS_WST) + (size_t)(hs * 128 + kq) * 1024 + k0 + kg;
#pragma unroll
    for (int i = 0; i < 4; ++i) { u32x2 o; o.x = cvt_pk_bf16(acc[i].x, acc[i].y); o.y = cvt_pk_bf16(acc[i].z, acc[i].w); *(u32x2*)(dst + (size_t)i * 1024) = o; }
}
__device__ __forceinline__ void p0_wcs_item(const Params& P, LAS float* L, int item) {
    int tid = threadIdx.x; asm volatile("" : "+v"(tid)); const int cs = item >> 4, g = (item >> 2) & 3, cb = item & 3;
    LAS float* tab = L;
    if (tid < 128) { float a = (float)tid / 64.0f; tab[tid] = cs ? -sinpif(a) : cospif(a); }
    __syncthreads();
    const int d = tid & 127, c0 = cb * 32 + (tid >> 7) * 8;
    float acc[8];
#pragma unroll
    for (int i = 0; i < 8; ++i) acc[i] = 0.f;
    const float* wf = P.w_fourier + (size_t)g * 16384 + d;
#pragma unroll 8
    for (int m = 0; m < 128; ++m) {
        const float wv = wf[m * 128];
#pragma unroll
        for (int i = 0; i < 8; ++i) acc[i] += tab[((c0 + i) * m) & 127] * wv;
    }
    const float alpha = 1.0f / sqrtf(2048.0f * 128.0f);
    bf16_t* row = (bf16_t*)(P.ws + WS_WCST) + (size_t)(cs * 512 + g * 128 + d) * 1024;
    const float am = cs ? -alpha : alpha;
#pragma unroll
    for (int g2 = 0; g2 < 4; ++g2) {
        u32x4 o = (u32x4){0u, 0u, 0u, 0u}, om = o;
        if (g2 == g) { o.x = cvt_pk_bf16(acc[0] * alpha, acc[1] * alpha); o.y = cvt_pk_bf16(acc[2] * alpha, acc[3] * alpha); o.z = cvt_pk_bf16(acc[4] * alpha, acc[5] * alpha); o.w = cvt_pk_bf16(acc[6] * alpha, acc[7] * alpha);
                       om.x = cvt_pk_bf16(acc[0] * am, acc[1] * am); om.y = cvt_pk_bf16(acc[2] * am, acc[3] * am); om.z = cvt_pk_bf16(acc[4] * am, acc[5] * am); om.w = cvt_pk_bf16(acc[6] * am, acc[7] * am); }
        *(u32x4*)(row + g2 * 128 + c0) = o;
        *(u32x4*)(row + 512 + g2 * 128 + c0) = om;
    }
}
__device__ __forceinline__ void p0_s5_item(const Params& P, LAS float* L, int item) {
    int tid = threadIdx.x; asm volatile("" : "+v"(tid)); const int g = item >> 3, dir = (item >> 2) & 1, qd = item & 3;
    LAS float* Pr = L; LAS float* Pi = L + 33 * 64; LAS float* Bbr = L + 2 * 33 * 64; LAS float* Bbi = Bbr + 1024; LAS float* Cr = Bbi + 1024; LAS float* Ci = Cr + 1024;
    const int dg = dir * 32 + g;
    const float dt = expf(P.log_dt[dg]);
    if (tid < 64) {
        const int n = tid; const int i = dg * 64 + n;
        float lr = P.lam_re[i], li = P.lam_im[i];
        float mag = expf(lr * dt); float ar = mag * cosf(li * dt), ai = mag * sinf(li * dt);
        float den = lr * lr + li * li;
        float cr = ((ar - 1.0f) * lr + ai * li) / den, ci = (ai * lr - (ar - 1.0f) * li) / den;
        for (int q = 0; q < 16; ++q) {
            float br = P.b_re[(size_t)i * 16 + q], bi = P.b_im[(size_t)i * 16 + q];
            Bbr[n * 16 + q] = cr * br - ci * bi; Bbi[n * 16 + q] = cr * bi + ci * br;
        }
    }
    for (int idx = tid; idx < 33 * 64; idx += 512) {
        int tau = idx >> 6, n = idx & 63; const int i = dg * 64 + n;
        float lr = P.lam_re[i], li = P.lam_im[i];
        float mag = expf((float)tau * lr * dt), ang = (float)tau * (li * dt);
        Pr[idx] = mag * cosf(ang); Pi[idx] = mag * sinf(ang);
    }
    for (int idx = tid; idx < 1024; idx += 512) { Cr[idx] = P.c_re[(size_t)dg * 1024 + idx]; Ci[idx] = P.c_im[(size_t)dg * 1024 + idx]; }
    __syncthreads();
    {
        const int pq = tid & 255, p = pq >> 4, q = pq & 15, tau0 = qd * 8 + (tid >> 8) * 4;
        float s[4] = {0.f, 0.f, 0.f, 0.f};
#pragma unroll 4
        for (int n = 0; n < 64; ++n) {
            const float cr = Cr[p * 64 + n], ci = Ci[p * 64 + n], br = Bbr[n * 16 + q], bi = Bbi[n * 16 + q];
            const float xr = cr * br - ci * bi, xi = cr * bi + ci * br;
#pragma unroll
            for (int j = 0; j < 4; ++j) s[j] += xr * Pr[(tau0 + j) * 64 + n] - xi * Pi[(tau0 + j) * 64 + n];
        }
        float* Kt = (float*)(P.ws + WS_KTAB) + (size_t)(g * 2 + dir) * 32 * 256;
#pragma unroll
        for (int j = 0; j < 4; ++j) Kt[(tau0 + j) * 256 + pq] = s[j];
    }
    {
        bf16_t* W = (bf16_t*)(P.ws + WS_WENDT) + (size_t)(g * 256 + dir * 128 + qd * 32) * 512;
        for (int idx = tid; idx < 32 * 512 / 2; idx += 512) {
            const int row = idx >> 8, col = (idx & 255) * 2; const int n = qd * 16 + (row >> 1), ri = row & 1, s = col >> 4, q = col & 15;
            const int tau = dir ? s : (31 - s);
            const float pr = Pr[tau * 64 + n], pi = Pi[tau * 64 + n];
            const float br0 = Bbr[n * 16 + q], bi0 = Bbi[n * 16 + q], br1 = Bbr[n * 16 + q + 1], bi1 = Bbi[n * 16 + q + 1];
            const float v0 = ri ? (pr * bi0 + pi * br0) : (pr * br0 - pi * bi0), v1 = ri ? (pr * bi1 + pi * br1) : (pr * br1 - pi * bi1);
            *(unsigned*)(W + (size_t)row * 512 + col) = cvt_pk_bf16(v0, v1);
        }
    }
    {
        bf16_t* Mp = (bf16_t*)(P.ws + WS_MAPT) + ((size_t)g * 512 + qd * 128) * 768 + 512 + dir * 128;
        for (int idx = tid; idx < 128 * 64; idx += 512) {
            const int row = idx >> 6, n = idx & 63; const int t = qd * 8 + (row >> 4), p = row & 15;
            const int tau = dir ? (32 - t) : (t + 1);
            const float cr = Cr[p * 64 + n], ci = Ci[p * 64 + n], pr = Pr[tau * 64 + n], pi = Pi[tau * 64 + n];
            *(unsigned*)(Mp + (size_t)row * 768 + n * 2) = cvt_pk_bf16(cr * pr - ci * pi, -(cr * pi + ci * pr));
        }
    }
}
__device__ __forceinline__ void p0_pos_item(const Params& P) {
    if (threadIdx.x < 64) ((u32x4*)(P.ws + WS_MISC + MISC_ZROW))[threadIdx.x] = (u32x4){0u, 0u, 0u, 0u};
    float* postab = (float*)(P.ws + WS_MISC + MISC_POS);
    for (int idx = threadIdx.x; idx < 96 * 512; idx += 512) {
        int row = idx >> 9, j = idx & 511, jj = j & 255;
        float omega = 1.0f / powf(10000.0f, (float)jj / 256.0f);
        float p = (float)(row < 32 ? row : row - 32);
        float a = p * omega;
        postab[idx] = (j < 256) ? sinf(a) : cosf(a);
    }
}
__device__ __forceinline__ void vtable_to_fp8(const Params& P, int wgi, int nwg);
__device__ __forceinline__ void utable_to_i8(const Params& P, int wgi, int nwg);
constexpr int P0_MOD = 96, P0_TW1 = 256, P0_TGLU = 64, P0_TOUT = 256, P0_WS = 256, P0_WCS = 32, P0_S5 = 256, P0_POS = 1;
constexpr int P0_NITEMS = P0_MOD + P0_TW1 + P0_TGLU + P0_TOUT + P0_WS + P0_WCS + P0_S5 + P0_POS;
constexpr int P0_EARLY = P0_MOD + P0_TW1 + P0_POS;
constexpr int P0_LATE = P0_S5 + P0_WS + P0_TOUT + P0_TGLU + P0_WCS;
__device__ __forceinline__ void p0_items(const Params& P, LAS unsigned char* lds) {
    LAS float* L = (LAS float*)lds;
    for (int it = blockIdx.x; it < P0_EARLY; it += gridDim.x) {
        __syncthreads();
        int r = it;
        if (r < P0_TW1) { p0_transpose_item(P.w_in, 1024, 1024, (bf16_t*)(P.ws + WS_W1T), L, r); continue; } r -= P0_TW1;
        if (r < P0_MOD) { p0_mod_item(P, L, r); continue; } r -= P0_MOD;
        p0_pos_item(P);
    }
    __syncthreads();
}
__device__ __forceinline__ void p0_late_items(const Params& P, LAS unsigned char* lds, int wgi, int nwg) {
    LAS float* L = (LAS float*)lds;
    for (int it = wgi; it < P0_LATE; it += nwg) {
        __syncthreads();
        int r = it;
        if (r < P0_S5) { p0_s5_item(P, L, r); continue; } r -= P0_S5;
        if (r < P0_WS) { p0_ws_item(P, L, r); continue; } r -= P0_WS;
        if (r < P0_TOUT) { p0_transpose_item(P.w_out, 1024, 1024, (bf16_t*)(P.ws + WS_WOUTT), L, r); continue; } r -= P0_TOUT;
        if (r < P0_TGLU) { p0_transpose_item(P.w_glu, 512, 512, (bf16_t*)(P.ws + WS_WGLUT), L, r); continue; } r -= P0_TGLU;
        p0_wcs_item(P, L, r);
    }
    __syncthreads();
    for (int i = threadIdx.x; i < 2048; i += 512) L[i] = cospif((float)i / 1024.0f);
    __syncthreads();
    bf16_t* CS = (bf16_t*)(P.ws + WS_CS);
    for (int i8 = wgi * 512 + threadIdx.x; i8 < 2 * 1024 * 1024 / 8; i8 += nwg * 512) {
        const int e = i8 * 8, cs = e >> 20, k = (e >> 10) & 1023, l0 = e & 1023, sh = cs ? 512 : 0;
        float v[8];
#pragma unroll
        for (int j = 0; j < 8; ++j) v[j] = L[((k * (l0 + j)) - sh) & 2047];
        u32x4 o; o.x = cvt_pk_bf16(v[0], v[1]); o.y = cvt_pk_bf16(v[2], v[3]); o.z = cvt_pk_bf16(v[4], v[5]); o.w = cvt_pk_bf16(v[6], v[7]);
        *(u32x4*)(CS + (size_t)e) = o;
    }
    __syncthreads();
}
__device__ __forceinline__ void phase0(const Params& P, LAS unsigned char* lds) {
    p0_items(P, lds);
}
template <bool TOK>
__device__ __forceinline__ void row_norm(int lane, const float* src, const float* posr, const float* posc, const float* gn, const float* sh, const float* sc, float* xpd, bf16_t* dst) {
    f32x4 v[4]; float ss = 0.f;
#pragma unroll
    for (int j = 0; j < 4; ++j) {
        const int col = 4 * lane + 256 * j;
        v[j] = *(const f32x4*)(src + col);
        if (TOK) { f32x4 p = (j < 2) ? *(const f32x4*)(posr + col) : *(const f32x4*)(posc + col - 512); v[j] = v[j] + p; *(f32x4*)(xpd + col) = v[j]; }
        ss += (v[j].x * v[j].x + v[j].y * v[j].y) + (v[j].z * v[j].z + v[j].w * v[j].w);
    }
    ss = wave_sum(ss);
    const float inv = rsqrtf(ss * (1.0f / 1024.0f) + 1e-6f);
#pragma unroll
    for (int j = 0; j < 4; ++j) {
        const int col = 4 * lane + 256 * j;
        f32x4 g = *(const f32x4*)(gn + col), s1 = *(const f32x4*)(sc + col), s0 = *(const f32x4*)(sh + col);
        f32x4 h = v[j] * inv * g * (s1 + 1.0f) + s0;
        u32x2 o; o.x = cvt_pk_bf16(h.x, h.y); o.y = cvt_pk_bf16(h.z, h.w);
        *(u32x2*)(dst + col) = o;
    }
}
__device__ __forceinline__ void row_norm2_tok(int lane, const float* src0, const float* src1, const float* posr0, const float* posc0, const float* posr1, const float* posc1,
                                              const float* gn, const float* sh0, const float* sc0, const float* sh1, const float* sc1, float* xpd0, float* xpd1, bf16_t* dst0, bf16_t* dst1) {
    f32x4 v0[4], v1[4], p0[4], p1[4];
#pragma unroll
    for (int j = 0; j < 4; ++j) {
        const int col = 4 * lane + 256 * j;
        v0[j] = *(const f32x4*)(src0 + col); v1[j] = *(const f32x4*)(src1 + col);
        p0[j] = (j < 2) ? *(const f32x4*)(posr0 + col) : *(const f32x4*)(posc0 + col - 512);
        p1[j] = (j < 2) ? *(const f32x4*)(posr1 + col) : *(const f32x4*)(posc1 + col - 512);
    }
    float ss0 = 0.f, ss1 = 0.f;
#pragma unroll
    for (int j = 0; j < 4; ++j) {
        const int col = 4 * lane + 256 * j;
        v0[j] = v0[j] + p0[j]; v1[j] = v1[j] + p1[j];
        ss0 += (v0[j].x * v0[j].x + v0[j].y * v0[j].y) + (v0[j].z * v0[j].z + v0[j].w * v0[j].w);
        ss1 += (v1[j].x * v1[j].x + v1[j].y * v1[j].y) + (v1[j].z * v1[j].z + v1[j].w * v1[j].w);
    }
#pragma unroll
    for (int o = 32; o > 0; o >>= 1) { ss0 += __shfl_xor(ss0, o); ss1 += __shfl_xor(ss1, o); }
    const float inv0 = rsqrtf(ss0 * (1.0f / 1024.0f) + 1e-6f), inv1 = rsqrtf(ss1 * (1.0f / 1024.0f) + 1e-6f);
#pragma unroll
    for (int j = 0; j < 4; ++j) {
        const int col = 4 * lane + 256 * j;
        const f32x4 g = *(const f32x4*)(gn + col);
        const f32x4 a1 = *(const f32x4*)(sc0 + col), a0 = *(const f32x4*)(sh0 + col), b1 = *(const f32x4*)(sc1 + col), b0 = *(const f32x4*)(sh1 + col);
        const f32x4 h0 = v0[j] * inv0 * g * (a1 + 1.0f) + a0, h1 = v1[j] * inv1 * g * (b1 + 1.0f) + b0;
        u32x2 o0, o1; o0.x = cvt_pk_bf16(h0.x, h0.y); o0.y = cvt_pk_bf16(h0.z, h0.w); o1.x = cvt_pk_bf16(h1.x, h1.y); o1.y = cvt_pk_bf16(h1.z, h1.w);
        *(u32x2*)(dst0 + col) = o0; *(u32x2*)(dst1 + col) = o1;
    }
}
template <int NR>
__device__ __forceinline__ void row_normN_ctx(int lane, const float* src, const float* gn, const float* sh, const float* sc, bf16_t* dst) {
    f32x4 v[NR][4]; float ss[NR];
#pragma unroll
    for (int r = 0; r < NR; ++r)
#pragma unroll
        for (int j = 0; j < 4; ++j) v[r][j] = *(const f32x4*)(src + (size_t)r * 1024 + 4 * lane + 256 * j);
#pragma unroll
    for (int r = 0; r < NR; ++r) { ss[r] = 0.f;
#pragma unroll
        for (int j = 0; j < 4; ++j) ss[r] += (v[r][j].x * v[r][j].x + v[r][j].y * v[r][j].y) + (v[r][j].z * v[r][j].z + v[r][j].w * v[r][j].w); }
#pragma unroll
    for (int o = 32; o > 0; o >>= 1) {
#pragma unroll
        for (int r = 0; r < NR; ++r) ss[r] += __shfl_xor(ss[r], o); }
#pragma unroll
    for (int j = 0; j < 4; ++j) {
        const int col = 4 * lane + 256 * j;
        const f32x4 g = *(const f32x4*)(gn + col), s1 = *(const f32x4*)(sc + col), s0 = *(const f32x4*)(sh + col);
        const f32x4 gs = g * (s1 + 1.0f);
#pragma unroll
        for (int r = 0; r < NR; ++r) {
            const float inv = rsqrtf(ss[r] * (1.0f / 1024.0f) + 1e-6f);
            const f32x4 h = v[r][j] * inv * gs + s0;
            u32x2 o; o.x = cvt_pk_bf16(h.x, h.y); o.y = cvt_pk_bf16(h.z, h.w);
            *(u32x2*)(dst + (size_t)r * 1024 + col) = o;
        }
    }
}
struct EpiU {
    static constexpr bool PERM = true, AFTER_DRAIN = false;
    bf16_t* aext; bf16_t* fb; int ctx_b;
    __device__ __forceinline__ void operator()(const f32x4 (&acc)[2][2][4][2], const pg8::Unit& u, int wr, int wc, int fr, int fq) const {
#pragma unroll
        for (int ai = 0; ai < 2; ++ai)
#pragma unroll
            for (int m = 0; m < 4; ++m) {
                const int rt = 128 * ai + 64 * wr + 16 * m + fr;
#pragma unroll
                for (int bj = 0; bj < 2; ++bj) {
                    const int gcol = u.pn * 256 + 128 * bj + 32 * wc + 8 * fq;
                    const f32x4 v0 = acc[ai][bj][m][0], v1 = acc[ai][bj][m][1];
                    u32x4 w; w.x = cvt_pk_bf16(v0.x, v0.y); w.y = cvt_pk_bf16(v0.z, v0.w); w.z = cvt_pk_bf16(v1.x, v1.y); w.w = cvt_pk_bf16(v1.z, v1.w);
                    bf16_t* dst;
                    if (ctx_b >= 0) {
                        if (rt >= 128) continue;
                        const int t = (ctx_b & 1) * 128 + rt, g = gcol >> 4, q0 = gcol & 15, row = 512 + (ctx_b >> 1) * 8 + (t >> 5);
                        dst = aext + ((size_t)(g * 768 + row) * 768 + (t & 31) * 16 + q0);
                    } else {
                        const int r = u.pm * 256 + rt;
                        if (u.pn < 2) { const int b = r >> 11, t = r & 2047, g = gcol >> 4, q0 = gcol & 15, row = b * 64 + (t >> 5);
                            dst = aext + ((size_t)(g * 768 + row) * 768 + (t & 31) * 16 + q0); }
                        else dst = fb + (size_t)r * 512 + (gcol - 512);
                    }
                    *(u32x4*)dst = w;
                }
            }
    }
};
__device__ __forceinline__ void phase1(const Params& P, LAS unsigned char* lds) {
    const int tid = threadIdx.x, lane = tid & 63, wave = tid >> 6, wg = blockIdx.x;
    tp_b(wg < 32 ? 70 : 71, lds);
    const float* mod = (const float*)(P.ws + WS_MISC + MISC_MOD);
    const float* postab = (const float*)(P.ws + WS_MISC + MISC_POS);
    if (wg < 32) {
        const int b = wg >> 2, half = (wg >> 1) & 1, pn = wg & 1;
        bf16_t* hcb = (bf16_t*)(P.ws + WS_HCB) + (size_t)wg * 128 * 1024;
        for (int j = 0; j < 16; j += 8) {
            const int rr = wave * 16 + j;
            row_normN_ctx<8>(lane, P.ctx + (size_t)(b * 256 + half * 128 + rr) * 1024, P.norm1_g, mod + 8 * NMOD, mod + 8 * NMOD + 1024, hcb + (size_t)rr * 1024);
        }
        asm volatile("s_waitcnt vmcnt(0)" ::: "memory");
        __syncthreads();
        pg8::Gemm g{1024, 1024, 1024};
        pg8::Unit u{(const char*)hcb, (const char*)((const bf16_t*)(P.ws + WS_W1T) + (size_t)pn * 256 * 1024), 0, pn, 0};
        EpiU E{(bf16_t*)(P.ws + WS_AEXT), nullptr, b * 2 + half};
        pg8::gemm_unit<EpiU>(lds, g, u, E);
    } else {
    const int gw = (wg - 32) * 8 + wave, ngw = (gridDim.x - 32) * 8;
    bf16_t* xb = (bf16_t*)(P.ws + WS_XB);
    for (int r0 = 2 * gw; r0 < NTOK; r0 += 2 * ngw) {
        const int r1 = r0 + 1; const int b = r0 >> 11, t0 = r0 & 2047, t1 = r1 & 2047;
        row_norm2_tok(lane, P.x + (size_t)r0 * 1024, P.x + (size_t)r1 * 1024, postab + (size_t)(t0 >> 6) * 512, postab + (size_t)(32 + (t0 & 63)) * 512,
                      postab + (size_t)(t1 >> 6) * 512, postab + (size_t)(32 + (t1 & 63)) * 512, P.norm1_g, mod + (size_t)b * NMOD, mod + (size_t)b * NMOD + 1024,
                      mod + (size_t)b * NMOD, mod + (size_t)b * NMOD + 1024, P.out + (size_t)r0 * 1024, P.out + (size_t)r1 * 1024, xb + (size_t)r0 * 1024, xb + (size_t)r1 * 1024);
    }
    }
    tp_e(blockIdx.x < 32 ? 70 : 71, lds);
}
__device__ __forceinline__ void p3_extra(const Params& P, LAS unsigned char* lds, int wgi, int nwg) {
    const int tid = threadIdx.x, lane = tid & 63, wave = tid >> 6;
    const float* mod = (const float*)(P.ws + WS_MISC + MISC_MOD);
    const int gw = wgi * 8 + wave, ngw = nwg * 8;
    {
        LAS float* sh2 = (LAS float*)lds;
        for (int idx = tid; idx < 8 * 1024; idx += 512) sh2[idx] = mod[(size_t)(idx >> 10) * NMOD + 3 * 1024 + (idx & 1023)];
        __syncthreads();
        const bf16_t* WsT = (const bf16_t*)(P.ws + WS_WST);
        float* bias = (float*)(P.ws + WS_MISC + MISC_BIAS);
        for (int n = gw; n < 2048; n += ngw) {
            float acc[8];
#pragma unroll
            for (int b = 0; b < 8; ++b) acc[b] = 0.f;
#pragma unroll
            for (int j = 0; j < 2; ++j) {
                const int k0 = lane * 8 + 512 * j;
                u32x4 wv = *(const u32x4*)(WsT + (size_t)n * 1024 + k0);
                float wf[8] = {bflo(wv.x), bfhi(wv.x), bflo(wv.y), bfhi(wv.y), bflo(wv.z), bfhi(wv.z), bflo(wv.w), bfhi(wv.w)};
#pragma unroll
                for (int b = 0; b < 8; ++b)
#pragma unroll
                    for (int i = 0; i < 8; ++i) acc[b] += sh2[b * 1024 + k0 + i] * wf[i];
            }
#pragma unroll
            for (int b = 0; b < 8; ++b) { float s = wave_sum(acc[b]); if (lane == 0) bias[b * 2048 + n] = s; }
        }
    }
}
__device__ __forceinline__ void mapt_assemble(const Params& P, int wgi, int nwg) {
    const int tid = threadIdx.x;
    {
        const float* Kt = (const float*)(P.ws + WS_KTAB);
        bf16_t* Mp = (bf16_t*)(P.ws + WS_MAPT);
        const int nthr = nwg * 512;
#pragma unroll 4
        for (int i8 = wgi * 512 + tid; i8 < 32 * 512 * 64; i8 += nthr) {
            const int g = i8 >> 15, row = (i8 >> 6) & 511, ch = i8 & 63; const int t = row >> 4, p = row & 15, s = ch >> 1, q8 = (ch & 1) * 8;
            f32x4 a0 = (f32x4){0.f, 0.f, 0.f, 0.f}, a1 = a0;
            if (t >= s) { const float* kp = Kt + ((size_t)((g * 2 + 0) * 32 + (t - s)) * 256 + p * 16 + q8); a0 = a0 + *(const f32x4*)kp; a1 = a1 + *(const f32x4*)(kp + 4); }
            if (s >= t) { const float* kp = Kt + ((size_t)((g * 2 + 1) * 32 + (s - t)) * 256 + p * 16 + q8); a0 = a0 + *(const f32x4*)kp; a1 = a1 + *(const f32x4*)(kp + 4); }
            u32x4 o; o.x = cvt_pk_bf16(a0.x, a0.y); o.y = cvt_pk_bf16(a0.z, a0.w); o.z = cvt_pk_bf16(a1.x, a1.y); o.w = cvt_pk_bf16(a1.z, a1.w);
            *(u32x4*)(Mp + ((size_t)(g * 512 + row) * 768 + s * 16 + q8)) = o;
        }
    }
}
__device__ __forceinline__ void phase2(const Params& P, LAS unsigned char* lds) {
    const int wg = blockIdx.x;
    const int wgid = (wg & 7) * 32 + (wg >> 3);
    const int pm = (wgid >> 5) * 8 + (wgid & 7), pn = (wgid & 31) >> 3;
    pg8::Gemm g{1024, 1024, 1024};
    pg8::Unit u{(const char*)((const bf16_t*)(P.ws + WS_XB) + (size_t)pm * 256 * 1024), (const char*)((const bf16_t*)(P.ws + WS_W1T) + (size_t)pn * 256 * 1024), pm, pn, 0};
    EpiU E{(bf16_t*)(P.ws + WS_AEXT), (bf16_t*)(P.ws + WS_FB), -1};
    pg8::gemm_unit<EpiU>(lds, g, u, E);
    mapt_assemble(P, wg, gridDim.x);
}

constexpr size_t WS_FOLD = WS_XB;
constexpr size_t WS_YGELU = WS_FB;
constexpr size_t WS_MIXIN = WS_XB;
struct EpiGT {
    static constexpr bool PERM = true, AFTER_DRAIN = false;
    bf16_t* gt;
    __device__ __forceinline__ void operator()(const f32x4 (&acc)[2][2][4][2], const pg8::Unit& u, int wr, int wc, int fr, int fq) const {
        const int b = u.pn >> 2;
#pragma unroll
        for (int ai = 0; ai < 2; ++ai)
#pragma unroll
            for (int m = 0; m < 4; ++m) {
                const int chp = u.pm * 256 + 128 * ai + 64 * wr + 16 * m + fr;
#pragma unroll
                for (int bj = 0; bj < 2; ++bj) {
                    const int l = (u.pn & 3) * 256 + 128 * bj + 32 * wc + 8 * fq;
                    const f32x4 v0 = acc[ai][bj][m][0], v1 = acc[ai][bj][m][1];
                    u32x4 w; w.x = cvt_pk_bf16(v0.x, v0.y); w.y = cvt_pk_bf16(v0.z, v0.w); w.z = cvt_pk_bf16(v1.x, v1.y); w.w = cvt_pk_bf16(v1.z, v1.w);
                    *(u32x4*)(gt + ((size_t)((b * 512 + (chp & 511)) * 2 + (chp >> 9)) * 1024 + l)) = w;
                }
            }
    }
};
struct EpiE {
    static constexpr bool PERM = false, AFTER_DRAIN = false;
    float* base;
    __device__ __forceinline__ void operator()(const f32x4 (&acc)[2][2][4][2], const pg8::Unit& u, int wr, int wc, int fr, int fq) const {
#pragma unroll
        for (int ai = 0; ai < 2; ++ai)
#pragma unroll
            for (int m = 0; m < 4; ++m) {
                const int rt = 128 * ai + 64 * wr + 16 * m + fr;
#pragma unroll
                for (int bj = 0; bj < 2; ++bj)
#pragma unroll
                    for (int n = 0; n < 2; ++n) *(f32x4*)(base + (size_t)rt * 256 + 128 * bj + 32 * wc + 16 * n + 4 * fq) = acc[ai][bj][m][n];
            }
    }
};
__device__ __forceinline__ unsigned bf2_add(unsigned a, unsigned b, float sg) { return cvt_pk_bf16(bflo(a) + sg * bflo(b), bfhi(a) + sg * bfhi(b)); }
__device__ __forceinline__ void phase3(const Params& P, LAS unsigned char* lds) {
    const int wg = blockIdx.x;
    if (wg < 128) {
        const int pm = wg & 3, pn = wg >> 2; const int b = pn >> 2, lbase = (pn & 3) * 256;
        const bf16_t* fb = (const bf16_t*)(P.ws + WS_FB) + (size_t)b * 2048 * 512;
        pg8::Gemm g{1024, 512, 1024};
        pg8::Unit u{(const char*)((const bf16_t*)(P.ws + WS_WCST) + (size_t)pm * 256 * 1024), (const char*)(fb + (size_t)lbase * 512), pm, pn, 0};
        u.b_alt = (const char*)(fb + (size_t)(2048 - lbase - 255) * 512);
        u.alt_from = 8;
        if (lbase == 0) { u.alt_zero_row = 0; u.alt_zero_off = (unsigned)((const char*)(P.ws + WS_MISC + MISC_ZROW) - (u.b_alt + (size_t)128 * 512 * 2)); }
        EpiGT E{(bf16_t*)(P.ws + WS_GT)};
        pg8::gemm_unit<EpiGT>(lds, g, u, E);
    } else if (wg < 224) {
        const int w2 = wg - 128; const int gg = w2 / 3, mt = w2 % 3;
        pg8::Gemm g{768, 512, 512};
        pg8::Unit u{(const char*)((const bf16_t*)(P.ws + WS_AEXT) + (size_t)(gg * 768 + mt * 256) * 768), (const char*)((const bf16_t*)(P.ws + WS_WENDT) + (size_t)gg * 256 * 512), mt, 0, gg};
        EpiE E{(float*)(P.ws + WS_E) + (size_t)(gg * 768 + mt * 256) * 256};
        pg8::gemm_unit<EpiE>(lds, g, u, E);
    }
    if (wg >= 128) { __syncthreads(); p3_extra(P, lds, wg - 128, 128); }
    {
        const int lane = threadIdx.x & 63, wave = threadIdx.x >> 6;
        float* ecv = (float*)(P.ws + WS_MISC + MISC_EC);
        const bf16_t* WcsT = (const bf16_t*)(P.ws + WS_WCST); const bf16_t* fb = (const bf16_t*)(P.ws + WS_FB);
#pragma unroll
        for (int q = 0; q < 2; ++q) {
            const int ent = wg * 16 + wave * 2 + q; const int b = ent >> 9, ch = ent & 511, gq = ch >> 7;
            const unsigned fw = *(const unsigned*)(fb + ((size_t)b * 2048 + 1024) * 512 + gq * 128 + 2 * lane);
            const unsigned ww = *(const unsigned*)(WcsT + (size_t)ch * 1024 + gq * 128 + 2 * lane);
            float e = bflo(fw) * bflo(ww) + bfhi(fw) * bfhi(ww);
            e = wave_sum(e);
            if (lane == 0) ecv[ent] = e;
        }
    }
}
struct EpiY {
    static constexpr bool PERM = true, AFTER_DRAIN = false;
    const bf16_t* arow; const float* dskip; bf16_t* yg; int g, mt, nt;
    __device__ __forceinline__ void operator()(const f32x4 (&acc)[2][2][4][2], const pg8::Unit& u, int wr, int wc, int fr, int fq) const {
        f32x4 d0[2], d1[2];
#pragma unroll
        for (int bj = 0; bj < 2; ++bj) { const int p0 = (nt * 256 + 128 * bj + 32 * wc + 8 * fq) & 15; d0[bj] = *(const f32x4*)(dskip + g * 16 + p0); d1[bj] = *(const f32x4*)(dskip + g * 16 + p0 + 4); }
#pragma unroll
        for (int ai = 0; ai < 2; ++ai) {
            u32x4 uv[4][2];
#pragma unroll
            for (int m = 0; m < 4; ++m)
#pragma unroll
                for (int bj = 0; bj < 2; ++bj) {
                    const int row = mt * 256 + 128 * ai + 64 * wr + 16 * m + fr; const int col0 = nt * 256 + 128 * bj + 32 * wc + 8 * fq;
                    uv[m][bj] = *(const u32x4*)(arow + (size_t)row * 768 + col0);
                }
#pragma unroll
            for (int m = 0; m < 4; ++m) {
                const int row = mt * 256 + 128 * ai + 64 * wr + 16 * m + fr; const int b = row >> 6, c = row & 63;
#pragma unroll
                for (int bj = 0; bj < 2; ++bj) {
                    const int col0 = nt * 256 + 128 * bj + 32 * wc + 8 * fq; const int t = col0 >> 4, p0 = col0 & 15;
                    const u32x4 uq = uv[m][bj];
                    const f32x4 v0 = acc[ai][bj][m][0], v1 = acc[ai][bj][m][1];
                    float y[8] = {v0.x + d0[bj].x * bflo(uq.x), v0.y + d0[bj].y * bfhi(uq.x), v0.z + d0[bj].z * bflo(uq.y), v0.w + d0[bj].w * bfhi(uq.y),
                                  v1.x + d1[bj].x * bflo(uq.z), v1.y + d1[bj].y * bfhi(uq.z), v1.z + d1[bj].z * bflo(uq.w), v1.w + d1[bj].w * bfhi(uq.w)};
#pragma unroll
                    for (int i = 0; i < 8; ++i) y[i] = gelu_tanh(y[i]);
                    u32x4 w; w.x = cvt_pk_bf16(y[0], y[1]); w.y = cvt_pk_bf16(y[2], y[3]); w.z = cvt_pk_bf16(y[4], y[5]); w.w = cvt_pk_bf16(y[6], y[7]);
                    const size_t tok = (size_t)b * 2048 + c * 32 + t;
                    *(u32x4*)(yg + tok * 512 + g * 16 + p0) = w;
                }
            }
        }
    }
};
struct EpiP {
    static constexpr bool PERM = true, AFTER_DRAIN = false;
    bf16_t* base;
    __device__ __forceinline__ void operator()(const f32x4 (&acc)[2][2][4][2], const pg8::Unit& u, int wr, int wc, int fr, int fq) const {
#pragma unroll
        for (int ai = 0; ai < 2; ++ai)
#pragma unroll
            for (int m = 0; m < 4; ++m) {
                const int rt = 128 * ai + 64 * wr + 16 * m + fr;
#pragma unroll
                for (int bj = 0; bj < 2; ++bj) {
                    const f32x4 v0 = acc[ai][bj][m][0], v1 = acc[ai][bj][m][1];
                    u32x4 w; w.x = cvt_pk_bf16(v0.x, v0.y); w.y = cvt_pk_bf16(v0.z, v0.w); w.z = cvt_pk_bf16(v1.x, v1.y); w.w = cvt_pk_bf16(v1.z, v1.w);
                    *(u32x4*)(base + (size_t)rt * 512 + 128 * bj + 32 * wc + 8 * fq) = w;
                }
            }
    }
};
__device__ __forceinline__ void s5_carry(const Params& P, int g, int mt) {
    const int tid = threadIdx.x; const int bl = tid >> 7, dir = (tid >> 6) & 1, n = tid & 63; const int b = mt * 4 + bl;
    const int dg = dir * 32 + g, i = dg * 64 + n;
    const float dt = expf(P.log_dt[dg]); const float lr = P.lam_re[i], li = P.lam_im[i];
    const float mag = expf(32.0f * lr * dt), ang = 32.0f * (li * dt);
    const float atr = mag * cosf(ang), ati = mag * sinf(ang);
    const float* Eg = (const float*)(P.ws + WS_E) + (size_t)g * 768 * 256 + dir * 128 + n * 2;
    bf16_t* Ag = (bf16_t*)(P.ws + WS_AEXT) + (size_t)g * 768 * 768 + 512 + dir * 128 + n * 2;
    float hr = 0.f, hi = 0.f;
    f32x2 ec[8], el[64];
#pragma unroll
    for (int k = 0; k < 8; ++k) { const int cp = dir ? 7 - k : k; ec[k] = *(const f32x2*)(Eg + (size_t)(512 + b * 8 + cp) * 256); }
#pragma unroll
    for (int k = 0; k < 64; ++k) { const int c = dir ? 63 - k : k; el[k] = *(const f32x2*)(Eg + (size_t)(b * 64 + c) * 256); }
#pragma unroll
    for (int k = 0; k < 8; ++k) { const float nr = atr * hr - ati * hi + ec[k].x, ni = atr * hi + ati * hr + ec[k].y; hr = nr; hi = ni; }
#pragma unroll
    for (int k = 0; k < 64; ++k) {
        const int c = dir ? 63 - k : k;
        *(unsigned*)(Ag + (size_t)(b * 64 + c) * 768) = cvt_pk_bf16(hr, hi);
        const float nr = atr * hr - ati * hi + el[k].x, ni = atr * hi + ati * hr + el[k].y; hr = nr; hi = ni;
    }
}
__device__ __forceinline__ void phase4(const Params& P, LAS unsigned char* lds) {
    const int wg = blockIdx.x;
    tp_b(wg < 128 ? 40 : 41, lds);
    if (wg < 128) {
        const int gg = wg >> 2, mt = (wg >> 1) & 1, nt = wg & 1;
        tp_b(42, lds);
        s5_carry(P, gg, mt);
        asm volatile("s_waitcnt vmcnt(0)" ::: "memory");
        __syncthreads();
        tp_e(42, lds); tp_b(43, lds);
        const bf16_t* Ag = (const bf16_t*)(P.ws + WS_AEXT) + (size_t)gg * 768 * 768;
        pg8::Gemm g{768, 768, 768};
        pg8::Unit u{(const char*)(Ag + (size_t)mt * 256 * 768), (const char*)((const bf16_t*)(P.ws + WS_MAPT) + (size_t)(gg * 512 + nt * 256) * 768), mt, nt, gg};
        EpiY E{Ag, P.s5_d, (bf16_t*)(P.ws + WS_YGELU), gg, mt, nt};
        pg8::gemm_unit<EpiY>(lds, g, u, E);
        tp_e(43, lds);
    }
    else {
        const int idx = wg - 128; const int b = idx & 7, j = idx >> 3; const int cs = j >> 3, mt = (j >> 1) & 3, nt = j & 1;
        pg8::Gemm g{1024, 2048, 1024};
        pg8::Unit u{(const char*)((const bf16_t*)(P.ws + WS_CS) + (size_t)(cs * 1024 + mt * 256) * 1024),
                    (const char*)((const bf16_t*)(P.ws + WS_GT) + ((size_t)(b * 512 + nt * 256) * 2 + cs) * 1024), mt, nt, b};
        EpiP E{(bf16_t*)(P.ws + WS_CSPART) + ((size_t)(cs * 8 + b) * 1024 + mt * 256) * 512 + nt * 256};
        pg8::gemm_unit<EpiP>(lds, g, u, E);
        utable_to_i8(P, wg - 128, 128);
    }
    tp_e(wg < 128 ? 40 : 41, lds);
    {
        const int lane = threadIdx.x & 63, wave = threadIdx.x >> 6;
        const float* ecv = (const float*)(P.ws + WS_MISC + MISC_EC); float* o1024 = (float*)(P.ws + WS_MISC + MISC_O1024);
        const bf16_t* GT = (const bf16_t*)(P.ws + WS_GT);
#pragma unroll
        for (int q = 0; q < 2; ++q) {
            const int ent = wg * 16 + wave * 2 + q; const int b = ent >> 9, ch = ent & 511;
            const u32x4 g0 = *(const u32x4*)(GT + (size_t)(b * 512 + ch) * 2048 + 16 * lane), g1 = *(const u32x4*)(GT + (size_t)(b * 512 + ch) * 2048 + 16 * lane + 8);
            float s = (bflo(g0.x) - bfhi(g0.x)) + (bflo(g0.y) - bfhi(g0.y)) + (bflo(g0.z) - bfhi(g0.z)) + (bflo(g0.w) - bfhi(g0.w))
                    + (bflo(g1.x) - bfhi(g1.x)) + (bflo(g1.y) - bfhi(g1.y)) + (bflo(g1.z) - bfhi(g1.z)) + (bflo(g1.w) - bfhi(g1.w));
            s = wave_sum(s);
            if (lane == 0) o1024[ent] = s + ecv[ent];
        }
    }
}
struct EpiGlu {
    static constexpr bool PERM = true, AFTER_DRAIN = false;
    const bf16_t* yg; const float* bglu; bf16_t* mixin;
    __device__ __forceinline__ void operator()(const f32x4 (&acc)[2][2][4][2], const pg8::Unit& u, int wr, int wc, int fr, int fq) const {
        f32x4 b0[2], b1[2];
#pragma unroll
        for (int bj = 0; bj < 2; ++bj) { const int c0 = u.pn * 256 + 128 * bj + 32 * wc + 8 * fq; b0[bj] = *(const f32x4*)(bglu + c0); b1[bj] = *(const f32x4*)(bglu + c0 + 4); }
#pragma unroll
        for (int ai = 0; ai < 2; ++ai) {
            u32x4 yv[4][2];
#pragma unroll
            for (int m = 0; m < 4; ++m)
#pragma unroll
                for (int bj = 0; bj < 2; ++bj) {
                    const size_t r = (size_t)u.pm * 256 + 128 * ai + 64 * wr + 16 * m + fr; const int c0 = u.pn * 256 + 128 * bj + 32 * wc + 8 * fq;
                    yv[m][bj] = *(const u32x4*)(yg + r * 512 + c0);
                }
#pragma unroll
            for (int m = 0; m < 4; ++m) {
                const size_t r = (size_t)u.pm * 256 + 128 * ai + 64 * wr + 16 * m + fr;
#pragma unroll
                for (int bj = 0; bj < 2; ++bj) {
                    const int c0 = u.pn * 256 + 128 * bj + 32 * wc + 8 * fq;
                    const u32x4 yq = yv[m][bj];
                    const f32x4 v0 = acc[ai][bj][m][0] + b0[bj], v1 = acc[ai][bj][m][1] + b1[bj];
                    float s[8] = {bflo(yq.x) * sigmoidf_(v0.x), bfhi(yq.x) * sigmoidf_(v0.y), bflo(yq.y) * sigmoidf_(v0.z), bfhi(yq.y) * sigmoidf_(v0.w),
                                  bflo(yq.z) * sigmoidf_(v1.x), bfhi(yq.z) * sigmoidf_(v1.y), bflo(yq.w) * sigmoidf_(v1.z), bfhi(yq.w) * sigmoidf_(v1.w)};
                    u32x4 w; w.x = cvt_pk_bf16(s[0], s[1]); w.y = cvt_pk_bf16(s[2], s[3]); w.z = cvt_pk_bf16(s[4], s[5]); w.w = cvt_pk_bf16(s[6], s[7]);
                    *(u32x4*)(mixin + r * 1024 + c0) = w;
                }
            }
        }
    }
};
__device__ __forceinline__ void phase5(const Params& P, LAS unsigned char* lds) {
    const int wg = blockIdx.x;
    tp_b(wg < 128 ? 50 : 51, lds);
    bf16_t* mixin = (bf16_t*)(P.ws + WS_MIXIN);
    if (wg < 128) {
        const int pm = wg >> 1, pn = wg & 1;
        const bf16_t* yg = (const bf16_t*)(P.ws + WS_YGELU);
        pg8::Gemm g{512, 512, 512};
        pg8::Unit u{(const char*)(yg + (size_t)pm * 256 * 512), (const char*)((const bf16_t*)(P.ws + WS_WGLUT) + (size_t)pn * 256 * 512), pm, pn, 0};
        EpiGlu E{yg, P.b_glu, mixin};
        pg8::gemm_unit<EpiGlu>(lds, g, u, E);
    } else {
        const bf16_t* Cp = (const bf16_t*)(P.ws + WS_CSPART); const bf16_t* Sp = Cp + (size_t)8 * 1024 * 512;
        const float* ecv = (const float*)(P.ws + WS_MISC + MISC_EC); const float* o1024 = (const float*)(P.ws + WS_MISC + MISC_O1024);
        for (int i8 = (wg - 128) * 512 + threadIdx.x; i8 < NTOK * 64; i8 += 128 * 512) {
            const int tok = i8 >> 6, ch = (i8 & 63) * 8; const int b = tok >> 11, k = tok & 2047;
            const f32x4 e0 = *(const f32x4*)(ecv + b * 512 + ch), e1 = *(const f32x4*)(ecv + b * 512 + ch + 4);
            float v[8];
            if (k == 1024) {
                const f32x4 o0 = *(const f32x4*)(o1024 + b * 512 + ch), o1 = *(const f32x4*)(o1024 + b * 512 + ch + 4);
                v[0] = o0.x; v[1] = o0.y; v[2] = o0.z; v[3] = o0.w; v[4] = o1.x; v[5] = o1.y; v[6] = o1.z; v[7] = o1.w;
            } else {
                const int kk = (k < 1024) ? k : 2048 - k; const float sg = (k < 1024) ? 1.0f : -1.0f, se = (kk & 1) ? -1.0f : 1.0f;
                const u32x4 c = *(const u32x4*)(Cp + ((size_t)b * 1024 + kk) * 512 + ch), s = *(const u32x4*)(Sp + ((size_t)b * 1024 + kk) * 512 + ch);
                v[0] = bflo(c.x) + sg * bflo(s.x) + se * e0.x; v[1] = bfhi(c.x) + sg * bfhi(s.x) + se * e0.y; v[2] = bflo(c.y) + sg * bflo(s.y) + se * e0.z; v[3] = bfhi(c.y) + sg * bfhi(s.y) + se * e0.w;
                v[4] = bflo(c.z) + sg * bflo(s.z) + se * e1.x; v[5] = bfhi(c.z) + sg * bfhi(s.z) + se * e1.y; v[6] = bflo(c.w) + sg * bflo(s.w) + se * e1.z; v[7] = bfhi(c.w) + sg * bfhi(s.w) + se * e1.w;
            }
            u32x4 w; w.x = cvt_pk_bf16(v[0], v[1]); w.y = cvt_pk_bf16(v[2], v[3]); w.z = cvt_pk_bf16(v[4], v[5]); w.w = cvt_pk_bf16(v[6], v[7]);
            *(u32x4*)(mixin + (size_t)tok * 1024 + 512 + ch) = w;
        }
        vtable_to_fp8(P, wg - 128, 128);
    }
    tp_e(blockIdx.x < 128 ? 50 : 51, lds);
}
constexpr size_t WS_X1B = WS_AEXT;
constexpr size_t WS_X1H = WS_GT;
constexpr size_t WS_PAIRS = WS_XB;
constexpr size_t MISC_SS = 1024 * 1024;
struct EpiOut {
    static constexpr bool PERM = false, AFTER_DRAIN = false;
    const float* x; const float* postab; bf16_t* x1h; const float* mod; const float* g2n; bf16_t* x1b; float* sspart;
    __device__ __forceinline__ void operator()(const f32x4 (&acc)[2][2][4][2], const pg8::Unit& u, int wr, int wc, int fr, int fq) const {
        const int b = (u.pm * 256) >> 11;
        const float* mrow = mod + (size_t)b * NMOD;
        f32x4 gA[2][2], gB[2][2];
#pragma unroll
        for (int bj = 0; bj < 2; ++bj)
#pragma unroll
            for (int n = 0; n < 2; ++n) {
                const int col = u.pn * 256 + 128 * bj + 32 * wc + 16 * n + 4 * fq;
                gA[bj][n] = *(const f32x4*)(mrow + 2 * 1024 + col);
                gB[bj][n] = *(const f32x4*)(g2n + col) * (*(const f32x4*)(mrow + 4 * 1024 + col) + 1.0f);
            }
#pragma unroll
        for (int ai = 0; ai < 2; ++ai)
#pragma unroll
            for (int m = 0; m < 4; ++m) {
                const size_t r = (size_t)u.pm * 256 + 128 * ai + 64 * wr + 16 * m + fr; const int t = (int)(r & 2047);
                const float* prow = postab + (size_t)((u.pn < 2) ? (t >> 6) : (32 + (t & 63))) * 512 + (u.pn & 1) * 256;
                f32x4 xp[2][2];
#pragma unroll
                for (int bj = 0; bj < 2; ++bj)
#pragma unroll
                    for (int n = 0; n < 2; ++n) { const int cl = 128 * bj + 32 * wc + 16 * n + 4 * fq;
                        xp[bj][n] = *(const f32x4*)(x + r * 1024 + u.pn * 256 + cl) + *(const f32x4*)(prow + cl); }
                float ss = 0.f;
#pragma unroll
                for (int bj = 0; bj < 2; ++bj)
#pragma unroll
                    for (int n = 0; n < 2; ++n) {
                        const int col = u.pn * 256 + 128 * bj + 32 * wc + 16 * n + 4 * fq;
                        const f32x4 x1 = xp[bj][n] + gA[bj][n] * acc[ai][bj][m][n];
                        ss += (x1.x * x1.x + x1.y * x1.y) + (x1.z * x1.z + x1.w * x1.w);
                        const f32x4 hb = x1 * gB[bj][n];
                        u32x2 o, oh; o.x = cvt_pk_bf16(hb.x, hb.y); o.y = cvt_pk_bf16(hb.z, hb.w); oh.x = cvt_pk_bf16(x1.x, x1.y); oh.y = cvt_pk_bf16(x1.z, x1.w);
                        *(u32x2*)(x1h + r * 1024 + col) = oh;
                        *(u32x2*)(x1b + r * 1024 + col) = o;
                    }
                ss += __shfl_xor(ss, 16); ss += __shfl_xor(ss, 32);
                if (fq == 0) sspart[r * 16 + u.pn * 4 + wc] = ss;
                if (m & 1) asm volatile("" ::: "memory");
            }
    }
};
__device__ __forceinline__ void phase6(const Params& P, LAS unsigned char* lds) {
    const int wg = blockIdx.x;
    const int wgid = (wg & 7) * 32 + (wg >> 3);
    const int pm = (wgid >> 5) * 8 + (wgid & 7), pn = (wgid & 31) >> 3;
    pg8::Gemm g{1024, 1024, 1024};
    pg8::Unit u{(const char*)((const bf16_t*)(P.ws + WS_MIXIN) + (size_t)pm * 256 * 1024), (const char*)((const bf16_t*)(P.ws + WS_WOUTT) + (size_t)pn * 256 * 1024), pm, pn, 0};
    EpiOut E{P.x, (const float*)(P.ws + WS_MISC + MISC_POS), (bf16_t*)(P.ws + WS_X1H), (const float*)(P.ws + WS_MISC + MISC_MOD), P.norm2_g, (bf16_t*)(P.ws + WS_X1B), (float*)(P.ws + WS_MISC + MISC_SS)};
    pg8::gemm_unit<EpiOut>(lds, g, u, E);
}
__device__ __forceinline__ unsigned key_pack(float v, unsigned tag, unsigned mask) {
    unsigned b = __float_as_uint(v); b ^= (b >> 31) ? 0xffffffffu : 0x80000000u; return (b & ~mask) | tag;
}
__device__ __forceinline__ float key_val(unsigned k, unsigned mask) { unsigned b = k & ~mask; b ^= (b >> 31) ? 0x80000000u : 0xffffffffu; return __uint_as_float(b); }
__device__ const unsigned char CAND_TAB[64] = {0,1,2,3,4,5,6,7,8,9,10,11,12,13,14,15,16,17,18,19,20,21,22,23,32,33,34,35,36,48,49,50,51,64,65,66,80,81,96,97,112,113,128,144,160,176,192,208,224,240,
    255,255,255,255,255,255,255,255,255,255,255,255,255,255};
#define DPP_ROR(v, n) ((unsigned)__builtin_amdgcn_update_dpp(0, (int)(v), 0x120 + (n), 0xf, 0xf, false))
__device__ __forceinline__ unsigned row_umax(unsigned m) {
    unsigned t;
    t = DPP_ROR(m, 8); m = m > t ? m : t; t = DPP_ROR(m, 4); m = m > t ? m : t; t = DPP_ROR(m, 2); m = m > t ? m : t; t = DPP_ROR(m, 1); m = m > t ? m : t;
    return m;
}
__device__ __forceinline__ float row_fsum(float s) {
    s += __int_as_float(__builtin_amdgcn_update_dpp(0, __float_as_int(s), 0x128, 0xf, 0xf, false));
    s += __int_as_float(__builtin_amdgcn_update_dpp(0, __float_as_int(s), 0x124, 0xf, 0xf, false));
    s += __int_as_float(__builtin_amdgcn_update_dpp(0, __float_as_int(s), 0x122, 0xf, 0xf, false));
    s += __int_as_float(__builtin_amdgcn_update_dpp(0, __float_as_int(s), 0x121, 0xf, 0xf, false));
    return s;
}
#define CE(a, b) do { const unsigned hi_ = (a) > (b) ? (a) : (b), lo_ = (a) > (b) ? (b) : (a); (a) = hi_; (b) = lo_; } while (0)
__device__ __forceinline__ unsigned row_top16_of128(unsigned (&k)[8], int l16) {
    CE(k[0], k[1]); CE(k[2], k[3]); CE(k[0], k[2]); CE(k[1], k[3]); CE(k[1], k[2]); CE(k[4], k[5]); CE(k[6], k[7]); CE(k[4], k[6]); CE(k[5], k[7]); CE(k[5], k[6]); CE(k[0], k[4]); CE(k[2], k[6]); CE(k[2], k[4]); CE(k[1], k[5]); CE(k[3], k[7]); CE(k[3], k[5]); CE(k[1], k[2]); CE(k[3], k[4]); CE(k[5], k[6]);
    unsigned mine = 0u;
#pragma unroll
    for (int q = 0; q < 16; ++q) {
        const unsigned m = row_umax(k[0]);
        const bool own = (k[0] == m);
#pragma unroll
        for (int i = 0; i < 7; ++i) k[i] = own ? k[i + 1] : k[i];
        k[7] = own ? 0u : k[7];
        mine = (l16 == q) ? m : mine;
    }
    return mine;
}
__device__ __forceinline__ void row_top16_of128_x2(unsigned (&a)[8], unsigned (&b)[8], int l16, unsigned& ma, unsigned& mb) {
    CE(a[0], a[1]); CE(b[0], b[1]); CE(a[2], a[3]); CE(b[2], b[3]); CE(a[0], a[2]); CE(b[0], b[2]); CE(a[1], a[3]); CE(b[1], b[3]); CE(a[1], a[2]); CE(b[1], b[2]); CE(a[4], a[5]); CE(b[4], b[5]); CE(a[6], a[7]); CE(b[6], b[7]); CE(a[4], a[6]); CE(b[4], b[6]); CE(a[5], a[7]); CE(b[5], b[7]); CE(a[5], a[6]); CE(b[5], b[6]); CE(a[0], a[4]); CE(b[0], b[4]); CE(a[2], a[6]); CE(b[2], b[6]); CE(a[2], a[4]); CE(b[2], b[4]); CE(a[1], a[5]); CE(b[1], b[5]); CE(a[3], a[7]); CE(b[3], b[7]); CE(a[3], a[5]); CE(b[3], b[5]); CE(a[1], a[2]); CE(b[1], b[2]); CE(a[3], a[4]); CE(b[3], b[4]); CE(a[5], a[6]); CE(b[5], b[6]);
    unsigned minea = 0u, mineb = 0u;
#pragma unroll
    for (int q = 0; q < 16; ++q) {
        const unsigned xa = row_umax(a[0]), xb = row_umax(b[0]);
        const bool owna = (a[0] == xa), ownb = (b[0] == xb);
#pragma unroll
        for (int i = 0; i < 7; ++i) { a[i] = owna ? a[i + 1] : a[i]; b[i] = ownb ? b[i + 1] : b[i]; }
        a[7] = owna ? 0u : a[7]; b[7] = ownb ? 0u : b[7];
        minea = (l16 == q) ? xa : minea; mineb = (l16 == q) ? xb : mineb;
    }
    ma = minea; mb = mineb;
}
__device__ __forceinline__ unsigned row_top16_of64(unsigned (&k)[4], int l16) {
    CE(k[0], k[1]); CE(k[2], k[3]); CE(k[0], k[2]); CE(k[1], k[3]); CE(k[1], k[2]);
    unsigned mine = 0u;
#pragma unroll
    for (int q = 0; q < 16; ++q) {
        const unsigned m = row_umax(k[0]);
        const bool own = (k[0] == m);
        k[0] = own ? k[1] : k[0]; k[1] = own ? k[2] : k[1]; k[2] = own ? k[3] : k[2]; k[3] = own ? 0u : k[3];
        mine = (l16 == q) ? m : mine;
    }
    return mine;
}
struct EpiTopk {
    static constexpr bool PERM = false, AFTER_DRAIN = true;
    const float* sspart; const float* bias; int* pexp; float* pw; int head;
    __device__ __forceinline__ void fused(const f32x4 (&acc)[2][2][4][2], const pg8::Unit& u, int wr, int wc, int fr, int fq, LAS unsigned char* lds, int wid, int lane) const {
        LAS float* S = (LAS float*)lds;
        tp_e(30, lds); tp_b(31, lds);
        LAS unsigned* TL = (LAS unsigned*)(lds + 133120) + wid * 128;
        const int dr = lane >> 4, l16 = lane & 15;
        unsigned cc[4];
#pragma unroll
        for (int k = 0; k < 4; ++k) cc[k] = CAND_TAB[l16 * 4 + k];
        const LAS float* INV = (const LAS float*)(lds + 138240);
        const LAS float* BSL = (const LAS float*)(lds + 139264);
#pragma unroll
        for (int ai = 0; ai < 2; ++ai) {
#pragma unroll
            for (int m = 0; m < 4; ++m) {
                const int rl = 64 * wr + 16 * m + fr; const float inv = INV[128 * ai + rl];
#pragma unroll
                for (int bj = 0; bj < 2; ++bj)
#pragma unroll
                    for (int n = 0; n < 2; ++n) {
                        const int c = 128 * bj + 32 * wc + 16 * n + 4 * fq;
                        const f32x4 s = acc[ai][bj][m][n] * inv + *(const LAS f32x4*)(BSL + c);
                        *(LAS f32x4*)(S + rl * 260 + c) = s;
                    }
            }
            __syncthreads();
            tp_e(31, lds); tp_b(32, lds);
            for (int bt = 0; bt < 4; ++bt) {
#pragma unroll
                for (int half = 0; half < 2; ++half) {
                    const int trow = wid * 16 + bt * 4 + half * 2 + (dr >> 1), side = dr & 1;
                    const LAS f32x4* sp = (const LAS f32x4*)(S + trow * 260 + side * 128 + 8 * l16);
                    const f32x4 v0 = sp[0], v1 = sp[1];
                    unsigned k[8];
                    const unsigned tg = 127u - 8u * (unsigned)l16;
                    k[0] = key_pack(v0.x, tg, 127u); k[1] = key_pack(v0.y, tg - 1u, 127u); k[2] = key_pack(v0.z, tg - 2u, 127u); k[3] = key_pack(v0.w, tg - 3u, 127u);
                    k[4] = key_pack(v1.x, tg - 4u, 127u); k[5] = key_pack(v1.y, tg - 5u, 127u); k[6] = key_pack(v1.z, tg - 6u, 127u); k[7] = key_pack(v1.w, tg - 7u, 127u);
                    const unsigned mine = row_top16_of128(k, l16);
                    TL[(half * 2 + (dr >> 1)) * 32 + side * 16 + l16] = mine;
                }
                asm volatile("s_waitcnt lgkmcnt(0)" ::: "memory");
                unsigned ck[4];
#pragma unroll
                for (int k = 0; k < 4; ++k) {
                    const unsigned code = cc[k]; const unsigned ci = (code >> 4) & 15u, cj = code & 15u;
                    const unsigned ka = TL[dr * 32 + ci], kb = TL[dr * 32 + 16 + cj];
                    const unsigned key = key_pack(key_val(ka, 127u) + key_val(kb, 127u), 255u - code, 255u);
                    ck[k] = (code == 255u) ? 0u : key;
                }
                const unsigned best = row_top16_of64(ck, l16);
                const unsigned flat = 255u - (best & 255u);
                const float bv = key_val(best, 255u);
                const float bmax = key_val(row_umax(best), 255u);
                const float e = expf(bv - bmax);
                const float sum = row_fsum(e);
                const unsigned k1s = TL[dr * 32 + (flat >> 4)], k2s = TL[dr * 32 + 16 + (flat & 15u)];
                const int idx1 = 127 - (int)(k1s & 127u), idx2 = 127 - (int)(k2s & 127u);
                const size_t tok = (size_t)u.pm * 256 + 128 * ai + wid * 16 + bt * 4 + dr;
                pexp[tok * 128 + head * 16 + l16] = idx1 * 128 + idx2; pw[tok * 128 + head * 16 + l16] = e / sum;
                asm volatile("s_waitcnt lgkmcnt(0)" ::: "memory");
            }
            tp_e(32, lds); tp_b(31, lds);
            __syncthreads();
        }
        tp_e(31, lds);
    }
};
__device__ __forceinline__ void phase7(const Params& P, LAS unsigned char* lds) {
    const int wg = blockIdx.x; const int x = wg & 7, li = wg >> 3;
    {
        const int pm0 = 8 * x + (li & 7);
        if (threadIdx.x < 256) {
            const float* sp = (const float*)(P.ws + WS_MISC + MISC_SS) + ((size_t)pm0 * 256 + threadIdx.x) * 16;
            const f32x4 a = *(const f32x4*)sp, b = *(const f32x4*)(sp + 4), c = *(const f32x4*)(sp + 8), d = *(const f32x4*)(sp + 12);
            const float tot = ((a.x + a.y) + (a.z + a.w)) + ((b.x + b.y) + (b.z + b.w)) + ((c.x + c.y) + (c.z + c.w)) + ((d.x + d.y) + (d.z + d.w));
            ((LAS float*)(lds + 138240))[threadIdx.x] = rsqrtf(tot * (1.0f / 1024.0f) + 1e-6f);
        }
        __syncthreads();
    }
    for (int rnd = 0; rnd < 2; ++rnd) {
        const int unit = li + 32 * rnd; const int pm = 8 * x + (unit & 7), head = unit >> 3;
        pg8::Gemm g{1024, 1024, 1024};
        pg8::Unit u{(const char*)((const bf16_t*)(P.ws + WS_X1B) + (size_t)pm * 256 * 1024), (const char*)((const bf16_t*)(P.ws + WS_WST) + (size_t)head * 256 * 1024), pm, head, 0};
        EpiTopk E{(const float*)(P.ws + WS_MISC + MISC_SS), (const float*)(P.ws + WS_MISC + MISC_BIAS), (int*)(P.ws + WS_PAIRS), (float*)(P.ws + WS_PAIRS) + (size_t)NTOK * 128, head};
        if (threadIdx.x < 64) {
            const int b = (pm * 256) >> 11;
            *(LAS f32x4*)(lds + 139264 + threadIdx.x * 16) = *(const f32x4*)((const float*)(P.ws + WS_MISC + MISC_BIAS) + (size_t)b * 2048 + head * 256 + threadIdx.x * 4);
        }
        __syncthreads();
        tp_b(30, lds);
        pg8::gemm_unit<EpiTopk>(lds, g, u, E);
    }
}
constexpr size_t WS_U8 = 216 * MiB;
constexpr size_t WS_V8 = 232 * MiB;
#define U8_SCALE 512.0f
#define V8_SCALE 16.0f
__device__ __forceinline__ unsigned pack4_fp8(f32x4 v, float sc) {
    v = v * sc;
    v.x = fminf(fmaxf(v.x, -448.f), 448.f); v.y = fminf(fmaxf(v.y, -448.f), 448.f); v.z = fminf(fmaxf(v.z, -448.f), 448.f); v.w = fminf(fmaxf(v.w, -448.f), 448.f);
    int t = __builtin_amdgcn_cvt_pk_fp8_f32(v.x, v.y, 0, false);
    t = __builtin_amdgcn_cvt_pk_fp8_f32(v.z, v.w, t, true);
    return (unsigned)t;
}
constexpr size_t MISC_SU = 2 * 1024 * 1024;
__device__ __forceinline__ unsigned pack4_i8(f32x4 v, float sc) {
    const int a = (int)rintf(v.x * sc), b = (int)rintf(v.y * sc), c = (int)rintf(v.z * sc), d = (int)rintf(v.w * sc);
    return ((unsigned)a & 255u) | (((unsigned)b & 255u) << 8) | (((unsigned)c & 255u) << 16) | ((unsigned)d << 24);
}
__device__ __forceinline__ void vtable_to_fp8(const Params& P, int wgi, int nwg) {
    const int nthr = nwg * 512;
    for (int i0 = wgi * 512 + threadIdx.x; i0 < 16384 * 64; i0 += nthr * 4) {
        f32x4 v[4][4]; bool ok[4];
#pragma unroll
        for (int q = 0; q < 4; ++q) {
            const int i = i0 + q * nthr; ok[q] = i < 16384 * 64;
            const float* src = P.v_tab + (size_t)(ok[q] ? i : i0) * 16;
#pragma unroll
            for (int j = 0; j < 4; ++j) v[q][j] = *(const f32x4*)(src + 4 * j);
        }
#pragma unroll
        for (int q = 0; q < 4; ++q) {
            const int i = i0 + q * nthr;
            if (ok[q]) { u32x4 o; o.x = pack4_fp8(v[q][0], V8_SCALE); o.y = pack4_fp8(v[q][1], V8_SCALE); o.z = pack4_fp8(v[q][2], V8_SCALE); o.w = pack4_fp8(v[q][3], V8_SCALE);
                *(u32x4*)(P.ws + WS_V8 + (size_t)i * 16) = o; }
        }
    }
}
__device__ __forceinline__ void utable_to_i8(const Params& P, int wgi, int nwg) {
    const int lane = threadIdx.x & 63, gw = wgi * 8 + (threadIdx.x >> 6), ngw = nwg * 8;
    float* su = (float*)(P.ws + WS_MISC + MISC_SU);
    for (int r0 = gw; r0 < 16384; r0 += 4 * ngw) {
        f32x4 v[4][4]; float mx[4];
#pragma unroll
        for (int q = 0; q < 4; ++q) { const int r = r0 + q * ngw; const float* src = P.u_tab + (size_t)(r < 16384 ? r : r0) * 1024 + 16 * lane;
#pragma unroll
            for (int j = 0; j < 4; ++j) v[q][j] = *(const f32x4*)(src + 4 * j); }
#pragma unroll
        for (int q = 0; q < 4; ++q) { float m = 0.f;
#pragma unroll
            for (int j = 0; j < 4; ++j) m = fmaxf(fmaxf(fmaxf(fabsf(v[q][j].x), fabsf(v[q][j].y)), fmaxf(fabsf(v[q][j].z), fabsf(v[q][j].w))), m);
            mx[q] = m; }
#pragma unroll
        for (int o = 32; o > 0; o >>= 1) {
#pragma unroll
            for (int q = 0; q < 4; ++q) mx[q] = fmaxf(mx[q], __shfl_xor(mx[q], o)); }
#pragma unroll
        for (int q = 0; q < 4; ++q) { const int r = r0 + q * ngw;
            if (r < 16384) { const float sc = mx[q] > 0.f ? 127.0f / mx[q] : 0.f;
                u32x4 o; o.x = pack4_i8(v[q][0], sc); o.y = pack4_i8(v[q][1], sc); o.z = pack4_i8(v[q][2], sc); o.w = pack4_i8(v[q][3], sc);
                *(u32x4*)(P.ws + WS_U8 + (size_t)r * 1024 + 16 * lane) = o;
                if (lane == 0) su[r] = mx[q] * (1.0f / 127.0f); } }
    }
}
__device__ __forceinline__ float dot16_fp8(const u32x4 r, const f32x2 (&h)[8]) {
    f32x2 a = __builtin_amdgcn_cvt_pk_f32_fp8((int)r.x, false) * h[0];
    a = a + __builtin_amdgcn_cvt_pk_f32_fp8((int)r.x, true) * h[1];
    a = a + __builtin_amdgcn_cvt_pk_f32_fp8((int)r.y, false) * h[2];
    a = a + __builtin_amdgcn_cvt_pk_f32_fp8((int)r.y, true) * h[3];
    a = a + __builtin_amdgcn_cvt_pk_f32_fp8((int)r.z, false) * h[4];
    a = a + __builtin_amdgcn_cvt_pk_f32_fp8((int)r.z, true) * h[5];
    a = a + __builtin_amdgcn_cvt_pk_f32_fp8((int)r.w, false) * h[6];
    a = a + __builtin_amdgcn_cvt_pk_f32_fp8((int)r.w, true) * h[7];
    return a.x + a.y;
}
__device__ __forceinline__ void axpy16_fp8(const u32x4 r, const float w, f32x2 (&acc)[8]) {
    const f32x2 ww = (f32x2){w, w};
    acc[0] = acc[0] + __builtin_amdgcn_cvt_pk_f32_fp8((int)r.x, false) * ww;
    acc[1] = acc[1] + __builtin_amdgcn_cvt_pk_f32_fp8((int)r.x, true) * ww;
    acc[2] = acc[2] + __builtin_amdgcn_cvt_pk_f32_fp8((int)r.y, false) * ww;
    acc[3] = acc[3] + __builtin_amdgcn_cvt_pk_f32_fp8((int)r.y, true) * ww;
    acc[4] = acc[4] + __builtin_amdgcn_cvt_pk_f32_fp8((int)r.z, false) * ww;
    acc[5] = acc[5] + __builtin_amdgcn_cvt_pk_f32_fp8((int)r.z, true) * ww;
    acc[6] = acc[6] + __builtin_amdgcn_cvt_pk_f32_fp8((int)r.w, false) * ww;
    acc[7] = acc[7] + __builtin_amdgcn_cvt_pk_f32_fp8((int)r.w, true) * ww;
}
__device__ __forceinline__ float reduce16(float (&d)[16], int lane) {
    float a[8], b[4], c[2];
    const bool b0 = lane & 1, b1 = lane & 2, b2 = lane & 4, b3 = lane & 8;
#pragma unroll
    for (int j = 0; j < 8; ++j) { const float keep = b0 ? d[2 * j + 1] : d[2 * j], send = b0 ? d[2 * j] : d[2 * j + 1]; a[j] = keep + __shfl_xor(send, 1); }
#pragma unroll
    for (int j = 0; j < 4; ++j) { const float keep = b1 ? a[2 * j + 1] : a[2 * j], send = b1 ? a[2 * j] : a[2 * j + 1]; b[j] = keep + __shfl_xor(send, 2); }
#pragma unroll
    for (int j = 0; j < 2; ++j) { const float keep = b2 ? b[2 * j + 1] : b[2 * j], send = b2 ? b[2 * j] : b[2 * j + 1]; c[j] = keep + __shfl_xor(send, 4); }
    const float keep = b3 ? c[1] : c[0], send = b3 ? c[0] : c[1];
    float v = keep + __shfl_xor(send, 8);
    v += __shfl_xor(v, 16); v += __shfl_xor(v, 32);
    return v;
}
__device__ __forceinline__ float reduce8(float (&d)[8], int lane) {
    float a[4], b[2];
    const bool b0 = lane & 1, b1 = lane & 2, b2 = lane & 4;
#pragma unroll
    for (int j = 0; j < 4; ++j) { const float keep = b0 ? d[2 * j + 1] : d[2 * j], send = b0 ? d[2 * j] : d[2 * j + 1]; a[j] = keep + __shfl_xor(send, 1); }
#pragma unroll
    for (int j = 0; j < 2; ++j) { const float keep = b1 ? a[2 * j + 1] : a[2 * j], send = b1 ? a[2 * j] : a[2 * j + 1]; b[j] = keep + __shfl_xor(send, 2); }
    const float keep = b2 ? b[1] : b[0], send = b2 ? b[0] : b[1];
    float v = keep + __shfl_xor(send, 4);
    v += __shfl_xor(v, 8); v += __shfl_xor(v, 16); v += __shfl_xor(v, 32);
    return v;
}
#ifndef VCH
#define VCH 8
#endif
constexpr int P8_LDS_SE = 0;
constexpr int P8_LDS_SW = 64 * 128 * 4;
constexpr int P8_LDS_SG = 2 * 64 * 128 * 4;
constexpr int P8_LDS_SO = 3 * 64 * 128 * 4;
typedef _Float16 h16x2 __attribute__((ext_vector_type(2)));
template <bool HI> __device__ __forceinline__ h16x2 cvt_fp8x2_f16(int s) { return __builtin_bit_cast(h16x2, __builtin_amdgcn_cvt_scalef32_pk_f16_fp8(s, 1.0f, HI)); }
__device__ __forceinline__ void axpy16_fp8_h(const u32x4 r, const h16x2 ww, h16x2 (&acc)[8]) {
    acc[0] = __builtin_elementwise_fma(cvt_fp8x2_f16<false>((int)r.x), ww, acc[0]);
    acc[1] = __builtin_elementwise_fma(cvt_fp8x2_f16<true>((int)r.x), ww, acc[1]);
    acc[2] = __builtin_elementwise_fma(cvt_fp8x2_f16<false>((int)r.y), ww, acc[2]);
    acc[3] = __builtin_elementwise_fma(cvt_fp8x2_f16<true>((int)r.y), ww, acc[3]);
    acc[4] = __builtin_elementwise_fma(cvt_fp8x2_f16<false>((int)r.z), ww, acc[4]);
    acc[5] = __builtin_elementwise_fma(cvt_fp8x2_f16<true>((int)r.z), ww, acc[5]);
    acc[6] = __builtin_elementwise_fma(cvt_fp8x2_f16<false>((int)r.w), ww, acc[6]);
    acc[7] = __builtin_elementwise_fma(cvt_fp8x2_f16<true>((int)r.w), ww, acc[7]);
}
__device__ __forceinline__ float dot16_i8(const u32x4 r, const int (&h)[4]) {
    int a = __builtin_amdgcn_sdot4((int)r.x, h[0], 0, false);
    a = __builtin_amdgcn_sdot4((int)r.y, h[1], a, false);
    a = __builtin_amdgcn_sdot4((int)r.z, h[2], a, false);
    a = __builtin_amdgcn_sdot4((int)r.w, h[3], a, false);
    return (float)a;
}
__device__ __forceinline__ void phase8(const Params& P, LAS unsigned char* lds) {
    const int lane = threadIdx.x & 63, wave = threadIdx.x >> 6;
    const float* mod = (const float*)(P.ws + WS_MISC + MISC_MOD); const float* sspart = (const float*)(P.ws + WS_MISC + MISC_SS);
    const float* su = (const float*)(P.ws + WS_MISC + MISC_SU);
    const bf16_t* x1h = (const bf16_t*)(P.ws + WS_X1H);
    const int* pexp = (const int*)(P.ws + WS_PAIRS); const float* pw = (const float*)(P.ws + WS_PAIRS) + (size_t)NTOK * 128;
    const unsigned char* u8 = P.ws + WS_U8; const unsigned char* v8 = P.ws + WS_V8; const unsigned lane16 = 16u * (unsigned)lane, lane64 = 64u * (unsigned)lane;
    LAS unsigned* SE = (LAS unsigned*)(lds + P8_LDS_SE) + wave * 8 * 128;
    LAS float* SW = (LAS float*)(lds + P8_LDS_SW) + wave * 8 * 128;
    LAS float* SD = SW;
    LAS float* SG = (LAS float*)(lds + P8_LDS_SG) + wave * 8 * 128;
    LAS int* SO = (LAS int*)(lds + P8_LDS_SO) + wave * 8 * 16;
    const int tok0 = __builtin_amdgcn_readfirstlane(blockIdx.x * 64 + wave * 8);
    const int b = tok0 >> 11; const float* mrow = mod + (size_t)b * NMOD;
    const unsigned long long ltmask = (1ull << lane) - 1ull;
    int hq[8][4]; float hsc[8];
    unsigned long long tq0 = 0ull;
#define TQB(id) do { if (TPROBE == (id) && threadIdx.x == 0) tq0 = __builtin_amdgcn_s_memrealtime(); } while (0)
#define TQE(id) do { if (TPROBE == (id) && threadIdx.x == 0) ((LAS unsigned*)(lds + 147456 - 16))[2] += (unsigned)(__builtin_amdgcn_s_memrealtime() - tq0); } while (0)
    TQB(20);
#pragma unroll 1
    for (int t = 0; t < 8; ++t) {
        const int tok = tok0 + t;
        const unsigned lane4 = 4u * (unsigned)lane;
        const int e0 = *(const int*)((const char*)(pexp + (size_t)tok * 128) + lane4), e1 = *(const int*)((const char*)(pexp + (size_t)tok * 128 + 64) + lane4);
        const float g0 = *(const float*)((const char*)(pw + (size_t)tok * 128) + lane4), g1 = *(const float*)((const char*)(pw + (size_t)tok * 128 + 64) + lane4);
        const int r0 = e0 >> 11, r1 = e1 >> 11;
        int base = 0, pos0 = 0, pos1 = 0, ov = 0;
#pragma unroll
        for (int rho = 0; rho < 8; ++rho) {
            const unsigned long long m0 = __ballot(r0 == rho), m1 = __ballot(r1 == rho);
            const int c0 = __popcll(m0), c1 = __popcll(m1);
            if (r0 == rho) pos0 = base + __popcll(m0 & ltmask);
            if (r1 == rho) pos1 = base + c0 + __popcll(m1 & ltmask);
            if (lane == rho) ov = base;
            base += c0 + c1;
        }
        if (lane >= 8) ov = 128;
        if (lane < 16) SO[t * 16 + lane] = ov;
        SE[t * 128 + pos0] = (unsigned)e0; SE[t * 128 + pos1] = (unsigned)e1;
        SG[t * 128 + pos0] = g0; SG[t * 128 + pos1] = g1;
    }
#pragma unroll
    for (int t = 0; t < 8; ++t) {
        const int tok = tok0 + t;
        float tot = 0.f;
#pragma unroll
        for (int i = 0; i < 4; ++i) { const f32x4 sp = *(const f32x4*)(sspart + (size_t)tok * 16 + 4 * i); tot += (sp.x + sp.y) + (sp.z + sp.w); }
        const float inv = rsqrtf(tot * (1.0f / 1024.0f) + 1e-6f);
        f32x4 h[4]; float mx = 0.f;
        const u32x4 xh0 = *(const u32x4*)((const char*)(x1h + (size_t)tok * 1024) + 2u * lane16), xh1 = *(const u32x4*)((const char*)(x1h + (size_t)tok * 1024) + 2u * lane16 + 16u);
        const f32x4 x1v[4] = {(f32x4){bflo(xh0.x), bfhi(xh0.x), bflo(xh0.y), bfhi(xh0.y)}, (f32x4){bflo(xh0.z), bfhi(xh0.z), bflo(xh0.w), bfhi(xh0.w)},
                              (f32x4){bflo(xh1.x), bfhi(xh1.x), bflo(xh1.y), bfhi(xh1.y)}, (f32x4){bflo(xh1.z), bfhi(xh1.z), bflo(xh1.w), bfhi(xh1.w)}};
#pragma unroll
        for (int j = 0; j < 4; ++j) {
            const unsigned bo = lane64 + 16u * j;
            const f32x4 x1 = x1v[j];
            const f32x4 gn = *(const f32x4*)((const char*)P.norm2_g + bo), sc2 = *(const f32x4*)((const char*)(mrow + 4 * 1024) + bo), sh2 = *(const f32x4*)((const char*)(mrow + 3 * 1024) + bo);
            h[j] = x1 * inv * gn * (sc2 + 1.0f) + sh2;
            mx = fmaxf(fmaxf(fmaxf(fabsf(h[j].x), fabsf(h[j].y)), fmaxf(fabsf(h[j].z), fabsf(h[j].w))), mx);
        }
#pragma unroll
        for (int o = 32; o > 0; o >>= 1) mx = fmaxf(mx, __shfl_xor(mx, o));
        const float qs = mx > 0.f ? 127.0f / mx : 0.f;
#pragma unroll
        for (int j = 0; j < 4; ++j) hq[t][j] = (int)pack4_i8(h[j], qs);
        hsc[t] = mx * (1.0f / 127.0f);
        if (t & 1) asm volatile("" ::: "memory");
    }
    asm volatile("s_waitcnt lgkmcnt(0)" ::: "memory");
    TQE(20); TQB(21);
    for (int rho = 0; rho < 8; ++rho) {
#pragma unroll
        for (int t = 0; t < 4; ++t) {
            const int tA = t, tB = t + 4;
            const int begA = __builtin_amdgcn_readfirstlane(SO[tA * 16 + rho]), endA = __builtin_amdgcn_readfirstlane(SO[tA * 16 + rho + 1]);
            const int begB = __builtin_amdgcn_readfirstlane(SO[tB * 16 + rho]), endB = __builtin_amdgcn_readfirstlane(SO[tB * 16 + rho + 1]);
            const int clA = endA > 0 ? endA - 1 : 0, clB = endB > 0 ? endB - 1 : 0;
            for (int cA = begA, cB = begB; cA < endA || cB < endB; cA += 8, cB += 8) {
                const int liA = cA + (lane & 7), liB = cB + (lane & 7);
                const int eA8 = (int)SE[tA * 128 + (liA < endA ? liA : clA)], eB8 = (int)SE[tB * 128 + (liB < endB ? liB : clB)];
                u32x4 rA[8], rB[8];
#pragma unroll
                for (int i = 0; i < 8; ++i) { const int e = __builtin_amdgcn_readlane(eA8, i); rA[i] = *(const u32x4*)(u8 + (size_t)e * 1024 + lane16); }
#pragma unroll
                for (int i = 0; i < 8; ++i) { const int e = __builtin_amdgcn_readlane(eB8, i); rB[i] = *(const u32x4*)(u8 + (size_t)e * 1024 + lane16); }
                float d[8];
#pragma unroll
                for (int i = 0; i < 8; ++i) d[i] = dot16_i8(rA[i], hq[tA]);
                const float vA = reduce8(d, lane);
                if (lane < 8 && liA < endA) SD[tA * 128 + liA] = vA * hsc[tA];
#pragma unroll
                for (int i = 0; i < 8; ++i) d[i] = dot16_i8(rB[i], hq[tB]);
                const float vB = reduce8(d, lane);
                if (lane < 8 && liB < endB) SD[tB * 128 + liB] = vB * hsc[tB];
            }
        }
    }
    asm volatile("s_waitcnt lgkmcnt(0)" ::: "memory");
    TQE(21); TQB(22);
#pragma unroll
    for (int t = 0; t < 8; ++t) {
        const unsigned ea = SE[t * 128 + lane], eb = SE[t * 128 + 64 + lane];
        const float sua = su[ea], sub = su[eb];
        const float d0 = SD[t * 128 + lane] * sua, d1 = SD[t * 128 + 64 + lane] * sub;
        const float ga = SG[t * 128 + lane], gb = SG[t * 128 + 64 + lane];
        const float w0 = ga * gelu_tanh(d0), w1 = gb * gelu_tanh(d1);
        asm volatile("s_waitcnt lgkmcnt(0)" ::: "memory");
        SW[t * 128 + lane] = w0; SW[t * 128 + 64 + lane] = w1;
    }
    asm volatile("s_waitcnt lgkmcnt(0)" ::: "memory");
    TQE(22); TQB(23);
    h16x2 acc[8][8];
#pragma unroll
    for (int t = 0; t < 8; ++t)
#pragma unroll
        for (int j = 0; j < 8; ++j) acc[t][j] = (h16x2){(_Float16)0.f, (_Float16)0.f};
    for (int rho = 0; rho < 8; ++rho) {
#pragma unroll
        for (int t = 0; t < 4; ++t) {
            const int tA = t, tB = t + 4;
            const int begA = __builtin_amdgcn_readfirstlane(SO[tA * 16 + rho]), endA = __builtin_amdgcn_readfirstlane(SO[tA * 16 + rho + 1]);
            const int begB = __builtin_amdgcn_readfirstlane(SO[tB * 16 + rho]), endB = __builtin_amdgcn_readfirstlane(SO[tB * 16 + rho + 1]);
            const int clA = endA > 0 ? endA - 1 : 0, clB = endB > 0 ? endB - 1 : 0;
            for (int cA = begA, cB = begB; cA < endA || cB < endB; cA += VCH, cB += VCH) {
                const int liA = cA + (lane & 7), liB = cB + (lane & 7);
                const int lcA = (liA < endA ? liA : clA), lcB = (liB < endB ? liB : clB);
                const int eA8 = (int)SE[tA * 128 + lcA], eB8 = (int)SE[tB * 128 + lcB];
                const float wA8 = (liA < endA) ? SW[tA * 128 + lcA] : 0.f, wB8 = (liB < endB) ? SW[tB * 128 + lcB] : 0.f;
                u32x4 rA[VCH], rB[VCH];
#pragma unroll
                for (int i = 0; i < VCH; ++i) { const int e = __builtin_amdgcn_readlane(eA8, i); rA[i] = *(const u32x4*)(v8 + (size_t)e * 1024 + lane16); }
#pragma unroll
                for (int i = 0; i < VCH; ++i) { const int e = __builtin_amdgcn_readlane(eB8, i); rB[i] = *(const u32x4*)(v8 + (size_t)e * 1024 + lane16); }
#pragma unroll
                for (int i = 0; i < VCH; ++i) { const float w = __int_as_float(__builtin_amdgcn_readlane(__float_as_int(wA8), i)); axpy16_fp8_h(rA[i], (h16x2){(_Float16)w, (_Float16)w}, acc[tA]); }
#pragma unroll
                for (int i = 0; i < VCH; ++i) { const float w = __int_as_float(__builtin_amdgcn_readlane(__float_as_int(wB8), i)); axpy16_fp8_h(rB[i], (h16x2){(_Float16)w, (_Float16)w}, acc[tB]); }
            }
        }
    }
    TQE(23); tp_e(90, lds);
    float tp_scale = 1.0f;
#if defined(TPROBE)
    if (TPROBE >= 0) { __syncthreads(); const unsigned ticks = ((LAS unsigned*)(lds + 147456 - 16))[2]; tp_scale = 1.0f + sqrtf((float)ticks * TPSCALE); }
#endif
#pragma unroll
    for (int t = 0; t < 8; ++t) {
        const int tok = tok0 + t;
        float ss = 0.f; f32x4 xo[4];
        const u32x4 xh0 = *(const u32x4*)((const char*)(x1h + (size_t)tok * 1024) + 2u * lane16), xh1 = *(const u32x4*)((const char*)(x1h + (size_t)tok * 1024) + 2u * lane16 + 16u);
        const f32x4 x1v[4] = {(f32x4){bflo(xh0.x), bfhi(xh0.x), bflo(xh0.y), bfhi(xh0.y)}, (f32x4){bflo(xh0.z), bfhi(xh0.z), bflo(xh0.w), bfhi(xh0.w)},
                              (f32x4){bflo(xh1.x), bfhi(xh1.x), bflo(xh1.y), bfhi(xh1.y)}, (f32x4){bflo(xh1.z), bfhi(xh1.z), bflo(xh1.w), bfhi(xh1.w)}};
#pragma unroll
        for (int j = 0; j < 4; ++j) {
            const unsigned bo = lane64 + 16u * j;
            const f32x4 x1 = x1v[j];
            const f32x4 g2 = *(const f32x4*)((const char*)(mrow + 5 * 1024) + bo) * (1.0f / V8_SCALE);
            const f32x4 pa = (f32x4){(float)acc[t][2 * j].x, (float)acc[t][2 * j].y, (float)acc[t][2 * j + 1].x, (float)acc[t][2 * j + 1].y};
            xo[j] = x1 + g2 * pa;
            ss += (xo[j].x * xo[j].x + xo[j].y * xo[j].y) + (xo[j].z * xo[j].z + xo[j].w * xo[j].w);
        }
        ss = wave_sum(ss);
        const float inv2 = rsqrtf(ss * (1.0f / 1024.0f) + 1e-6f);
#pragma unroll
        for (int j = 0; j < 4; ++j) {
            const unsigned bo = lane64 + 16u * j;
            const f32x4 fg = *(const f32x4*)((const char*)P.final_g + bo);
            *(f32x4*)((char*)(P.out + (size_t)tok * 1024) + bo) = xo[j] * (inv2 * tp_scale) * fg;
        }
        if ((t & 3) == 3) asm volatile("" ::: "memory");
    }
}
constexpr int LDS_BARST = 147456 - 16;
typedef __attribute__((address_space(4))) const Params* KParamsPtr;
#if defined(__HIP_DEVICE_COMPILE__)
#define LOADP(name) Params name; { KParamsPtr q_ = (KParamsPtr)__builtin_amdgcn_kernarg_segment_ptr(); asm volatile("" : "+s"(q_)); name = *q_; }
#else
#define LOADP(name) Params name = P;
#endif
__global__ void __launch_bounds__(512, 2) k_mega(Params P) {
    extern __shared__ __attribute__((aligned(16))) unsigned char lds_raw[];
    LAS unsigned char* lds = (LAS unsigned char*)lds_raw;
    const int lo = P.ph_lo, hi = P.ph_hi;
    const bool fused = (hi - lo) > 1;
    XcdBarrier bar; bar.bar = (unsigned*)(P.ws + WS_MISC + MISC_BAR); bar.x = 0; bar.st = (volatile LAS unsigned*)(lds + LDS_BARST);
    if (fused) {
        if (threadIdx.x < 4) ((LAS unsigned*)(lds + LDS_BARST))[threadIdx.x] = 0u;
        __syncthreads();
        bar = xcd_barrier_post((unsigned*)(P.ws + WS_MISC + MISC_BAR), (volatile LAS unsigned*)(lds + LDS_BARST));
    }
#ifndef REPMASK
#define REPMASK 0
#endif
#ifndef TPROBE
#define TPROBE (-1)
#endif
#define TPB(id) do { if (TPROBE == (id) && threadIdx.x == 0) tp_t0 = __builtin_amdgcn_s_memrealtime(); } while (0)
#define TPE(id) do { if (TPROBE == (id) && threadIdx.x == 0) ((LAS unsigned*)(lds + LDS_BARST))[2] += (unsigned)(__builtin_amdgcn_s_memrealtime() - tp_t0); } while (0)
    unsigned long long tp_t0 = 0ull;
    if (TPROBE >= 0) { if (threadIdx.x == 0) ((LAS unsigned*)(lds + LDS_BARST))[2] = 0u; }
    tp_b(90, lds);
#define IN(k) (lo <= (k) && (k) < hi)
#define REP(k, call) do { if (fused && ((REPMASK >> (k)) & 1)) { xcd_barrier(bar); call; } } while (0)
#define SEAM(k) do { if (fused && IN(k) && IN((k) + 1)) { TPB(10 + (k)); xcd_barrier(bar); TPE(10 + (k)); } } while (0)
    if (IN(0)) { LOADP(Pk); TPB(0); phase0(Pk, lds); TPE(0); REP(0, phase0(Pk, lds)); }
    if (fused && IN(0) && IN(1)) { TPB(10); cg::this_grid().sync(); TPE(10); }
    if (IN(1)) { LOADP(Pk); TPB(1); phase1(Pk, lds); TPE(1); REP(1, phase1(Pk, lds)); }
    if (IN(1) && blockIdx.x >= 32) { LOADP(Pk); __syncthreads(); p0_late_items(Pk, lds, blockIdx.x - 32, gridDim.x - 32); }
    SEAM(1);
    if (IN(2)) { LOADP(Pk); TPB(2); phase2(Pk, lds); TPE(2); REP(2, phase2(Pk, lds)); }
    SEAM(2);
    if (IN(3)) { LOADP(Pk); TPB(3); phase3(Pk, lds); TPE(3); REP(3, phase3(Pk, lds)); }
    SEAM(3);
    if (IN(4)) { LOADP(Pk); TPB(4); phase4(Pk, lds); TPE(4); REP(4, phase4(Pk, lds)); }
    SEAM(4);
    if (IN(5)) { LOADP(Pk); TPB(5); phase5(Pk, lds); TPE(5); REP(5, phase5(Pk, lds)); }
    SEAM(5);
    if (IN(6)) { LOADP(Pk); TPB(6); phase6(Pk, lds); TPE(6); REP(6, phase6(Pk, lds)); }
    SEAM(6);
    if (IN(7)) { LOADP(Pk); TPB(7); phase7(Pk, lds); TPE(7); REP(7, phase7(Pk, lds)); }
    SEAM(7);
    if (IN(8)) { LOADP(Pk); TPB(8); phase8(Pk, lds); TPE(8); REP(8, phase8(Pk, lds)); }
#undef IN
#undef SEAM
}
extern "C" void kernel_launch(void* const* d_in, const int* in_sizes, int n_in, void* d_out, int out_size, void* d_ws, size_t ws_size, hipStream_t stream) {
    static int grid = 0;
    if (!grid) {
        (void)hipFuncSetAttribute((const void*)k_mega, hipFuncAttributeMaxDynamicSharedMemorySize, LDS_BYTES);
        int dev = 0, cus = 0, per_cu = 0;
        (void)hipGetDevice(&dev);
        (void)hipDeviceGetAttribute(&cus, hipDeviceAttributeMultiprocessorCount, dev);
        (void)hipOccupancyMaxActiveBlocksPerMultiprocessor(&per_cu, (const void*)k_mega, 512, LDS_BYTES);
        grid = (per_cu >= 1 && cus >= 256) ? 256 : -1;
    }
    if (grid < 0) return;
    (void)hipMemsetAsync((char*)d_ws + WS_MISC + MISC_BAR, 0, XCD_BAR_WORDS * 4, stream);
    Params P{};
    const float** pp = (const float**)&P;
    for (int i = 0; i < 26; ++i) pp[i] = (const float*)d_in[i];
    P.out = (float*)d_out; P.ws = (unsigned char*)d_ws; P.ph_lo = 0; P.ph_hi = 9;
    void* args[] = {&P};
    (void)hipLaunchCooperativeKernel((const void*)k_mega, dim3(grid), dim3(512), args, LDS_BYTES, stream);
}
```

```cpp
#define REPMASK 0
#define P0REP 0
#define P1REP 0
#include <hip/hip_runtime.h>
#include <hip/hip_cooperative_groups.h>
#include <stdint.h>
#include <math.h>
namespace cg = cooperative_groups;

#define DM 1024
#define NB 8
#define SEQ 2048
#define CTXL 256
#define NTOK (NB * SEQ)
#define NCTX (NB * CTXL)
#define NMOD 6144
#define MiB (1024ull * 1024ull)
#ifndef TPROBE
#define TPROBE (-1)
#endif
#ifndef TPSCALE
#define TPSCALE 1e-7f
#endif
#define LAS __attribute__((address_space(3)))
typedef unsigned short bf16_t;
typedef short bf16x8 __attribute__((ext_vector_type(8)));
typedef float f32x4 __attribute__((ext_vector_type(4)));
typedef float f32x2 __attribute__((ext_vector_type(2)));
typedef unsigned u32x4 __attribute__((ext_vector_type(4)));
typedef unsigned u32x2 __attribute__((ext_vector_type(2)));

__device__ __forceinline__ float gelu_tanh(float x) {
    const float z = x * (1.5957691216057308f + 0.07135481627f * x * x);
    return x * __builtin_amdgcn_rcpf(1.0f + __expf(-z));
}
__device__ __forceinline__ float sigmoidf_(float x) { return __builtin_amdgcn_rcpf(1.0f + __expf(-x)); }
__device__ __forceinline__ float silu_(float x) { return x * sigmoidf_(x); }
__device__ __forceinline__ float wave_sum(float v) {
#pragma unroll
    for (int o = 32; o > 0; o >>= 1) v += __shfl_xor(v, o);
    return v;
}
__device__ __forceinline__ unsigned cvt_pk_bf16(float lo, float hi) { unsigned r; asm volatile("v_cvt_pk_bf16_f32 %0, %1, %2" : "=v"(r) : "v"(lo), "v"(hi)); return r; }
__device__ __forceinline__ float bf2f(bf16_t v) { return __uint_as_float(((unsigned)v) << 16); }
__device__ __forceinline__ float bflo(unsigned w) { return __uint_as_float(w << 16); }
__device__ __forceinline__ float bfhi(unsigned w) { return __uint_as_float(w & 0xffff0000u); }

__device__ __forceinline__ void tp_b(int id, LAS unsigned char* lds) { if (TPROBE == id && threadIdx.x == 0) ((LAS unsigned*)(lds + 147456 - 16))[3] = (unsigned)__builtin_amdgcn_s_memrealtime(); }
__device__ __forceinline__ void tp_e(int id, LAS unsigned char* lds) { if (TPROBE == id && threadIdx.x == 0) ((LAS unsigned*)(lds + 147456 - 16))[2] += (unsigned)__builtin_amdgcn_s_memrealtime() - ((LAS unsigned*)(lds + 147456 - 16))[3]; }
#define XB_TMO      128
#define XB_XCNT(j)  (256  + 64 * (j))
#define XB_XSUB(j)  (1280 + 64 * (j))
#define XB_XGEN(j)  (2304 + 64 * (j))
#define XB_TOP      3328
#define XB_TOPGEN   3392
#define XCD_BAR_WORDS 3456
#define XB_SPIN_CAP (1u << 18)
__device__ __forceinline__ unsigned xb_ld(unsigned* p)              { return __hip_atomic_load(p, __ATOMIC_RELAXED, __HIP_MEMORY_SCOPE_AGENT); }
__device__ __forceinline__ unsigned xb_add(unsigned* p, unsigned v) { return __hip_atomic_fetch_add(p, v, __ATOMIC_RELAXED, __HIP_MEMORY_SCOPE_AGENT); }
__device__ __forceinline__ unsigned xb_xcc_id() { return (unsigned)__builtin_amdgcn_s_getreg((3 << 11) | 20) & 0xFu; }
#define XB_SPIN(cond, bar) do { unsigned _sp = 0; while (cond) { __builtin_amdgcn_s_sleep(1); \
    if ((++_sp & 255u) == 0u) { if (xb_ld(&(bar)[XB_TMO])) break; if (_sp > XB_SPIN_CAP) { atomicAdd(&(bar)[XB_TMO], 1u); break; } } } } while (0)
struct XcdBarrier { unsigned* bar; unsigned x; volatile LAS unsigned* st; };
__device__ __forceinline__ XcdBarrier xcd_barrier_post(unsigned* bar, volatile LAS unsigned* st) {
    XcdBarrier b; b.bar = bar; b.x = xb_xcc_id(); b.st = st;
    if (threadIdx.x == 0) (void)xb_add(&bar[XB_XCNT(b.x)], 1u);
    return b;
}
__device__ __forceinline__ void xcd_barrier_complete(unsigned* bar, unsigned x, unsigned& nloc, unsigned& nx) {
    const unsigned G = gridDim.x * gridDim.y * gridDim.z;
    unsigned sum, cnt, mine, sp = 0u;
    for (;;) {
        sum = 0u; cnt = 0u; mine = 0u;
#pragma unroll
        for (unsigned j = 0; j < 16; ++j) { const unsigned c = xb_ld(&bar[XB_XCNT(j)]); sum += c; cnt += (c > 0u) ? 1u : 0u; mine = (j == x) ? c : mine; }
        if (sum == G) break;
        __builtin_amdgcn_s_sleep(1);
        if ((++sp & 255u) == 0u) { if (xb_ld(&bar[XB_TMO])) break; if (sp > XB_SPIN_CAP) { atomicAdd(&bar[XB_TMO], 1u); break; } }
    }
    nloc = mine > 0u ? mine : 1u; nx = cnt > 0u ? cnt : 1u;
}
__device__ __forceinline__ void xcd_barrier(const XcdBarrier& b) {
    asm volatile("s_waitcnt vmcnt(0)" ::: "memory");
    __syncthreads();
    if (threadIdx.x == 0) {
        unsigned* bar = b.bar;
        __builtin_amdgcn_s_waitcnt(0);
        unsigned nloc = b.st[0], nx = b.st[1];
        if (nloc == 0u) { xcd_barrier_complete(bar, b.x, nloc, nx); b.st[0] = nloc; b.st[1] = nx; }
        const unsigned old = xb_add(&bar[XB_XSUB(b.x)], 1u);
        const unsigned gen = old / nloc;
        if (old + 1u == (gen + 1u) * nloc) {
            __builtin_amdgcn_fence(__ATOMIC_RELEASE, "agent");
            asm volatile("s_waitcnt vmcnt(0)" ::: "memory");
            const unsigned og = xb_add(&bar[XB_TOP], 1u);
            const unsigned tg = og / nx;
            if (og + 1u == (tg + 1u) * nx) xb_add(&bar[XB_TOPGEN], 1u);
            else XB_SPIN(xb_ld(&bar[XB_TOPGEN]) == tg, bar);
            __builtin_amdgcn_fence(__ATOMIC_ACQUIRE, "agent");
            xb_add(&bar[XB_XGEN(b.x)], 1u);
            asm volatile("s_waitcnt vmcnt(0)" ::: "memory");
        } else {
            XB_SPIN(xb_ld(&bar[XB_XGEN(b.x)]) == gen, bar);
            __builtin_amdgcn_fence(__ATOMIC_ACQUIRE, "agent");
            asm volatile("s_waitcnt vmcnt(0)" ::: "memory");
        }
    }
    __syncthreads();
}
namespace pg8 {
constexpr int BM = 256, BK = 64, HALF = 128, HTB = HALF * BK * 2, STAGE_BYTES = 8 * HTB;
__device__ __forceinline__ int lds_byte(int r, int c) { const int st = (r >> 4) * 2 + (c >> 5), rr = r & 15, cc = c & 31, ob = rr * 64 + cc * 2; return st * 1024 + (ob ^ (((ob >> 9) & 1) << 5)); }
__device__ __forceinline__ void stage_rc(int b, int& R, int& C) { const int st = b / 1024, sb = b % 1024, swz = sb ^ (((sb >> 9) & 1) << 5); R = (st >> 1) * 16 + swz / 64; C = (st & 1) * 32 + (swz % 64) / 2; }
__device__ __forceinline__ int perm32(int rho) { const int n = rho >> 4, i = rho & 15; return 8 * (i >> 2) + 4 * n + (i & 3); }
struct Unit { const char* a; const char* b; int pm, pn, z;
              const char* b_alt = nullptr; int alt_from = 1 << 30; int alt_zero_row = -1; unsigned alt_zero_off = 0u; };
struct Gemm { int lda, ldb, K; };
template <class Epi>
__device__ __forceinline__ void gemm_unit(LAS unsigned char* lds, const Gemm g, const Unit cur, const Epi& E) {
    const int tid = threadIdx.x, wid = __builtin_amdgcn_readfirstlane(tid >> 6), lane = tid & 63, wr = wid >> 2, wc = wid & 3, fr = lane & 15, fq = lane >> 4;
    const int K = g.K, nt = K / BK;
    unsigned voffA[2], voffB[2], voffM[2];
#pragma unroll
    for (int i = 0; i < 2; ++i) { int R, C; stage_rc(tid * 16 + i * 8192, R, C); const int Rb = Epi::PERM ? ((R & ~31) + perm32(R & 31)) : R;
        voffA[i] = (unsigned)(R * g.lda + C) * 2u; voffB[i] = (unsigned)(Rb * g.ldb + C) * 2u;
        voffM[i] = (unsigned)((127 - Rb) * g.ldb + C) * 2u; }
    const size_t kstep = (size_t)(BK * 2);
    const size_t hstepA = (size_t)HALF * g.lda * 2, hstepB = (size_t)HALF * g.ldb * 2;
    const unsigned ldsw = (unsigned)wid * 1024u;
    const int aoff = lds_byte(wr * 64 + fr, fq * 8), boff = lds_byte(wc * 32 + fr, fq * 8);
#define PG8_SA(b, h) (((b) * 2 + (h)) * HTB)
#define PG8_SB(b, h) ((4 + (b) * 2 + (h)) * HTB)
#define PG8_STAGE2(bufoff, gbase, v0_, v1_) do { \
        __builtin_amdgcn_global_load_lds((const unsigned*)((const char*)(gbase) + (v0_)), (LAS unsigned*)(lds + (bufoff) + ldsw), 16, 0, 0); \
        __builtin_amdgcn_global_load_lds((const unsigned*)((const char*)(gbase) + (v1_)), (LAS unsigned*)(lds + (bufoff) + ldsw + 8192), 16, 0, 0); } while (0)
#define PG8_STAGE(bufoff, gbase, voff) PG8_STAGE2(bufoff, gbase, (voff)[0], (voff)[1])
    const int altf = cur.alt_from;
    unsigned voffM0[2];
#pragma unroll
    for (int i = 0; i < 2; ++i) { int R, C; stage_rc(tid * 16 + i * 8192, R, C); const int Rb = Epi::PERM ? ((R & ~31) + perm32(R & 31)) : R;
        voffM0[i] = (Rb == cur.alt_zero_row) ? (cur.alt_zero_off + (unsigned)C * 2u) : voffM[i]; }
#define PG8_BBASE(tau, h) ((tau) < altf ? (cB + (size_t)(tau) * kstep + ((h) ? hstepB : 0)) : (cur.b_alt + (size_t)((tau) - altf) * kstep + ((h) ? 0 : hstepB)))
#define PG8_STAGEB(bufoff, tau, h) do { const bool alt_ = (tau) >= altf; \
        PG8_STAGE2(bufoff, PG8_BBASE(tau, h), alt_ ? ((h) ? voffM[0] : voffM0[0]) : voffB[0], alt_ ? ((h) ? voffM[1] : voffM0[1]) : voffB[1]); } while (0)
#define PG8_LDA(dst, b, h) do { _Pragma("unroll") for (int m = 0; m < 4; ++m) _Pragma("unroll") for (int k = 0; k < 2; ++k) dst[m][k] = *(const LAS bf16x8*)(lds + PG8_SA(b, h) + aoff + m * 2048 + k * 1024); } while (0)
#define PG8_LDB(dst, b, h) do { _Pragma("unroll") for (int n = 0; n < 2; ++n) _Pragma("unroll") for (int k = 0; k < 2; ++k) dst[n][k] = *(const LAS bf16x8*)(lds + PG8_SB(b, h) + boff + n * 2048 + k * 1024); } while (0)
#define PG8_MMA(ai, bj, At, Bt) do { __builtin_amdgcn_s_setprio(1); _Pragma("unroll") for (int m = 0; m < 4; ++m) _Pragma("unroll") for (int n = 0; n < 2; ++n) _Pragma("unroll") for (int k = 0; k < 2; ++k) \
        acc[ai][bj][m][n] = __builtin_amdgcn_mfma_f32_16x16x32_bf16(Bt[n][k], At[m][k], acc[ai][bj][m][n], 0, 0, 0); __builtin_amdgcn_s_setprio(0); } while (0)
#define PG8_WAIT_V(n) asm volatile("s_waitcnt vmcnt(" #n ")" ::: "memory")
#define PG8_WAIT_L(n) asm volatile("s_waitcnt lgkmcnt(" #n ")" ::: "memory")
#define PG8_BAR __builtin_amdgcn_s_barrier()
#define PG8_SCHED __builtin_amdgcn_sched_barrier(0)
    f32x4 acc[2][2][4][2];
#pragma unroll
    for (int a = 0; a < 2; ++a)
#pragma unroll
        for (int b = 0; b < 2; ++b)
#pragma unroll
            for (int m = 0; m < 4; ++m)
#pragma unroll
                for (int n = 0; n < 2; ++n) acc[a][b][m][n] = (f32x4){0.f, 0.f, 0.f, 0.f};
    bf16x8 At[4][2], B0[2][2], B1[2][2];
    const char* cA = cur.a; const char* cB = cur.b;
    PG8_STAGEB(PG8_SB(0, 0), 0, 0); PG8_STAGE(PG8_SA(0, 0), cA, voffA); PG8_STAGEB(PG8_SB(0, 1), 0, 1); PG8_STAGE(PG8_SA(0, 1), cA + hstepA, voffA);
    if (wr == 1) PG8_BAR;
    PG8_WAIT_V(4); PG8_BAR;
    PG8_STAGEB(PG8_SB(1, 0), 1, 0); PG8_STAGE(PG8_SA(1, 0), cA + kstep, voffA); PG8_STAGEB(PG8_SB(1, 1), 1, 1);
    PG8_WAIT_V(6); PG8_BAR;
    for (int t = 0; t < nt; t += 2) {
        const bool last = (t == nt - 2);
        const char* a1 = cA + (size_t)(t + 1) * kstep;
        const char* a2 = last ? cA : cA + (size_t)(t + 2) * kstep;
        const char* a3 = a2 + kstep; const int tb2 = last ? 0 : t + 2, tb3 = tb2 + 1;
        PG8_LDB(B0, 0, 0); PG8_SCHED; PG8_LDA(At, 0, 0); PG8_STAGE(PG8_SA(1, 1), a1 + hstepA, voffA);
        PG8_WAIT_L(8); PG8_BAR; PG8_WAIT_L(0); PG8_MMA(0, 0, At, B0); PG8_BAR; PG8_SCHED;
        PG8_LDB(B1, 0, 1); PG8_STAGEB(PG8_SB(0, 0), tb2, 0);
        PG8_BAR; PG8_WAIT_L(0); PG8_MMA(0, 1, At, B1); PG8_BAR;
        PG8_LDA(At, 0, 1); PG8_STAGE(PG8_SA(0, 0), a2, voffA);
        PG8_BAR; PG8_WAIT_L(0); PG8_MMA(1, 0, At, B0); PG8_BAR; PG8_SCHED;
        PG8_STAGEB(PG8_SB(0, 1), tb2, 1);
        PG8_WAIT_V(6); PG8_BAR; PG8_MMA(1, 1, At, B1); PG8_BAR;
        PG8_LDB(B0, 1, 0); PG8_SCHED; PG8_LDA(At, 1, 0); PG8_STAGE(PG8_SA(0, 1), a2 + hstepA, voffA);
        PG8_WAIT_L(8); PG8_BAR; PG8_WAIT_L(0); PG8_MMA(0, 0, At, B0); PG8_BAR; PG8_SCHED;
        PG8_LDB(B1, 1, 1); PG8_STAGEB(PG8_SB(1, 0), tb3, 0);
        PG8_BAR; PG8_WAIT_L(0); PG8_MMA(0, 1, At, B1); PG8_BAR;
        PG8_LDA(At, 1, 1); PG8_STAGE(PG8_SA(1, 0), a3, voffA);
        PG8_BAR; PG8_WAIT_L(0); PG8_MMA(1, 0, At, B0); PG8_BAR; PG8_SCHED;
        PG8_STAGEB(PG8_SB(1, 1), tb3, 1);
        PG8_WAIT_V(6); PG8_BAR; PG8_MMA(1, 1, At, B1); PG8_BAR;
    }
    if constexpr (!Epi::AFTER_DRAIN) { E(acc, cur, wr, wc, fr, fq); }
    PG8_WAIT_V(0);
    if (wr == 0) PG8_BAR;
    PG8_BAR;
    if constexpr (Epi::AFTER_DRAIN) { E.fused(acc, cur, wr, wc, fr, fq, lds, wid, lane); }
#undef PG8_SA
#undef PG8_SB
#undef PG8_STAGE
#undef PG8_STAGE2
#undef PG8_STAGEB
#undef PG8_BBASE
#undef PG8_LDA
#undef PG8_LDB
#undef PG8_MMA
#undef PG8_WAIT_V
#undef PG8_WAIT_L
#undef PG8_BAR
#undef PG8_SCHED
}
}
constexpr size_t WS_W1T = 0 * MiB;
constexpr size_t WS_WGLUT = 2 * MiB;
constexpr size_t WS_WOUTT = 3 * MiB;
constexpr size_t WS_WST = 5 * MiB;
constexpr size_t WS_WCST = 14 * MiB;
constexpr size_t WS_CS = 10 * MiB;
constexpr size_t WS_WENDT = 26 * MiB;
constexpr size_t WS_MAPT = 34 * MiB;
constexpr size_t WS_KTAB = 59 * MiB;
constexpr size_t WS_XB = 68 * MiB;
constexpr size_t WS_HCB = 100 * MiB;
constexpr size_t WS_AEXT = 108 * MiB;
constexpr size_t WS_FB = 144 * MiB;
constexpr size_t WS_GT = 160 * MiB;
constexpr size_t WS_CSPART = 176 * MiB;
constexpr size_t WS_E = 192 * MiB;
constexpr size_t WS_MISC = 250 * MiB;
constexpr size_t MISC_MOD = 0, MISC_POS = 256 * 1024, MISC_BIAS = 512 * 1024, MISC_BAR = 640 * 1024, MISC_EC = 704 * 1024, MISC_O1024 = 720 * 1024, MISC_ZROW = 736 * 1024;

struct Params {
    const float *x, *c, *ctx, *c_ctx, *w_mod, *b_mod, *norm1_g, *norm2_g, *w_in, *w_out, *lam_re, *lam_im, *log_dt, *b_re, *b_im, *c_re, *c_im, *s5_d,
        *w_glu, *b_glu, *w_fourier, *w_q, *sub_keys, *u_tab, *v_tab, *final_g;
    float* out; unsigned char* ws; int ph_lo, ph_hi;
};
constexpr int LDS_BYTES = 147456;

__device__ __forceinline__ void p0_mod_item(const Params& P, LAS float* L, int item) {
    int tid = threadIdx.x; asm volatile("" : "+v"(tid)); const int w = tid >> 6, l = tid & 63;
    LAS float* act = L; LAS float* red = L + 9 * 1024;
    for (int idx = tid; idx < 9 * 1024; idx += 512) { int r = idx >> 10, k = idx & 1023; float v = (r < 8) ? P.c[r * 1024 + k] : P.c_ctx[k]; act[idx] = silu_(v); }
    __syncthreads();
    const int j = item * 64 + l;
    float acc[9];
#pragma unroll
    for (int r = 0; r < 9; ++r) acc[r] = 0.f;
    for (int k0 = w * 128; k0 < w * 128 + 128; k0 += 16) {
        float wv[16];
#pragma unroll
        for (int i = 0; i < 16; ++i) wv[i] = P.w_mod[(size_t)(k0 + i) * NMOD + j];
#pragma unroll
        for (int i = 0; i < 16; ++i)
#pragma unroll
            for (int r = 0; r < 9; ++r) acc[r] += act[r * 1024 + k0 + i] * wv[i];
    }
#pragma unroll
    for (int r = 0; r < 9; ++r) red[(w * 9 + r) * 64 + l] = acc[r];
    __syncthreads();
    float* mod = (float*)(P.ws + WS_MISC + MISC_MOD);
    for (int idx = tid; idx < 9 * 64; idx += 512) {
        int r = idx >> 6, l2 = idx & 63; float s = 0.f;
#pragma unroll
        for (int ww = 0; ww < 8; ++ww) s += red[(ww * 9 + r) * 64 + l2];
        mod[r * NMOD + item * 64 + l2] = s + P.b_mod[item * 64 + l2];
    }
}
__device__ __forceinline__ void p0_transpose_item(const float* src, int K, int N, bf16_t* dst, LAS float* L, int item) {
    int tid = threadIdx.x; asm volatile("" : "+v"(tid)); const int ntn = N / 64; const int k0 = (item / ntn) * 64, n0 = (item % ntn) * 64;
#pragma unroll
    for (int pass = 0; pass < 2; ++pass) {
        int kk = (tid >> 4) + 32 * pass, c4 = (tid & 15) * 4;
        f32x4 v = *(const f32x4*)(src + (size_t)(k0 + kk) * N + n0 + c4);
        L[kk * 65 + c4 + 0] = v.x; L[kk * 65 + c4 + 1] = v.y; L[kk * 65 + c4 + 2] = v.z; L[kk * 65 + c4 + 3] = v.w;
    }
    __syncthreads();
    const int n = tid >> 3, k8 = (tid & 7) * 8;
    u32x4 o;
    o.x = cvt_pk_bf16(L[(k8 + 0) * 65 + n], L[(k8 + 1) * 65 + n]); o.y = cvt_pk_bf16(L[(k8 + 2) * 65 + n], L[(k8 + 3) * 65 + n]);
    o.z = cvt_pk_bf16(L[(k8 + 4) * 65 + n], L[(k8 + 5) * 65 + n]); o.w = cvt_pk_bf16(L[(k8 + 6) * 65 + n], L[(k8 + 7) * 65 + n]);
    *(u32x4*)(dst + (size_t)(n0 + n) * K + k0 + k8) = o;
}
__device__ __forceinline__ void p0_ws_item(const Params& P, LAS float* L, int item) {
    int tid = threadIdx.x; asm volatile("" : "+v"(tid)); const int hs = item >> 4, k0 = (item & 15) * 64;
    LAS float* keysT = L;
    LAS float* wqT = L + 128 * 132;
    {
        f32x4 kv[8];
#pragma unroll
        for (int i = 0; i < 8; ++i) kv[i] = *(const f32x4*)(P.sub_keys + (size_t)hs * 16384 + (tid + 512 * i) * 4);
        f32x4 wv[4];
#pragma unroll
        for (int i = 0; i < 4; ++i) { const int idx = tid + 512 * i; const int kk = idx >> 5, d4 = (idx & 31) * 4; wv[i] = *(const f32x4*)(P.w_q + (size_t)(k0 + kk) * 2048 + hs * 128 + d4); }
#pragma unroll
        for (int i = 0; i < 8; ++i) { const int idx = (tid + 512 * i) * 4; const int key = idx >> 7, d = idx & 127;
            keysT[(d + 0) * 132 + key] = kv[i].x; keysT[(d + 1) * 132 + key] = kv[i].y; keysT[(d + 2) * 132 + key] = kv[i].z; keysT[(d + 3) * 132 + key] = kv[i].w; }
#pragma unroll
        for (int i = 0; i < 4; ++i) { const int idx = tid + 512 * i; const int kk = idx >> 5, d4 = (idx & 31) * 4;
            wqT[(d4 + 0) * 68 + kk] = wv[i].x; wqT[(d4 + 1) * 68 + kk] = wv[i].y; wqT[(d4 + 2) * 68 + kk] = wv[i].z; wqT[(d4 + 3) * 68 + kk] = wv[i].w; }
    }
    __syncthreads();
    const int kq = (tid & 31) * 4, kg = (tid >> 5) * 4;
    f32x4 acc[4];
#pragma unroll
    for (int i = 0; i < 4; ++i) acc[i] = (f32x4){0.f, 0.f, 0.f, 0.f};
#pragma unroll 4
    for (int d = 0; d < 128; ++d) {
        const f32x4 kv = *(const LAS f32x4*)(keysT + d * 132 + kq), wv = *(const LAS f32x4*)(wqT + d * 68 + kg);
        acc[0] = acc[0] + wv * kv.x; acc[1] = acc[1] + wv * kv.y; acc[2] = acc[2] + wv * kv.z; acc[3] = acc[3] + wv * kv.w;
    }
    bf16_t* dst = (bf16_t*)(P.ws + WS_WST) + (size_t)(hs * 128 + kq) * 1024 + k0 + kg;
#pragma unroll
    for (int i = 0; i < 4; ++i) { u32x2 o; o.x = cvt_pk_bf16(acc[i].x, acc[i].y); o.y = cvt_pk_bf16(acc[i].z, acc[i].w); *(u32x2*)(dst + (size_t)i * 1024) = o; }
}
__device__ __forceinline__ void p0_wcs_item(const Params& P, LAS float* L, int item) {
    int tid = threadIdx.x; asm volatile("" : "+v"(tid)); const int cs = item >> 4, g = (item >> 2) & 3, cb = item & 3;
    LAS float* tab = L;
    if (tid < 128) { float a = (float)tid / 64.0f; tab[tid] = cs ? -sinpif(a) : cospif(a); }
    __syncthreads();
    const int d = tid & 127, c0 = cb * 32 + (tid >> 7) * 8;
    float acc[8];
#pragma unroll
    for (int i = 0; i < 8; ++i) acc[i] = 0.f;
    const float* wf = P.w_fourier + (size_t)g * 16384 + d;
#pragma unroll 8
    for (int m = 0; m < 128; ++m) {
        const float wv = wf[m * 128];
#pragma unroll
        for (int i = 0; i < 8; ++i) acc[i] += tab[((c0 + i) * m) & 127] * wv;
    }
    const float alpha = 1.0f / sqrtf(2048.0f * 128.0f);
    bf16_t* row = (bf16_t*)(P.ws + WS_WCST) + (size_t)(cs * 512 + g * 128 + d) * 1024;
    const float am = cs ? -alpha : alpha;
#pragma unroll
    for (int g2 = 0; g2 < 4; ++g2) {
        u32x4 o = (u32x4){0u, 0u, 0u, 0u}, om = o;
        if (g2 == g) { o.x = cvt_pk_bf16(acc[0] * alpha, acc[1] * alpha); o.y = cvt_pk_bf16(acc[2] * alpha, acc[3] * alpha); o.z = cvt_pk_bf16(acc[4] * alpha, acc[5] * alpha); o.w = cvt_pk_bf16(acc[6] * alpha, acc[7] * alpha);
                       om.x = cvt_pk_bf16(acc[0] * am, acc[1] * am); om.y = cvt_pk_bf16(acc[2] * am, acc[3] * am); om.z = cvt_pk_bf16(acc[4] * am, acc[5] * am); om.w = cvt_pk_bf16(acc[6] * am, acc[7] * am); }
        *(u32x4*)(row + g2 * 128 + c0) = o;
        *(u32x4*)(row + 512 + g2 * 128 + c0) = om;
    }
}
__device__ __forceinline__ void p0_s5_item(const Params& P, LAS float* L, int item) {
    int tid = threadIdx.x; asm volatile("" : "+v"(tid)); const int g = item >> 3, dir = (item >> 2) & 1, qd = item & 3;
    LAS float* Pr = L; LAS float* Pi = L + 33 * 64; LAS float* Bbr = L + 2 * 33 * 64; LAS float* Bbi = Bbr + 1024; LAS float* Cr = Bbi + 1024; LAS float* Ci = Cr + 1024;
    const int dg = dir * 32 + g;
    const float dt = expf(P.log_dt[dg]);
    if (tid < 64) {
        const int n = tid; const int i = dg * 64 + n;
        float lr = P.lam_re[i], li = P.lam_im[i];
        float mag = expf(lr * dt); float ar = mag * cosf(li * dt), ai = mag * sinf(li * dt);
        float den = lr * lr + li * li;
        float cr = ((ar - 1.0f) * lr + ai * li) / den, ci = (ai * lr - (ar - 1.0f) * li) / den;
        for (int q = 0; q < 16; ++q) {
            float br = P.b_re[(size_t)i * 16 + q], bi = P.b_im[(size_t)i * 16 + q];
            Bbr[n * 16 + q] = cr * br - ci * bi; Bbi[n * 16 + q] = cr * bi + ci * br;
        }
    }
    for (int idx = tid; idx < 33 * 64; idx += 512) {
        int tau = idx >> 6, n = idx & 63; const int i = dg * 64 + n;
        float lr = P.lam_re[i], li = P.lam_im[i];
        float mag = expf((float)tau * lr * dt), ang = (float)tau * (li * dt);
        Pr[idx] = mag * cosf(ang); Pi[idx] = mag * sinf(ang);
    }
    for (int idx = tid; idx < 1024; idx += 512) { Cr[idx] = P.c_re[(size_t)dg * 1024 + idx]; Ci[idx] = P.c_im[(size_t)dg * 1024 + idx]; }
    __syncthreads();
    {
        const int pq = tid & 255, p = pq >> 4, q = pq & 15, tau0 = qd * 8 + (tid >> 8) * 4;
        float s[4] = {0.f, 0.f, 0.f, 0.f};
#pragma unroll 4
        for (int n = 0; n < 64; ++n) {
            const float cr = Cr[p * 64 + n], ci = Ci[p * 64 + n], br = Bbr[n * 16 + q], bi = Bbi[n * 16 + q];
            const float xr = cr * br - ci * bi, xi = cr * bi + ci * br;
#pragma unroll
            for (int j = 0; j < 4; ++j) s[j] += xr * Pr[(tau0 + j) * 64 + n] - xi * Pi[(tau0 + j) * 64 + n];
        }
        float* Kt = (float*)(P.ws + WS_KTAB) + (size_t)(g * 2 + dir) * 32 * 256;
#pragma unroll
        for (int j = 0; j < 4; ++j) Kt[(tau0 + j) * 256 + pq] = s[j];
    }
    {
        bf16_t* W = (bf16_t*)(P.ws + WS_WENDT) + (size_t)(g * 256 + dir * 128 + qd * 32) * 512;
        for (int idx = tid; idx < 32 * 512 / 2; idx += 512) {
            const int row = idx >> 8, col = (idx & 255) * 2; const int n = qd * 16 + (row >> 1), ri = row & 1, s = col >> 4, q = col & 15;
            const int tau = dir ? s : (31 - s);
            const float pr = Pr[tau * 64 + n], pi = Pi[tau * 64 + n];
            const float br0 = Bbr[n * 16 + q], bi0 = Bbi[n * 16 + q], br1 = Bbr[n * 16 + q + 1], bi1 = Bbi[n * 16 + q + 1];
            const float v0 = ri ? (pr * bi0 + pi * br0) : (pr * br0 - pi * bi0), v1 = ri ? (pr * bi1 + pi * br1) : (pr * br1 - pi * bi1);
            *(unsigned*)(W + (size_t)row * 512 + col) = cvt_pk_bf16(v0, v1);
        }
    }
    {
        bf16_t* Mp = (bf16_t*)(P.ws + WS_MAPT) + ((size_t)g * 512 + qd * 128) * 768 + 512 + dir * 128;
        for (int idx = tid; idx < 128 * 64; idx += 512) {
            const int row = idx >> 6, n = idx & 63; const int t = qd * 8 + (row >> 4), p = row & 15;
            const int tau = dir ? (32 - t) : (t + 1);
            const float cr = Cr[p * 64 + n], ci = Ci[p * 64 + n], pr = Pr[tau * 64 + n], pi = Pi[tau * 64 + n];
            *(unsigned*)(Mp + (size_t)row * 768 + n * 2) = cvt_pk_bf16(cr * pr - ci * pi, -(cr * pi + ci * pr));
        }
    }
}
__device__ __forceinline__ void p0_pos_item(const Params& P) {
    if (threadIdx.x < 64) ((u32x4*)(P.ws + WS_MISC + MISC_ZROW))[threadIdx.x] = (u32x4){0u, 0u, 0u, 0u};
    float* postab = (float*)(P.ws + WS_MISC + MISC_POS);
    for (int idx = threadIdx.x; idx < 96 * 512; idx += 512) {
        int row = idx >> 9, j = idx & 511, jj = j & 255;
        float omega = 1.0f / powf(10000.0f, (float)jj / 256.0f);
        float p = (float)(row < 32 ? row : row - 32);
        float a = p * omega;
        postab[idx] = (j < 256) ? sinf(a) : cosf(a);
    }
}
__device__ __forceinline__ void vtable_to_fp8(const Params& P, int wgi, int nwg);
__device__ __forceinline__ void utable_to_i8(const Params& P, int wgi, int nwg);
constexpr int P0_MOD = 96, P0_TW1 = 256, P0_TGLU = 64, P0_TOUT = 256, P0_WS = 256, P0_WCS = 32, P0_S5 = 256, P0_POS = 1;
constexpr int P0_NITEMS = P0_MOD + P0_TW1 + P0_TGLU + P0_TOUT + P0_WS + P0_WCS + P0_S5 + P0_POS;
constexpr int P0_EARLY = P0_MOD + P0_TW1 + P0_POS;
constexpr int P0_LATE = P0_S5 + P0_WS + P0_TOUT + P0_TGLU + P0_WCS;
__device__ __forceinline__ void p0_items(const Params& P, LAS unsigned char* lds) {
    LAS float* L = (LAS float*)lds;
    for (int it = blockIdx.x; it < P0_EARLY; it += gridDim.x) {
        __syncthreads();
        int r = it;
        if (r < P0_TW1) { p0_transpose_item(P.w_in, 1024, 1024, (bf16_t*)(P.ws + WS_W1T), L, r); continue; } r -= P0_TW1;
        if (r < P0_MOD) { p0_mod_item(P, L, r); continue; } r -= P0_MOD;
        p0_pos_item(P);
    }
    __syncthreads();
}
__device__ __forceinline__ void p0_late_items(const Params& P, LAS unsigned char* lds, int wgi, int nwg) {
    LAS float* L = (LAS float*)lds;
    for (int it = wgi; it < P0_LATE; it += nwg) {
        __syncthreads();
        int r = it;
        if (r < P0_S5) { p0_s5_item(P, L, r); continue; } r -= P0_S5;
        if (r < P0_WS) { p0_ws_item(P, L, r); continue; } r -= P0_WS;
        if (r < P0_TOUT) { p0_transpose_item(P.w_out, 1024, 1024, (bf16_t*)(P.ws + WS_WOUTT), L, r); continue; } r -= P0_TOUT;
        if (r < P0_TGLU) { p0_transpose_item(P.w_glu, 512, 512, (bf16_t*)(P.ws + WS_WGLUT), L, r); continue; } r -= P0_TGLU;
        p0_wcs_item(P, L, r);
    }
    __syncthreads();
    for (int i = threadIdx.x; i < 2048; i += 512) L[i] = cospif((float)i / 1024.0f);
    __syncthreads();
    bf16_t* CS = (bf16_t*)(P.ws + WS_CS);
    for (int i8 = wgi * 512 + threadIdx.x; i8 < 2 * 1024 * 1024 / 8; i8 += nwg * 512) {
        const int e = i8 * 8, cs = e >> 20, k = (e >> 10) & 1023, l0 = e & 1023, sh = cs ? 512 : 0;
        float v[8];
#pragma unroll
        for (int j = 0; j < 8; ++j) v[j] = L[((k * (l0 + j)) - sh) & 2047];
        u32x4 o; o.x = cvt_pk_bf16(v[0], v[1]); o.y = cvt_pk_bf16(v[2], v[3]); o.z = cvt_pk_bf16(v[4], v[5]); o.w = cvt_pk_bf16(v[6], v[7]);
        *(u32x4*)(CS + (size_t)e) = o;
    }
    __syncthreads();
}
__device__ __forceinline__ void phase0(const Params& P, LAS unsigned char* lds) {
    p0_items(P, lds);
}
template <bool TOK>
__device__ __forceinline__ void row_norm(int lane, const float* src, const float* posr, const float* posc, const float* gn, const float* sh, const float* sc, float* xpd, bf16_t* dst) {
    f32x4 v[4]; float ss = 0.f;
#pragma unroll
    for (int j = 0; j < 4; ++j) {
        const int col = 4 * lane + 256 * j;
        v[j] = *(const f32x4*)(src + col);
        if (TOK) { f32x4 p = (j < 2) ? *(const f32x4*)(posr + col) : *(const f32x4*)(posc + col - 512); v[j] = v[j] + p; *(f32x4*)(xpd + col) = v[j]; }
        ss += (v[j].x * v[j].x + v[j].y * v[j].y) + (v[j].z * v[j].z + v[j].w * v[j].w);
    }
    ss = wave_sum(ss);
    const float inv = rsqrtf(ss * (1.0f / 1024.0f) + 1e-6f);
#pragma unroll
    for (int j = 0; j < 4; ++j) {
        const int col = 4 * lane + 256 * j;
        f32x4 g = *(const f32x4*)(gn + col), s1 = *(const f32x4*)(sc + col), s0 = *(const f32x4*)(sh + col);
        f32x4 h = v[j] * inv * g * (s1 + 1.0f) + s0;
        u32x2 o; o.x = cvt_pk_bf16(h.x, h.y); o.y = cvt_pk_bf16(h.z, h.w);
        *(u32x2*)(dst + col) = o;
    }
}
__device__ __forceinline__ void row_norm2_tok(int lane, const float* src0, const float* src1, const float* posr0, const float* posc0, const float* posr1, const float* posc1,
                                              const float* gn, const float* sh0, const float* sc0, const float* sh1, const float* sc1, float* xpd0, float* xpd1, bf16_t* dst0, bf16_t* dst1) {
    f32x4 v0[4], v1[4], p0[4], p1[4];
#pragma unroll
    for (int j = 0; j < 4; ++j) {
        const int col = 4 * lane + 256 * j;
        v0[j] = *(const f32x4*)(src0 + col); v1[j] = *(const f32x4*)(src1 + col);
        p0[j] = (j < 2) ? *(const f32x4*)(posr0 + col) : *(const f32x4*)(posc0 + col - 512);
        p1[j] = (j < 2) ? *(const f32x4*)(posr1 + col) : *(const f32x4*)(posc1 + col - 512);
    }
    float ss0 = 0.f, ss1 = 0.f;
#pragma unroll
    for (int j = 0; j < 4; ++j) {
        const int col = 4 * lane + 256 * j;
        v0[j] = v0[j] + p0[j]; v1[j] = v1[j] + p1[j];
        ss0 += (v0[j].x * v0[j].x + v0[j].y * v0[j].y) + (v0[j].z * v0[j].z + v0[j].w * v0[j].w);
        ss1 += (v1[j].x * v1[j].x + v1[j].y * v1[j].y) + (v1[j].z * v1[j].z + v1[j].w * v1[j].w);
    }
#pragma unroll
    for (int o = 32; o > 0; o >>= 1) { ss0 += __shfl_xor(ss0, o); ss1 += __shfl_xor(ss1, o); }
    const float inv0 = rsqrtf(ss0 * (1.0f / 1024.0f) + 1e-6f), inv1 = rsqrtf(ss1 * (1.0f / 1024.0f) + 1e-6f);
#pragma unroll
    for (int j = 0; j < 4; ++j) {
        const int col = 4 * lane + 256 * j;
        const f32x4 g = *(const f32x4*)(gn + col);
        const f32x4 a1 = *(const f32x4*)(sc0 + col), a0 = *(const f32x4*)(sh0 + col), b1 = *(const f32x4*)(sc1 + col), b0 = *(const f32x4*)(sh1 + col);
        const f32x4 h0 = v0[j] * inv0 * g * (a1 + 1.0f) + a0, h1 = v1[j] * inv1 * g * (b1 + 1.0f) + b0;
        u32x2 o0, o1; o0.x = cvt_pk_bf16(h0.x, h0.y); o0.y = cvt_pk_bf16(h0.z, h0.w); o1.x = cvt_pk_bf16(h1.x, h1.y); o1.y = cvt_pk_bf16(h1.z, h1.w);
        *(u32x2*)(dst0 + col) = o0; *(u32x2*)(dst1 + col) = o1;
    }
}
template <int NR>
__device__ __forceinline__ void row_normN_ctx(int lane, const float* src, const float* gn, const float* sh, const float* sc, bf16_t* dst) {
    f32x4 v[NR][4]; float ss[NR];
#pragma unroll
    for (int r = 0; r < NR; ++r)
#pragma unroll
        for (int j = 0; j < 4; ++j) v[r][j] = *(const f32x4*)(src + (size_t)r * 1024 + 4 * lane + 256 * j);
#pragma unroll
    for (int r = 0; r < NR; ++r) { ss[r] = 0.f;
#pragma unroll
        for (int j = 0; j < 4; ++j) ss[r] += (v[r][j].x * v[r][j].x + v[r][j].y * v[r][j].y) + (v[r][j].z * v[r][j].z + v[r][j].w * v[r][j].w); }
#pragma unroll
    for (int o = 32; o > 0; o >>= 1) {
#pragma unroll
        for (int r = 0; r < NR; ++r) ss[r] += __shfl_xor(ss[r], o); }
#pragma unroll
    for (int j = 0; j < 4; ++j) {
        const int col = 4 * lane + 256 * j;
        const f32x4 g = *(const f32x4*)(gn + col), s1 = *(const f32x4*)(sc + col), s0 = *(const f32x4*)(sh + col);
        const f32x4 gs = g * (s1 + 1.0f);
#pragma unroll
        for (int r = 0; r < NR; ++r) {
            const float inv = rsqrtf(ss[r] * (1.0f / 1024.0f) + 1e-6f);
            const f32x4 h = v[r][j] * inv * gs + s0;
            u32x2 o; o.x = cvt_pk_bf16(h.x, h.y); o.y = cvt_pk_bf16(h.z, h.w);
            *(u32x2*)(dst + (size_t)r * 1024 + col) = o;
        }
    }
}
struct EpiU {
    static constexpr bool PERM = true, AFTER_DRAIN = false;
    bf16_t* aext; bf16_t* fb; int ctx_b;
    __device__ __forceinline__ void operator()(const f32x4 (&acc)[2][2][4][2], const pg8::Unit& u, int wr, int wc, int fr, int fq) const {
#pragma unroll
        for (int ai = 0; ai < 2; ++ai)
#pragma unroll
            for (int m = 0; m < 4; ++m) {
                const int rt = 128 * ai + 64 * wr + 16 * m + fr;
#pragma unroll
                for (int bj = 0; bj < 2; ++bj) {
                    const int gcol = u.pn * 256 + 128 * bj + 32 * wc + 8 * fq;
                    const f32x4 v0 = acc[ai][bj][m][0], v1 = acc[ai][bj][m][1];
                    u32x4 w; w.x = cvt_pk_bf16(v0.x, v0.y); w.y = cvt_pk_bf16(v0.z, v0.w); w.z = cvt_pk_bf16(v1.x, v1.y); w.w = cvt_pk_bf16(v1.z, v1.w);
                    bf16_t* dst;
                    if (ctx_b >= 0) {
                        if (rt >= 128) continue;
                        const int t = (ctx_b & 1) * 128 + rt, g = gcol >> 4, q0 = gcol & 15, row = 512 + (ctx_b >> 1) * 8 + (t >> 5);
                        dst = aext + ((size_t)(g * 768 + row) * 768 + (t & 31) * 16 + q0);
                    } else {
                        const int r = u.pm * 256 + rt;
                        if (u.pn < 2) { const int b = r >> 11, t = r & 2047, g = gcol >> 4, q0 = gcol & 15, row = b * 64 + (t >> 5);
                            dst = aext + ((size_t)(g * 768 + row) * 768 + (t & 31) * 16 + q0); }
                        else dst = fb + (size_t)r * 512 + (gcol - 512);
                    }
                    *(u32x4*)dst = w;
                }
            }
    }
};
__device__ __forceinline__ void phase1(const Params& P, LAS unsigned char* lds) {
    const int tid = threadIdx.x, lane = tid & 63, wave = tid >> 6, wg = blockIdx.x;
    tp_b(wg < 32 ? 70 : 71, lds);
    const float* mod = (const float*)(P.ws + WS_MISC + MISC_MOD);
    const float* postab = (const float*)(P.ws + WS_MISC + MISC_POS);
    if (wg < 32) {
        const int b = wg >> 2, half = (wg >> 1) & 1, pn = wg & 1;
        bf16_t* hcb = (bf16_t*)(P.ws + WS_HCB) + (size_t)wg * 128 * 1024;
        for (int j = 0; j < 16; j += 8) {
            const int rr = wave * 16 + j;
            row_normN_ctx<8>(lane, P.ctx + (size_t)(b * 256 + half * 128 + rr) * 1024, P.norm1_g, mod + 8 * NMOD, mod + 8 * NMOD + 1024, hcb + (size_t)rr * 1024);
        }
        asm volatile("s_waitcnt vmcnt(0)" ::: "memory");
        __syncthreads();
        pg8::Gemm g{1024, 1024, 1024};
        pg8::Unit u{(const char*)hcb, (const char*)((const bf16_t*)(P.ws + WS_W1T) + (size_t)pn * 256 * 1024), 0, pn, 0};
        EpiU E{(bf16_t*)(P.ws + WS_AEXT), nullptr, b * 2 + half};
        pg8::gemm_unit<EpiU>(lds, g, u, E);
    } else {
    const int gw = (wg - 32) * 8 + wave, ngw = (gridDim.x - 32) * 8;
    bf16_t* xb = (bf16_t*)(P.ws + WS_XB);
    for (int r0 = 2 * gw; r0 < NTOK; r0 += 2 * ngw) {
        const int r1 = r0 + 1; const int b = r0 >> 11, t0 = r0 & 2047, t1 = r1 & 2047;
        row_norm2_tok(lane, P.x + (size_t)r0 * 1024, P.x + (size_t)r1 * 1024, postab + (size_t)(t0 >> 6) * 512, postab + (size_t)(32 + (t0 & 63)) * 512,
                      postab + (size_t)(t1 >> 6) * 512, postab + (size_t)(32 + (t1 & 63)) * 512, P.norm1_g, mod + (size_t)b * NMOD, mod + (size_t)b * NMOD + 1024,
                      mod + (size_t)b * NMOD, mod + (size_t)b * NMOD + 1024, P.out + (size_t)r0 * 1024, P.out + (size_t)r1 * 1024, xb + (size_t)r0 * 1024, xb + (size_t)r1 * 1024);
    }
    }
    tp_e(blockIdx.x < 32 ? 70 : 71, lds);
}
__device__ __forceinline__ void p3_extra(const Params& P, LAS unsigned char* lds, int wgi, int nwg) {
    const int tid = threadIdx.x, lane = tid & 63, wave = tid >> 6;
    const float* mod = (const float*)(P.ws + WS_MISC + MISC_MOD);
    const int gw = wgi * 8 + wave, ngw = nwg * 8;
    {
        LAS float* sh2 = (LAS float*)lds;
        for (int idx = tid; idx < 8 * 1024; idx += 512) sh2[idx] = mod[(size_t)(idx >> 10) * NMOD + 3 * 1024 + (idx & 1023)];
        __syncthreads();
        const bf16_t* WsT = (const bf16_t*)(P.ws + WS_WST);
        float* bias = (float*)(P.ws + WS_MISC + MISC_BIAS);
        for (int n = gw; n < 2048; n += ngw) {
            float acc[8];
#pragma unroll
            for (int b = 0; b < 8; ++b) acc[b] = 0.f;
#pragma unroll
            for (int j = 0; j < 2; ++j) {
                const int k0 = lane * 8 + 512 * j;
                u32x4 wv = *(const u32x4*)(WsT + (size_t)n * 1024 + k0);
                float wf[8] = {bflo(wv.x), bfhi(wv.x), bflo(wv.y), bfhi(wv.y), bflo(wv.z), bfhi(wv.z), bflo(wv.w), bfhi(wv.w)};
#pragma unroll
                for (int b = 0; b < 8; ++b)
#pragma unroll
                    for (int i = 0; i < 8; ++i) acc[b] += sh2[b * 1024 + k0 + i] * wf[i];
            }
#pragma unroll
            for (int b = 0; b < 8; ++b) { float s = wave_sum(acc[b]); if (lane == 0) bias[b * 2048 + n] = s; }
        }
    }
}
__device__ __forceinline__ void mapt_assemble(const Params& P, int wgi, int nwg) {
    const int tid = threadIdx.x;
    {
        const float* Kt = (const float*)(P.ws + WS_KTAB);
        bf16_t* Mp = (bf16_t*)(P.ws + WS_MAPT);
        const int nthr = nwg * 512;
#pragma unroll 4
        for (int i8 = wgi * 512 + tid; i8 < 32 * 512 * 64; i8 += nthr) {
            const int g = i8 >> 15, row = (i8 >> 6) & 511, ch = i8 & 63; const int t = row >> 4, p = row & 15, s = ch >> 1, q8 = (ch & 1) * 8;
            f32x4 a0 = (f32x4){0.f, 0.f, 0.f, 0.f}, a1 = a0;
            if (t >= s) { const float* kp = Kt + ((size_t)((g * 2 + 0) * 32 + (t - s)) * 256 + p * 16 + q8); a0 = a0 + *(const f32x4*)kp; a1 = a1 + *(const f32x4*)(kp + 4); }
            if (s >= t) { const float* kp = Kt + ((size_t)((g * 2 + 1) * 32 + (s - t)) * 256 + p * 16 + q8); a0 = a0 + *(const f32x4*)kp; a1 = a1 + *(const f32x4*)(kp + 4); }
            u32x4 o; o.x = cvt_pk_bf16(a0.x, a0.y); o.y = cvt_pk_bf16(a0.z, a0.w); o.z = cvt_pk_bf16(a1.x, a1.y); o.w = cvt_pk_bf16(a1.z, a1.w);
            *(u32x4*)(Mp + ((size_t)(g * 512 + row) * 768 + s * 16 + q8)) = o;
        }
    }
}
__device__ __forceinline__ void phase2(const Params& P, LAS unsigned char* lds) {
    const int wg = blockIdx.x;
    const int wgid = (wg & 7) * 32 + (wg >> 3);
    const int pm = (wgid >> 5) * 8 + (wgid & 7), pn = (wgid & 31) >> 3;
    pg8::Gemm g{1024, 1024, 1024};
    pg8::Unit u{(const char*)((const bf16_t*)(P.ws + WS_XB) + (size_t)pm * 256 * 1024), (const char*)((const bf16_t*)(P.ws + WS_W1T) + (size_t)pn * 256 * 1024), pm, pn, 0};
    EpiU E{(bf16_t*)(P.ws + WS_AEXT), (bf16_t*)(P.ws + WS_FB), -1};
    pg8::gemm_unit<EpiU>(lds, g, u, E);
    mapt_assemble(P, wg, gridDim.x);
}

constexpr size_t WS_FOLD = WS_XB;
constexpr size_t WS_YGELU = WS_FB;
constexpr size_t WS_MIXIN = WS_XB;
struct EpiGT {
    static constexpr bool PERM = true, AFTER_DRAIN = false;
    bf16_t* gt;
    __device__ __forceinline__ void operator()(const f32x4 (&acc)[2][2][4][2], const pg8::Unit& u, int wr, int wc, int fr, int fq) const {
        const int b = u.pn >> 2;
#pragma unroll
        for (int ai = 0; ai < 2; ++ai)
#pragma unroll
            for (int m = 0; m < 4; ++m) {
                const int chp = u.pm * 256 + 128 * ai + 64 * wr + 16 * m + fr;
#pragma unroll
                for (int bj = 0; bj < 2; ++bj) {
                    const int l = (u.pn & 3) * 256 + 128 * bj + 32 * wc + 8 * fq;
                    const f32x4 v0 = acc[ai][bj][m][0], v1 = acc[ai][bj][m][1];
                    u32x4 w; w.x = cvt_pk_bf16(v0.x, v0.y); w.y = cvt_pk_bf16(v0.z, v0.w); w.z = cvt_pk_bf16(v1.x, v1.y); w.w = cvt_pk_bf16(v1.z, v1.w);
                    *(u32x4*)(gt + ((size_t)((b * 512 + (chp & 511)) * 2 + (chp >> 9)) * 1024 + l)) = w;
                }
            }
    }
};
struct EpiE {
    static constexpr bool PERM = false, AFTER_DRAIN = false;
    float* base;
    __device__ __forceinline__ void operator()(const f32x4 (&acc)[2][2][4][2], const pg8::Unit& u, int wr, int wc, int fr, int fq) const {
#pragma unroll
        for (int ai = 0; ai < 2; ++ai)
#pragma unroll
            for (int m = 0; m < 4; ++m) {
                const int rt = 128 * ai + 64 * wr + 16 * m + fr;
#pragma unroll
                for (int bj = 0; bj < 2; ++bj)
#pragma unroll
                    for (int n = 0; n < 2; ++n) *(f32x4*)(base + (size_t)rt * 256 + 128 * bj + 32 * wc + 16 * n + 4 * fq) = acc[ai][bj][m][n];
            }
    }
};
__device__ __forceinline__ unsigned bf2_add(unsigned a, unsigned b, float sg) { return cvt_pk_bf16(bflo(a) + sg * bflo(b), bfhi(a) + sg * bfhi(b)); }
__device__ __forceinline__ void phase3(const Params& P, LAS unsigned char* lds) {
    const int wg = blockIdx.x;
    if (wg < 128) {
        const int pm = wg & 3, pn = wg >> 2; const int b = pn >> 2, lbase = (pn & 3) * 256;
        const bf16_t* fb = (const bf16_t*)(P.ws + WS_FB) + (size_t)b * 2048 * 512;
        pg8::Gemm g{1024, 512, 1024};
        pg8::Unit u{(const char*)((const bf16_t*)(P.ws + WS_WCST) + (size_t)pm * 256 * 1024), (const char*)(fb + (size_t)lbase * 512), pm, pn, 0};
        u.b_alt = (const char*)(fb + (size_t)(2048 - lbase - 255) * 512);
        u.alt_from = 8;
        if (lbase == 0) { u.alt_zero_row = 0; u.alt_zero_off = (unsigned)((const char*)(P.ws + WS_MISC + MISC_ZROW) - (u.b_alt + (size_t)128 * 512 * 2)); }
        EpiGT E{(bf16_t*)(P.ws + WS_GT)};
        pg8::gemm_unit<EpiGT>(lds, g, u, E);
    } else if (wg < 224) {
        const int w2 = wg - 128; const int gg = w2 / 3, mt = w2 % 3;
        pg8::Gemm g{768, 512, 512};
        pg8::Unit u{(const char*)((const bf16_t*)(P.ws + WS_AEXT) + (size_t)(gg * 768 + mt * 256) * 768), (const char*)((const bf16_t*)(P.ws + WS_WENDT) + (size_t)gg * 256 * 512), mt, 0, gg};
        EpiE E{(float*)(P.ws + WS_E) + (size_t)(gg * 768 + mt * 256) * 256};
        pg8::gemm_unit<EpiE>(lds, g, u, E);
    }
    if (wg >= 128) { __syncthreads(); p3_extra(P, lds, wg - 128, 128); }
    {
        const int lane = threadIdx.x & 63, wave = threadIdx.x >> 6;
        float* ecv = (float*)(P.ws + WS_MISC + MISC_EC);
        const bf16_t* WcsT = (const bf16_t*)(P.ws + WS_WCST); const bf16_t* fb = (const bf16_t*)(P.ws + WS_FB);
#pragma unroll
        for (int q = 0; q < 2; ++q) {
            const int ent = wg * 16 + wave * 2 + q; const int b = ent >> 9, ch = ent & 511, gq = ch >> 7;
            const unsigned fw = *(const unsigned*)(fb + ((size_t)b * 2048 + 1024) * 512 + gq * 128 + 2 * lane);
            const unsigned ww = *(const unsigned*)(WcsT + (size_t)ch * 1024 + gq * 128 + 2 * lane);
            float e = bflo(fw) * bflo(ww) + bfhi(fw) * bfhi(ww);
            e = wave_sum(e);
            if (lane == 0) ecv[ent] = e;
        }
    }
}
struct EpiY {
    static constexpr bool PERM = true, AFTER_DRAIN = false;
    const bf16_t* arow; const float* dskip; bf16_t* yg; int g, mt, nt;
    __device__ __forceinline__ void operator()(const f32x4 (&acc)[2][2][4][2], const pg8::Unit& u, int wr, int wc, int fr, int fq) const {
        f32x4 d0[2], d1[2];
#pragma unroll
        for (int bj = 0; bj < 2; ++bj) { const int p0 = (nt * 256 + 128 * bj + 32 * wc + 8 * fq) & 15; d0[bj] = *(const f32x4*)(dskip + g * 16 + p0); d1[bj] = *(const f32x4*)(dskip + g * 16 + p0 + 4); }
#pragma unroll
        for (int ai = 0; ai < 2; ++ai) {
            u32x4 uv[4][2];
#pragma unroll
            for (int m = 0; m < 4; ++m)
#pragma unroll
                for (int bj = 0; bj < 2; ++bj) {
                    const int row = mt * 256 + 128 * ai + 64 * wr + 16 * m + fr; const int col0 = nt * 256 + 128 * bj + 32 * wc + 8 * fq;
                    uv[m][bj] = *(const u32x4*)(arow + (size_t)row * 768 + col0);
                }
#pragma unroll
            for (int m = 0; m < 4; ++m) {
                const int row = mt * 256 + 128 * ai + 64 * wr + 16 * m + fr; const int b = row >> 6, c = row & 63;
#pragma unroll
                for (int bj = 0; bj < 2; ++bj) {
                    const int col0 = nt * 256 + 128 * bj + 32 * wc + 8 * fq; const int t = col0 >> 4, p0 = col0 & 15;
                    const u32x4 uq = uv[m][bj];
                    const f32x4 v0 = acc[ai][bj][m][0], v1 = acc[ai][bj][m][1];
                    float y[8] = {v0.x + d0[bj].x * bflo(uq.x), v0.y + d0[bj].y * bfhi(uq.x), v0.z + d0[bj].z * bflo(uq.y), v0.w + d0[bj].w * bfhi(uq.y),
                                  v1.x + d1[bj].x * bflo(uq.z), v1.y + d1[bj].y * bfhi(uq.z), v1.z + d1[bj].z * bflo(uq.w), v1.w + d1[bj].w * bfhi(uq.w)};
#pragma unroll
                    for (int i = 0; i < 8; ++i) y[i] = gelu_tanh(y[i]);
                    u32x4 w; w.x = cvt_pk_bf16(y[0], y[1]); w.y = cvt_pk_bf16(y[2], y[3]); w.z = cvt_pk_bf16(y[4], y[5]); w.w = cvt_pk_bf16(y[6], y[7]);
                    const size_t tok = (size_t)b * 2048 + c * 32 + t;
                    *(u32x4*)(yg + tok * 512 + g * 16 + p0) = w;
                }
            }
        }
    }
};
struct EpiP {
    static constexpr bool PERM = true, AFTER_DRAIN = false;
    bf16_t* base;
    __device__ __forceinline__ void operator()(const f32x4 (&acc)[2][2][4][2], const pg8::Unit& u, int wr, int wc, int fr, int fq) const {
#pragma unroll
        for (int ai = 0; ai < 2; ++ai)
#pragma unroll
            for (int m = 0; m < 4; ++m) {
                const int rt = 128 * ai + 64 * wr + 16 * m + fr;
#pragma unroll
                for (int bj = 0; bj < 2; ++bj) {
                    const f32x4 v0 = acc[ai][bj][m][0], v1 = acc[ai][bj][m][1];
                    u32x4 w; w.x = cvt_pk_bf16(v0.x, v0.y); w.y = cvt_pk_bf16(v0.z, v0.w); w.z = cvt_pk_bf16(v1.x, v1.y); w.w = cvt_pk_bf16(v1.z, v1.w);
                    *(u32x4*)(base + (size_t)rt * 512 + 128 * bj + 32 * wc + 8 * fq) = w;
                }
            }
    }
};
__device__ __forceinline__ void s5_carry(const Params& P, int g, int mt) {
    const int tid = threadIdx.x; const int bl = tid >> 7, dir = (tid >> 6) & 1, n = tid & 63; const int b = mt * 4 + bl;
    const int dg = dir * 32 + g, i = dg * 64 + n;
    const float dt = expf(P.log_dt[dg]); const float lr = P.lam_re[i], li = P.lam_im[i];
    const float mag = expf(32.0f * lr * dt), ang = 32.0f * (li * dt);
    const float atr = mag * cosf(ang), ati = mag * sinf(ang);
    const float* Eg = (const float*)(P.ws + WS_E) + (size_t)g * 768 * 256 + dir * 128 + n * 2;
    bf16_t* Ag = (bf16_t*)(P.ws + WS_AEXT) + (size_t)g * 768 * 768 + 512 + dir * 128 + n * 2;
    float hr = 0.f, hi = 0.f;
    f32x2 ec[8], el[64];
#pragma unroll
    for (int k = 0; k < 8; ++k) { const int cp = dir ? 7 - k : k; ec[k] = *(const f32x2*)(Eg + (size_t)(512 + b * 8 + cp) * 256); }
#pragma unroll
    for (int k = 0; k < 64; ++k) { const int c = dir ? 63 - k : k; el[k] = *(const f32x2*)(Eg + (size_t)(b * 64 + c) * 256); }
#pragma unroll
    for (int k = 0; k < 8; ++k) { const float nr = atr * hr - ati * hi + ec[k].x, ni = atr * hi + ati * hr + ec[k].y; hr = nr; hi = ni; }
#pragma unroll
    for (int k = 0; k < 64; ++k) {
        const int c = dir ? 63 - k : k;
        *(unsigned*)(Ag + (size_t)(b * 64 + c) * 768) = cvt_pk_bf16(hr, hi);
        const float nr = atr * hr - ati * hi + el[k].x, ni = atr * hi + ati * hr + el[k].y; hr = nr; hi = ni;
    }
}
__device__ __forceinline__ void phase4(const Params& P, LAS unsigned char* lds) {
    const int wg = blockIdx.x;
    tp_b(wg < 128 ? 40 : 41, lds);
    if (wg < 128) {
        const int gg = wg >> 2, mt = (wg >> 1) & 1, nt = wg & 1;
        tp_b(42, lds);
        s5_carry(P, gg, mt);
        asm volatile("s_waitcnt vmcnt(0)" ::: "memory");
        __syncthreads();
        tp_e(42, lds); tp_b(43, lds);
        const bf16_t* Ag = (const bf16_t*)(P.ws + WS_AEXT) + (size_t)gg * 768 * 768;
        pg8::Gemm g{768, 768, 768};
        pg8::Unit u{(const char*)(Ag + (size_t)mt * 256 * 768), (const char*)((const bf16_t*)(P.ws + WS_MAPT) + (size_t)(gg * 512 + nt * 256) * 768), mt, nt, gg};
        EpiY E{Ag, P.s5_d, (bf16_t*)(P.ws + WS_YGELU), gg, mt, nt};
        pg8::gemm_unit<EpiY>(lds, g, u, E);
        tp_e(43, lds);
    }
    else {
        const int idx = wg - 128; const int b = idx & 7, j = idx >> 3; const int cs = j >> 3, mt = (j >> 1) & 3, nt = j & 1;
        pg8::Gemm g{1024, 2048, 1024};
        pg8::Unit u{(const char*)((const bf16_t*)(P.ws + WS_CS) + (size_t)(cs * 1024 + mt * 256) * 1024),
                    (const char*)((const bf16_t*)(P.ws + WS_GT) + ((size_t)(b * 512 + nt * 256) * 2 + cs) * 1024), mt, nt, b};
        EpiP E{(bf16_t*)(P.ws + WS_CSPART) + ((size_t)(cs * 8 + b) * 1024 + mt * 256) * 512 + nt * 256};
        pg8::gemm_unit<EpiP>(lds, g, u, E);
        utable_to_i8(P, wg - 128, 128);
    }
    tp_e(wg < 128 ? 40 : 41, lds);
    {
        const int lane = threadIdx.x & 63, wave = threadIdx.x >> 6;
        const float* ecv = (const float*)(P.ws + WS_MISC + MISC_EC); float* o1024 = (float*)(P.ws + WS_MISC + MISC_O1024);
        const bf16_t* GT = (const bf16_t*)(P.ws + WS_GT);
#pragma unroll
        for (int q = 0; q < 2; ++q) {
            const int ent = wg * 16 + wave * 2 + q; const int b = ent >> 9, ch = ent & 511;
            const u32x4 g0 = *(const u32x4*)(GT + (size_t)(b * 512 + ch) * 2048 + 16 * lane), g1 = *(const u32x4*)(GT + (size_t)(b * 512 + ch) * 2048 + 16 * lane + 8);
            float s = (bflo(g0.x) - bfhi(g0.x)) + (bflo(g0.y) - bfhi(g0.y)) + (bflo(g0.z) - bfhi(g0.z)) + (bflo(g0.w) - bfhi(g0.w))
                    + (bflo(g1.x) - bfhi(g1.x)) + (bflo(g1.y) - bfhi(g1.y)) + (bflo(g1.z) - bfhi(g1.z)) + (bflo(g1.w) - bfhi(g1.w));
            s = wave_sum(s);
            if (lane == 0) o1024[ent] = s + ecv[ent];
        }
    }
}
struct EpiGlu {
    static constexpr bool PERM = true, AFTER_DRAIN = false;
    const bf16_t* yg; const float* bglu; bf16_t* mixin;
    __device__ __forceinline__ void operator()(const f32x4 (&acc)[2][2][4][2], const pg8::Unit& u, int wr, int wc, int fr, int fq) const {
        f32x4 b0[2], b1[2];
#pragma unroll
        for (int bj = 0; bj < 2; ++bj) { const int c0 = u.pn * 256 + 128 * bj + 32 * wc + 8 * fq; b0[bj] = *(const f32x4*)(bglu + c0); b1[bj] = *(const f32x4*)(bglu + c0 + 4); }
#pragma unroll
        for (int ai = 0; ai < 2; ++ai) {
            u32x4 yv[4][2];
#pragma unroll
            for (int m = 0; m < 4; ++m)
#pragma unroll
                for (int bj = 0; bj < 2; ++bj) {
                    const size_t r = (size_t)u.pm * 256 + 128 * ai + 64 * wr + 16 * m + fr; const int c0 = u.pn * 256 + 128 * bj + 32 * wc + 8 * fq;
                    yv[m][bj] = *(const u32x4*)(yg + r * 512 + c0);
                }
#pragma unroll
            for (int m = 0; m < 4; ++m) {
                const size_t r = (size_t)u.pm * 256 + 128 * ai + 64 * wr + 16 * m + fr;
#pragma unroll
                for (int bj = 0; bj < 2; ++bj) {
                    const int c0 = u.pn * 256 + 128 * bj + 32 * wc + 8 * fq;
                    const u32x4 yq = yv[m][bj];
                    const f32x4 v0 = acc[ai][bj][m][0] + b0[bj], v1 = acc[ai][bj][m][1] + b1[bj];
                    float s[8] = {bflo(yq.x) * sigmoidf_(v0.x), bfhi(yq.x) * sigmoidf_(v0.y), bflo(yq.y) * sigmoidf_(v0.z), bfhi(yq.y) * sigmoidf_(v0.w),
                                  bflo(yq.z) * sigmoidf_(v1.x), bfhi(yq.z) * sigmoidf_(v1.y), bflo(yq.w) * sigmoidf_(v1.z), bfhi(yq.w) * sigmoidf_(v1.w)};
                    u32x4 w; w.x = cvt_pk_bf16(s[0], s[1]); w.y = cvt_pk_bf16(s[2], s[3]); w.z = cvt_pk_bf16(s[4], s[5]); w.w = cvt_pk_bf16(s[6], s[7]);
                    *(u32x4*)(mixin + r * 1024 + c0) = w;
                }
            }
        }
    }
};
__device__ __forceinline__ void phase5(const Params& P, LAS unsigned char* lds) {
    const int wg = blockIdx.x;
    tp_b(wg < 128 ? 50 : 51, lds);
    bf16_t* mixin = (bf16_t*)(P.ws + WS_MIXIN);
    if (wg < 128) {
        const int pm = wg >> 1, pn = wg & 1;
        const bf16_t* yg = (const bf16_t*)(P.ws + WS_YGELU);
        pg8::Gemm g{512, 512, 512};
        pg8::Unit u{(const char*)(yg + (size_t)pm * 256 * 512), (const char*)((const bf16_t*)(P.ws + WS_WGLUT) + (size_t)pn * 256 * 512), pm, pn, 0};
        EpiGlu E{yg, P.b_glu, mixin};
        pg8::gemm_unit<EpiGlu>(lds, g, u, E);
    } else {
        const bf16_t* Cp = (const bf16_t*)(P.ws + WS_CSPART); const bf16_t* Sp = Cp + (size_t)8 * 1024 * 512;
        const float* ecv = (const float*)(P.ws + WS_MISC + MISC_EC); const float* o1024 = (const float*)(P.ws + WS_MISC + MISC_O1024);
        for (int i8 = (wg - 128) * 512 + threadIdx.x; i8 < NTOK * 64; i8 += 128 * 512) {
            const int tok = i8 >> 6, ch = (i8 & 63) * 8; const int b = tok >> 11, k = tok & 2047;
            const f32x4 e0 = *(const f32x4*)(ecv + b * 512 + ch), e1 = *(const f32x4*)(ecv + b * 512 + ch + 4);
            float v[8];
            if (k == 1024) {
                const f32x4 o0 = *(const f32x4*)(o1024 + b * 512 + ch), o1 = *(const f32x4*)(o1024 + b * 512 + ch + 4);
                v[0] = o0.x; v[1] = o0.y; v[2] = o0.z; v[3] = o0.w; v[4] = o1.x; v[5] = o1.y; v[6] = o1.z; v[7] = o1.w;
            } else {
                const int kk = (k < 1024) ? k : 2048 - k; const float sg = (k < 1024) ? 1.0f : -1.0f, se = (kk & 1) ? -1.0f : 1.0f;
                const u32x4 c = *(const u32x4*)(Cp + ((size_t)b * 1024 + kk) * 512 + ch), s = *(const u32x4*)(Sp + ((size_t)b * 1024 + kk) * 512 + ch);
                v[0] = bflo(c.x) + sg * bflo(s.x) + se * e0.x; v[1] = bfhi(c.x) + sg * bfhi(s.x) + se * e0.y; v[2] = bflo(c.y) + sg * bflo(s.y) + se * e0.z; v[3] = bfhi(c.y) + sg * bfhi(s.y) + se * e0.w;
                v[4] = bflo(c.z) + sg * bflo(s.z) + se * e1.x; v[5] = bfhi(c.z) + sg * bfhi(s.z) + se * e1.y; v[6] = bflo(c.w) + sg * bflo(s.w) + se * e1.z; v[7] = bfhi(c.w) + sg * bfhi(s.w) + se * e1.w;
            }
            u32x4 w; w.x = cvt_pk_bf16(v[0], v[1]); w.y = cvt_pk_bf16(v[2], v[3]); w.z = cvt_pk_bf16(v[4], v[5]); w.w = cvt_pk_bf16(v[6], v[7]);
            *(u32x4*)(mixin + (size_t)tok * 1024 + 512 + ch) = w;
        }
        vtable_to_fp8(P, wg - 128, 128);
    }
    tp_e(blockIdx.x < 128 ? 50 : 51, lds);
}
constexpr size_t WS_X1B = WS_AEXT;
constexpr size_t WS_X1H = WS_GT;
constexpr size_t WS_PAIRS = WS_XB;
constexpr size_t MISC_SS = 1024 * 1024;
struct EpiOut {
    static constexpr bool PERM = false, AFTER_DRAIN = false;
    const float* x; const float* postab; bf16_t* x1h; const float* mod; const float* g2n; bf16_t* x1b; float* sspart;
    __device__ __forceinline__ void operator()(const f32x4 (&acc)[2][2][4][2], const pg8::Unit& u, int wr, int wc, int fr, int fq) const {
        const int b = (u.pm * 256) >> 11;
        const float* mrow = mod + (size_t)b * NMOD;
        f32x4 gA[2][2], gB[2][2];
#pragma unroll
        for (int bj = 0; bj < 2; ++bj)
#pragma unroll
            for (int n = 0; n < 2; ++n) {
                const int col = u.pn * 256 + 128 * bj + 32 * wc + 16 * n + 4 * fq;
                gA[bj][n] = *(const f32x4*)(mrow + 2 * 1024 + col);
                gB[bj][n] = *(const f32x4*)(g2n + col) * (*(const f32x4*)(mrow + 4 * 1024 + col) + 1.0f);
            }
#pragma unroll
        for (int ai = 0; ai < 2; ++ai)
#pragma unroll
            for (int m = 0; m < 4; ++m) {
                const size_t r = (size_t)u.pm * 256 + 128 * ai + 64 * wr + 16 * m + fr; const int t = (int)(r & 2047);
                const float* prow = postab + (size_t)((u.pn < 2) ? (t >> 6) : (32 + (t & 63))) * 512 + (u.pn & 1) * 256;
                f32x4 xp[2][2];
#pragma unroll
                for (int bj = 0; bj < 2; ++bj)
#pragma unroll
                    for (int n = 0; n < 2; ++n) { const int cl = 128 * bj + 32 * wc + 16 * n + 4 * fq;
                        xp[bj][n] = *(const f32x4*)(x + r * 1024 + u.pn * 256 + cl) + *(const f32x4*)(prow + cl); }
                float ss = 0.f;
#pragma unroll
                for (int bj = 0; bj < 2; ++bj)
#pragma unroll
                    for (int n = 0; n < 2; ++n) {
                        const int col = u.pn * 256 + 128 * bj + 32 * wc + 16 * n + 4 * fq;
                        const f32x4 x1 = xp[bj][n] + gA[bj][n] * acc[ai][bj][m][n];
                        ss += (x1.x * x1.x + x1.y * x1.y) + (x1.z * x1.z + x1.w * x1.w);
                        const f32x4 hb = x1 * gB[bj][n];
                        u32x2 o, oh; o.x = cvt_pk_bf16(hb.x, hb.y); o.y = cvt_pk_bf16(hb.z, hb.w); oh.x = cvt_pk_bf16(x1.x, x1.y); oh.y = cvt_pk_bf16(x1.z, x1.w);
                        *(u32x2*)(x1h + r * 1024 + col) = oh;
                        *(u32x2*)(x1b + r * 1024 + col) = o;
                    }
                ss += __shfl_xor(ss, 16); ss += __shfl_xor(ss, 32);
                if (fq == 0) sspart[r * 16 + u.pn * 4 + wc] = ss;
                if (m & 1) asm volatile("" ::: "memory");
            }
    }
};
__device__ __forceinline__ void phase6(const Params& P, LAS unsigned char* lds) {
    const int wg = blockIdx.x;
    const int wgid = (wg & 7) * 32 + (wg >> 3);
    const int pm = (wgid >> 5) * 8 + (wgid & 7), pn = (wgid & 31) >> 3;
    pg8::Gemm g{1024, 1024, 1024};
    pg8::Unit u{(const char*)((const bf16_t*)(P.ws + WS_MIXIN) + (size_t)pm * 256 * 1024), (const char*)((const bf16_t*)(P.ws + WS_WOUTT) + (size_t)pn * 256 * 1024), pm, pn, 0};
    EpiOut E{P.x, (const float*)(P.ws + WS_MISC + MISC_POS), (bf16_t*)(P.ws + WS_X1H), (const float*)(P.ws + WS_MISC + MISC_MOD), P.norm2_g, (bf16_t*)(P.ws + WS_X1B), (float*)(P.ws + WS_MISC + MISC_SS)};
    pg8::gemm_unit<EpiOut>(lds, g, u, E);
}
__device__ __forceinline__ unsigned key_pack(float v, unsigned tag, unsigned mask) {
    unsigned b = __float_as_uint(v); b ^= (b >> 31) ? 0xffffffffu : 0x80000000u; return (b & ~mask) | tag;
}
__device__ __forceinline__ float key_val(unsigned k, unsigned mask) { unsigned b = k & ~mask; b ^= (b >> 31) ? 0x80000000u : 0xffffffffu; return __uint_as_float(b); }
__device__ const unsigned char CAND_TAB[64] = {0,1,2,3,4,5,6,7,8,9,10,11,12,13,14,15,16,17,18,19,20,21,22,23,32,33,34,35,36,48,49,50,51,64,65,66,80,81,96,97,112,113,128,144,160,176,192,208,224,240,
    255,255,255,255,255,255,255,255,255,255,255,255,255,255};
#define DPP_ROR(v, n) ((unsigned)__builtin_amdgcn_update_dpp(0, (int)(v), 0x120 + (n), 0xf, 0xf, false))
__device__ __forceinline__ unsigned row_umax(unsigned m) {
    unsigned t;
    t = DPP_ROR(m, 8); m = m > t ? m : t; t = DPP_ROR(m, 4); m = m > t ? m : t; t = DPP_ROR(m, 2); m = m > t ? m : t; t = DPP_ROR(m, 1); m = m > t ? m : t;
    return m;
}
__device__ __forceinline__ float row_fsum(float s) {
    s += __int_as_float(__builtin_amdgcn_update_dpp(0, __float_as_int(s), 0x128, 0xf, 0xf, false));
    s += __int_as_float(__builtin_amdgcn_update_dpp(0, __float_as_int(s), 0x124, 0xf, 0xf, false));
    s += __int_as_float(__builtin_amdgcn_update_dpp(0, __float_as_int(s), 0x122, 0xf, 0xf, false));
    s += __int_as_float(__builtin_amdgcn_update_dpp(0, __float_as_int(s), 0x121, 0xf, 0xf, false));
    return s;
}
#define CE(a, b) do { const unsigned hi_ = (a) > (b) ? (a) : (b), lo_ = (a) > (b) ? (b) : (a); (a) = hi_; (b) = lo_; } while (0)
__device__ __forceinline__ unsigned row_top16_of128(unsigned (&k)[8], int l16) {
    CE(k[0], k[1]); CE(k[2], k[3]); CE(k[0], k[2]); CE(k[1], k[3]); CE(k[1], k[2]); CE(k[4], k[5]); CE(k[6], k[7]); CE(k[4], k[6]); CE(k[5], k[7]); CE(k[5], k[6]); CE(k[0], k[4]); CE(k[2], k[6]); CE(k[2], k[4]); CE(k[1], k[5]); CE(k[3], k[7]); CE(k[3], k[5]); CE(k[1], k[2]); CE(k[3], k[4]); CE(k[5], k[6]);
    unsigned mine = 0u;
#pragma unroll
    for (int q = 0; q < 16; ++q) {
        const unsigned m = row_umax(k[0]);
        const bool own = (k[0] == m);
#pragma unroll
        for (int i = 0; i < 7; ++i) k[i] = own ? k[i + 1] : k[i];
        k[7] = own ? 0u : k[7];
        mine = (l16 == q) ? m : mine;
    }
    return mine;
}
__device__ __forceinline__ void row_top16_of128_x2(unsigned (&a)[8], unsigned (&b)[8], int l16, unsigned& ma, unsigned& mb) {
    CE(a[0], a[1]); CE(b[0], b[1]); CE(a[2], a[3]); CE(b[2], b[3]); CE(a[0], a[2]); CE(b[0], b[2]); CE(a[1], a[3]); CE(b[1], b[3]); CE(a[1], a[2]); CE(b[1], b[2]); CE(a[4], a[5]); CE(b[4], b[5]); CE(a[6], a[7]); CE(b[6], b[7]); CE(a[4], a[6]); CE(b[4], b[6]); CE(a[5], a[7]); CE(b[5], b[7]); CE(a[5], a[6]); CE(b[5], b[6]); CE(a[0], a[4]); CE(b[0], b[4]); CE(a[2], a[6]); CE(b[2], b[6]); CE(a[2], a[4]); CE(b[2], b[4]); CE(a[1], a[5]); CE(b[1], b[5]); CE(a[3], a[7]); CE(b[3], b[7]); CE(a[3], a[5]); CE(b[3], b[5]); CE(a[1], a[2]); CE(b[1], b[2]); CE(a[3], a[4]); CE(b[3], b[4]); CE(a[5], a[6]); CE(b[5], b[6]);
    unsigned minea = 0u, mineb = 0u;
#pragma unroll
    for (int q = 0; q < 16; ++q) {
        const unsigned xa = row_umax(a[0]), xb = row_umax(b[0]);
        const bool owna = (a[0] == xa), ownb = (b[0] == xb);
#pragma unroll
        for (int i = 0; i < 7; ++i) { a[i] = owna ? a[i + 1] : a[i]; b[i] = ownb ? b[i + 1] : b[i]; }
        a[7] = owna ? 0u : a[7]; b[7] = ownb ? 0u : b[7];
        minea = (l16 == q) ? xa : minea; mineb = (l16 == q) ? xb : mineb;
    }
    ma = minea; mb = mineb;
}
__device__ __forceinline__ unsigned row_top16_of64(unsigned (&k)[4], int l16) {
    CE(k[0], k[1]); CE(k[2], k[3]); CE(k[0], k[2]); CE(k[1], k[3]); CE(k[1], k[2]);
    unsigned mine = 0u;
#pragma unroll
    for (int q = 0; q < 16; ++q) {
        const unsigned m = row_umax(k[0]);
        const bool own = (k[0] == m);
        k[0] = own ? k[1] : k[0]; k[1] = own ? k[2] : k[1]; k[2] = own ? k[3] : k[2]; k[3] = own ? 0u : k[3];
        mine = (l16 == q) ? m : mine;
    }
    return mine;
}
struct EpiTopk {
    static constexpr bool PERM = false, AFTER_DRAIN = true;
    const float* sspart; const float* bias; int* pexp; float* pw; int head;
    __device__ __forceinline__ void fused(const f32x4 (&acc)[2][2][4][2], const pg8::Unit& u, int wr, int wc, int fr, int fq, LAS unsigned char* lds, int wid, int lane) const {
        LAS float* S = (LAS float*)lds;
        tp_e(30, lds); tp_b(31, lds);
        LAS unsigned* TL = (LAS unsigned*)(lds + 133120) + wid * 128;
        const int dr = lane >> 4, l16 = lane & 15;
        unsigned cc[4];
#pragma unroll
        for (int k = 0; k < 4; ++k) cc[k] = CAND_TAB[l16 * 4 + k];
        const LAS float* INV = (const LAS float*)(lds + 138240);
        const LAS float* BSL = (const LAS float*)(lds + 139264);
#pragma unroll
        for (int ai = 0; ai < 2; ++ai) {
#pragma unroll
            for (int m = 0; m < 4; ++m) {
                const int rl = 64 * wr + 16 * m + fr; const float inv = INV[128 * ai + rl];
#pragma unroll
                for (int bj = 0; bj < 2; ++bj)
#pragma unroll
                    for (int n = 0; n < 2; ++n) {
                        const int c = 128 * bj + 32 * wc + 16 * n + 4 * fq;
                        const f32x4 s = acc[ai][bj][m][n] * inv + *(const LAS f32x4*)(BSL + c);
                        *(LAS f32x4*)(S + rl * 260 + c) = s;
                    }
            }
            __syncthreads();
            tp_e(31, lds); tp_b(32, lds);
            for (int bt = 0; bt < 4; ++bt) {
#pragma unroll
                for (int half = 0; half < 2; ++half) {
                    const int trow = wid * 16 + bt * 4 + half * 2 + (dr >> 1), side = dr & 1;
                    const LAS f32x4* sp = (const LAS f32x4*)(S + trow * 260 + side * 128 + 8 * l16);
                    const f32x4 v0 = sp[0], v1 = sp[1];
                    unsigned k[8];
                    const unsigned tg = 127u - 8u * (unsigned)l16;
                    k[0] = key_pack(v0.x, tg, 127u); k[1] = key_pack(v0.y, tg - 1u, 127u); k[2] = key_pack(v0.z, tg - 2u, 127u); k[3] = key_pack(v0.w, tg - 3u, 127u);
                    k[4] = key_pack(v1.x, tg - 4u, 127u); k[5] = key_pack(v1.y, tg - 5u, 127u); k[6] = key_pack(v1.z, tg - 6u, 127u); k[7] = key_pack(v1.w, tg - 7u, 127u);
                    const unsigned mine = row_top16_of128(k, l16);
                    TL[(half * 2 + (dr >> 1)) * 32 + side * 16 + l16] = mine;
                }
                asm volatile("s_waitcnt lgkmcnt(0)" ::: "memory");
                unsigned ck[4];
#pragma unroll
                for (int k = 0; k < 4; ++k) {
                    const unsigned code = cc[k]; const unsigned ci = (code >> 4) & 15u, cj = code & 15u;
                    const unsigned ka = TL[dr * 32 + ci], kb = TL[dr * 32 + 16 + cj];
                    const unsigned key = key_pack(key_val(ka, 127u) + key_val(kb, 127u), 255u - code, 255u);
                    ck[k] = (code == 255u) ? 0u : key;
                }
                const unsigned best = row_top16_of64(ck, l16);
                const unsigned flat = 255u - (best & 255u);
                const float bv = key_val(best, 255u);
                const float bmax = key_val(row_umax(best), 255u);
                const float e = expf(bv - bmax);
                const float sum = row_fsum(e);
                const unsigned k1s = TL[dr * 32 + (flat >> 4)], k2s = TL[dr * 32 + 16 + (flat & 15u)];
                const int idx1 = 127 - (int)(k1s & 127u), idx2 = 127 - (int)(k2s & 127u);
                const size_t tok = (size_t)u.pm * 256 + 128 * ai + wid * 16 + bt * 4 + dr;
                pexp[tok * 128 + head * 16 + l16] = idx1 * 128 + idx2; pw[tok * 128 + head * 16 + l16] = e / sum;
                asm volatile("s_waitcnt lgkmcnt(0)" ::: "memory");
            }
            tp_e(32, lds); tp_b(31, lds);
            __syncthreads();
        }
        tp_e(31, lds);
    }
};
__device__ __forceinline__ void phase7(const Params& P, LAS unsigned char* lds) {
    const int wg = blockIdx.x; const int x = wg & 7, li = wg >> 3;
    {
        const int pm0 = 8 * x + (li & 7);
        if (threadIdx.x < 256) {
            const float* sp = (const float*)(P.ws + WS_MISC + MISC_SS) + ((size_t)pm0 * 256 + threadIdx.x) * 16;
            const f32x4 a = *(const f32x4*)sp, b = *(const f32x4*)(sp + 4), c = *(const f32x4*)(sp + 8), d = *(const f32x4*)(sp + 12);
            const float tot = ((a.x + a.y) + (a.z + a.w)) + ((b.x + b.y) + (b.z + b.w)) + ((c.x + c.y) + (c.z + c.w)) + ((d.x + d.y) + (d.z + d.w));
            ((LAS float*)(lds + 138240))[threadIdx.x] = rsqrtf(tot * (1.0f / 1024.0f) + 1e-6f);
        }
        __syncthreads();
    }
    for (int rnd = 0; rnd < 2; ++rnd) {
        const int unit = li + 32 * rnd; const int pm = 8 * x + (unit & 7), head = unit >> 3;
        pg8::Gemm g{1024, 1024, 1024};
        pg8::Unit u{(const char*)((const bf16_t*)(P.ws + WS_X1B) + (size_t)pm * 256 * 1024), (const char*)((const bf16_t*)(P.ws + WS_WST) + (size_t)head * 256 * 1024), pm, head, 0};
        EpiTopk E{(const float*)(P.ws + WS_MISC + MISC_SS), (const float*)(P.ws + WS_MISC + MISC_BIAS), (int*)(P.ws + WS_PAIRS), (float*)(P.ws + WS_PAIRS) + (size_t)NTOK * 128, head};
        if (threadIdx.x < 64) {
            const int b = (pm * 256) >> 11;
            *(LAS f32x4*)(lds + 139264 + threadIdx.x * 16) = *(const f32x4*)((const float*)(P.ws + WS_MISC + MISC_BIAS) + (size_t)b * 2048 + head * 256 + threadIdx.x * 4);
        }
        __syncthreads();
        tp_b(30, lds);
        pg8::gemm_unit<EpiTopk>(lds, g, u, E);
    }
}
constexpr size_t WS_U8 = 216 * MiB;
constexpr size_t WS_V8 = 232 * MiB;
#define U8_SCALE 512.0f
#define V8_SCALE 16.0f
__device__ __forceinline__ unsigned pack4_fp8(f32x4 v, float sc) {
    v = v * sc;
    v.x = fminf(fmaxf(v.x, -448.f), 448.f); v.y = fminf(fmaxf(v.y, -448.f), 448.f); v.z = fminf(fmaxf(v.z, -448.f), 448.f); v.w = fminf(fmaxf(v.w, -448.f), 448.f);
    int t = __builtin_amdgcn_cvt_pk_fp8_f32(v.x, v.y, 0, false);
    t = __builtin_amdgcn_cvt_pk_fp8_f32(v.z, v.w, t, true);
    return (unsigned)t;
}
constexpr size_t MISC_SU = 2 * 1024 * 1024;
__device__ __forceinline__ unsigned pack4_i8(f32x4 v, float sc) {
    const int a = (int)rintf(v.x * sc), b = (int)rintf(v.y * sc), c = (int)rintf(v.z * sc), d = (int)rintf(v.w * sc);
    return ((unsigned)a & 255u) | (((unsigned)b & 255u) << 8) | (((unsigned)c & 255u) << 16) | ((unsigned)d << 24);
}
__device__ __forceinline__ void vtable_to_fp8(const Params& P, int wgi, int nwg) {
    const int nthr = nwg * 512;
    for (int i0 = wgi * 512 + threadIdx.x; i0 < 16384 * 64; i0 += nthr * 4) {
        f32x4 v[4][4]; bool ok[4];
#pragma unroll
        for (int q = 0; q < 4; ++q) {
            const int i = i0 + q * nthr; ok[q] = i < 16384 * 64;
            const float* src = P.v_tab + (size_t)(ok[q] ? i : i0) * 16;
#pragma unroll
            for (int j = 0; j < 4; ++j) v[q][j] = *(const f32x4*)(src + 4 * j);
        }
#pragma unroll
        for (int q = 0; q < 4; ++q) {
            const int i = i0 + q * nthr;
            if (ok[q]) { u32x4 o; o.x = pack4_fp8(v[q][0], V8_SCALE); o.y = pack4_fp8(v[q][1], V8_SCALE); o.z = pack4_fp8(v[q][2], V8_SCALE); o.w = pack4_fp8(v[q][3], V8_SCALE);
                *(u32x4*)(P.ws + WS_V8 + (size_t)i * 16) = o; }
        }
    }
}
__device__ __forceinline__ void utable_to_i8(const Params& P, int wgi, int nwg) {
    const int lane = threadIdx.x & 63, gw = wgi * 8 + (threadIdx.x >> 6), ngw = nwg * 8;
    float* su = (float*)(P.ws + WS_MISC + MISC_SU);
    for (int r0 = gw; r0 < 16384; r0 += 4 * ngw) {
        f32x4 v[4][4]; float mx[4];
#pragma unroll
        for (int q = 0; q < 4; ++q) { const int r = r0 + q * ngw; const float* src = P.u_tab + (size_t)(r < 16384 ? r : r0) * 1024 + 16 * lane;
#pragma unroll
            for (int j = 0; j < 4; ++j) v[q][j] = *(const f32x4*)(src + 4 * j); }
#pragma unroll
        for (int q = 0; q < 4; ++q) { float m = 0.f;
#pragma unroll
            for (int j = 0; j < 4; ++j) m = fmaxf(fmaxf(fmaxf(fabsf(v[q][j].x), fabsf(v[q][j].y)), fmaxf(fabsf(v[q][j].z), fabsf(v[q][j].w))), m);
            mx[q] = m; }
#pragma unroll
        for (int o = 32; o > 0; o >>= 1) {
#pragma unroll
            for (int q = 0; q < 4; ++q) mx[q] = fmaxf(mx[q], __shfl_xor(mx[q], o)); }
#pragma unroll
        for (int q = 0; q < 4; ++q) { const int r = r0 + q * ngw;
            if (r < 16384) { const float sc = mx[q] > 0.f ? 127.0f / mx[q] : 0.f;
                u32x4 o; o.x = pack4_i8(v[q][0], sc); o.y = pack4_i8(v[q][1], sc); o.z = pack4_i8(v[q][2], sc); o.w = pack4_i8(v[q][3], sc);
                *(u32x4*)(P.ws + WS_U8 + (size_t)r * 1024 + 16 * lane) = o;
                if (lane == 0) su[r] = mx[q] * (1.0f / 127.0f); } }
    }
}
__device__ __forceinline__ float dot16_fp8(const u32x4 r, const f32x2 (&h)[8]) {
    f32x2 a = __builtin_amdgcn_cvt_pk_f32_fp8((int)r.x, false) * h[0];
    a = a + __builtin_amdgcn_cvt_pk_f32_fp8((int)r.x, true) * h[1];
    a = a + __builtin_amdgcn_cvt_pk_f32_fp8((int)r.y, false) * h[2];
    a = a + __builtin_amdgcn_cvt_pk_f32_fp8((int)r.y, true) * h[3];
    a = a + __builtin_amdgcn_cvt_pk_f32_fp8((int)r.z, false) * h[4];
    a = a + __builtin_amdgcn_cvt_pk_f32_fp8((int)r.z, true) * h[5];
    a = a + __builtin_amdgcn_cvt_pk_f32_fp8((int)r.w, false) * h[6];
    a = a + __builtin_amdgcn_cvt_pk_f32_fp8((int)r.w, true) * h[7];
    return a.x + a.y;
}
__device__ __forceinline__ void axpy16_fp8(const u32x4 r, const float w, f32x2 (&acc)[8]) {
    const f32x2 ww = (f32x2){w, w};
    acc[0] = acc[0] + __builtin_amdgcn_cvt_pk_f32_fp8((int)r.x, false) * ww;
    acc[1] = acc[1] + __builtin_amdgcn_cvt_pk_f32_fp8((int)r.x, true) * ww;
    acc[2] = acc[2] + __builtin_amdgcn_cvt_pk_f32_fp8((int)r.y, false) * ww;
    acc[3] = acc[3] + __builtin_amdgcn_cvt_pk_f32_fp8((int)r.y, true) * ww;
    acc[4] = acc[4] + __builtin_amdgcn_cvt_pk_f32_fp8((int)r.z, false) * ww;
    acc[5] = acc[5] + __builtin_amdgcn_cvt_pk_f32_fp8((int)r.z, true) * ww;
    acc[6] = acc[6] + __builtin_amdgcn_cvt_pk_f32_fp8((int)r.w, false) * ww;
    acc[7] = acc[7] + __builtin_amdgcn_cvt_pk_f32_fp8((int)r.w, true) * ww;
}
__device__ __forceinline__ float reduce16(float (&d)[16], int lane) {
    float a[8], b[4], c[2];
    const bool b0 = lane & 1, b1 = lane & 2, b2 = lane & 4, b3 = lane & 8;
#pragma unroll
    for (int j = 0; j < 8; ++j) { const float keep = b0 ? d[2 * j + 1] : d[2 * j], send = b0 ? d[2 * j] : d[2 * j + 1]; a[j] = keep + __shfl_xor(send, 1); }
#pragma unroll
    for (int j = 0; j < 4; ++j) { const float keep = b1 ? a[2 * j + 1] : a[2 * j], send = b1 ? a[2 * j] : a[2 * j + 1]; b[j] = keep + __shfl_xor(send, 2); }
#pragma unroll
    for (int j = 0; j < 2; ++j) { const float keep = b2 ? b[2 * j + 1] : b[2 * j], send = b2 ? b[2 * j] : b[2 * j + 1]; c[j] = keep + __shfl_xor(send, 4); }
    const float keep = b3 ? c[1] : c[0], send = b3 ? c[0] : c[1];
    float v = keep + __shfl_xor(send, 8);
    v += __shfl_xor(v, 16); v += __shfl_xor(v, 32);
    return v;
}
__device__ __forceinline__ float reduce8(float (&d)[8], int lane) {
    float a[4], b[2];
    const bool b0 = lane & 1, b1 = lane & 2, b2 = lane & 4;
#pragma unroll
    for (int j = 0; j < 4; ++j) { const float keep = b0 ? d[2 * j + 1] : d[2 * j], send = b0 ? d[2 * j] : d[2 * j + 1]; a[j] = keep + __shfl_xor(send, 1); }
#pragma unroll
    for (int j = 0; j < 2; ++j) { const float keep = b1 ? a[2 * j + 1] : a[2 * j], send = b1 ? a[2 * j] : a[2 * j + 1]; b[j] = keep + __shfl_xor(send, 2); }
    const float keep = b2 ? b[1] : b[0], send = b2 ? b[0] : b[1];
    float v = keep + __shfl_xor(send, 4);
    v += __shfl_xor(v, 8); v += __shfl_xor(v, 16); v += __shfl_xor(v, 32);
    return v;
}
#ifndef VCH
#define VCH 8
#endif
#ifndef PEER_PF
#define PEER_PF 0
#endif
constexpr int P8_LDS_SE = 0;
constexpr int P8_LDS_SW = 64 * 128 * 4;
constexpr int P8_LDS_SG = 2 * 64 * 128 * 4;
constexpr int P8_LDS_SO = 3 * 64 * 128 * 4;
typedef _Float16 h16x2 __attribute__((ext_vector_type(2)));
template <bool HI> __device__ __forceinline__ h16x2 cvt_fp8x2_f16(int s) { return __builtin_bit_cast(h16x2, __builtin_amdgcn_cvt_scalef32_pk_f16_fp8(s, 1.0f, HI)); }
__device__ __forceinline__ void axpy16_fp8_h(const u32x4 r, const h16x2 ww, h16x2 (&acc)[8]) {
    acc[0] = __builtin_elementwise_fma(cvt_fp8x2_f16<false>((int)r.x), ww, acc[0]);
    acc[1] = __builtin_elementwise_fma(cvt_fp8x2_f16<true>((int)r.x), ww, acc[1]);
    acc[2] = __builtin_elementwise_fma(cvt_fp8x2_f16<false>((int)r.y), ww, acc[2]);
    acc[3] = __builtin_elementwise_fma(cvt_fp8x2_f16<true>((int)r.y), ww, acc[3]);
    acc[4] = __builtin_elementwise_fma(cvt_fp8x2_f16<false>((int)r.z), ww, acc[4]);
    acc[5] = __builtin_elementwise_fma(cvt_fp8x2_f16<true>((int)r.z), ww, acc[5]);
    acc[6] = __builtin_elementwise_fma(cvt_fp8x2_f16<false>((int)r.w), ww, acc[6]);
    acc[7] = __builtin_elementwise_fma(cvt_fp8x2_f16<true>((int)r.w), ww, acc[7]);
}
__device__ __forceinline__ void l2_prefetch_issue(const unsigned char* tab, int rho, u32x4 (&pf)[8]) {
    const unsigned char* base = tab + (size_t)rho * (2048 * 1024) + (size_t)(blockIdx.x >> 3) * 65536 + threadIdx.x * 16;
#pragma unroll
    for (int k = 0; k < 8; ++k) pf[k] = *(const u32x4*)(base + k * 8192);
}
__device__ __forceinline__ void l2_prefetch_sink(u32x4 (&pf)[8]) {
#pragma unroll
    for (int k = 0; k < 8; ++k) asm volatile("" :: "v"(pf[k]));
}
__device__ __forceinline__ float dot16_i8(const u32x4 r, const int (&h)[4]) {
    int a = __builtin_amdgcn_sdot4((int)r.x, h[0], 0, false);
    a = __builtin_amdgcn_sdot4((int)r.y, h[1], a, false);
    a = __builtin_amdgcn_sdot4((int)r.z, h[2], a, false);
    a = __builtin_amdgcn_sdot4((int)r.w, h[3], a, false);
    return (float)a;
}
__device__ __forceinline__ void phase8(const Params& P, LAS unsigned char* lds) {
    const int lane = threadIdx.x & 63, wave = threadIdx.x >> 6;
    const float* mod = (const float*)(P.ws + WS_MISC + MISC_MOD); const float* sspart = (const float*)(P.ws + WS_MISC + MISC_SS);
    const float* su = (const float*)(P.ws + WS_MISC + MISC_SU);
    const bf16_t* x1h = (const bf16_t*)(P.ws + WS_X1H);
    const int* pexp = (const int*)(P.ws + WS_PAIRS); const float* pw = (const float*)(P.ws + WS_PAIRS) + (size_t)NTOK * 128;
    const unsigned char* u8 = P.ws + WS_U8; const unsigned char* v8 = P.ws + WS_V8; const unsigned lane16 = 16u * (unsigned)lane, lane64 = 64u * (unsigned)lane;
    LAS unsigned* SE = (LAS unsigned*)(lds + P8_LDS_SE) + wave * 8 * 128;
    LAS float* SW = (LAS float*)(lds + P8_LDS_SW) + wave * 8 * 128;
    LAS float* SD = SW;
    LAS float* SG = (LAS float*)(lds + P8_LDS_SG) + wave * 8 * 128;
    LAS int* SO = (LAS int*)(lds + P8_LDS_SO) + wave * 8 * 16;
    const int tok0 = __builtin_amdgcn_readfirstlane(blockIdx.x * 64 + wave * 8);
    const int b = tok0 >> 11; const float* mrow = mod + (size_t)b * NMOD;
    const unsigned long long ltmask = (1ull << lane) - 1ull;
    int hq[8][4]; float hsc[8];
    unsigned long long tq0 = 0ull;
#define TQB(id) do { if (TPROBE == (id) && threadIdx.x == 0) tq0 = __builtin_amdgcn_s_memrealtime(); } while (0)
#define TQE(id) do { if (TPROBE == (id) && threadIdx.x == 0) ((LAS unsigned*)(lds + 147456 - 16))[2] += (unsigned)(__builtin_amdgcn_s_memrealtime() - tq0); } while (0)
    TQB(20);
#pragma unroll 1
    for (int t = 0; t < 8; ++t) {
        const int tok = tok0 + t;
        const unsigned lane4 = 4u * (unsigned)lane;
        const int e0 = *(const int*)((const char*)(pexp + (size_t)tok * 128) + lane4), e1 = *(const int*)((const char*)(pexp + (size_t)tok * 128 + 64) + lane4);
        const float g0 = *(const float*)((const char*)(pw + (size_t)tok * 128) + lane4), g1 = *(const float*)((const char*)(pw + (size_t)tok * 128 + 64) + lane4);
        const int r0 = e0 >> 11, r1 = e1 >> 11;
        int base = 0, pos0 = 0, pos1 = 0, ov = 0;
#pragma unroll
        for (int rho = 0; rho < 8; ++rho) {
            const unsigned long long m0 = __ballot(r0 == rho), m1 = __ballot(r1 == rho);
            const int c0 = __popcll(m0), c1 = __popcll(m1);
            if (r0 == rho) pos0 = base + __popcll(m0 & ltmask);
            if (r1 == rho) pos1 = base + c0 + __popcll(m1 & ltmask);
            if (lane == rho) ov = base;
            base += c0 + c1;
        }
        if (lane >= 8) ov = 128;
        if (lane < 16) SO[t * 16 + lane] = ov;
        SE[t * 128 + pos0] = (unsigned)e0; SE[t * 128 + pos1] = (unsigned)e1;
        SG[t * 128 + pos0] = g0; SG[t * 128 + pos1] = g1;
    }
#pragma unroll
    for (int t = 0; t < 8; ++t) {
        const int tok = tok0 + t;
        float tot = 0.f;
#pragma unroll
        for (int i = 0; i < 4; ++i) { const f32x4 sp = *(const f32x4*)(sspart + (size_t)tok * 16 + 4 * i); tot += (sp.x + sp.y) + (sp.z + sp.w); }
        const float inv = rsqrtf(tot * (1.0f / 1024.0f) + 1e-6f);
        f32x4 h[4]; float mx = 0.f;
        const u32x4 xh0 = *(const u32x4*)((const char*)(x1h + (size_t)tok * 1024) + 2u * lane16), xh1 = *(const u32x4*)((const char*)(x1h + (size_t)tok * 1024) + 2u * lane16 + 16u);
        const f32x4 x1v[4] = {(f32x4){bflo(xh0.x), bfhi(xh0.x), bflo(xh0.y), bfhi(xh0.y)}, (f32x4){bflo(xh0.z), bfhi(xh0.z), bflo(xh0.w), bfhi(xh0.w)},
                              (f32x4){bflo(xh1.x), bfhi(xh1.x), bflo(xh1.y), bfhi(xh1.y)}, (f32x4){bflo(xh1.z), bfhi(xh1.z), bflo(xh1.w), bfhi(xh1.w)}};
#pragma unroll
        for (int j = 0; j < 4; ++j) {
            const unsigned bo = lane64 + 16u * j;
            const f32x4 x1 = x1v[j];
            const f32x4 gn = *(const f32x4*)((const char*)P.norm2_g + bo), sc2 = *(const f32x4*)((const char*)(mrow + 4 * 1024) + bo), sh2 = *(const f32x4*)((const char*)(mrow + 3 * 1024) + bo);
            h[j] = x1 * inv * gn * (sc2 + 1.0f) + sh2;
            mx = fmaxf(fmaxf(fmaxf(fabsf(h[j].x), fabsf(h[j].y)), fmaxf(fabsf(h[j].z), fabsf(h[j].w))), mx);
        }
#pragma unroll
        for (int o = 32; o > 0; o >>= 1) mx = fmaxf(mx, __shfl_xor(mx, o));
        const float qs = mx > 0.f ? 127.0f / mx : 0.f;
#pragma unroll
        for (int j = 0; j < 4; ++j) hq[t][j] = (int)pack4_i8(h[j], qs);
        hsc[t] = mx * (1.0f / 127.0f);
        if (t & 1) asm volatile("" ::: "memory");
    }
    asm volatile("s_waitcnt lgkmcnt(0)" ::: "memory");
    TQE(20); TQB(21);
    for (int rho = 0; rho < 8; ++rho) {
        u32x4 pf[8]; if (PEER_PF) l2_prefetch_issue(rho < 7 ? u8 : v8, rho < 7 ? rho + 1 : 0, pf);
#pragma unroll
        for (int t = 0; t < 4; ++t) {
            const int tA = t, tB = t + 4;
            const int begA = __builtin_amdgcn_readfirstlane(SO[tA * 16 + rho]), endA = __builtin_amdgcn_readfirstlane(SO[tA * 16 + rho + 1]);
            const int begB = __builtin_amdgcn_readfirstlane(SO[tB * 16 + rho]), endB = __builtin_amdgcn_readfirstlane(SO[tB * 16 + rho + 1]);
            const int clA = endA > 0 ? endA - 1 : 0, clB = endB > 0 ? endB - 1 : 0;
            for (int cA = begA, cB = begB; cA < endA || cB < endB; cA += 8, cB += 8) {
                const int liA = cA + (lane & 7), liB = cB + (lane & 7);
                const int eA8 = (int)SE[tA * 128 + (liA < endA ? liA : clA)], eB8 = (int)SE[tB * 128 + (liB < endB ? liB : clB)];
                u32x4 rA[8], rB[8];
#pragma unroll
                for (int i = 0; i < 8; ++i) { const int e = __builtin_amdgcn_readlane(eA8, i); rA[i] = *(const u32x4*)(u8 + (size_t)e * 1024 + lane16); }
#pragma unroll
                for (int i = 0; i < 8; ++i) { const int e = __builtin_amdgcn_readlane(eB8, i); rB[i] = *(const u32x4*)(u8 + (size_t)e * 1024 + lane16); }
                float d[8];
#pragma unroll
                for (int i = 0; i < 8; ++i) d[i] = dot16_i8(rA[i], hq[tA]);
                const float vA = reduce8(d, lane);
                if (lane < 8 && liA < endA) SD[tA * 128 + liA] = vA * hsc[tA];
#pragma unroll
                for (int i = 0; i < 8; ++i) d[i] = dot16_i8(rB[i], hq[tB]);
                const float vB = reduce8(d, lane);
                if (lane < 8 && liB < endB) SD[tB * 128 + liB] = vB * hsc[tB];
            }
        }
        if (PEER_PF) l2_prefetch_sink(pf);
    }
    asm volatile("s_waitcnt lgkmcnt(0)" ::: "memory");
    TQE(21); TQB(22);
#pragma unroll
    for (int t = 0; t < 8; ++t) {
        const unsigned ea = SE[t * 128 + lane], eb = SE[t * 128 + 64 + lane];
        const float sua = su[ea], sub = su[eb];
        const float d0 = SD[t * 128 + lane] * sua, d1 = SD[t * 128 + 64 + lane] * sub;
        const float ga = SG[t * 128 + lane], gb = SG[t * 128 + 64 + lane];
        const float w0 = ga * gelu_tanh(d0), w1 = gb * gelu_tanh(d1);
        asm volatile("s_waitcnt lgkmcnt(0)" ::: "memory");
        SW[t * 128 + lane] = w0; SW[t * 128 + 64 + lane] = w1;
    }
    asm volatile("s_waitcnt lgkmcnt(0)" ::: "memory");
    TQE(22); TQB(23);
    h16x2 acc[8][8];
#pragma unroll
    for (int t = 0; t < 8; ++t)
#pragma unroll
        for (int j = 0; j < 8; ++j) acc[t][j] = (h16x2){(_Float16)0.f, (_Float16)0.f};
    for (int rho = 0; rho < 8; ++rho) {
        u32x4 pf[8]; if (PEER_PF && rho < 7) l2_prefetch_issue(v8, rho + 1, pf);
#pragma unroll
        for (int t = 0; t < 4; ++t) {
            const int tA = t, tB = t + 4;
            const int begA = __builtin_amdgcn_readfirstlane(SO[tA * 16 + rho]), endA = __builtin_amdgcn_readfirstlane(SO[tA * 16 + rho + 1]);
            const int begB = __builtin_amdgcn_readfirstlane(SO[tB * 16 + rho]), endB = __builtin_amdgcn_readfirstlane(SO[tB * 16 + rho + 1]);
            const int clA = endA > 0 ? endA - 1 : 0, clB = endB > 0 ? endB - 1 : 0;
            for (int cA = begA, cB = begB; cA < endA || cB < endB; cA += VCH, cB += VCH) {
                const int liA = cA + (lane & 7), liB = cB + (lane & 7);
                const int lcA = (liA < endA ? liA : clA), lcB = (liB < endB ? liB : clB);
                const int eA8 = (int)SE[tA * 128 + lcA], eB8 = (int)SE[tB * 128 + lcB];
                const float wA8 = (liA < endA) ? SW[tA * 128 + lcA] : 0.f, wB8 = (liB < endB) ? SW[tB * 128 + lcB] : 0.f;
                u32x4 rA[VCH], rB[VCH];
#pragma unroll
                for (int i = 0; i < VCH; ++i) { const int e = __builtin_amdgcn_readlane(eA8, i); rA[i] = *(const u32x4*)(v8 + (size_t)e * 1024 + lane16); }
#pragma unroll
                for (int i = 0; i < VCH; ++i) { const int e = __builtin_amdgcn_readlane(eB8, i); rB[i] = *(const u32x4*)(v8 + (size_t)e * 1024 + lane16); }
#pragma unroll
                for (int i = 0; i < VCH; ++i) { const float w = __int_as_float(__builtin_amdgcn_readlane(__float_as_int(wA8), i)); axpy16_fp8_h(rA[i], (h16x2){(_Float16)w, (_Float16)w}, acc[tA]); }
#pragma unroll
                for (int i = 0; i < VCH; ++i) { const float w = __int_as_float(__builtin_amdgcn_readlane(__float_as_int(wB8), i)); axpy16_fp8_h(rB[i], (h16x2){(_Float16)w, (_Float16)w}, acc[tB]); }
            }
        }
        if (PEER_PF && rho < 7) l2_prefetch_sink(pf);
    }
    TQE(23); tp_e(90, lds);
    float tp_scale = 1.0f;
#if defined(TPROBE)
    if (TPROBE >= 0) { __syncthreads(); const unsigned ticks = ((LAS unsigned*)(lds + 147456 - 16))[2]; tp_scale = 1.0f + sqrtf((float)ticks * TPSCALE); }
#endif
#pragma unroll
    for (int t = 0; t < 8; ++t) {
        const int tok = tok0 + t;
        float ss = 0.f; f32x4 xo[4];
        const u32x4 xh0 = *(const u32x4*)((const char*)(x1h + (size_t)tok * 1024) + 2u * lane16), xh1 = *(const u32x4*)((const char*)(x1h + (size_t)tok * 1024) + 2u * lane16 + 16u);
        const f32x4 x1v[4] = {(f32x4){bflo(xh0.x), bfhi(xh0.x), bflo(xh0.y), bfhi(xh0.y)}, (f32x4){bflo(xh0.z), bfhi(xh0.z), bflo(xh0.w), bfhi(xh0.w)},
                              (f32x4){bflo(xh1.x), bfhi(xh1.x), bflo(xh1.y), bfhi(xh1.y)}, (f32x4){bflo(xh1.z), bfhi(xh1.z), bflo(xh1.w), bfhi(xh1.w)}};
#pragma unroll
        for (int j = 0; j < 4; ++j) {
            const unsigned bo = lane64 + 16u * j;
            const f32x4 x1 = x1v[j];
            const f32x4 g2 = *(const f32x4*)((const char*)(mrow + 5 * 1024) + bo) * (1.0f / V8_SCALE);
            const f32x4 pa = (f32x4){(float)acc[t][2 * j].x, (float)acc[t][2 * j].y, (float)acc[t][2 * j + 1].x, (float)acc[t][2 * j + 1].y};
            xo[j] = x1 + g2 * pa;
            ss += (xo[j].x * xo[j].x + xo[j].y * xo[j].y) + (xo[j].z * xo[j].z + xo[j].w * xo[j].w);
        }
        ss = wave_sum(ss);
        const float inv2 = rsqrtf(ss * (1.0f / 1024.0f) + 1e-6f);
#pragma unroll
        for (int j = 0; j < 4; ++j) {
            const unsigned bo = lane64 + 16u * j;
            const f32x4 fg = *(const f32x4*)((const char*)P.final_g + bo);
            *(f32x4*)((char*)(P.out + (size_t)tok * 1024) + bo) = xo[j] * (inv2 * tp_scale) * fg;
        }
        if ((t & 3) == 3) asm volatile("" ::: "memory");
    }
}
constexpr int LDS_BARST = 147456 - 16;
typedef __attribute__((address_space(4))) const Params* KParamsPtr;
#if defined(__HIP_DEVICE_COMPILE__)
#define LOADP(name) Params name; { KParamsPtr q_ = (KParamsPtr)__builtin_amdgcn_kernarg_segment_ptr(); asm volatile("" : "+s"(q_)); name = *q_; }
#else
#define LOADP(name) Params name = P;
#endif
__global__ void __launch_bounds__(512, 2) k_mega(Params P) {
    extern __shared__ __attribute__((aligned(16))) unsigned char lds_raw[];
    LAS unsigned char* lds = (LAS unsigned char*)lds_raw;
    const int lo = P.ph_lo, hi = P.ph_hi;
    const bool fused = (hi - lo) > 1;
    XcdBarrier bar; bar.bar = (unsigned*)(P.ws + WS_MISC + MISC_BAR); bar.x = 0; bar.st = (volatile LAS unsigned*)(lds + LDS_BARST);
    if (fused) {
        if (threadIdx.x < 4) ((LAS unsigned*)(lds + LDS_BARST))[threadIdx.x] = 0u;
        if (blockIdx.x == 0) { unsigned* bw = (unsigned*)(P.ws + WS_MISC + MISC_BAR); for (int i = threadIdx.x; i < XCD_BAR_WORDS; i += 512) bw[i] = 0u; }
        __syncthreads();
    }
#ifndef REPMASK
#define REPMASK 0
#endif
#ifndef TPROBE
#define TPROBE (-1)
#endif
#define TPB(id) do { if (TPROBE == (id) && threadIdx.x == 0) tp_t0 = __builtin_amdgcn_s_memrealtime(); } while (0)
#define TPE(id) do { if (TPROBE == (id) && threadIdx.x == 0) ((LAS unsigned*)(lds + LDS_BARST))[2] += (unsigned)(__builtin_amdgcn_s_memrealtime() - tp_t0); } while (0)
    unsigned long long tp_t0 = 0ull;
    if (TPROBE >= 0) { if (threadIdx.x == 0) ((LAS unsigned*)(lds + LDS_BARST))[2] = 0u; }
    tp_b(90, lds);
#define IN(k) (lo <= (k) && (k) < hi)
#define REP(k, call) do { if (fused && ((REPMASK >> (k)) & 1)) { xcd_barrier(bar); call; } } while (0)
#define SEAM(k) do { if (fused && IN(k) && IN((k) + 1)) { TPB(10 + (k)); xcd_barrier(bar); TPE(10 + (k)); } } while (0)
    if (IN(0)) { LOADP(Pk); TPB(0); phase0(Pk, lds); TPE(0); REP(0, phase0(Pk, lds)); }
    if (fused && IN(0) && IN(1)) { TPB(10); cg::this_grid().sync(); bar = xcd_barrier_post((unsigned*)(P.ws + WS_MISC + MISC_BAR), (volatile LAS unsigned*)(lds + LDS_BARST)); TPE(10); }
    if (IN(1)) { LOADP(Pk); TPB(1); phase1(Pk, lds); TPE(1); REP(1, phase1(Pk, lds)); }
    if (IN(1) && blockIdx.x >= 32) { LOADP(Pk); __syncthreads(); p0_late_items(Pk, lds, blockIdx.x - 32, gridDim.x - 32); }
    SEAM(1);
    if (IN(2)) { LOADP(Pk); TPB(2); phase2(Pk, lds); TPE(2); REP(2, phase2(Pk, lds)); }
    SEAM(2);
    if (IN(3)) { LOADP(Pk); TPB(3); phase3(Pk, lds); TPE(3); REP(3, phase3(Pk, lds)); }
    SEAM(3);
    if (IN(4)) { LOADP(Pk); TPB(4); phase4(Pk, lds); TPE(4); REP(4, phase4(Pk, lds)); }
    SEAM(4);
    if (IN(5)) { LOADP(Pk); TPB(5); phase5(Pk, lds); TPE(5); REP(5, phase5(Pk, lds)); }
    SEAM(5);
    if (IN(6)) { LOADP(Pk); TPB(6); phase6(Pk, lds); TPE(6); REP(6, phase6(Pk, lds)); }
    SEAM(6);
    if (IN(7)) { LOADP(Pk); TPB(7); phase7(Pk, lds); TPE(7); REP(7, phase7(Pk, lds)); }
    SEAM(7);
    if (IN(8)) { LOADP(Pk); TPB(8); phase8(Pk, lds); TPE(8); REP(8, phase8(Pk, lds)); }
#undef IN
#undef SEAM
}
extern "C" void kernel_launch(void* const* d_in, const int* in_sizes, int n_in, void* d_out, int out_size, void* d_ws, size_t ws_size, hipStream_t stream) {
    static int grid = 0;
    if (!grid) {
        (void)hipFuncSetAttribute((const void*)k_mega, hipFuncAttributeMaxDynamicSharedMemorySize, LDS_BYTES);
        int dev = 0, cus = 0, per_cu = 0;
        (void)hipGetDevice(&dev);
        (void)hipDeviceGetAttribute(&cus, hipDeviceAttributeMultiprocessorCount, dev);
        (void)hipOccupancyMaxActiveBlocksPerMultiprocessor(&per_cu, (const void*)k_mega, 512, LDS_BYTES);
        grid = (per_cu >= 1 && cus >= 256) ? 256 : -1;
    }
    if (grid < 0) return;
    Params P{};
    const float** pp = (const float**)&P;
    for (int i = 0; i < 26; ++i) pp[i] = (const float*)d_in[i];
    P.out = (float*)d_out; P.ws = (unsigned char*)d_ws; P.ph_lo = 0; P.ph_hi = 9;
    void* args[] = {&P};
    (void)hipLaunchCooperativeKernel((const void*)k_mega, dim3(grid), dim3(512), args, LDS_BYTES, stream);
}
```
